# Optimizing an MI355X kernel written in HIP

```python
import jax, jax.numpy as jnp
from jax import lax
import numpy as np

D_MODEL = 1024
BATCH = 4
SEQ = 4096
DEPTH = 2
DEC_BATCH = 2
DEC_SEQ = 8192
PAST_LEN = 128

GRID_W = 64
A_HEADS = 4
A_DK = 32
A_DV = 64
A_W = A_HEADS * A_DV
A_KW = A_HEADS * A_DK
GLA_RANK = 16
GLA_GATE_NORM = 16.0
GLA_CHUNK = 64
B_GROUPS = 4
B_GC = 64
B_W = B_GROUPS * B_GC
C_HEADS = 8
C_KV = 2
C_HD = 64
C_W = C_HEADS * C_HD
C_KVW = C_KV * C_HD
Q_BLOCK = 128
ROPE_AXIS_DIM = C_HD // 2
ROPE_THETA = 10000.0
D_GROUPS = 4
D_GC = 64
D_W = D_GROUPS * D_GC
SGU_CHUNK = 128
D_MIX = A_W + B_W + C_W + D_W
IN_SPLITS = (A_KW, A_KW, A_W, 2 * GLA_RANK, B_W, C_W, C_KVW, C_KVW, D_W, D_W, D_MIX)
D_IN = 2 * A_KW + A_W + 2 * GLA_RANK + B_W + C_W + 2 * C_KVW + 2 * D_W + D_MIX
EPS = 1e-6

kernel_name = "hymba_style_bidir_hybrid_encoder"


def rms_norm(x, g):
    xf = x.astype(jnp.float32)
    y = xf * lax.rsqrt(jnp.mean(xf * xf, axis=-1, keepdims=True) + EPS)
    return (y * g.astype(jnp.float32)).astype(x.dtype)


def gla_chunked(q, k, v, g, strict):
    bsz, n, h, dk = q.shape
    dv = v.shape[-1]
    nc = n // GLA_CHUNK

    def chunks(t):
        return t.astype(jnp.float32).reshape(bsz, nc, GLA_CHUNK, h, t.shape[-1]).transpose(1, 0, 3, 2, 4)

    qc, kc, vc, gc = chunks(q), chunks(k), chunks(v), chunks(g)
    mask = jnp.tril(jnp.ones((GLA_CHUNK, GLA_CHUNK), dtype=bool), k=-1 if strict else 0)

    def step(state, inp):
        qi, ki, vi, gi = inp
        b = jnp.cumsum(gi, axis=-2)
        inter = jnp.einsum('bhtd,bhdv->bhtv', qi * jnp.exp(b), state)
        diff = b[:, :, :, None, :] - b[:, :, None, :, :]
        decay = jnp.exp(jnp.where(mask[:, :, None], diff, -jnp.inf))
        scores = jnp.einsum('bhtd,bhsd,bhtsd->bhts', qi, ki, decay)
        intra = jnp.einsum('bhts,bhsv->bhtv', scores, vi)
        b_last = b[:, :, -1:, :]
        state = jnp.exp(b_last[:, :, 0, :])[..., None] * state + jnp.einsum(
            'bhsd,bhsv->bhdv', ki * jnp.exp(b_last - b), vi)
        return state, inter + intra

    state0 = jnp.zeros((bsz, h, dk, dv), jnp.float32)
    _, out = lax.scan(step, state0, (qc, kc, vc, gc))
    return out.transpose(1, 0, 3, 2, 4).reshape(bsz, n, h, dv)


def gla_branch(q, k, v, lr, wg2_f, bg_f, wg2_b, bg_b, onorm_g):
    bsz, n, _ = q.shape
    q = q.reshape(bsz, n, A_HEADS, A_DK) * (A_DK ** -0.5)
    k = k.reshape(bsz, n, A_HEADS, A_DK)
    v = v.reshape(bsz, n, A_HEADS, A_DV)
    lr_f, lr_b = jnp.split(lr, 2, axis=-1)

    def log_gate(lr_d, w2, b2):
        logits = (lr_d @ w2 + b2).astype(jnp.float32)
        return (jax.nn.log_sigmoid(logits) / GLA_GATE_NORM).reshape(bsz, n, A_HEADS, A_DK)

    o_f = gla_chunked(q, k, v, log_gate(lr_f, wg2_f, bg_f), strict=False)
    flip = lambda t: jnp.flip(t, axis=1)
    o_b = flip(gla_chunked(flip(q), flip(k), flip(v), flip(log_gate(lr_b, wg2_b, bg_b)), strict=True))
    o = rms_norm(o_f + o_b, onorm_g)
    return o.reshape(bsz, n, A_W).astype(v.dtype)


def fnet_branch(u, fnet_w):
    bsz, n, _ = u.shape
    uf = u.astype(jnp.float32).reshape(bsz, n, B_GROUPS, B_GC)
    mixed = jnp.real(jnp.fft.fft2(uf, axes=(1, 3), norm="ortho"))
    return mixed.reshape(bsz, n, B_W).astype(u.dtype) @ fnet_w


def axial_rope_angles(n_tokens):
    rows = n_tokens // GRID_W
    row = jnp.repeat(jnp.arange(rows, dtype=jnp.float32), GRID_W)
    col = jnp.tile(jnp.arange(GRID_W, dtype=jnp.float32), rows)
    freqs = ROPE_THETA ** (-jnp.arange(0, ROPE_AXIS_DIM, 2, dtype=jnp.float32) / ROPE_AXIS_DIM)
    ang = jnp.concatenate([row[:, None] * freqs, col[:, None] * freqs], axis=-1)
    return jnp.cos(ang), jnp.sin(ang)


def apply_rope(x, cos, sin):
    xf = x.astype(jnp.float32).reshape(*x.shape[:-1], C_HD // 2, 2)
    x0, x1 = xf[..., 0], xf[..., 1]
    c = cos[None, :, None, :]
    s = sin[None, :, None, :]
    out = jnp.stack([x0 * c - x1 * s, x0 * s + x1 * c], axis=-1).reshape(x.shape)
    return out.astype(x.dtype)


def attention_branch(q, k, v, qn_g, kn_g):
    bsz, n, _ = q.shape
    nb = n // Q_BLOCK
    grp = C_HEADS // C_KV
    q = rms_norm(q.reshape(bsz, n, C_HEADS, C_HD), qn_g)
    k = rms_norm(k.reshape(bsz, n, C_KV, C_HD), kn_g)
    v = v.reshape(bsz, n, C_KV, C_HD)
    cos, sin = axial_rope_angles(n)
    q = apply_rope(q, cos, sin)
    k = apply_rope(k, cos, sin)
    qb = q.reshape(bsz, nb, Q_BLOCK, C_KV, grp, C_HD).transpose(1, 0, 3, 4, 2, 5)
    kt = k.transpose(0, 2, 1, 3)
    vt = v.transpose(0, 2, 1, 3)
    scale = C_HD ** -0.5

    def attend_block(qblk):
        s = jnp.einsum('bkgqd,bksd->bkgqs', qblk, kt).astype(jnp.float32) * scale
        p = jax.nn.softmax(s, axis=-1)
        return jnp.einsum('bkgqs,bksd->bkgqd', p.astype(vt.dtype), vt)

    o = lax.map(attend_block, qb)
    return o.transpose(1, 0, 4, 2, 3, 5).reshape(bsz, n, C_W)


def sgu_branch(u, v, norm_g, w_s, b_s):
    bsz, n, _ = u.shape
    nch = n // SGU_CHUNK
    vn = rms_norm(v, norm_g).reshape(bsz, nch, SGU_CHUNK, D_GROUPS, D_GC)
    mixed = jnp.einsum('gts,bnsgc->bntgc', w_s, vn) + b_s.T[None, None, :, :, None]
    return u * mixed.reshape(bsz, n, D_W)


def hybrid_layer(x, c, ada_w, ada_b, pre_g, post_g, w_in, gla_wg2_f, gla_bg_f, gla_wg2_b, gla_bg_b,
                 gla_onorm_g, fnet_w, q_norm_g, k_norm_g, sgu_norm_g, sgu_w, sgu_b, w_out):
    shift, scale, gate = jnp.split(jax.nn.silu(c) @ ada_w + ada_b, 3, axis=-1)
    h = rms_norm(x, pre_g) * (1 + scale[:, None, :]) + shift[:, None, :]
    proj = h @ w_in
    splits = [int(i) for i in np.cumsum(IN_SPLITS)[:-1]]
    a_q, a_k, a_v, a_lr, b_u, c_q, c_k, c_v, d_u, d_v, z = jnp.split(proj, splits, axis=-1)
    out_a = gla_branch(a_q, a_k, a_v, a_lr, gla_wg2_f, gla_bg_f, gla_wg2_b, gla_bg_b, gla_onorm_g)
    out_b = fnet_branch(b_u, fnet_w)
    out_c = attention_branch(c_q, c_k, c_v, q_norm_g, k_norm_g)
    out_d = sgu_branch(d_u, d_v, sgu_norm_g, sgu_w, sgu_b)
    mixed = jnp.concatenate([out_a, out_b, out_c, out_d], axis=-1) * jax.nn.silu(z)
    y = rms_norm(mixed @ w_out, post_g)
    return x + gate[:, None, :] * y


def setup_inputs(seed: int = 0) -> dict:
    key = jax.random.key(seed)
    ks = jax.random.split(key, 21)
    f32 = jnp.float32
    nrm = lambda k, shape, s: jax.random.normal(k, shape, f32) * s
    return {
        "x_prompt": nrm(ks[0], (BATCH, SEQ, D_MODEL), 1.0),
        "x_sample": nrm(ks[1], (DEC_BATCH, DEC_SEQ, D_MODEL), 1.0),
        "c_prompt": nrm(ks[2], (BATCH, D_MODEL), 1.0),
        "c_sample": nrm(ks[3], (DEC_BATCH, D_MODEL), 1.0),
        "ada_w": nrm(ks[4], (DEPTH, D_MODEL, 3 * D_MODEL), 0.5 * D_MODEL ** -0.5),
        "ada_b": nrm(ks[5], (DEPTH, 3 * D_MODEL), 0.02),
        "norm_pre_g": 1.0 + nrm(ks[6], (DEPTH, D_MODEL), 0.02),
        "norm_post_g": 1.0 + nrm(ks[7], (DEPTH, D_MODEL), 0.02),
        "w_in": nrm(ks[8], (DEPTH, D_MODEL, D_IN), D_MODEL ** -0.5),
        "gla_wg2_f": nrm(ks[9], (DEPTH, GLA_RANK, A_KW), GLA_RANK ** -0.5),
        "gla_bg_f": nrm(ks[10], (DEPTH, A_KW), 0.1),
        "gla_wg2_b": nrm(ks[11], (DEPTH, GLA_RANK, A_KW), GLA_RANK ** -0.5),
        "gla_bg_b": nrm(ks[12], (DEPTH, A_KW), 0.1),
        "gla_onorm_g": 1.0 + nrm(ks[13], (DEPTH, A_DV), 0.02),
        "fnet_w": nrm(ks[14], (DEPTH, B_W, B_W), B_W ** -0.5),
        "q_norm_g": 1.0 + nrm(ks[15], (DEPTH, C_HD), 0.02),
        "k_norm_g": 1.0 + nrm(ks[16], (DEPTH, C_HD), 0.02),
        "sgu_norm_g": 1.0 + nrm(ks[17], (DEPTH, D_W), 0.02),
        "sgu_w": nrm(ks[18], (DEPTH, D_GROUPS, SGU_CHUNK, SGU_CHUNK), SGU_CHUNK ** -0.5),
        "sgu_b": 1.0 + nrm(ks[19], (DEPTH, D_GROUPS, SGU_CHUNK), 0.02),
        "w_out": nrm(ks[20], (DEPTH, D_MIX, D_MODEL), D_MIX ** -0.5),
    }


def reference(x_prompt, x_sample, c_prompt, c_sample, ada_w, ada_b, norm_pre_g, norm_post_g, w_in,
              gla_wg2_f, gla_bg_f, gla_wg2_b, gla_bg_b, gla_onorm_g, fnet_w, q_norm_g, k_norm_g,
              sgu_norm_g, sgu_w, sgu_b, w_out):
    y_prompt = x_prompt
    y_sample = x_sample
    for l in range(DEPTH):
        layer_params = (ada_w[l], ada_b[l], norm_pre_g[l], norm_post_g[l], w_in[l],
                        gla_wg2_f[l], gla_bg_f[l], gla_wg2_b[l], gla_bg_b[l], gla_onorm_g[l],
                        fnet_w[l], q_norm_g[l], k_norm_g[l], sgu_norm_g[l], sgu_w[l], sgu_b[l], w_out[l])
        y_prompt = hybrid_layer(y_prompt, c_prompt, *layer_params)
        y_sample = hybrid_layer(y_sample, c_sample, *layer_params)
    return (y_prompt, y_sample)
```

```cpp
#include <hip/hip_runtime.h>
#include <hip/hip_cooperative_groups.h>
#include <cstdio>
#include <cstdint>
namespace cg = cooperative_groups;
__device__ __forceinline__ int otid() { int t = threadIdx.x; asm volatile("" : "+v"(t)); return t; }
namespace pg8 {
#define PG8_LAS __attribute__((address_space(3)))
typedef unsigned short bf16_t;
typedef short bf16x8 __attribute__((ext_vector_type(8)));
typedef float f32x4 __attribute__((ext_vector_type(4)));
typedef unsigned u32x4 __attribute__((ext_vector_type(4)));
constexpr int BM = 256, BK = 64, HALF = 128, HTB = HALF * BK * 2  , STAGE_BYTES = 8 * HTB, NXCD = 8, WGM = 8;

__host__ __device__ __forceinline__ int lds_byte(int r, int c) { const int st = (r >> 4) * 2 + (c >> 5), rr = r & 15, cc = c & 31, ob = rr * 64 + cc * 2; return st * 1024 + (ob ^ (((ob >> 9) & 1) << 5)); }
__host__ __device__ __forceinline__ void stage_rc(int b, int& R, int& C) { const int st = b / 1024, sb = b % 1024, swz = sb ^ (((sb >> 9) & 1) << 5); R = (st >> 1) * 16 + swz / 64; C = (st & 1) * 32 + (swz % 64) / 2; }
__host__ __device__ __forceinline__ int perm32(int rho) { const int n = rho >> 4, i = rho & 15; return 8 * (i >> 2) + 4 * n + (i & 3); }

struct Unit { int pm, pn; };
struct Gemm { const bf16_t* A; const bf16_t* Bt; int M, N, K, lda, ldb; };

struct StaticOrder {
    int nM, nN, nwg, G, c;
    __host__ __device__ void init(int M, int N, int G_, int c_) { nM = M / BM; nN = N / BM; nwg = nM * nN; G = G_; c = c_; }
    __host__ __device__ bool next(int i, Unit& u) const {
        const long L = (long)i * G + c; if (L >= nwg) return false;
        int wgid = (int)L; { const int q = nwg / NXCD, r = nwg % NXCD, xcd = wgid % NXCD, off = wgid / NXCD; wgid = (xcd < r ? xcd * (q + 1) : r * (q + 1) + (xcd - r) * q) + off; }
        const int nig = WGM * nN, gid = wgid / nig, fm = gid * WGM, gsz = (nM - fm) < WGM ? (nM - fm) : WGM;
        u.pm = fm + ((wgid % nig) % gsz); u.pn = (wgid % nig) / gsz; return true;
    }
    __device__ __forceinline__ void a_ready(const Unit&) const {}
    __device__ __forceinline__ void done(const Unit&) const {}
};

__device__ __forceinline__ unsigned cvt_pk_bf16(float lo, float hi) { unsigned r; asm volatile("v_cvt_pk_bf16_f32 %0, %1, %2" : "=v"(r) : "v"(lo), "v"(hi)); return r; }
__device__ __forceinline__ float silu_f(float z) { return z / (1.f + __expf(-z)); }
struct EpiX {
    static constexpr bool PERM = true, AFTER_DRAIN = false;
    int mode; bf16_t* O1; int ld1; bf16_t* O2; int ld2; int col_off;
    __device__ __forceinline__ void operator()(const f32x4 (&acc)[2][2][4][2], const Unit& u, int wr, int wc, int fr, int fq) const {
        const int row0 = u.pm * BM + wr * 64 + fr;
        bf16_t* base; int ld, colt;
        if (mode == 0) { if (u.pn < 8) { base = O1; ld = ld1; colt = u.pn * BM; } else { base = O2; ld = ld2; colt = (u.pn - 8) * BM; } }
        else { base = O1; ld = ld1; colt = col_off + u.pn * BM; }
        const int col0 = colt + wc * 32 + 8 * fq;
#pragma unroll
        for (int ai = 0; ai < 2; ++ai)
#pragma unroll
            for (int m = 0; m < 4; ++m) { bf16_t* rowp = base + (size_t)(row0 + ai * HALF + m * 16) * ld + col0;
#pragma unroll
                for (int bj = 0; bj < 2; ++bj) { f32x4 v0 = acc[ai][bj][m][0], v1 = acc[ai][bj][m][1];
                    if (mode == 2) { const u32x4 z = *(const u32x4*)(rowp + bj * HALF);
                        v0[0] *= silu_f(__uint_as_float(z.x << 16)); v0[1] *= silu_f(__uint_as_float(z.x & 0xffff0000u));
                        v0[2] *= silu_f(__uint_as_float(z.y << 16)); v0[3] *= silu_f(__uint_as_float(z.y & 0xffff0000u));
                        v1[0] *= silu_f(__uint_as_float(z.z << 16)); v1[1] *= silu_f(__uint_as_float(z.z & 0xffff0000u));
                        v1[2] *= silu_f(__uint_as_float(z.w << 16)); v1[3] *= silu_f(__uint_as_float(z.w & 0xffff0000u)); }
                    u32x4 w; w.x = cvt_pk_bf16(v0[0], v0[1]); w.y = cvt_pk_bf16(v0[2], v0[3]); w.z = cvt_pk_bf16(v1[0], v1[1]); w.w = cvt_pk_bf16(v1[2], v1[3]);
                    *(u32x4*)(rowp + bj * HALF) = w; } }
    }
};
#ifndef PG8_SP2
#define PG8_SP2 true
#endif
#ifndef PG8_ALIGN
#define PG8_ALIGN true
#endif
template <class Epi, class Sched, bool ALIGN_EPI = false, bool SP2 = false>
__device__ __forceinline__ void gemm_phase(PG8_LAS unsigned char* lds, const Gemm g, const Sched& S, const Epi& E) {
    const int tid = otid(), wid = __builtin_amdgcn_readfirstlane(tid >> 6), lane = tid & 63, wr = wid >> 2, wc = wid & 3, fr = lane & 15, fq = lane >> 4;
    const int K = g.K, nt = K / BK;
    unsigned voffA[2], voffB[2];
#pragma unroll
    for (int i = 0; i < 2; ++i) { int R, C; stage_rc(tid * 16 + i * 8192, R, C); const int Rb = Epi::PERM ? ((R & ~31) + perm32(R & 31)) : R;
        voffA[i] = (unsigned)(R * g.lda + C) * 2u; voffB[i] = (unsigned)(Rb * g.ldb + C) * 2u; }
    const size_t kstep = (size_t)(BK * 2);
    const size_t hstepA = (size_t)HALF * g.lda * 2, hstepB = (size_t)HALF * g.ldb * 2;
    const size_t tstepA = 2 * hstepA, tstepB = 2 * hstepB;
    const unsigned ldsw = (unsigned)wid * 1024u;
    const int aoff = lds_byte(wr * 64 + fr, fq * 8), boff = lds_byte(wc * 32 + fr, fq * 8);
#define PG8_SA(b, h) (((b) * 2 + (h)) * HTB)
#define PG8_SB(b, h) ((4 + (b) * 2 + (h)) * HTB)
#define PG8_STAGE(bufoff, gbase, voff) do { _Pragma("unroll") for (int _i = 0; _i < 2; ++_i) \
        __builtin_amdgcn_global_load_lds((const unsigned*)((const char*)(gbase) + (voff)[_i]), (PG8_LAS unsigned*)(lds + (bufoff) + ldsw + _i * 8192), 16, 0, 0); } while (0)
#define PG8_LDA(dst, b, h) do { _Pragma("unroll") for (int m = 0; m < 4; ++m) _Pragma("unroll") for (int k = 0; k < 2; ++k) dst[m][k] = *(const PG8_LAS bf16x8*)(lds + PG8_SA(b, h) + aoff + m * 2048 + k * 1024); } while (0)
#define PG8_LDB(dst, b, h) do { _Pragma("unroll") for (int n = 0; n < 2; ++n) _Pragma("unroll") for (int k = 0; k < 2; ++k) dst[n][k] = *(const PG8_LAS bf16x8*)(lds + PG8_SB(b, h) + boff + n * 2048 + k * 1024); } while (0)
#define PG8_MMA(ai, bj, At, Bt) do { __builtin_amdgcn_s_setprio(1); _Pragma("unroll") for (int m = 0; m < 4; ++m) _Pragma("unroll") for (int n = 0; n < 2; ++n) _Pragma("unroll") for (int k = 0; k < 2; ++k) \
        acc[ai][bj][m][n] = __builtin_amdgcn_mfma_f32_16x16x32_bf16(Bt[n][k], At[m][k], acc[ai][bj][m][n], 0, 0, 0); __builtin_amdgcn_s_setprio(0); } while (0)
#define PG8_WAIT_V(n) asm volatile("s_waitcnt vmcnt(" #n ")" ::: "memory")
#define PG8_WAIT_L(n) asm volatile("s_waitcnt lgkmcnt(" #n ")" ::: "memory")
#define PG8_BAR __builtin_amdgcn_s_barrier()
#define PG8_SCHED __builtin_amdgcn_sched_barrier(0)
    Unit cur, nxt; int ui = 0;
    if (!S.next(0, cur)) return;
    f32x4 acc[2][2][4][2];
#pragma unroll
    for (int a = 0; a < 2; ++a)
#pragma unroll
        for (int b = 0; b < 2; ++b)
#pragma unroll
            for (int m = 0; m < 4; ++m)
#pragma unroll
                for (int n = 0; n < 2; ++n) acc[a][b][m][n] = (f32x4){0.f, 0.f, 0.f, 0.f};
    bf16x8 At[4][2], B0[2][2], B1[2][2];
    const char* cA = (const char*)g.A + (size_t)cur.pm * tstepA; const char* cB = (const char*)g.Bt + (size_t)cur.pn * tstepB;
    S.a_ready(cur);
    if constexpr (SP2) {
        PG8_STAGE(PG8_SB(0, 0), cB, voffB); PG8_STAGE(PG8_SB(0, 1), cB + hstepB, voffB); PG8_STAGE(PG8_SA(0, 0), cA, voffA); PG8_STAGE(PG8_SA(0, 1), cA + hstepA, voffA);
        if (wr == 1) PG8_BAR;
        PG8_WAIT_V(2); PG8_BAR;
        PG8_STAGE(PG8_SB(1, 0), cB + kstep, voffB); PG8_STAGE(PG8_SA(1, 0), cA + kstep, voffA); PG8_STAGE(PG8_SB(1, 1), cB + hstepB + kstep, voffB);
        PG8_WAIT_V(6); PG8_BAR;
    } else {
        PG8_STAGE(PG8_SB(0, 0), cB, voffB); PG8_STAGE(PG8_SA(0, 0), cA, voffA); PG8_STAGE(PG8_SB(0, 1), cB + hstepB, voffB); PG8_STAGE(PG8_SA(0, 1), cA + hstepA, voffA);
        if (wr == 1) PG8_BAR;
        PG8_WAIT_V(4); PG8_BAR;
        PG8_STAGE(PG8_SB(1, 0), cB + kstep, voffB); PG8_STAGE(PG8_SA(1, 0), cA + kstep, voffA); PG8_STAGE(PG8_SB(1, 1), cB + hstepB + kstep, voffB);
        PG8_WAIT_V(6); PG8_BAR;
    }
    for (;;) {
        const bool has_next = S.next(ui + 1, nxt);
        const char* nA = has_next ? (const char*)g.A + (size_t)nxt.pm * tstepA : cA; const char* nB = has_next ? (const char*)g.Bt + (size_t)nxt.pn * tstepB : cB;
        for (int t = 0; t < nt; t += 2) {
            const bool last = (t == nt - 2);
            const char* a1 = cA + (size_t)(t + 1) * kstep;
            const char* a2 = last ? nA : cA + (size_t)(t + 2) * kstep; const char* b2 = last ? nB : cB + (size_t)(t + 2) * kstep;
            const char* a3 = a2 + kstep; const char* b3 = b2 + kstep;
            if (last && has_next) S.a_ready(nxt);
            if constexpr (SP2) {
            PG8_LDB(B0, 0, 0); PG8_LDB(B1, 0, 1); PG8_SCHED; PG8_LDA(At, 0, 0); PG8_STAGE(PG8_SA(1, 1), a1 + hstepA, voffA);
            PG8_WAIT_V(8); PG8_WAIT_L(0); PG8_BAR; PG8_MMA(0, 0, At, B0); PG8_MMA(0, 1, At, B1); PG8_BAR; PG8_SCHED;
            PG8_LDA(At, 0, 1); PG8_STAGE(PG8_SB(0, 0), b2, voffB); PG8_STAGE(PG8_SB(0, 1), b2 + hstepB, voffB); PG8_STAGE(PG8_SA(0, 0), a2, voffA);
            PG8_WAIT_V(8); PG8_WAIT_L(0); PG8_BAR; PG8_MMA(1, 0, At, B0); PG8_MMA(1, 1, At, B1); PG8_BAR; PG8_SCHED;
            PG8_LDB(B0, 1, 0); PG8_LDB(B1, 1, 1); PG8_SCHED; PG8_LDA(At, 1, 0); PG8_STAGE(PG8_SA(0, 1), a2 + hstepA, voffA);
            PG8_WAIT_V(8); PG8_WAIT_L(0); PG8_BAR; PG8_MMA(0, 0, At, B0); PG8_MMA(0, 1, At, B1); PG8_BAR; PG8_SCHED;
            PG8_LDA(At, 1, 1); PG8_STAGE(PG8_SB(1, 0), b3, voffB); PG8_STAGE(PG8_SB(1, 1), b3 + hstepB, voffB); PG8_STAGE(PG8_SA(1, 0), a3, voffA);
            PG8_WAIT_V(8); PG8_WAIT_L(0); PG8_BAR; PG8_MMA(1, 0, At, B0); PG8_MMA(1, 1, At, B1); PG8_BAR; PG8_SCHED;
            } else {
            PG8_LDB(B0, 0, 0); PG8_SCHED; PG8_LDA(At, 0, 0); PG8_STAGE(PG8_SA(1, 1), a1 + hstepA, voffA);
            PG8_WAIT_L(8); PG8_BAR; PG8_WAIT_L(0); PG8_MMA(0, 0, At, B0); PG8_BAR; PG8_SCHED;
            PG8_LDB(B1, 0, 1); PG8_STAGE(PG8_SB(0, 0), b2, voffB);
            PG8_BAR; PG8_WAIT_L(0); PG8_MMA(0, 1, At, B1); PG8_BAR;
            PG8_LDA(At, 0, 1); PG8_STAGE(PG8_SA(0, 0), a2, voffA);
            PG8_BAR; PG8_WAIT_L(0); PG8_MMA(1, 0, At, B0); PG8_BAR; PG8_SCHED;
            PG8_STAGE(PG8_SB(0, 1), b2 + hstepB, voffB);
            PG8_WAIT_V(6); PG8_BAR; PG8_MMA(1, 1, At, B1); PG8_BAR;
            PG8_LDB(B0, 1, 0); PG8_SCHED; PG8_LDA(At, 1, 0); PG8_STAGE(PG8_SA(0, 1), a2 + hstepA, voffA);
            PG8_WAIT_L(8); PG8_BAR; PG8_WAIT_L(0); PG8_MMA(0, 0, At, B0); PG8_BAR; PG8_SCHED;
            PG8_LDB(B1, 1, 1); PG8_STAGE(PG8_SB(1, 0), b3, voffB);
            PG8_BAR; PG8_WAIT_L(0); PG8_MMA(0, 1, At, B1); PG8_BAR;
            PG8_LDA(At, 1, 1); PG8_STAGE(PG8_SA(1, 0), a3, voffA);
            PG8_BAR; PG8_WAIT_L(0); PG8_MMA(1, 0, At, B0); PG8_BAR; PG8_SCHED;
            PG8_STAGE(PG8_SB(1, 1), b3 + hstepB, voffB);
            PG8_WAIT_V(6); PG8_BAR; PG8_MMA(1, 1, At, B1); PG8_BAR;
            }
        }
        if constexpr (ALIGN_EPI) { if (wr == 0) PG8_BAR; }
        if constexpr (!Epi::AFTER_DRAIN) { E(acc, cur, wr, wc, fr, fq); S.done(cur); }
        if (!has_next) break;
#pragma unroll
        for (int a = 0; a < 2; ++a)
#pragma unroll
            for (int b = 0; b < 2; ++b)
#pragma unroll
                for (int m = 0; m < 4; ++m)
#pragma unroll
                    for (int n = 0; n < 2; ++n) acc[a][b][m][n] = (f32x4){0.f, 0.f, 0.f, 0.f};
        cur = nxt; cA = nA; cB = nB; ++ui;
        if constexpr (ALIGN_EPI) { if (wr == 1) PG8_BAR; }
    }
    PG8_WAIT_V(0);
    if constexpr (!ALIGN_EPI) { if (wr == 0) PG8_BAR; }
    PG8_BAR;
    if constexpr (Epi::AFTER_DRAIN) { E.fused(acc, cur, wr, wc, fr, fq, lds, wid, lane); S.done(cur); }
#undef PG8_SA
#undef PG8_SB
#undef PG8_STAGE
#undef PG8_LDA
#undef PG8_LDB
#undef PG8_MMA
#undef PG8_WAIT_V
#undef PG8_WAIT_L
#undef PG8_BAR
#undef PG8_SCHED
}
}
#include <hip/hip_bf16.h>
#include <cmath>
namespace attn_body {
using bf16=__hip_bfloat16;
using bf16x8=__attribute__((ext_vector_type(8)))short;
using s16x4=__attribute__((ext_vector_type(4)))short;
using f32x16=__attribute__((ext_vector_type(16)))float;
using u32x4=__attribute__((ext_vector_type(4)))unsigned;
constexpr int D=64,DM=2048,KDM=64;
constexpr int NW=8,QBLK=32,QB=QBLK*NW,KVBLK=64;
constexpr int ATTN_PITCH=DM, ATTN_UNIT_ROWS=QB;
__device__ __forceinline__ int crow(int r,int hi){return (r&3)+8*(r>>2)+4*hi;}
#define SBAR() __builtin_amdgcn_sched_barrier(0)
__device__ __forceinline__ void cmask(f32x16&p0,f32x16&p1,int jb,int qrel,int hi){
  const float NEG=-INFINITY; int kb=64*jb+4*hi;
  #pragma unroll
  for(int r=0;r<16;++r){int kv=kb+(r&3)+8*(r>>2); if(kv>qrel)p0[r]=NEG; if(kv+32>qrel)p1[r]=NEG;}
}

constexpr int NSLOT=3, SLOTB=8192;
constexpr int LDS_K=0, LDS_V=NSLOT*SLOTB, LDS_WS=2*NSLOT*SLOTB, LDS_OST=LDS_WS+NW*64*4, LDS_BYTES=LDS_OST+NW*4096;
constexpr float C2=0.125f*1.4426950408889634f;
__device__ __forceinline__ void glds16(const void*gsrc,unsigned lds_dst){unsigned keep;
  asm volatile("s_mov_b32 %0, m0\n\ts_mov_b32 m0, %2\n\ts_nop 0\n\tglobal_load_lds_dwordx4 %1, off\n\ts_mov_b32 m0, %0":"=&s"(keep):"v"(gsrc),"s"(lds_dst):"memory");}
__device__ __forceinline__ float max3f(float a,float b,float c){float r;asm("v_max3_f32 %0, %1, %2, %3":"=v"(r):"v"(a),"v"(b),"v"(c));return r;}
__device__ __forceinline__ float max2f(float a,float b){float r;asm("v_max_f32_e32 %0, %1, %2":"=v"(r):"v"(a),"v"(b));return r;}
__device__ __forceinline__ float fadd_s(float a,float b){float r;asm("v_add_f32_e32 %0, %1, %2":"=v"(r):"v"(a),"v"(b));return r;}
__device__ __forceinline__ float fsub_s(float a,float b){float r;asm("v_sub_f32_e32 %0, %1, %2":"=v"(r):"v"(a),"v"(b));return r;}
typedef float f32x2_t __attribute__((ext_vector_type(2))); typedef __bf16 bf16x2_t __attribute__((ext_vector_type(2)));
__device__ __forceinline__ unsigned cvtpk_s(float lo,float hi){f32x2_t v={lo,hi};bf16x2_t b=__builtin_convertvector(v,bf16x2_t);return __builtin_bit_cast(unsigned,b);}
#define WAIT_BAR(N) asm volatile("s_waitcnt vmcnt(" #N ") lgkmcnt(0)\n\ts_barrier":::"memory")

__device__ __forceinline__ void qkt(f32x16&p0,f32x16&p1,const char*Kslot,const bf16x8*qr,const f32x16&negm,int r32,int hi){
  const char*kb=Kslot+hi*1024+r32*16;
  #pragma unroll
  for(int d0=0;d0<4;++d0){
    const bf16x8 b0=*reinterpret_cast<const bf16x8*>(kb+d0*2048);
    const bf16x8 b1=*reinterpret_cast<const bf16x8*>(kb+d0*2048+512);
    if(d0==0){p0=__builtin_amdgcn_mfma_f32_32x32x16_bf16(b0,qr[0],negm,0,0,0);p1=__builtin_amdgcn_mfma_f32_32x32x16_bf16(b1,qr[0],negm,0,0,0);}
    else{p0=__builtin_amdgcn_mfma_f32_32x32x16_bf16(b0,qr[d0],p0,0,0,0);p1=__builtin_amdgcn_mfma_f32_32x32x16_bf16(b1,qr[d0],p1,0,0,0);}}
}
typedef __attribute__((address_space(3))) const char* lds_cptr;
typedef short v4i16_t __attribute__((ext_vector_type(4)));
__device__ __forceinline__ void kload8(bf16x8*kf,lds_cptr kp){
  kf[0]=*(const __attribute__((address_space(3))) bf16x8*)(kp);      kf[1]=*(const __attribute__((address_space(3))) bf16x8*)(kp+512);
  kf[2]=*(const __attribute__((address_space(3))) bf16x8*)(kp+2048); kf[3]=*(const __attribute__((address_space(3))) bf16x8*)(kp+2560);
  kf[4]=*(const __attribute__((address_space(3))) bf16x8*)(kp+4096); kf[5]=*(const __attribute__((address_space(3))) bf16x8*)(kp+4608);
  kf[6]=*(const __attribute__((address_space(3))) bf16x8*)(kp+6144); kf[7]=*(const __attribute__((address_space(3))) bf16x8*)(kp+6656);
}
__device__ __forceinline__ void kload2(bf16x8*kf,lds_cptr kp,int j){ kf[2*j]=*(const __attribute__((address_space(3))) bf16x8*)(kp+j*2048); kf[2*j+1]=*(const __attribute__((address_space(3))) bf16x8*)(kp+j*2048+512); }
__device__ __forceinline__ s16x4 vtr(lds_cptr p){ return __builtin_bit_cast(s16x4,__builtin_amdgcn_ds_read_tr16_b64_v4i16((__attribute__((address_space(3))) v4i16_t*)p)); }
__device__ __forceinline__ float rowmax(const f32x16&p0,const f32x16&p1){
  float a=max3f(p0[0],p0[1],p1[0]),b=max3f(p0[2],p0[3],p1[1]);a=max3f(a,p1[2],p1[3]);
  #pragma unroll
  for(int r=4;r<16;r+=4){a=max3f(a,p0[r],p0[r+1]);b=max3f(b,p0[r+2],p0[r+3]);a=max3f(a,p1[r],p1[r+1]);b=max3f(b,p1[r+2],p1[r+3]);}
  const float m=max2f(a,b);
  auto rr=__builtin_amdgcn_permlane32_swap(__float_as_uint(m),__float_as_uint(m),false,false);
  return max2f(__uint_as_float(rr[0]),__uint_as_float(rr[1]));
}
__device__ __forceinline__ void pv(f32x16*o,int vb,bf16x8 pa0,bf16x8 pa1,bf16x8 pa2,bf16x8 pa3){
  #pragma unroll
  for(int d0=0;d0<2;++d0){s16x4 lo[4],hi[4];
    #pragma unroll
    for(int ks=0;ks<4;++ks){
      asm volatile("ds_read_b64_tr_b16 %0,%1 offset:%c2":"=&v"(lo[ks]):"v"(vb),"i"(d0*4096+ks*1024):"memory");
      asm volatile("ds_read_b64_tr_b16 %0,%1 offset:%c2":"=&v"(hi[ks]):"v"(vb),"i"(d0*4096+ks*1024+512):"memory");}
    asm volatile("s_waitcnt lgkmcnt(0)":::"memory");SBAR();
    #define PK(k) (bf16x8){lo[k][0],lo[k][1],lo[k][2],lo[k][3],hi[k][0],hi[k][1],hi[k][2],hi[k][3]}
    o[d0]=__builtin_amdgcn_mfma_f32_32x32x16_bf16(pa0,PK(0),o[d0],0,0,0);
    o[d0]=__builtin_amdgcn_mfma_f32_32x32x16_bf16(pa1,PK(1),o[d0],0,0,0);
    o[d0]=__builtin_amdgcn_mfma_f32_32x32x16_bf16(pa2,PK(2),o[d0],0,0,0);
    o[d0]=__builtin_amdgcn_mfma_f32_32x32x16_bf16(pa3,PK(3),o[d0],0,0,0);
    #undef PK
  }
}

#ifndef ATTN_STORE16
#define ATTN_STORE16(p,v) (*(u32x4*)(p)=(v))
#endif
template<int THRL> __device__ __forceinline__ void attn_unit(const bf16*Qblk,const bf16*__restrict__ Kh,const bf16*__restrict__ Vh,bf16*Oblk,const int NT,char*shm){
  const int tid=otid(),lane=tid&63,r32=lane&31,hi=lane>>5; const int wid=__builtin_amdgcn_readfirstlane(tid>>6);
  const bf16*Qw=Qblk+(long)wid*QBLK*DM;
  const unsigned lds0=(unsigned)(uintptr_t)shm;
  float*wsf=(float*)(shm+LDS_WS)+wid*64;
  const bf16*ksrc=Kh+(long)lane*KDM+wid*8;
  const bf16*vsrc=Vh+(long)(16*(wid&3)+(lane>>2))*KDM+(wid>>2)*32+(lane&3)*8;
  const unsigned kdst=lds0+LDS_K+wid*1024, vdst=lds0+LDS_V+wid*1024;
  #define DMA_K(t,slot) glds16(ksrc+(long)(t)*KVBLK*KDM,(unsigned)__builtin_amdgcn_readfirstlane(kdst+(slot)))
  #define DMA_V(t,slot) glds16(vsrc+(long)(t)*KVBLK*KDM,(unsigned)__builtin_amdgcn_readfirstlane(vdst+(slot)))
  const int vb0=(int)(lds0+LDS_V)+((lane>>4)&1)*32+(lane&3)*8+(4*hi+((lane&15)>>2))*64;
  const char*Kbase=shm+LDS_K; bf16x8 kf[8];
  const lds_cptr shm3=(lds_cptr)shm; const lds_cptr kp0=shm3+LDS_K+hi*1024+r32*16; const lds_cptr vp0=shm3+LDS_V+((lane>>4)&1)*32+(lane&3)*8+(4*hi+((lane&15)>>2))*64;
  DMA_K(0,0);DMA_V(0,0);DMA_K(1,SLOTB);
  bf16x8 qr[4];
  #pragma unroll
  for(int d0=0;d0<4;++d0)qr[d0]=*reinterpret_cast<const bf16x8*>(&Qw[(long)r32*DM+d0*16+hi*8]);
  float mhat=0.f,l_reg=0.f;f32x16 o[2];o[0]=f32x16{};o[1]=f32x16{};f32x16 negm=f32x16{};asm volatile("":"+v"(negm));
  #define CMASK(P0,P1,t) do{}while(0)
  bool resc=false;
  #define START(P0,P1) do{ const float rm=rowmax(P0,P1); resc=false; \
    { const float dl=rm; mhat=fadd_s(mhat,dl); \
      _Pragma("unroll") for(int r=0;r<16;++r){P0[r]=fsub_s(P0[r],dl);P1[r]=fsub_s(P1[r],dl);} \
      _Pragma("unroll") for(int r=0;r<16;++r)negm[r]=-mhat; asm volatile("":"+v"(negm)); } \
    _Pragma("unroll") for(int r=0;r<16;++r)P0[r]=__builtin_amdgcn_exp2f(P0[r]); }while(0)
  #define RESC() do{ if(resc){ asm volatile("s_waitcnt lgkmcnt(0)":::"memory"); \
      _Pragma("unroll") for(int d_=0;d_<2;++d_) _Pragma("unroll") for(int r=0;r<16;++r)o[d_][r]*=wsf[crow(r,hi)]; } }while(0)
  f32x16 pA0,pA1,pB0,pB1;
  int sl_prev=0,sl_cur=0,sl_next=SLOTB;
  #define ROT() do{sl_prev=sl_cur;sl_cur=sl_next;sl_next=(sl_next==(NSLOT-1)*SLOTB)?0:sl_next+SLOTB;}while(0)
  DMA_K(2,2*SLOTB);
  WAIT_BAR(3);
  qkt(pA0,pA1,Kbase,qr,negm,r32,hi);asm volatile("s_nop 15\n\ts_nop 7":"+v"(pA0),"+v"(pA1));CMASK(pA0,pA1,0);
  START(pA0,pA1);
  _Pragma("unroll") for(int r=0;r<16;++r)pA1[r]=__builtin_amdgcn_exp2f(pA1[r]);
  WAIT_BAR(0);
  DMA_K(3,0);DMA_V(1,SLOTB);
  ROT();
  kload8(kf,kp0+sl_cur);
  WAIT_BAR(2);
  s16x4 vlo[8],vhi[8]; u32x4 pw0,pw1,pw2,pw3;
  #define PKW(P,B) cvtpk_s(P[B],P[B+1])
  #define PAF(k) __builtin_bit_cast(bf16x8,pw##k)
  #define VFR(i) (bf16x8){vlo[i][0],vlo[i][1],vlo[i][2],vlo[i][3],vhi[i][0],vhi[i][1],vhi[i][2],vhi[i][3]}
  #define PIN(x) asm volatile("":"+v"(x))
  #define MX3(a,b,c) __builtin_fmaxf(__builtin_fmaxf((a),(b)),(c))
  #define GAPA(MF,A0,A1,A2,A3,W0,W1,PW) do{ MF; sacc+=A0; sacc+=A1; sacc+=A2; sacc+=A3; PIN(sacc); W0; W1; PIN(PW); SBAR(); }while(0)
  #define EX(v) __builtin_amdgcn_exp2f(v)
  #define GAPB(MF,X,B) do{ MF; X[B]=EX(X[B]); X[B+1]=EX(X[B+1]); X[B+2]=EX(X[B+2]); X[B+3]=EX(X[B+3]); PIN(X); SBAR(); }while(0)
  #define VRD(i) do{ vlo[i]=vtr(vp_+(((i)>>2)*4096+((i)&3)*1024)); vhi[i]=vtr(vp_+(((i)>>2)*4096+((i)&3)*1024+512)); }while(0)
  #define KRD(G,j) do{ if(G){ kload2(kf,kp0+sl_next,j); SBAR(); } }while(0)
  #define STEP(C0,C1,P0,P1,t,GK,GV,GL) do{ SBAR(); \
    const lds_cptr vp_=vp0+sl_prev; \
    VRD(0); SBAR(); float sacc=(P0[0]+P0[1]); \
    GAPA(C0=__builtin_amdgcn_mfma_f32_32x32x16_bf16(kf[0],qr[0],negm,0,0,0), P0[2],P0[3],P0[4],P0[5],     pw0[0]=PKW(P0,0), pw0[1]=PKW(P0,2), pw0); \
    VRD(4); SBAR(); GAPA(C1=__builtin_amdgcn_mfma_f32_32x32x16_bf16(kf[1],qr[0],negm,0,0,0), P0[6],P0[7],P0[8],P0[9],     pw0[2]=PKW(P0,4), pw0[3]=PKW(P0,6), pw0); \
    VRD(1); SBAR(); GAPA(C0=__builtin_amdgcn_mfma_f32_32x32x16_bf16(kf[2],qr[1],C0,0,0,0),   P0[10],P0[11],P0[12],P0[13], pw1[0]=PKW(P0,8), pw1[1]=PKW(P0,10), pw1); \
    VRD(5); SBAR(); GAPA(C1=__builtin_amdgcn_mfma_f32_32x32x16_bf16(kf[3],qr[1],C1,0,0,0),   P0[14],P0[15],P1[0],P1[1],   pw1[2]=PKW(P0,12),pw1[3]=PKW(P0,14), pw1); \
    VRD(2); SBAR(); GAPA(C0=__builtin_amdgcn_mfma_f32_32x32x16_bf16(kf[4],qr[2],C0,0,0,0),   P1[2],P1[3],P1[4],P1[5],     pw2[0]=PKW(P1,0), pw2[1]=PKW(P1,2), pw2); \
    VRD(6); SBAR(); GAPA(C1=__builtin_amdgcn_mfma_f32_32x32x16_bf16(kf[5],qr[2],C1,0,0,0),   P1[6],P1[7],P1[8],P1[9],     pw2[2]=PKW(P1,4), pw2[3]=PKW(P1,6), pw2); \
    VRD(3); SBAR(); GAPA(C0=__builtin_amdgcn_mfma_f32_32x32x16_bf16(kf[6],qr[3],C0,0,0,0),   P1[10],P1[11],P1[12],P1[13], pw3[0]=PKW(P1,8), pw3[1]=PKW(P1,10), pw3); \
    VRD(7); SBAR(); GAPA(C1=__builtin_amdgcn_mfma_f32_32x32x16_bf16(kf[7],qr[3],C1,0,0,0),   P1[14],P1[15],0.f,0.f,       pw3[2]=PKW(P1,12),pw3[3]=PKW(P1,14), pw3); \
    l_reg+=sacc; \
    if(GK){DMA_K((t)+3,sl_cur);} if(GV){DMA_V((t)+1,sl_next);} \
    CMASK(C0,C1,t); \
    { float a=MX3(C0[0],C0[1],C1[0]),b=MX3(C0[2],C0[3],C1[1]); a=MX3(a,C1[2],C1[3]); \
      _Pragma("unroll") for(int r=4;r<16;r+=4){a=MX3(a,C0[r],C0[r+1]);b=MX3(b,C0[r+2],C0[r+3]);a=MX3(a,C1[r],C1[r+1]);b=MX3(b,C1[r+2],C1[r+3]);} \
      float rm=__builtin_fmaxf(a,b); { auto rr=__builtin_amdgcn_permlane32_swap(__float_as_uint(rm),__float_as_uint(rm),false,false); rm=__builtin_fmaxf(__uint_as_float(rr[0]),__uint_as_float(rr[1])); } \
      resc=false; \
      if(__builtin_expect(__any(rm>(float)THRL),0)){ const float dl=__builtin_fmaxf(rm,0.f); mhat+=dl; \
        _Pragma("unroll") for(int r=0;r<16;++r){C0[r]-=dl;C1[r]-=dl;} \
        _Pragma("unroll") for(int r=0;r<16;++r)negm[r]=-mhat; asm volatile("":"+v"(negm)); \
        const float f=__builtin_amdgcn_exp2f(-dl); l_reg*=f; if(hi==0)wsf[r32]=f; resc=true; } } \
    SBAR(); \
    GAPB(o[0]=__builtin_amdgcn_mfma_f32_32x32x16_bf16(PAF(0),VFR(0),o[0],0,0,0), C0,0); \
    GAPB(o[1]=__builtin_amdgcn_mfma_f32_32x32x16_bf16(PAF(0),VFR(4),o[1],0,0,0), C0,4); \
    KRD(GL,0); GAPB(o[0]=__builtin_amdgcn_mfma_f32_32x32x16_bf16(PAF(1),VFR(1),o[0],0,0,0), C0,8); \
    KRD(GL,1); GAPB(o[1]=__builtin_amdgcn_mfma_f32_32x32x16_bf16(PAF(1),VFR(5),o[1],0,0,0), C0,12); \
    KRD(GL,2); GAPB(o[0]=__builtin_amdgcn_mfma_f32_32x32x16_bf16(PAF(2),VFR(2),o[0],0,0,0), C1,0); \
    KRD(GL,3); GAPB(o[1]=__builtin_amdgcn_mfma_f32_32x32x16_bf16(PAF(2),VFR(6),o[1],0,0,0), C1,4); \
    GAPB(o[0]=__builtin_amdgcn_mfma_f32_32x32x16_bf16(PAF(3),VFR(3),o[0],0,0,0), C1,8); \
    GAPB(o[1]=__builtin_amdgcn_mfma_f32_32x32x16_bf16(PAF(3),VFR(7),o[1],0,0,0), C1,12); \
    }while(0)
  int t=1;
  #undef CMASK
  #define CMASK(P0,P1,t) do{}while(0)
  for(;t+5<NT;t+=2){
    STEP(pB0,pB1,pA0,pA1,t,true,true,true);     WAIT_BAR(2); RESC(); ROT();
    STEP(pA0,pA1,pB0,pB1,t+1,true,true,true);   WAIT_BAR(2); RESC(); ROT();
  }
  #undef CMASK
  #define CMASK(P0,P1,t) do{}while(0)
  #define ENDW(tt) do{ if((tt)+3<NT){WAIT_BAR(2);} else if((tt)+2<NT){WAIT_BAR(1);} else {WAIT_BAR(0);} }while(0)
  for(;t+1<NT;t+=2){
    STEP(pB0,pB1,pA0,pA1,t,(t+3<NT),(t+1<NT),(t+1<NT));       ENDW(t);   RESC(); ROT();
    STEP(pA0,pA1,pB0,pB1,t+1,(t+4<NT),(t+2<NT),(t+2<NT));     ENDW(t+1); RESC(); ROT();
  }
  STEP(pB0,pB1,pA0,pA1,NT-1,false,false,false); RESC();
  { float sacc=pB0[0]+pB0[1]; _Pragma("unroll") for(int r=2;r<16;++r)sacc+=pB0[r]; _Pragma("unroll") for(int r=0;r<16;++r)sacc+=pB1[r]; l_reg+=sacc;
    pw0=(u32x4){PKW(pB0,0),PKW(pB0,2),PKW(pB0,4),PKW(pB0,6)};pw1=(u32x4){PKW(pB0,8),PKW(pB0,10),PKW(pB0,12),PKW(pB0,14)};pw2=(u32x4){PKW(pB1,0),PKW(pB1,2),PKW(pB1,4),PKW(pB1,6)};pw3=(u32x4){PKW(pB1,8),PKW(pB1,10),PKW(pB1,12),PKW(pB1,14)};
    SBAR(); pv(o,vb0+sl_cur,PAF(0),PAF(1),PAF(2),PAF(3)); }
  #undef PKW
  #undef PAF
  #undef VFR
  #undef PIN
  #undef MX3
  #undef GAPA
  #undef GAPB
  #undef EX
  #undef VRD
  #undef KRD
  #undef STEP
  #undef ENDW
  {auto rr=__builtin_amdgcn_permlane32_swap(__float_as_uint(l_reg),__float_as_uint(l_reg),false,false);l_reg=__uint_as_float(rr[0])+__uint_as_float(rr[1]);}
  if(hi==0)wsf[32+r32]=l_reg;asm volatile("s_waitcnt lgkmcnt(0)":::"memory");
  float rli[16];
  #pragma unroll
  for(int r=0;r<16;++r)rli[r]=__builtin_amdgcn_rcpf(wsf[32+crow(r,hi)]);
  bf16*Ow=Oblk+(long)wid*QBLK*DM;
  { bf16*stg=(bf16*)(shm+LDS_OST)+wid*2048;
    #pragma unroll
    for(int r=0;r<16;++r){const int orow=crow(r,hi);
      #pragma unroll
      for(int d0=0;d0<2;++d0)stg[orow*64+d0*32+r32]=__float2bfloat16(o[d0][r]*rli[r]);}
    asm volatile("s_waitcnt lgkmcnt(0)":::"memory");
    #pragma unroll
    for(int i=0;i<4;++i){const int row=i*8+(lane>>3),ch=lane&7; const u32x4 v=*(const u32x4*)(stg+row*64+ch*8); const u32x4 z=*(const u32x4*)(Ow+(long)row*DM+ch*8); u32x4 w;
      #pragma unroll
      for(int e=0;e<4;++e){ const float a0=__uint_as_float(v[e]<<16),a1=__uint_as_float(v[e]&0xffff0000u),z0=__uint_as_float(z[e]<<16),z1=__uint_as_float(z[e]&0xffff0000u);
        w[e]=cvtpk_s(a0*z0/(1.f+__expf(-z0)),a1*z1/(1.f+__expf(-z1))); }
      ATTN_STORE16(Ow+(long)row*DM+ch*8,w);} }
  asm volatile("s_waitcnt lgkmcnt(0)\n\ts_barrier":::"memory");
  #undef DMA_K
  #undef DMA_V
  #undef CMASK
  #undef START
  #undef RESC
  #undef ROT
}
constexpr int ATTN_LDS_BYTES=LDS_BYTES;
}
typedef unsigned short u16;
#define LAS __attribute__((address_space(3)))
#define DI __device__ __forceinline__
typedef unsigned v4u __attribute__((ext_vector_type(4)));
typedef unsigned v2u __attribute__((ext_vector_type(2)));
typedef float v4f __attribute__((ext_vector_type(4)));

constexpr int T_TOK = 32768, P1P = 2048, P2P = 1536;
constexpr int P1_Z = 0, P1_Q = 1280, P1_K = 1792, P1_V = 1920;
constexpr int P2_AQ = 0, P2_AK = 128, P2_AV = 256, P2_GF = 512, P2_GB = 640, P2_BU = 768, P2_DU = 1024, P2_DV = 1280, P2_U = 1024;
constexpr size_t MiB = 1u << 20;
constexpr size_t WS_DFT = 256 * 1024, WS_BAR = 512 * 1024, BAR_BYTES = 16384;
constexpr size_t WS_MOD = 0, WS_WIN = 2 * MiB, WS_WOUT = 16 * MiB, WS_WF = 21 * MiB, WS_U0 = 22 * MiB, WS_HB = 86 * MiB, WS_P2 = 150 * MiB, WS_DEC = 246 * MiB, WS_END = 247 * MiB;
constexpr size_t HB_GS = 0, HB_KC = 16 * MiB, HB_VC = 24 * MiB, HB_TP = 32 * MiB;
constexpr int LDS_BYTES = 147456;
constexpr float EPSN = 1e-6f;
constexpr float ATT_C2 = 0.125f * 1.4426950408889634f;

struct Params {
    const float *xp, *xs, *cp, *cs, *ada_w, *ada_b, *pre_g, *post_g, *w_in, *wg2f, *bgf, *wg2b, *bgb, *onorm_g, *fnet_w, *qn_g, *kn_g, *sgu_ng, *sgu_w, *sgu_b, *w_out;
    float* out; unsigned char* ws;
};
typedef const float* cfp;
struct Ctx { float* out; unsigned char* ws; LAS cfp* tab; };

DI float bf2f(u16 v) { return __uint_as_float((unsigned)v << 16); }
DI float bflo(unsigned w) { return __uint_as_float(w << 16); }
DI float bfhi(unsigned w) { return __uint_as_float(w & 0xffff0000u); }
DI unsigned f2bf(float f) { unsigned u = __float_as_uint(f); return (u + 0x7fffu + ((u >> 16) & 1u)) >> 16; }
DI unsigned pk2(float lo, float hi) { return f2bf(lo) | (f2bf(hi) << 16); }
DI float wave_sum(float v) {
#pragma unroll
    for (int o = 1; o < 64; o <<= 1) v += __shfl_xor(v, o);
    return v;
}
using pg8::silu_f;
DI float logsig(float x) { return fminf(x, 0.f) - log1pf(__expf(-fabsf(x))); }
DI void seq_info(int s, int& row0, int& N) { if (s < 4) { row0 = s * 4096; N = 4096; } else { row0 = 16384 + (s - 4) * 8192; N = 8192; } }
DI int row_seq(int r) { return r < 16384 ? (r >> 12) : 4 + ((r - 16384) >> 13); }
DI void unpack8(const v4u r, float (&f)[8]) { f[0] = bflo(r.x); f[1] = bfhi(r.x); f[2] = bflo(r.y); f[3] = bfhi(r.y); f[4] = bflo(r.z); f[5] = bfhi(r.z); f[6] = bflo(r.w); f[7] = bfhi(r.w); }
DI v4u pack8(const float (&f)[8]) { v4u r; r.x = pk2(f[0], f[1]); r.y = pk2(f[2], f[3]); r.z = pk2(f[4], f[5]); r.w = pk2(f[6], f[7]); return r; }
#define LDS_WAIT() asm volatile("s_waitcnt lgkmcnt(0)" ::: "memory")


typedef short bf16x8_t __attribute__((ext_vector_type(8)));
typedef float f32x4_t __attribute__((ext_vector_type(4)));
DI bf16x8_t ldfrag(const LAS u16* base, int pitch, int row0, int k0, int lane) { return *(const LAS bf16x8_t*)(base + (row0 + (lane & 15)) * pitch + k0 + 8 * (lane >> 4)); }
#define MFMA16(a, b, c) __builtin_amdgcn_mfma_f32_16x16x32_bf16((a), (b), (c), 0, 0, 0)
DI float wave_prefix(float g, int lane) {
#pragma unroll
    for (int o = 1; o < 64; o <<= 1) { const float t = __shfl_up(g, o); if (lane >= o) g += t; }
    return g; }
DI float wave_suffix(float g, int lane) {
#pragma unroll
    for (int o = 1; o < 64; o <<= 1) { const float t = __shfl_down(g, o); if (lane + o < 64) g += t; }
    return g; }
DI int win_src_col(int j) {
    if (j < 1280) return 2080 + j;
    if (j < 1792) return 800 + (j - 1280);
    if (j < 1920) return 1312 + (j - 1792);
    if (j < 2048) return 1440 + (j - 1920);
    const int q = j - 2048;
    if (q < 512) return q;
    if (q < 768) return -1;
    if (q < 1024) return 544 + (q - 768);
    if (q < 1280) return 1568 + (q - 1024);
    return 1824 + (q - 1280);
}
DI void transpose_item(const float* W, int ldw, int src_n0, int K, u16* WT, int dst_n0, int k0, LAS float* scr, int lane) {
#pragma unroll 8
    for (int i = 0; i < 32; ++i) { const int kk = 2 * i + (lane >> 5); scr[kk * 33 + (lane & 31)] = W[(size_t)(k0 + kk) * ldw + src_n0 + (lane & 31)]; }
    LDS_WAIT();
    const int c = lane & 7;
#pragma unroll
    for (int j = 0; j < 4; ++j) { const int n = (lane >> 3) + 8 * j; const LAS float* s = scr + (8 * c) * 33 + n;
        v4u o; o.x = pk2(s[0 * 33], s[1 * 33]); o.y = pk2(s[2 * 33], s[3 * 33]); o.z = pk2(s[4 * 33], s[5 * 33]); o.w = pk2(s[6 * 33], s[7 * 33]);
        *(v4u*)(WT + (size_t)(dst_n0 + n) * K + k0 + 8 * c) = o; }
    LDS_WAIT();
}
DI void phase0(const Ctx& p, LAS unsigned char* L) {
    const int tid = otid(), lane = tid & 63, wave = tid >> 6;
    const int gw = blockIdx.x * 8 + wave, NGW = gridDim.x * 8, gt = blockIdx.x * 512 + tid, NGT = gridDim.x * 512;
    LAS float* scr = (LAS float*)(L + wave * 16384);
    u16* WinT = (u16*)(p.ws + WS_WIN); u16* WoutT = (u16*)(p.ws + WS_WOUT); u16* WfT = (u16*)(p.ws + WS_WF); float* mod = (float*)(p.ws + WS_MOD);
    constexpr int I_IN = 16 * 112, I_OUT = 20 * 32, I_L = I_IN + I_OUT;
    for (int it = gw; it < 2 * I_L; it += NGW) {
        const int l = it / I_L; int r = it % I_L;
        if (r < I_IN) { const int kb = r / 112, nb = r % 112; const int src = win_src_col(nb * 32); if (src < 0) continue;
            transpose_item(p.tab[8] + (size_t)l * 1024 * 3360, 3360, src, 1024, WinT + (size_t)l * 3584 * 1024, nb * 32, kb * 64, scr, lane); }
        else { r -= I_IN; const int kb = r / 32, nb = r % 32;
            transpose_item(p.tab[20] + (size_t)l * 1280 * 1024, 1024, nb * 32, 1280, WoutT + (size_t)l * 1024 * 1280, nb * 32, kb * 64, scr, lane); }
    }
    for (int e = gt; e < 2 * 256 * 1024; e += NGT) { const int l = e >> 18, r = e & 262143, j = r >> 10, k = r & 1023, dirb = j >> 7, jj = j & 127;
        const float* wi = p.tab[8] + (size_t)l * 1024 * 3360 + (size_t)k * 3360 + 512 + dirb * 16;
        const float* w2 = (dirb ? p.tab[11] : p.tab[9]) + l * 16 * 128 + jj; float a = 0.f;
#pragma unroll
        for (int r2 = 0; r2 < 16; ++r2) a += wi[r2] * w2[r2 * 128];
        WinT[(size_t)l * 3584 * 1024 + (size_t)(2560 + j) * 1024 + k] = (u16)f2bf(a); }
    for (int e = gt; e < 2 * 256 * 512; e += NGT) { const int l = e >> 17, r = e & 131071, n = r >> 9, kk = r & 511, im = kk >> 8, g = (kk & 255) >> 6, c = kk & 63;
        const float* fw = p.tab[14] + (size_t)l * 65536 + (size_t)(g * 64) * 256 + n; float a = 0.f;
        for (int j = 0; j < 64; ++j) { const float ang = (float)((j * c) & 63) * (1.f / 32.f); const float t = im ? sinpif(ang) : cospif(ang); a += t * fw[j * 256]; }
        WfT[(size_t)l * 131072 + n * 512 + kk] = (u16)f2bf(a * 0.125f); }
    { u16* dft = (u16*)(p.ws + WS_DFT);
        for (int e = gt; e < 4096; e += NGT) { const int k = e >> 6, n = e & 63; const float a = (float)((k * n) & 63) * (1.f / 32.f); dft[e] = (u16)f2bf(cospif(a)); dft[4096 + e] = (u16)f2bf(sinpif(a)); }
        for (int e = gt; e < 16384; e += NGT) { const int k = e >> 7, n = e & 127; const float a = (float)((k * n) & 127) * (1.f / 64.f); dft[8192 + e] = (u16)f2bf(cospif(a)); dft[8192 + 16384 + e] = (u16)f2bf(sinpif(a)); } }
    __syncthreads();
    LAS float* sc = (LAS float*)L; LAS float* red = sc + 6144;
    for (int e = tid; e < 6144; e += 512) { const int s = e >> 10, k = e & 1023; const float c = s < 4 ? p.tab[2][s * 1024 + k] : p.tab[3][(s - 4) * 1024 + k]; sc[e] = c / (1.f + expf(-c)); }
    __syncthreads();
    for (int item = blockIdx.x; item < 96; item += gridDim.x) {
        const int l = item / 48, jb = item % 48, j = jb * 64 + lane, kg = wave;
        float acc[6] = {0.f, 0.f, 0.f, 0.f, 0.f, 0.f};
        const float* aw = p.tab[4] + (size_t)l * 1024 * 3072 + j;
        for (int k = kg * 128; k < kg * 128 + 128; ++k) { const float w = aw[(size_t)k * 3072];
#pragma unroll
            for (int s = 0; s < 6; ++s) acc[s] += sc[s * 1024 + k] * w; }
#pragma unroll
        for (int s = 0; s < 6; ++s) red[(kg * 6 + s) * 64 + lane] = acc[s];
        __syncthreads();
        if (tid < 384) { const int s = tid >> 6; float a = p.tab[5][l * 3072 + jb * 64 + lane];
#pragma unroll
            for (int k8 = 0; k8 < 8; ++k8) a += red[(k8 * 6 + s) * 64 + lane];
            mod[(size_t)(l * 6 + s) * 3072 + jb * 64 + lane] = a; }
        __syncthreads();
    }
}

DI void add_branch(v4f (&v)[4], const u16* urow, const float* gate, const float* pg, int lane) {
    v4f u[4]; float ss = 0.f;
#pragma unroll
    for (int j = 0; j < 4; ++j) { const v2u r = *(const v2u*)(urow + 256 * j + 4 * lane); u[j] = (v4f){bflo(r.x), bfhi(r.x), bflo(r.y), bfhi(r.y)};
        ss += (u[j].x * u[j].x + u[j].y * u[j].y) + (u[j].z * u[j].z + u[j].w * u[j].w); }
    const float rstd = 1.f / sqrtf(wave_sum(ss) * (1.f / 1024.f) + EPSN);
#pragma unroll
    for (int j = 0; j < 4; ++j) { const v4f g = *(const v4f*)(gate + 256 * j + 4 * lane), q = *(const v4f*)(pg + 256 * j + 4 * lane); v[j] += g * (u[j] * rstd * q); }
}
DI void phaseA(const Ctx& p, int l) {
    const int tid = otid(), lane = tid & 63, wave = tid >> 6, gw = blockIdx.x * 8 + wave, NGW = gridDim.x * 8;
    const float* mod = (const float*)(p.ws + WS_MOD); const u16* U0 = (const u16*)(p.ws + WS_U0); u16* HB = (u16*)(p.ws + WS_HB);
    for (int row = gw; row < T_TOK; row += NGW) {
        const int s = row_seq(row);
        const float* xr = row < 16384 ? p.tab[0] + (size_t)row * 1024 : p.tab[1] + (size_t)(row - 16384) * 1024;
        v4f v[4];
#pragma unroll
        for (int j = 0; j < 4; ++j) v[j] = *(const v4f*)(xr + 256 * j + 4 * lane);
        if (l >= 1) add_branch(v, U0 + (size_t)row * 1024, mod + (size_t)(0 * 6 + s) * 3072 + 2048, p.tab[7], lane);
        if (l == 2) { add_branch(v, HB + (size_t)row * 1024, mod + (size_t)(1 * 6 + s) * 3072 + 2048, p.tab[7] + 1024, lane);
            float* o = p.out + (size_t)row * 1024;
#pragma unroll
            for (int j = 0; j < 4; ++j) *(v4f*)(o + 256 * j + 4 * lane) = v[j];
            continue; }
        float ss = 0.f;
#pragma unroll
        for (int j = 0; j < 4; ++j) ss += (v[j].x * v[j].x + v[j].y * v[j].y) + (v[j].z * v[j].z + v[j].w * v[j].w);
        const float rstd = 1.f / sqrtf(wave_sum(ss) * (1.f / 1024.f) + EPSN);
        const float* md = mod + (size_t)(l * 6 + s) * 3072;
#pragma unroll
        for (int j = 0; j < 4; ++j) { const int col = 256 * j + 4 * lane;
            const v4f sh = *(const v4f*)(md + col), scl = *(const v4f*)(md + 1024 + col), g = *(const v4f*)(p.tab[6] + l * 1024 + col);
            const v4f h = v[j] * rstd * g * (scl + 1.f) + sh;
            v2u o; o.x = pk2(h.x, h.y); o.y = pk2(h.z, h.w); *(v2u*)(HB + (size_t)row * 1024 + col) = o; }
    }
}

DI void qk_prep(const Ctx& p, int l) {
    const int tid = otid(), lane = tid & 63, wave = tid >> 6, gw = blockIdx.x * 8 + wave, NGW = gridDim.x * 8;
    u16* P1 = (u16*)p.out; const int i = lane & 31; unsigned* KC = (unsigned*)(p.ws + WS_HB + HB_KC); unsigned* VC = (unsigned*)(p.ws + WS_HB + HB_VC);
    const float freq = exp2f(-(float)(i & 15) * (13.287712379549449f / 16.f));
    const float gq0 = p.tab[15][l * 64 + 2 * i], gq1 = p.tab[15][l * 64 + 2 * i + 1], gk0 = p.tab[16][l * 64 + 2 * i], gk1 = p.tab[16][l * 64 + 2 * i + 1];
    for (int rowb = gw * 2; rowb < T_TOK; rowb += NGW * 2) {
        unsigned wv[2][6];
#pragma unroll
        for (int r = 0; r < 2; ++r) { const unsigned* ptr = (const unsigned*)(P1 + (size_t)(rowb + r) * P1P + P1_Q);
#pragma unroll
            for (int it = 0; it < 6; ++it) wv[r][it] = ptr[it * 64 + lane]; }
#pragma unroll
        for (int r = 0; r < 2; ++r) { const int row = rowb + r;
            const int s = row_seq(row); int row0, N; seq_info(s, row0, N); const int pos = row - row0;
            const float coord = (i < 16) ? (float)(pos >> 6) : (float)(pos & 63);
            float sn, cs; sincosf(coord * freq, &sn, &cs);
            unsigned* ptr = (unsigned*)(P1 + (size_t)row * P1P + P1_Q);
            const size_t cidx = ((size_t)row0 * 2 + (size_t)(lane >> 5) * N + pos) * 32 + i;
#pragma unroll
            for (int it = 0; it < 5; ++it) { const bool isq = it < 4;
                const unsigned w = wv[r][it]; const float x0 = bflo(w), x1 = bfhi(w);
                float ss = x0 * x0 + x1 * x1;
#pragma unroll
                for (int o = 1; o < 32; o <<= 1) ss += __shfl_xor(ss, o);
                const float rstd = 1.f / sqrtf(ss * (1.f / 64.f) + EPSN);
                const float y0 = x0 * rstd * (isq ? gq0 : gk0), y1 = x1 * rstd * (isq ? gq1 : gk1);
                float o0 = y0 * cs - y1 * sn, o1 = y0 * sn + y1 * cs;
                if (isq) { ptr[it * 64 + lane] = pk2(o0 * ATT_C2, o1 * ATT_C2); } else { KC[cidx] = pk2(o0, o1); } }
            VC[cidx] = wv[r][5]; }
    }
}
DI void gla_local_item(const Ctx& p, int l, int item, LAS float* F) {
    const int tid = otid(), lane = tid & 63, w = tid >> 6; const int gc = item >> 2, h = item & 3; const size_t rb = (size_t)gc * 64;
    const u16* P2 = (const u16*)(p.ws + WS_P2);
    LAS float* Gf = F; LAS float* Gb = Gf + 2112; LAS float* Kx = Gb + 2112; LAS u16* KDT = (LAS u16*)(Kx + 2112); LAS u16* VT = KDT + 2 * 32 * 72;
    { const int t2 = tid & 255, i = t2 >> 2, c = t2 & 3; const u16* r = P2 + (rb + i) * P2P + h * 32 + c * 8; float f[8];
        if (tid < 256) { unpack8(*(const v4u*)(r + P2_AK), f);
#pragma unroll
            for (int q = 0; q < 8; ++q) Kx[i * 33 + c * 8 + q] = f[q];
            unpack8(*(const v4u*)(r + P2_GF), f);
#pragma unroll
            for (int q = 0; q < 8; ++q) Gf[i * 33 + c * 8 + q] = f[q]; }
        else { unpack8(*(const v4u*)(r + P2_GB), f);
#pragma unroll
            for (int q = 0; q < 8; ++q) Gb[i * 33 + c * 8 + q] = f[q]; } }
    { const int i = tid >> 3, c = tid & 7; const v4u raw = *(const v4u*)(P2 + (rb + i) * P2P + P2_AV + h * 64 + c * 8);
        const unsigned ww[4] = {raw.x, raw.y, raw.z, raw.w};
#pragma unroll
        for (int q = 0; q < 4; ++q) { VT[(c * 8 + 2 * q) * 72 + i] = (u16)(ww[q] & 0xffffu); VT[(c * 8 + 2 * q + 1) * 72 + i] = (u16)(ww[q] >> 16); } }
    __syncthreads();
    u16* GS = (u16*)(p.ws + WS_HB + HB_GS); float* DEC = (float*)(p.ws + WS_DEC); const size_t slot = (size_t)(gc * 4 + h) * 2;
    { const int dir = w >> 2; const float* bias = p.tab[dir ? 12 : 10] + l * 128 + h * 32; const LAS float* G = dir ? Gb : Gf;
#pragma unroll
        for (int c = 0; c < 8; ++c) { const int d = (w & 3) * 8 + c;
            float g = logsig(G[lane * 33 + d] + bias[d]) * (1.f / 16.f);
            g = dir ? wave_suffix(g, lane) : wave_prefix(g, lane);
            const float bl = __shfl(g, dir ? 0 : 63);
            KDT[(dir * 32 + d) * 72 + lane] = (u16)f2bf(Kx[lane * 33 + d] * __expf(bl - g));
            if (lane == 0) DEC[(slot + dir) * 32 + d] = __expf(bl); } }
    __syncthreads();
    { const int dir = w >> 2, mt = (w >> 1) & 1;
#pragma unroll
        for (int q = 0; q < 2; ++q) { const int nt = (w & 1) * 2 + q; f32x4_t acc = {0.f, 0.f, 0.f, 0.f};
#pragma unroll
            for (int ks = 0; ks < 2; ++ks) acc = MFMA16(ldfrag(KDT + dir * 32 * 72, 72, mt * 16, ks * 32, lane), ldfrag(VT, 72, nt * 16, ks * 32, lane), acc);
#pragma unroll
            for (int j = 0; j < 4; ++j) GS[(slot + dir) * 2048 + (mt * 16 + 4 * (lane >> 4) + j) * 64 + nt * 16 + (lane & 15)] = (u16)f2bf(acc[j]); } }
    __syncthreads();
}
DI void sgu_item(const Ctx& p, int l, int item, LAS float* F) {
    const int tid = otid(), lane = tid & 63, w = tid >> 6; const int ch = item >> 2, g = item & 3; const size_t rb = (size_t)ch * 128;
    const u16* P2 = (const u16*)(p.ws + WS_P2); u16* P1 = (u16*)p.out;
    LAS float* OUTF = F; LAS u16* WB = (LAS u16*)(F + 128 * 65); LAS u16* VNT = WB + 128 * 136;
    { const int row = tid >> 2, qt = tid & 3; const u16* dv = P2 + (rb + row) * P2P + P2_DV; float ss = 0.f; float f[8];
#pragma unroll
        for (int c = 0; c < 8; ++c) { unpack8(*(const v4u*)(dv + qt * 64 + c * 8), f);
#pragma unroll
            for (int q = 0; q < 8; ++q) ss += f[q] * f[q]; }
        ss += __shfl_xor(ss, 1); ss += __shfl_xor(ss, 2);
        const float rstd = 1.f / sqrtf(ss * (1.f / 256.f) + EPSN); const float* ng = p.tab[17] + l * 256 + g * 64 + qt * 16;
#pragma unroll
        for (int c = 0; c < 2; ++c) { unpack8(*(const v4u*)(dv + g * 64 + qt * 16 + c * 8), f);
#pragma unroll
            for (int q = 0; q < 8; ++q) VNT[(qt * 16 + c * 8 + q) * 136 + row] = (u16)f2bf(f[q] * rstd * ng[c * 8 + q]); } }
    { const float* wsrc = p.tab[18] + (size_t)(l * 4 + g) * 16384;
#pragma unroll
        for (int r = 0; r < 8; ++r) { const int idx = tid + r * 512, t = idx >> 5, s4 = (idx & 31) * 4; const v4f v = *(const v4f*)(wsrc + idx * 4);
            v2u o; o.x = pk2(v.x, v.y); o.y = pk2(v.z, v.w); *(LAS v2u*)(WB + t * 136 + s4) = o; } }
    __syncthreads();
    {
#pragma unroll
        for (int nt = 0; nt < 4; ++nt) { f32x4_t acc = {0.f, 0.f, 0.f, 0.f};
#pragma unroll
            for (int ks = 0; ks < 4; ++ks) acc = MFMA16(ldfrag(WB, 136, w * 16, ks * 32, lane), ldfrag(VNT, 136, nt * 16, ks * 32, lane), acc);
#pragma unroll
            for (int j = 0; j < 4; ++j) OUTF[(w * 16 + 4 * (lane >> 4) + j) * 65 + nt * 16 + (lane & 15)] = acc[j]; } }
    __syncthreads();
#pragma unroll
    for (int r = 0; r < 2; ++r) { const int task = tid + r * 512, t = task >> 3, c8 = (task & 7) * 8; float acc[8];
#pragma unroll
        for (int e = 0; e < 8; ++e) acc[e] = OUTF[t * 65 + c8 + e];
        const float bias = p.tab[19][(l * 4 + g) * 128 + t];
        float uu[8], zz[8]; unpack8(*(const v4u*)(P2 + (rb + t) * P2P + P2_DU + g * 64 + c8), uu);
        u16* mz = P1 + (rb + t) * P1P + 1024 + g * 64 + c8; unpack8(*(const v4u*)mz, zz);
#pragma unroll
        for (int e = 0; e < 8; ++e) acc[e] = (acc[e] + bias) * uu[e] * silu_f(zz[e]);
        *(v4u*)mz = pack8(acc); }
    __syncthreads();
}
template <int N1> DI void fnet1_body(const Ctx& p, int row0, int N, int n2, int cb, LAS float* F) {
    constexpr int PN = N1 + 8, MT = N1 / 16, NTW = MT;
    const int tid = otid(), lane = tid & 63, w = tid >> 6;
    const u16* P2 = (const u16*)(p.ws + WS_P2); u16* TP = (u16*)(p.ws + WS_HB + HB_TP);
    const u16* Cg = (const u16*)(p.ws + WS_DFT) + (N1 == 64 ? 0 : 8192); const u16* Sg = Cg + N1 * N1;
    LAS float* tw = F; LAS u16* XT = (LAS u16*)(F + 256); LAS u16* FC = XT + 128 * PN; LAS u16* FS = FC + N1 * PN; LAS u16* OUT = FC;
#pragma unroll
    for (int r = 0; r < N1 / 32; ++r) { const int idx = tid + r * 512, n1 = idx >> 4, c = idx & 15; const v4u raw = *(const v4u*)(P2 + (size_t)(row0 + n1 * 64 + n2) * P2P + P2_BU + cb * 128 + c * 8);
        const unsigned ww[4] = {raw.x, raw.y, raw.z, raw.w};
#pragma unroll
        for (int q = 0; q < 4; ++q) { XT[(c * 8 + 2 * q) * PN + n1] = (u16)(ww[q] & 0xffffu); XT[(c * 8 + 2 * q + 1) * PN + n1] = (u16)(ww[q] >> 16); } }
#pragma unroll
    for (int r = 0; r < N1 * N1 / 8 / 512; ++r) { const int idx = tid + r * 512, k1 = idx / (N1 / 8), c = idx % (N1 / 8);
        *(LAS v4u*)(FC + k1 * PN + c * 8) = *(const v4u*)(Cg + k1 * N1 + c * 8); *(LAS v4u*)(FS + k1 * PN + c * 8) = *(const v4u*)(Sg + k1 * N1 + c * 8); }
    if (tid < N1) { const float ph = 2.f * (float)((n2 * tid) & (N - 1)) / (float)N; tw[2 * tid] = cospif(ph); tw[2 * tid + 1] = sinpif(ph); }
    __syncthreads();
    f32x4_t ac[NTW], as[NTW];
#pragma unroll
    for (int q = 0; q < NTW; ++q) { const int id = w + 8 * q, mt = id % MT, nt = id / MT; ac[q] = (f32x4_t){0.f, 0.f, 0.f, 0.f}; as[q] = ac[q];
#pragma unroll
        for (int ks = 0; ks < N1 / 32; ++ks) { const bf16x8_t b = ldfrag(XT, PN, nt * 16, ks * 32, lane);
            ac[q] = MFMA16(ldfrag(FC, PN, mt * 16, ks * 32, lane), b, ac[q]); as[q] = MFMA16(ldfrag(FS, PN, mt * 16, ks * 32, lane), b, as[q]); } }
    __syncthreads();
    const float scale = 1.f / sqrtf((float)N1);
#pragma unroll
    for (int q = 0; q < NTW; ++q) { const int id = w + 8 * q, mt = id % MT, nt = id / MT;
#pragma unroll
        for (int j = 0; j < 4; ++j) { const int k1 = mt * 16 + 4 * (lane >> 4) + j, col = nt * 16 + (lane & 15); const float cw = tw[2 * k1], sw = tw[2 * k1 + 1];
            const float tr = ac[q][j], ti = -as[q][j];
            OUT[k1 * 256 + col] = (u16)f2bf((tr * cw + ti * sw) * scale); OUT[k1 * 256 + 128 + col] = (u16)f2bf((ti * cw - tr * sw) * scale); } }
    __syncthreads();
#pragma unroll
    for (int r = 0; r < N1 / 16; ++r) { const int idx = tid + r * 512, k1 = idx >> 5, c = idx & 31;
        const v4u v = *(const LAS v4u*)(OUT + k1 * 256 + c * 8);
        *(v4u*)(TP + (size_t)(row0 + k1 * 64 + n2) * 512 + (c >> 4) * 256 + cb * 128 + (c & 15) * 8) = v; }
    __syncthreads();
}
DI void fnet1_item(const Ctx& p, int item, LAS float* F) {
    const int s = item >> 7, r = item & 127, n2 = r >> 1, cb = r & 1; int row0, N; seq_info(s, row0, N);
    if (N == 4096) fnet1_body<64>(p, row0, N, n2, cb, F); else fnet1_body<128>(p, row0, N, n2, cb, F);
}
DI void fnet2_item(const Ctx& p, int item, LAS float* F) {
    const int tid = otid(), lane = tid & 63, w = tid >> 6; int s, k1; if (item < 256) { s = item >> 6; k1 = item & 63; } else { s = 4 + ((item - 256) >> 7); k1 = (item - 256) & 127; }
    int row0, N; seq_info(s, row0, N); const int N1 = N >> 6;
    u16* P2 = (u16*)(p.ws + WS_P2); const u16* TP = (const u16*)(p.ws + WS_HB + HB_TP); const u16* Cg = (const u16*)(p.ws + WS_DFT); const u16* Sg = Cg + 4096;
    LAS u16* BT = (LAS u16*)F; LAS u16* A1 = BT + 256 * 136; LAS u16* A2 = A1 + 64 * 136; LAS u16* OUT = BT;
#pragma unroll
    for (int r = 0; r < 8; ++r) { const int idx = tid + r * 512, n2 = idx >> 6, c = idx & 63; const v4u raw = *(const v4u*)(TP + (size_t)(row0 + k1 * 64 + n2) * 512 + c * 8);
        const unsigned ww[4] = {raw.x, raw.y, raw.z, raw.w}; const int col0 = (c & 31) * 8, kk = (c >> 5) * 64 + n2;
#pragma unroll
        for (int q = 0; q < 4; ++q) { BT[(col0 + 2 * q) * 136 + kk] = (u16)(ww[q] & 0xffffu); BT[(col0 + 2 * q + 1) * 136 + kk] = (u16)(ww[q] >> 16); } }
    { const int k2 = tid >> 3, c8 = (tid & 7) * 8; const v4u c = *(const v4u*)(Cg + k2 * 64 + c8), sv = *(const v4u*)(Sg + k2 * 64 + c8); const v4u ns = sv ^ (v4u){0x80008000u, 0x80008000u, 0x80008000u, 0x80008000u};
        *(LAS v4u*)(A1 + k2 * 136 + c8) = c; *(LAS v4u*)(A1 + k2 * 136 + 64 + c8) = sv; *(LAS v4u*)(A2 + k2 * 136 + c8) = ns; *(LAS v4u*)(A2 + k2 * 136 + 64 + c8) = c; }
    __syncthreads();
    f32x4_t acc[16]; const LAS u16* Aw = (w < 4) ? A1 : A2; const int mt = w & 3;
#pragma unroll
    for (int nt = 0; nt < 16; ++nt) { acc[nt] = (f32x4_t){0.f, 0.f, 0.f, 0.f};
#pragma unroll
        for (int ks = 0; ks < 4; ++ks) acc[nt] = MFMA16(ldfrag(Aw, 136, mt * 16, ks * 32, lane), ldfrag(BT, 136, nt * 16, ks * 32, lane), acc[nt]); }
    __syncthreads();
#pragma unroll
    for (int nt = 0; nt < 16; ++nt)
#pragma unroll
        for (int j = 0; j < 4; ++j) OUT[(mt * 16 + 4 * (lane >> 4) + j) * 512 + (w >> 2) * 256 + nt * 16 + (lane & 15)] = (u16)f2bf(acc[nt][j] * 0.125f);
    __syncthreads();
#pragma unroll
    for (int r = 0; r < 8; ++r) { const int idx = tid + r * 512, k2 = idx >> 6, c = idx & 63; const v4u v = *(const LAS v4u*)(OUT + k2 * 512 + c * 8);
        *(v4u*)(P2 + (size_t)(row0 + k1 + N1 * k2) * P2P + P2_U + c * 8) = v; }
    __syncthreads();
}
DI void gla_scan_item(const Ctx& p, int item) {
    const int tid = otid(); const int chain = item >> 2, e = (item & 3) * 512 + tid; const int s = chain >> 3, h = (chain >> 1) & 3, dir = chain & 1;
    int row0, N; seq_info(s, row0, N); const int NC = N >> 6, gc0 = row0 >> 6, d = e >> 6;
    u16* GS = (u16*)(p.ws + WS_HB + HB_GS); const float* DEC = (const float*)(p.ws + WS_DEC);
    float S = 0.f;
    for (int st = 0; st < NC; st += 32) { u16 tmp[32]; float dc[32];
#pragma unroll
        for (int u = 0; u < 32; ++u) { const int c = dir ? NC - 1 - (st + u) : st + u; const size_t slot = (size_t)((gc0 + c) * 4 + h) * 2 + dir; tmp[u] = GS[slot * 2048 + e]; dc[u] = DEC[slot * 32 + d]; }
#pragma unroll
        for (int u = 0; u < 32; ++u) { const int c = dir ? NC - 1 - (st + u) : st + u; const size_t slot = (size_t)((gc0 + c) * 4 + h) * 2 + dir; GS[slot * 2048 + e] = (u16)f2bf(S); S = dc[u] * S + bf2f(tmp[u]); } }
}
DI void gla_out_item(const Ctx& p, int l, int item, LAS float* F) {
    const int tid = otid(), lane = tid & 63, w = tid >> 6; const int gc = item >> 2, h = item & 3; const size_t rb = (size_t)gc * 64;
    const u16* P2 = (const u16*)(p.ws + WS_P2); u16* P1 = (u16*)p.out;
    LAS float* Gf = F; LAS float* Gb = Gf + 2112; LAS float* Qx = Gb + 2112; LAS float* Kx = Qx + 2112; LAS float* O = Kx + 2112;
    LAS u16* QF = (LAS u16*)(O + 64 * 65); LAS u16* KF = QF + 64 * 40; LAS u16* QB = KF + 64 * 40; LAS u16* KB = QB + 64 * 40;
    LAS u16* VT = KB + 64 * 40; LAS u16* SC = VT + 64 * 72; LAS u16* SFT = SC + 64 * 72; LAS u16* SBT = SFT + 64 * 40;
    const u16* GS = (const u16*)(p.ws + WS_HB + HB_GS); const size_t slot = (size_t)(gc * 4 + h) * 2;
    { const int t2 = tid & 255, i = t2 >> 2, c = t2 & 3; const u16* r = P2 + (rb + i) * P2P + h * 32 + c * 8; float f[8];
        LAS float* d0 = (tid < 256) ? Qx : Kx; LAS float* d1 = (tid < 256) ? Gf : Gb;
        unpack8(*(const v4u*)(r + ((tid < 256) ? P2_AQ : P2_AK)), f);
#pragma unroll
        for (int q = 0; q < 8; ++q) d0[i * 33 + c * 8 + q] = f[q];
        unpack8(*(const v4u*)(r + ((tid < 256) ? P2_GF : P2_GB)), f);
#pragma unroll
        for (int q = 0; q < 8; ++q) d1[i * 33 + c * 8 + q] = f[q]; }
    { const int i = tid >> 3, c = tid & 7; const v4u raw = *(const v4u*)(P2 + (rb + i) * P2P + P2_AV + h * 64 + c * 8);
        const unsigned ww[4] = {raw.x, raw.y, raw.z, raw.w};
#pragma unroll
        for (int q = 0; q < 4; ++q) { VT[(c * 8 + 2 * q) * 72 + i] = (u16)(ww[q] & 0xffffu); VT[(c * 8 + 2 * q + 1) * 72 + i] = (u16)(ww[q] >> 16); } }
    { const int e4 = tid * 4, d = e4 >> 6, v = e4 & 63; const v2u a = *(const v2u*)(GS + slot * 2048 + e4), b = *(const v2u*)(GS + (slot + 1) * 2048 + e4);
        SFT[(v + 0) * 40 + d] = (u16)(a.x & 0xffffu); SFT[(v + 1) * 40 + d] = (u16)(a.x >> 16); SFT[(v + 2) * 40 + d] = (u16)(a.y & 0xffffu); SFT[(v + 3) * 40 + d] = (u16)(a.y >> 16);
        SBT[(v + 0) * 40 + d] = (u16)(b.x & 0xffffu); SBT[(v + 1) * 40 + d] = (u16)(b.x >> 16); SBT[(v + 2) * 40 + d] = (u16)(b.y & 0xffffu); SBT[(v + 3) * 40 + d] = (u16)(b.y >> 16); }
    __syncthreads();
    { const int dir = w >> 2; const float* bias = p.tab[dir ? 12 : 10] + l * 128 + h * 32; const LAS float* G = dir ? Gb : Gf; LAS u16* QT = dir ? QB : QF; LAS u16* KT = dir ? KB : KF;
#pragma unroll
        for (int c = 0; c < 8; ++c) { const int d = (w & 3) * 8 + c;
            float g = logsig(G[lane * 33 + d] + bias[d]) * (1.f / 16.f);
            g = dir ? wave_suffix(g, lane) : wave_prefix(g, lane);
            QT[lane * 40 + d] = (u16)f2bf(Qx[lane * 33 + d] * 0.17677669529663687f * __expf(g));
            KT[lane * 40 + d] = (u16)f2bf(Kx[lane * 33 + d] * __expf(-g)); } }
    __syncthreads();
#pragma unroll
    for (int q = 0; q < 2; ++q) { const int id = 2 * w + q, ti = id >> 2, si = id & 3; const f32x4_t z4 = {0.f, 0.f, 0.f, 0.f}; f32x4_t acc;
        if (si < ti) acc = MFMA16(ldfrag(QF, 40, ti * 16, 0, lane), ldfrag(KF, 40, si * 16, 0, lane), z4);
        else if (si > ti) acc = MFMA16(ldfrag(QB, 40, ti * 16, 0, lane), ldfrag(KB, 40, si * 16, 0, lane), z4);
        else { const f32x4_t af = MFMA16(ldfrag(QF, 40, ti * 16, 0, lane), ldfrag(KF, 40, si * 16, 0, lane), z4), ab = MFMA16(ldfrag(QB, 40, ti * 16, 0, lane), ldfrag(KB, 40, si * 16, 0, lane), z4);
#pragma unroll
            for (int j = 0; j < 4; ++j) acc[j] = ((lane & 15) <= 4 * (lane >> 4) + j) ? af[j] : ab[j]; }
#pragma unroll
        for (int j = 0; j < 4; ++j) SC[(ti * 16 + 4 * (lane >> 4) + j) * 72 + si * 16 + (lane & 15)] = (u16)f2bf(acc[j]); }
    __syncthreads();
#pragma unroll
    for (int q = 0; q < 2; ++q) { const int id = 2 * w + q, ti = id >> 2, vi = id & 3; f32x4_t acc = {0.f, 0.f, 0.f, 0.f};
        acc = MFMA16(ldfrag(SC, 72, ti * 16, 0, lane), ldfrag(VT, 72, vi * 16, 0, lane), acc);
        acc = MFMA16(ldfrag(SC, 72, ti * 16, 32, lane), ldfrag(VT, 72, vi * 16, 32, lane), acc);
        acc = MFMA16(ldfrag(QF, 40, ti * 16, 0, lane), ldfrag(SFT, 40, vi * 16, 0, lane), acc);
        acc = MFMA16(ldfrag(QB, 40, ti * 16, 0, lane), ldfrag(SBT, 40, vi * 16, 0, lane), acc);
#pragma unroll
        for (int j = 0; j < 4; ++j) O[(ti * 16 + 4 * (lane >> 4) + j) * 65 + vi * 16 + (lane & 15)] = acc[j]; }
    __syncthreads();
    { const int t = tid >> 3, v8 = (tid & 7) * 8; float acc[8]; float ss = 0.f;
#pragma unroll
        for (int e = 0; e < 8; ++e) { acc[e] = O[t * 65 + v8 + e]; ss += acc[e] * acc[e]; }
        ss += __shfl_xor(ss, 1); ss += __shfl_xor(ss, 2); ss += __shfl_xor(ss, 4);
        const float rstd = 1.f / sqrtf(ss * (1.f / 64.f) + EPSN);
        u16* mz = P1 + (rb + t) * P1P + h * 64 + v8; float zz[8]; unpack8(*(const v4u*)mz, zz);
#pragma unroll
        for (int e = 0; e < 8; ++e) acc[e] = acc[e] * rstd * p.tab[13][l * 64 + v8 + e] * silu_f(zz[e]);
        *(v4u*)mz = pack8(acc); }
    __syncthreads();
}
#define XB_TMO      128
#define XB_XCNT(j)  (256  + 64 * (j))
#define XB_XSUB(j)  (1280 + 64 * (j))
#define XB_XGEN(j)  (2304 + 64 * (j))
#define XB_TOP      3328
#define XB_TOPGEN   3392
#define XCD_BAR_WORDS 3456
#define XB_SPIN_CAP (1u << 18)

__device__ __forceinline__ unsigned xb_ld(unsigned* p)              { return __hip_atomic_load(p, __ATOMIC_RELAXED, __HIP_MEMORY_SCOPE_AGENT); }
__device__ __forceinline__ unsigned xb_add(unsigned* p, unsigned v) { return __hip_atomic_fetch_add(p, v, __ATOMIC_RELAXED, __HIP_MEMORY_SCOPE_AGENT); }
__device__ __forceinline__ unsigned xb_xcc_id() { return (unsigned)__builtin_amdgcn_s_getreg((3 << 11) | 20) & 0xFu; }
#define XB_SPIN(cond, bar) do { unsigned _sp = 0; while (cond) { __builtin_amdgcn_s_sleep(1); \
    if ((++_sp & 255u) == 0u) { if (xb_ld(&(bar)[XB_TMO])) break; if (_sp > XB_SPIN_CAP) { atomicAdd(&(bar)[XB_TMO], 1u); break; } } } } while (0)

struct XcdBarrier {
    unsigned* bar; unsigned x;
    volatile LAS unsigned* st;
};

__device__ __forceinline__ XcdBarrier xcd_barrier_post(unsigned* bar, volatile LAS unsigned* st) {
    XcdBarrier b; b.bar = bar; b.x = xb_xcc_id(); b.st = st;
    if (threadIdx.x == 0) (void)xb_add(&bar[XB_XCNT(b.x)], 1u);
    return b;
}
__device__ __forceinline__ void xcd_barrier_complete(unsigned* bar, unsigned x, unsigned& nloc, unsigned& nx) {
    const unsigned G = gridDim.x * gridDim.y * gridDim.z;
    unsigned sum, cnt, mine, sp = 0u;
    for (;;) {
        sum = 0u; cnt = 0u; mine = 0u;
#pragma unroll
        for (unsigned j = 0; j < 16; ++j) { const unsigned c = xb_ld(&bar[XB_XCNT(j)]); sum += c; cnt += (c > 0u) ? 1u : 0u; mine = (j == x) ? c : mine; }
        if (sum == G) break;
        __builtin_amdgcn_s_sleep(1);
        if ((++sp & 255u) == 0u) { if (xb_ld(&bar[XB_TMO])) break; if (sp > XB_SPIN_CAP) { atomicAdd(&bar[XB_TMO], 1u); break; } }
    }
    nloc = mine > 0u ? mine : 1u; nx = cnt > 0u ? cnt : 1u;
}

__device__ __forceinline__ void xcd_barrier(const XcdBarrier& b) {
    asm volatile("s_waitcnt vmcnt(0)" ::: "memory");
    __syncthreads();
    if (threadIdx.x == 0) {
        unsigned* bar = b.bar;
        __builtin_amdgcn_s_waitcnt(0);
        unsigned nloc = b.st[0], nx = b.st[1];
        if (nloc == 0u) { xcd_barrier_complete(bar, b.x, nloc, nx); b.st[0] = nloc; b.st[1] = nx; }
        const unsigned old = xb_add(&bar[XB_XSUB(b.x)], 1u);
        const unsigned gen = old / nloc;
        if (old + 1u == (gen + 1u) * nloc) {
            __builtin_amdgcn_fence(__ATOMIC_RELEASE, "agent");
            asm volatile("s_waitcnt vmcnt(0)" ::: "memory");
            const unsigned og = xb_add(&bar[XB_TOP], 1u);
            const unsigned tg = og / nx;
            if (og + 1u == (tg + 1u) * nx) xb_add(&bar[XB_TOPGEN], 1u);
            else XB_SPIN(xb_ld(&bar[XB_TOPGEN]) == tg, bar);
            __builtin_amdgcn_fence(__ATOMIC_ACQUIRE, "agent");
            xb_add(&bar[XB_XGEN(b.x)], 1u);
            asm volatile("s_waitcnt vmcnt(0)" ::: "memory");
        } else {
            XB_SPIN(xb_ld(&bar[XB_XGEN(b.x)]) == gen, bar);
            __builtin_amdgcn_fence(__ATOMIC_ACQUIRE, "agent");
            asm volatile("s_waitcnt vmcnt(0)" ::: "memory");
        }
    }
    __syncthreads();
}


#ifndef GM
#define GM 7
#endif
#ifndef PH
#define PH 1023
#endif
__global__ void __launch_bounds__(512, 2) fwd_kernel(Params kp) {
    extern __shared__ __attribute__((aligned(16))) unsigned char lds[];
    cg::grid_group grid = cg::this_grid();
    LAS unsigned char* L = (LAS unsigned char*)lds; LAS float* F = (LAS float*)lds;
    const int G = gridDim.x, bid = blockIdx.x;
    Ctx p; p.out = kp.out; p.ws = kp.ws; p.tab = (LAS cfp*)(L + 131072);
    if (otid() == 0) { p.tab[0] = kp.xp; p.tab[1] = kp.xs; p.tab[2] = kp.cp; p.tab[3] = kp.cs; p.tab[4] = kp.ada_w; p.tab[5] = kp.ada_b; p.tab[6] = kp.pre_g; p.tab[7] = kp.post_g; p.tab[8] = kp.w_in;
        p.tab[9] = kp.wg2f; p.tab[10] = kp.bgf; p.tab[11] = kp.wg2b; p.tab[12] = kp.bgb; p.tab[13] = kp.onorm_g; p.tab[14] = kp.fnet_w; p.tab[15] = kp.qn_g; p.tab[16] = kp.kn_g; p.tab[17] = kp.sgu_ng;
        p.tab[18] = kp.sgu_w; p.tab[19] = kp.sgu_b; p.tab[20] = kp.w_out; }
    volatile LAS unsigned* bst = (volatile LAS unsigned*)(L + 131072 + 256);
    if (otid() < 4) bst[otid()] = 0u;
    __syncthreads();
    const XcdBarrier xbar = xcd_barrier_post((unsigned*)(p.ws + WS_BAR), bst);
    u16* P1 = (u16*)p.out; u16* P2 = (u16*)(p.ws + WS_P2); u16* HB = (u16*)(p.ws + WS_HB); u16* U0 = (u16*)(p.ws + WS_U0);


#if PH & 1
    phase0(p, L);
#endif
    grid.sync();
    for (int step = 0; step < 12; ++step) {
        const int l = step / 6, ph = step % 6;
        bool do_gemm = false; pg8::Gemm g{nullptr, nullptr, T_TOK, 0, 0, 0, 0}; pg8::EpiX E{0, nullptr, 0, nullptr, 0, 0};
        if (ph == 0) {
#if PH & 2
            phaseA(p, l);
#endif
        } else if (ph == 1) {
            g.A = HB; g.Bt = (const u16*)(p.ws + WS_WIN) + (size_t)l * 3584 * 1024; g.N = 3584; g.K = 1024; g.lda = 1024; g.ldb = 1024;
            E.mode = 0; E.O1 = P1; E.ld1 = P1P; E.O2 = P2; E.ld2 = P2P; do_gemm = true;
        } else if (ph == 2) {
#if PH & 4
            qk_prep(p, l);
#endif
#if PH & 8
            for (int it = bid; it < 2048; it += G) gla_local_item(p, l, it, F);
#endif
#if PH & 16
            for (int it = bid; it < 1024; it += G) sgu_item(p, l, it, F);
#endif
#if PH & 32
            for (int it = bid; it < 768; it += G) fnet1_item(p, it, F);
#endif
        } else if (ph == 3) {
#if PH & 64
            for (int it = bid; it < 192; it += G) gla_scan_item(p, it);
#endif
#if PH & 128
            for (int it = bid; it < 512; it += G) fnet2_item(p, it, F);
#endif
            __syncthreads();
#ifndef SKIP_ATTN
            for (int u = ((G & 7) == 0 ? (bid & 7) * (G >> 3) + (bid >> 3) : bid); u < 1024; u += G) {
                int s, h, qb;
                if (u < 512) { s = u >> 7; const int r = u & 127; h = r >> 4; qb = r & 15; } else { const int u2 = u - 512; s = 4 + (u2 >> 8); const int r = u2 & 255; h = r >> 5; qb = r & 31; }
                int row0, N; seq_info(s, row0, N);
                const attn_body::bf16* Pb = (const attn_body::bf16*)P1;
                const attn_body::bf16* KCb = (const attn_body::bf16*)(p.ws + WS_HB + HB_KC) + ((size_t)row0 * 2 + (size_t)(h >> 2) * N) * 64;
                const attn_body::bf16* VCb = (const attn_body::bf16*)(p.ws + WS_HB + HB_VC) + ((size_t)row0 * 2 + (size_t)(h >> 2) * N) * 64;
                attn_body::attn_unit<8>(Pb + (size_t)(row0 + qb * 256) * P1P + P1_Q + h * 64, KCb, VCb,
                                        (attn_body::bf16*)P1 + (size_t)(row0 + qb * 256) * P1P + 512 + h * 64, N >> 6, (char*)lds);
            }
#endif
        } else if (ph == 4) {
#if PH & 256
            for (int it = bid; it < 2048; it += G) gla_out_item(p, l, it, F);
#endif
            g.A = P2 + P2_U; g.Bt = (const u16*)(p.ws + WS_WF) + (size_t)l * 131072; g.N = 256; g.K = 512; g.lda = P2P; g.ldb = 512;
            E.mode = 2; E.O1 = P1; E.ld1 = P1P; E.col_off = 256; do_gemm = true;
        } else {
            g.A = P1; g.Bt = (const u16*)(p.ws + WS_WOUT) + (size_t)l * 1024 * 1280; g.N = 1024; g.K = 1280; g.lda = P1P; g.ldb = 1280;
            E.mode = 1; E.O1 = (l == 0) ? U0 : HB; E.ld1 = 1024; do_gemm = true;
        }
#if GM
        if (do_gemm) { pg8::StaticOrder S; S.init(T_TOK, g.N, G, bid); pg8::gemm_phase<pg8::EpiX, pg8::StaticOrder, PG8_ALIGN, PG8_SP2>(L, g, S, E); }
#endif
        xcd_barrier(xbar);
    }
#if PH & 2
    phaseA(p, 2);
#endif
}

extern "C" void kernel_launch(void* const* d_in, const int* in_sizes, int n_in, void* d_out, int out_size, void* d_ws, size_t ws_size, hipStream_t stream) {
    static int grid = 0;
    if (grid == 0) {
        if (n_in != 21 || out_size != T_TOK * 1024 || ws_size < WS_END) { fprintf(stderr, "kernel_launch: unexpected sizes n_in %d out %d ws %zu\n", n_in, out_size, ws_size); grid = -1; return; }
        int dev = 0, cus = 0, per_cu = 0;
        (void)hipGetDevice(&dev); (void)hipDeviceGetAttribute(&cus, hipDeviceAttributeMultiprocessorCount, dev);
        if (hipFuncSetAttribute((const void*)fwd_kernel, hipFuncAttributeMaxDynamicSharedMemorySize, LDS_BYTES) != hipSuccess) { fprintf(stderr, "kernel_launch: hipFuncSetAttribute failed\n"); grid = -1; return; }
        if (hipOccupancyMaxActiveBlocksPerMultiprocessor(&per_cu, (const void*)fwd_kernel, 512, LDS_BYTES) != hipSuccess || per_cu < 1) { fprintf(stderr, "kernel_launch: occupancy query gave %d\n", per_cu); per_cu = 1; }
        (void)hipGetLastError();
        grid = cus * 1;
        fprintf(stderr, "kernel_launch: grid %d (per_cu %d) ws %zu\n", grid, per_cu, ws_size);
    }
    if (grid < 0) return;
    Params p{};
    const float** pp = (const float**)&p;
    for (int i = 0; i < 21; ++i) pp[i] = (const float*)d_in[i];
    p.out = (float*)d_out; p.ws = (unsigned char*)d_ws;
    if (hipMemsetAsync((char*)d_ws + WS_BAR, 0, BAR_BYTES, stream) != hipSuccess) { fprintf(stderr, "kernel_launch: memset failed\n"); return; }
    void* args[] = {&p};
    hipError_t e = hipLaunchCooperativeKernel((const void*)fwd_kernel, dim3(grid), dim3(512), args, LDS_BYTES, stream);
    if (e != hipSuccess) fprintf(stderr, "cooperative launch failed: %s (grid %d)\n", hipGetErrorString(e), grid);
}
```

```cpp
#include <hip/hip_runtime.h>
#include <hip/hip_cooperative_groups.h>
#include <cstdio>
#include <cstdint>
namespace cg = cooperative_groups;
__device__ __forceinline__ int otid() { int t = threadIdx.x; asm volatile("" : "+v"(t)); return t; }
namespace pg8 {
#define PG8_LAS __attribute__((address_space(3)))
typedef unsigned short bf16_t;
typedef short bf16x8 __attribute__((ext_vector_type(8)));
typedef float f32x4 __attribute__((ext_vector_type(4)));
typedef unsigned u32x4 __attribute__((ext_vector_type(4)));
constexpr int BM = 256, BK = 64, HALF = 128, HTB = HALF * BK * 2  , STAGE_BYTES = 8 * HTB, NXCD = 8, WGM = 8;

__host__ __device__ __forceinline__ int lds_byte(int r, int c) { const int st = (r >> 4) * 2 + (c >> 5), rr = r & 15, cc = c & 31, ob = rr * 64 + cc * 2; return st * 1024 + (ob ^ (((ob >> 9) & 1) << 5)); }
__host__ __device__ __forceinline__ void stage_rc(int b, int& R, int& C) { const int st = b / 1024, sb = b % 1024, swz = sb ^ (((sb >> 9) & 1) << 5); R = (st >> 1) * 16 + swz / 64; C = (st & 1) * 32 + (swz % 64) / 2; }
__host__ __device__ __forceinline__ int perm32(int rho) { const int n = rho >> 4, i = rho & 15; return 8 * (i >> 2) + 4 * n + (i & 3); }

struct Unit { int pm, pn; };
struct Gemm { const bf16_t* A; const bf16_t* Bt; int M, N, K, lda, ldb; };

struct StaticOrder {
    int nM, nN, nwg, G, c;
    __host__ __device__ void init(int M, int N, int G_, int c_) { nM = M / BM; nN = N / BM; nwg = nM * nN; G = G_; c = c_; }
    __host__ __device__ bool next(int i, Unit& u) const {
        const long L = (long)i * G + c; if (L >= nwg) return false;
        int wgid = (int)L; { const int q = nwg / NXCD, r = nwg % NXCD, xcd = wgid % NXCD, off = wgid / NXCD; wgid = (xcd < r ? xcd * (q + 1) : r * (q + 1) + (xcd - r) * q) + off; }
        const int nig = WGM * nN, gid = wgid / nig, fm = gid * WGM, gsz = (nM - fm) < WGM ? (nM - fm) : WGM;
        u.pm = fm + ((wgid % nig) % gsz); u.pn = (wgid % nig) / gsz; return true;
    }
    __device__ __forceinline__ void a_ready(const Unit&) const {}
    __device__ __forceinline__ void done(const Unit&) const {}
};

__device__ __forceinline__ unsigned cvt_pk_bf16(float lo, float hi) { unsigned r; asm volatile("v_cvt_pk_bf16_f32 %0, %1, %2" : "=v"(r) : "v"(lo), "v"(hi)); return r; }
__device__ __forceinline__ float silu_f(float z) { return z / (1.f + __expf(-z)); }
struct EpiX {
    static constexpr bool PERM = true, AFTER_DRAIN = false;
    int mode; bf16_t* O1; int ld1; bf16_t* O2; int ld2; int col_off;
    __device__ __forceinline__ void operator()(const f32x4 (&acc)[2][2][4][2], const Unit& u, int wr, int wc, int fr, int fq) const {
        const int row0 = u.pm * BM + wr * 64 + fr;
        bf16_t* base; int ld, colt;
        if (mode == 0) { if (u.pn < 8) { base = O1; ld = ld1; colt = u.pn * BM; } else { base = O2; ld = ld2; colt = (u.pn - 8) * BM; } }
        else { base = O1; ld = ld1; colt = col_off + u.pn * BM; }
        const int col0 = colt + wc * 32 + 8 * fq;
#pragma unroll
        for (int ai = 0; ai < 2; ++ai)
#pragma unroll
            for (int m = 0; m < 4; ++m) { bf16_t* rowp = base + (size_t)(row0 + ai * HALF + m * 16) * ld + col0;
#pragma unroll
                for (int bj = 0; bj < 2; ++bj) { f32x4 v0 = acc[ai][bj][m][0], v1 = acc[ai][bj][m][1];
                    if (mode == 2) { const u32x4 z = *(const u32x4*)(rowp + bj * HALF);
                        v0[0] *= silu_f(__uint_as_float(z.x << 16)); v0[1] *= silu_f(__uint_as_float(z.x & 0xffff0000u));
                        v0[2] *= silu_f(__uint_as_float(z.y << 16)); v0[3] *= silu_f(__uint_as_float(z.y & 0xffff0000u));
                        v1[0] *= silu_f(__uint_as_float(z.z << 16)); v1[1] *= silu_f(__uint_as_float(z.z & 0xffff0000u));
                        v1[2] *= silu_f(__uint_as_float(z.w << 16)); v1[3] *= silu_f(__uint_as_float(z.w & 0xffff0000u)); }
                    u32x4 w; w.x = cvt_pk_bf16(v0[0], v0[1]); w.y = cvt_pk_bf16(v0[2], v0[3]); w.z = cvt_pk_bf16(v1[0], v1[1]); w.w = cvt_pk_bf16(v1[2], v1[3]);
                    *(u32x4*)(rowp + bj * HALF) = w; } }
    }
};
#ifndef PG8_SP2
#define PG8_SP2 true
#endif
#ifndef PG8_ALIGN
#define PG8_ALIGN true
#endif
template <class Epi, class Sched, bool ALIGN_EPI = false, bool SP2 = false>
__device__ __forceinline__ void gemm_phase(PG8_LAS unsigned char* lds, const Gemm g, const Sched& S, const Epi& E) {
    const int tid = otid(), wid = __builtin_amdgcn_readfirstlane(tid >> 6), lane = tid & 63, wr = wid >> 2, wc = wid & 3, fr = lane & 15, fq = lane >> 4;
    const int K = g.K, nt = K / BK;
    unsigned voffA[2], voffB[2];
#pragma unroll
    for (int i = 0; i < 2; ++i) { int R, C; stage_rc(tid * 16 + i * 8192, R, C); const int Rb = Epi::PERM ? ((R & ~31) + perm32(R & 31)) : R;
        voffA[i] = (unsigned)(R * g.lda + C) * 2u; voffB[i] = (unsigned)(Rb * g.ldb + C) * 2u; }
    const size_t kstep = (size_t)(BK * 2);
    const size_t hstepA = (size_t)HALF * g.lda * 2, hstepB = (size_t)HALF * g.ldb * 2;
    const size_t tstepA = 2 * hstepA, tstepB = 2 * hstepB;
    const unsigned ldsw = (unsigned)wid * 1024u;
    const int aoff = lds_byte(wr * 64 + fr, fq * 8), boff = lds_byte(wc * 32 + fr, fq * 8);
#define PG8_SA(b, h) (((b) * 2 + (h)) * HTB)
#define PG8_SB(b, h) ((4 + (b) * 2 + (h)) * HTB)
#define PG8_STAGE(bufoff, gbase, voff) do { _Pragma("unroll") for (int _i = 0; _i < 2; ++_i) \
        __builtin_amdgcn_global_load_lds((const unsigned*)((const char*)(gbase) + (voff)[_i]), (PG8_LAS unsigned*)(lds + (bufoff) + ldsw + _i * 8192), 16, 0, 0); } while (0)
#define PG8_LDA(dst, b, h) do { _Pragma("unroll") for (int m = 0; m < 4; ++m) _Pragma("unroll") for (int k = 0; k < 2; ++k) dst[m][k] = *(const PG8_LAS bf16x8*)(lds + PG8_SA(b, h) + aoff + m * 2048 + k * 1024); } while (0)
#define PG8_LDB(dst, b, h) do { _Pragma("unroll") for (int n = 0; n < 2; ++n) _Pragma("unroll") for (int k = 0; k < 2; ++k) dst[n][k] = *(const PG8_LAS bf16x8*)(lds + PG8_SB(b, h) + boff + n * 2048 + k * 1024); } while (0)
#define PG8_MMA(ai, bj, At, Bt) do { __builtin_amdgcn_s_setprio(1); _Pragma("unroll") for (int m = 0; m < 4; ++m) _Pragma("unroll") for (int n = 0; n < 2; ++n) _Pragma("unroll") for (int k = 0; k < 2; ++k) \
        acc[ai][bj][m][n] = __builtin_amdgcn_mfma_f32_16x16x32_bf16(Bt[n][k], At[m][k], acc[ai][bj][m][n], 0, 0, 0); __builtin_amdgcn_s_setprio(0); } while (0)
#define PG8_WAIT_V(n) asm volatile("s_waitcnt vmcnt(" #n ")" ::: "memory")
#define PG8_WAIT_L(n) asm volatile("s_waitcnt lgkmcnt(" #n ")" ::: "memory")
#define PG8_BAR __builtin_amdgcn_s_barrier()
#define PG8_SCHED __builtin_amdgcn_sched_barrier(0)
    Unit cur, nxt; int ui = 0;
    if (!S.next(0, cur)) return;
    f32x4 acc[2][2][4][2];
#pragma unroll
    for (int a = 0; a < 2; ++a)
#pragma unroll
        for (int b = 0; b < 2; ++b)
#pragma unroll
            for (int m = 0; m < 4; ++m)
#pragma unroll
                for (int n = 0; n < 2; ++n) acc[a][b][m][n] = (f32x4){0.f, 0.f, 0.f, 0.f};
    bf16x8 At[4][2], B0[2][2], B1[2][2];
    const char* cA = (const char*)g.A + (size_t)cur.pm * tstepA; const char* cB = (const char*)g.Bt + (size_t)cur.pn * tstepB;
    S.a_ready(cur);
    if constexpr (SP2) {
        PG8_STAGE(PG8_SB(0, 0), cB, voffB); PG8_STAGE(PG8_SB(0, 1), cB + hstepB, voffB); PG8_STAGE(PG8_SA(0, 0), cA, voffA); PG8_STAGE(PG8_SA(0, 1), cA + hstepA, voffA);
        if (wr == 1) PG8_BAR;
        PG8_WAIT_V(2); PG8_BAR;
        PG8_STAGE(PG8_SB(1, 0), cB + kstep, voffB); PG8_STAGE(PG8_SA(1, 0), cA + kstep, voffA); PG8_STAGE(PG8_SB(1, 1), cB + hstepB + kstep, voffB);
        PG8_WAIT_V(6); PG8_BAR;
    } else {
        PG8_STAGE(PG8_SB(0, 0), cB, voffB); PG8_STAGE(PG8_SA(0, 0), cA, voffA); PG8_STAGE(PG8_SB(0, 1), cB + hstepB, voffB); PG8_STAGE(PG8_SA(0, 1), cA + hstepA, voffA);
        if (wr == 1) PG8_BAR;
        PG8_WAIT_V(4); PG8_BAR;
        PG8_STAGE(PG8_SB(1, 0), cB + kstep, voffB); PG8_STAGE(PG8_SA(1, 0), cA + kstep, voffA); PG8_STAGE(PG8_SB(1, 1), cB + hstepB + kstep, voffB);
        PG8_WAIT_V(6); PG8_BAR;
    }
    for (;;) {
        const bool has_next = S.next(ui + 1, nxt);
        const char* nA = has_next ? (const char*)g.A + (size_t)nxt.pm * tstepA : cA; const char* nB = has_next ? (const char*)g.Bt + (size_t)nxt.pn * tstepB : cB;
        for (int t = 0; t < nt; t += 2) {
            const bool last = (t == nt - 2);
            const char* a1 = cA + (size_t)(t + 1) * kstep;
            const char* a2 = last ? nA : cA + (size_t)(t + 2) * kstep; const char* b2 = last ? nB : cB + (size_t)(t + 2) * kstep;
            const char* a3 = a2 + kstep; const char* b3 = b2 + kstep;
            if (last && has_next) S.a_ready(nxt);
            if constexpr (SP2) {
            PG8_LDB(B0, 0, 0); PG8_LDB(B1, 0, 1); PG8_SCHED; PG8_LDA(At, 0, 0); PG8_STAGE(PG8_SA(1, 1), a1 + hstepA, voffA);
            PG8_WAIT_V(8); PG8_WAIT_L(0); PG8_BAR; PG8_MMA(0, 0, At, B0); PG8_MMA(0, 1, At, B1); PG8_BAR; PG8_SCHED;
            PG8_LDA(At, 0, 1); PG8_STAGE(PG8_SB(0, 0), b2, voffB); PG8_STAGE(PG8_SB(0, 1), b2 + hstepB, voffB); PG8_STAGE(PG8_SA(0, 0), a2, voffA);
            PG8_WAIT_V(8); PG8_WAIT_L(0); PG8_BAR; PG8_MMA(1, 0, At, B0); PG8_MMA(1, 1, At, B1); PG8_BAR; PG8_SCHED;
            PG8_LDB(B0, 1, 0); PG8_LDB(B1, 1, 1); PG8_SCHED; PG8_LDA(At, 1, 0); PG8_STAGE(PG8_SA(0, 1), a2 + hstepA, voffA);
            PG8_WAIT_V(8); PG8_WAIT_L(0); PG8_BAR; PG8_MMA(0, 0, At, B0); PG8_MMA(0, 1, At, B1); PG8_BAR; PG8_SCHED;
            PG8_LDA(At, 1, 1); PG8_STAGE(PG8_SB(1, 0), b3, voffB); PG8_STAGE(PG8_SB(1, 1), b3 + hstepB, voffB); PG8_STAGE(PG8_SA(1, 0), a3, voffA);
            PG8_WAIT_V(8); PG8_WAIT_L(0); PG8_BAR; PG8_MMA(1, 0, At, B0); PG8_MMA(1, 1, At, B1); PG8_BAR; PG8_SCHED;
            } else {
            PG8_LDB(B0, 0, 0); PG8_SCHED; PG8_LDA(At, 0, 0); PG8_STAGE(PG8_SA(1, 1), a1 + hstepA, voffA);
            PG8_WAIT_L(8); PG8_BAR; PG8_WAIT_L(0); PG8_MMA(0, 0, At, B0); PG8_BAR; PG8_SCHED;
            PG8_LDB(B1, 0, 1); PG8_STAGE(PG8_SB(0, 0), b2, voffB);
            PG8_BAR; PG8_WAIT_L(0); PG8_MMA(0, 1, At, B1); PG8_BAR;
            PG8_LDA(At, 0, 1); PG8_STAGE(PG8_SA(0, 0), a2, voffA);
            PG8_BAR; PG8_WAIT_L(0); PG8_MMA(1, 0, At, B0); PG8_BAR; PG8_SCHED;
            PG8_STAGE(PG8_SB(0, 1), b2 + hstepB, voffB);
            PG8_WAIT_V(6); PG8_BAR; PG8_MMA(1, 1, At, B1); PG8_BAR;
            PG8_LDB(B0, 1, 0); PG8_SCHED; PG8_LDA(At, 1, 0); PG8_STAGE(PG8_SA(0, 1), a2 + hstepA, voffA);
            PG8_WAIT_L(8); PG8_BAR; PG8_WAIT_L(0); PG8_MMA(0, 0, At, B0); PG8_BAR; PG8_SCHED;
            PG8_LDB(B1, 1, 1); PG8_STAGE(PG8_SB(1, 0), b3, voffB);
            PG8_BAR; PG8_WAIT_L(0); PG8_MMA(0, 1, At, B1); PG8_BAR;
            PG8_LDA(At, 1, 1); PG8_STAGE(PG8_SA(1, 0), a3, voffA);
            PG8_BAR; PG8_WAIT_L(0); PG8_MMA(1, 0, At, B0); PG8_BAR; PG8_SCHED;
            PG8_STAGE(PG8_SB(1, 1), b3 + hstepB, voffB);
            PG8_WAIT_V(6); PG8_BAR; PG8_MMA(1, 1, At, B1); PG8_BAR;
            }
        }
        if constexpr (ALIGN_EPI) { if (wr == 0) PG8_BAR; }
        if constexpr (!Epi::AFTER_DRAIN) { E(acc, cur, wr, wc, fr, fq); S.done(cur); }
        if (!has_next) break;
#pragma unroll
        for (int a = 0; a < 2; ++a)
#pragma unroll
            for (int b = 0; b < 2; ++b)
#pragma unroll
                for (int m = 0; m < 4; ++m)
#pragma unroll
                    for (int n = 0; n < 2; ++n) acc[a][b][m][n] = (f32x4){0.f, 0.f, 0.f, 0.f};
        cur = nxt; cA = nA; cB = nB; ++ui;
        if constexpr (ALIGN_EPI) { if (wr == 1) PG8_BAR; }
    }
    PG8_WAIT_V(0);
    if constexpr (!ALIGN_EPI) { if (wr == 0) PG8_BAR; }
    PG8_BAR;
    if constexpr (Epi::AFTER_DRAIN) { E.fused(acc, cur, wr, wc, fr, fq, lds, wid, lane); S.done(cur); }
#undef PG8_SA
#undef PG8_SB
#undef PG8_STAGE
#undef PG8_LDA
#undef PG8_LDB
#undef PG8_MMA
#undef PG8_WAIT_V
#undef PG8_WAIT_L
#undef PG8_BAR
#undef PG8_SCHED
}
}
#include <hip/hip_bf16.h>
#include <cmath>
namespace attn_body {
using bf16=__hip_bfloat16;
using bf16x8=__attribute__((ext_vector_type(8)))short;
using s16x4=__attribute__((ext_vector_type(4)))short;
using f32x16=__attribute__((ext_vector_type(16)))float;
using u32x4=__attribute__((ext_vector_type(4)))unsigned;
constexpr int D=64,DM=2048,KDM=64;
constexpr int NW=8,QBLK=32,QB=QBLK*NW,KVBLK=64;
constexpr int ATTN_PITCH=DM, ATTN_UNIT_ROWS=QB;
__device__ __forceinline__ int crow(int r,int hi){return (r&3)+8*(r>>2)+4*hi;}
#define SBAR() __builtin_amdgcn_sched_barrier(0)
__device__ __forceinline__ void cmask(f32x16&p0,f32x16&p1,int jb,int qrel,int hi){
  const float NEG=-INFINITY; int kb=64*jb+4*hi;
  #pragma unroll
  for(int r=0;r<16;++r){int kv=kb+(r&3)+8*(r>>2); if(kv>qrel)p0[r]=NEG; if(kv+32>qrel)p1[r]=NEG;}
}

constexpr int NSLOT=3, SLOTB=8192;
constexpr int LDS_K=0, LDS_V=NSLOT*SLOTB, LDS_WS=2*NSLOT*SLOTB, LDS_OST=LDS_WS+NW*64*4, LDS_BYTES=LDS_OST+NW*4096;
constexpr float C2=0.125f*1.4426950408889634f;
__device__ __forceinline__ void glds16(const void*gsrc,unsigned lds_dst){unsigned keep;
  asm volatile("s_mov_b32 %0, m0\n\ts_mov_b32 m0, %2\n\ts_nop 0\n\tglobal_load_lds_dwordx4 %1, off\n\ts_mov_b32 m0, %0":"=&s"(keep):"v"(gsrc),"s"(lds_dst):"memory");}
__device__ __forceinline__ float max3f(float a,float b,float c){float r;asm("v_max3_f32 %0, %1, %2, %3":"=v"(r):"v"(a),"v"(b),"v"(c));return r;}
__device__ __forceinline__ float max2f(float a,float b){float r;asm("v_max_f32_e32 %0, %1, %2":"=v"(r):"v"(a),"v"(b));return r;}
__device__ __forceinline__ float fadd_s(float a,float b){float r;asm("v_add_f32_e32 %0, %1, %2":"=v"(r):"v"(a),"v"(b));return r;}
__device__ __forceinline__ float fsub_s(float a,float b){float r;asm("v_sub_f32_e32 %0, %1, %2":"=v"(r):"v"(a),"v"(b));return r;}
typedef float f32x2_t __attribute__((ext_vector_type(2))); typedef __bf16 bf16x2_t __attribute__((ext_vector_type(2)));
__device__ __forceinline__ unsigned cvtpk_s(float lo,float hi){f32x2_t v={lo,hi};bf16x2_t b=__builtin_convertvector(v,bf16x2_t);return __builtin_bit_cast(unsigned,b);}
#define WAIT_BAR(N) asm volatile("s_waitcnt vmcnt(" #N ") lgkmcnt(0)\n\ts_barrier":::"memory")

__device__ __forceinline__ void qkt(f32x16&p0,f32x16&p1,const char*Kslot,const bf16x8*qr,const f32x16&negm,int r32,int hi){
  const char*kb=Kslot+hi*1024+r32*16;
  #pragma unroll
  for(int d0=0;d0<4;++d0){
    const bf16x8 b0=*reinterpret_cast<const bf16x8*>(kb+d0*2048);
    const bf16x8 b1=*reinterpret_cast<const bf16x8*>(kb+d0*2048+512);
    if(d0==0){p0=__builtin_amdgcn_mfma_f32_32x32x16_bf16(b0,qr[0],negm,0,0,0);p1=__builtin_amdgcn_mfma_f32_32x32x16_bf16(b1,qr[0],negm,0,0,0);}
    else{p0=__builtin_amdgcn_mfma_f32_32x32x16_bf16(b0,qr[d0],p0,0,0,0);p1=__builtin_amdgcn_mfma_f32_32x32x16_bf16(b1,qr[d0],p1,0,0,0);}}
}
typedef __attribute__((address_space(3))) const char* lds_cptr;
typedef short v4i16_t __attribute__((ext_vector_type(4)));
__device__ __forceinline__ void kload8(bf16x8*kf,lds_cptr kp){
  kf[0]=*(const __attribute__((address_space(3))) bf16x8*)(kp);      kf[1]=*(const __attribute__((address_space(3))) bf16x8*)(kp+512);
  kf[2]=*(const __attribute__((address_space(3))) bf16x8*)(kp+2048); kf[3]=*(const __attribute__((address_space(3))) bf16x8*)(kp+2560);
  kf[4]=*(const __attribute__((address_space(3))) bf16x8*)(kp+4096); kf[5]=*(const __attribute__((address_space(3))) bf16x8*)(kp+4608);
  kf[6]=*(const __attribute__((address_space(3))) bf16x8*)(kp+6144); kf[7]=*(const __attribute__((address_space(3))) bf16x8*)(kp+6656);
}
__device__ __forceinline__ void kload2(bf16x8*kf,lds_cptr kp,int j){ kf[2*j]=*(const __attribute__((address_space(3))) bf16x8*)(kp+j*2048); kf[2*j+1]=*(const __attribute__((address_space(3))) bf16x8*)(kp+j*2048+512); }
__device__ __forceinline__ s16x4 vtr(lds_cptr p){ return __builtin_bit_cast(s16x4,__builtin_amdgcn_ds_read_tr16_b64_v4i16((__attribute__((address_space(3))) v4i16_t*)p)); }
__device__ __forceinline__ float rowmax(const f32x16&p0,const f32x16&p1){
  float a=max3f(p0[0],p0[1],p1[0]),b=max3f(p0[2],p0[3],p1[1]);a=max3f(a,p1[2],p1[3]);
  #pragma unroll
  for(int r=4;r<16;r+=4){a=max3f(a,p0[r],p0[r+1]);b=max3f(b,p0[r+2],p0[r+3]);a=max3f(a,p1[r],p1[r+1]);b=max3f(b,p1[r+2],p1[r+3]);}
  const float m=max2f(a,b);
  auto rr=__builtin_amdgcn_permlane32_swap(__float_as_uint(m),__float_as_uint(m),false,false);
  return max2f(__uint_as_float(rr[0]),__uint_as_float(rr[1]));
}
__device__ __forceinline__ void pv(f32x16*o,int vb,bf16x8 pa0,bf16x8 pa1,bf16x8 pa2,bf16x8 pa3){
  #pragma unroll
  for(int d0=0;d0<2;++d0){s16x4 lo[4],hi[4];
    #pragma unroll
    for(int ks=0;ks<4;++ks){
      asm volatile("ds_read_b64_tr_b16 %0,%1 offset:%c2":"=&v"(lo[ks]):"v"(vb),"i"(d0*4096+ks*1024):"memory");
      asm volatile("ds_read_b64_tr_b16 %0,%1 offset:%c2":"=&v"(hi[ks]):"v"(vb),"i"(d0*4096+ks*1024+512):"memory");}
    asm volatile("s_waitcnt lgkmcnt(0)":::"memory");SBAR();
    #define PK(k) (bf16x8){lo[k][0],lo[k][1],lo[k][2],lo[k][3],hi[k][0],hi[k][1],hi[k][2],hi[k][3]}
    o[d0]=__builtin_amdgcn_mfma_f32_32x32x16_bf16(pa0,PK(0),o[d0],0,0,0);
    o[d0]=__builtin_amdgcn_mfma_f32_32x32x16_bf16(pa1,PK(1),o[d0],0,0,0);
    o[d0]=__builtin_amdgcn_mfma_f32_32x32x16_bf16(pa2,PK(2),o[d0],0,0,0);
    o[d0]=__builtin_amdgcn_mfma_f32_32x32x16_bf16(pa3,PK(3),o[d0],0,0,0);
    #undef PK
  }
}

#ifndef ATTN_STORE16
#define ATTN_STORE16(p,v) (*(u32x4*)(p)=(v))
#endif
template<int THRL> __device__ __forceinline__ void attn_unit(const bf16*Qblk,const bf16*__restrict__ Kh,const bf16*__restrict__ Vh,bf16*Oblk,const int NT,char*shm){
  const int tid=otid(),lane=tid&63,r32=lane&31,hi=lane>>5; const int wid=__builtin_amdgcn_readfirstlane(tid>>6);
  const bf16*Qw=Qblk+(long)wid*QBLK*DM;
  const unsigned lds0=(unsigned)(uintptr_t)shm;
  float*wsf=(float*)(shm+LDS_WS)+wid*64;
  const bf16*ksrc=Kh+(long)lane*KDM+wid*8;
  const bf16*vsrc=Vh+(long)(16*(wid&3)+(lane>>2))*KDM+(wid>>2)*32+(lane&3)*8;
  const unsigned kdst=lds0+LDS_K+wid*1024, vdst=lds0+LDS_V+wid*1024;
  #define DMA_K(t,slot) glds16(ksrc+(long)(t)*KVBLK*KDM,(unsigned)__builtin_amdgcn_readfirstlane(kdst+(slot)))
  #define DMA_V(t,slot) glds16(vsrc+(long)(t)*KVBLK*KDM,(unsigned)__builtin_amdgcn_readfirstlane(vdst+(slot)))
  const int vb0=(int)(lds0+LDS_V)+((lane>>4)&1)*32+(lane&3)*8+(4*hi+((lane&15)>>2))*64;
  const char*Kbase=shm+LDS_K; bf16x8 kf[8];
  const lds_cptr shm3=(lds_cptr)shm; const lds_cptr kp0=shm3+LDS_K+hi*1024+r32*16; const lds_cptr vp0=shm3+LDS_V+((lane>>4)&1)*32+(lane&3)*8+(4*hi+((lane&15)>>2))*64;
  DMA_K(0,0);DMA_V(0,0);DMA_K(1,SLOTB);
  bf16x8 qr[4];
  #pragma unroll
  for(int d0=0;d0<4;++d0)qr[d0]=*reinterpret_cast<const bf16x8*>(&Qw[(long)r32*DM+d0*16+hi*8]);
  float mhat=0.f,l_reg=0.f;f32x16 o[2];o[0]=f32x16{};o[1]=f32x16{};f32x16 negm=f32x16{};asm volatile("":"+v"(negm));
  #define CMASK(P0,P1,t) do{}while(0)
  bool resc=false;
  #define START(P0,P1) do{ const float rm=rowmax(P0,P1); resc=false; \
    { const float dl=rm; mhat=fadd_s(mhat,dl); \
      _Pragma("unroll") for(int r=0;r<16;++r){P0[r]=fsub_s(P0[r],dl);P1[r]=fsub_s(P1[r],dl);} \
      _Pragma("unroll") for(int r=0;r<16;++r)negm[r]=-mhat; asm volatile("":"+v"(negm)); } \
    _Pragma("unroll") for(int r=0;r<16;++r)P0[r]=__builtin_amdgcn_exp2f(P0[r]); }while(0)
  #define RESC() do{ if(resc){ asm volatile("s_waitcnt lgkmcnt(0)":::"memory"); \
      _Pragma("unroll") for(int d_=0;d_<2;++d_) _Pragma("unroll") for(int r=0;r<16;++r)o[d_][r]*=wsf[crow(r,hi)]; } }while(0)
  f32x16 pA0,pA1,pB0,pB1;
  int sl_prev=0,sl_cur=0,sl_next=SLOTB;
  #define ROT() do{sl_prev=sl_cur;sl_cur=sl_next;sl_next=(sl_next==(NSLOT-1)*SLOTB)?0:sl_next+SLOTB;}while(0)
  DMA_K(2,2*SLOTB);
  WAIT_BAR(3);
  qkt(pA0,pA1,Kbase,qr,negm,r32,hi);asm volatile("s_nop 15\n\ts_nop 7":"+v"(pA0),"+v"(pA1));CMASK(pA0,pA1,0);
  START(pA0,pA1);
  _Pragma("unroll") for(int r=0;r<16;++r)pA1[r]=__builtin_amdgcn_exp2f(pA1[r]);
  WAIT_BAR(0);
  DMA_K(3,0);DMA_V(1,SLOTB);
  ROT();
  kload8(kf,kp0+sl_cur);
  WAIT_BAR(2);
  s16x4 vlo[8],vhi[8]; u32x4 pw0,pw1,pw2,pw3;
  #define PKW(P,B) cvtpk_s(P[B],P[B+1])
  #define PAF(k) __builtin_bit_cast(bf16x8,pw##k)
  #define VFR(i) (bf16x8){vlo[i][0],vlo[i][1],vlo[i][2],vlo[i][3],vhi[i][0],vhi[i][1],vhi[i][2],vhi[i][3]}
  #define PIN(x) asm volatile("":"+v"(x))
  #define MX3(a,b,c) __builtin_fmaxf(__builtin_fmaxf((a),(b)),(c))
  #define GAPA(MF,A0,A1,A2,A3,W0,W1,PW) do{ MF; sacc+=A0; sacc+=A1; sacc+=A2; sacc+=A3; PIN(sacc); W0; W1; PIN(PW); SBAR(); }while(0)
  #define EX(v) __builtin_amdgcn_exp2f(v)
  #define GAPB(MF,X,B) do{ MF; X[B]=EX(X[B]); X[B+1]=EX(X[B+1]); X[B+2]=EX(X[B+2]); X[B+3]=EX(X[B+3]); PIN(X); SBAR(); }while(0)
  #define VRD(i) do{ vlo[i]=vtr(vp_+(((i)>>2)*4096+((i)&3)*1024)); vhi[i]=vtr(vp_+(((i)>>2)*4096+((i)&3)*1024+512)); }while(0)
  #define KRD(G,j) do{ if(G){ kload2(kf,kp0+sl_next,j); SBAR(); } }while(0)
  #define STEP(C0,C1,P0,P1,t,GK,GV,GL) do{ SBAR(); \
    const lds_cptr vp_=vp0+sl_prev; \
    VRD(0); SBAR(); float sacc=(P0[0]+P0[1]); \
    GAPA(C0=__builtin_amdgcn_mfma_f32_32x32x16_bf16(kf[0],qr[0],negm,0,0,0), P0[2],P0[3],P0[4],P0[5],     pw0[0]=PKW(P0,0), pw0[1]=PKW(P0,2), pw0); \
    VRD(4); SBAR(); GAPA(C1=__builtin_amdgcn_mfma_f32_32x32x16_bf16(kf[1],qr[0],negm,0,0,0), P0[6],P0[7],P0[8],P0[9],     pw0[2]=PKW(P0,4), pw0[3]=PKW(P0,6), pw0); \
    VRD(1); SBAR(); GAPA(C0=__builtin_amdgcn_mfma_f32_32x32x16_bf16(kf[2],qr[1],C0,0,0,0),   P0[10],P0[11],P0[12],P0[13], pw1[0]=PKW(P0,8), pw1[1]=PKW(P0,10), pw1); \
    VRD(5); SBAR(); GAPA(C1=__builtin_amdgcn_mfma_f32_32x32x16_bf16(kf[3],qr[1],C1,0,0,0),   P0[14],P0[15],P1[0],P1[1],   pw1[2]=PKW(P0,12),pw1[3]=PKW(P0,14), pw1); \
    VRD(2); SBAR(); GAPA(C0=__builtin_amdgcn_mfma_f32_32x32x16_bf16(kf[4],qr[2],C0,0,0,0),   P1[2],P1[3],P1[4],P1[5],     pw2[0]=PKW(P1,0), pw2[1]=PKW(P1,2), pw2); \
    VRD(6); SBAR(); GAPA(C1=__builtin_amdgcn_mfma_f32_32x32x16_bf16(kf[5],qr[2],C1,0,0,0),   P1[6],P1[7],P1[8],P1[9],     pw2[2]=PKW(P1,4), pw2[3]=PKW(P1,6), pw2); \
    VRD(3); SBAR(); GAPA(C0=__builtin_amdgcn_mfma_f32_32x32x16_bf16(kf[6],qr[3],C0,0,0,0),   P1[10],P1[11],P1[12],P1[13], pw3[0]=PKW(P1,8), pw3[1]=PKW(P1,10), pw3); \
    VRD(7); SBAR(); GAPA(C1=__builtin_amdgcn_mfma_f32_32x32x16_bf16(kf[7],qr[3],C1,0,0,0),   P1[14],P1[15],0.f,0.f,       pw3[2]=PKW(P1,12),pw3[3]=PKW(P1,14), pw3); \
    l_reg+=sacc; \
    if(GK){DMA_K((t)+3,sl_cur);} if(GV){DMA_V((t)+1,sl_next);} \
    CMASK(C0,C1,t); \
    { float a=MX3(C0[0],C0[1],C1[0]),b=MX3(C0[2],C0[3],C1[1]); a=MX3(a,C1[2],C1[3]); \
      _Pragma("unroll") for(int r=4;r<16;r+=4){a=MX3(a,C0[r],C0[r+1]);b=MX3(b,C0[r+2],C0[r+3]);a=MX3(a,C1[r],C1[r+1]);b=MX3(b,C1[r+2],C1[r+3]);} \
      float rm=__builtin_fmaxf(a,b); { auto rr=__builtin_amdgcn_permlane32_swap(__float_as_uint(rm),__float_as_uint(rm),false,false); rm=__builtin_fmaxf(__uint_as_float(rr[0]),__uint_as_float(rr[1])); } \
      resc=false; \
      if(__builtin_expect(__any(rm>(float)THRL),0)){ const float dl=__builtin_fmaxf(rm,0.f); mhat+=dl; \
        _Pragma("unroll") for(int r=0;r<16;++r){C0[r]-=dl;C1[r]-=dl;} \
        _Pragma("unroll") for(int r=0;r<16;++r)negm[r]=-mhat; asm volatile("":"+v"(negm)); \
        const float f=__builtin_amdgcn_exp2f(-dl); l_reg*=f; if(hi==0)wsf[r32]=f; resc=true; } } \
    SBAR(); \
    GAPB(o[0]=__builtin_amdgcn_mfma_f32_32x32x16_bf16(PAF(0),VFR(0),o[0],0,0,0), C0,0); \
    GAPB(o[1]=__builtin_amdgcn_mfma_f32_32x32x16_bf16(PAF(0),VFR(4),o[1],0,0,0), C0,4); \
    KRD(GL,0); GAPB(o[0]=__builtin_amdgcn_mfma_f32_32x32x16_bf16(PAF(1),VFR(1),o[0],0,0,0), C0,8); \
    KRD(GL,1); GAPB(o[1]=__builtin_amdgcn_mfma_f32_32x32x16_bf16(PAF(1),VFR(5),o[1],0,0,0), C0,12); \
    KRD(GL,2); GAPB(o[0]=__builtin_amdgcn_mfma_f32_32x32x16_bf16(PAF(2),VFR(2),o[0],0,0,0), C1,0); \
    KRD(GL,3); GAPB(o[1]=__builtin_amdgcn_mfma_f32_32x32x16_bf16(PAF(2),VFR(6),o[1],0,0,0), C1,4); \
    GAPB(o[0]=__builtin_amdgcn_mfma_f32_32x32x16_bf16(PAF(3),VFR(3),o[0],0,0,0), C1,8); \
    GAPB(o[1]=__builtin_amdgcn_mfma_f32_32x32x16_bf16(PAF(3),VFR(7),o[1],0,0,0), C1,12); \
    }while(0)
  int t=1;
  #undef CMASK
  #define CMASK(P0,P1,t) do{}while(0)
  for(;t+5<NT;t+=2){
    STEP(pB0,pB1,pA0,pA1,t,true,true,true);     WAIT_BAR(2); RESC(); ROT();
    STEP(pA0,pA1,pB0,pB1,t+1,true,true,true);   WAIT_BAR(2); RESC(); ROT();
  }
  #undef CMASK
  #define CMASK(P0,P1,t) do{}while(0)
  #define ENDW(tt) do{ if((tt)+3<NT){WAIT_BAR(2);} else if((tt)+2<NT){WAIT_BAR(1);} else {WAIT_BAR(0);} }while(0)
  for(;t+1<NT;t+=2){
    STEP(pB0,pB1,pA0,pA1,t,(t+3<NT),(t+1<NT),(t+1<NT));       ENDW(t);   RESC(); ROT();
    STEP(pA0,pA1,pB0,pB1,t+1,(t+4<NT),(t+2<NT),(t+2<NT));     ENDW(t+1); RESC(); ROT();
  }
  STEP(pB0,pB1,pA0,pA1,NT-1,false,false,false); RESC();
  { float sacc=pB0[0]+pB0[1]; _Pragma("unroll") for(int r=2;r<16;++r)sacc+=pB0[r]; _Pragma("unroll") for(int r=0;r<16;++r)sacc+=pB1[r]; l_reg+=sacc;
    pw0=(u32x4){PKW(pB0,0),PKW(pB0,2),PKW(pB0,4),PKW(pB0,6)};pw1=(u32x4){PKW(pB0,8),PKW(pB0,10),PKW(pB0,12),PKW(pB0,14)};pw2=(u32x4){PKW(pB1,0),PKW(pB1,2),PKW(pB1,4),PKW(pB1,6)};pw3=(u32x4){PKW(pB1,8),PKW(pB1,10),PKW(pB1,12),PKW(pB1,14)};
    SBAR(); pv(o,vb0+sl_cur,PAF(0),PAF(1),PAF(2),PAF(3)); }
  #undef PKW
  #undef PAF
  #undef VFR
  #undef PIN
  #undef MX3
  #undef GAPA
  #undef GAPB
  #undef EX
  #undef VRD
  #undef KRD
  #undef STEP
  #undef ENDW
  {auto rr=__builtin_amdgcn_permlane32_swap(__float_as_uint(l_reg),__float_as_uint(l_reg),false,false);l_reg=__uint_as_float(rr[0])+__uint_as_float(rr[1]);}
  if(hi==0)wsf[32+r32]=l_reg;asm volatile("s_waitcnt lgkmcnt(0)":::"memory");
  float rli[16];
  #pragma unroll
  for(int r=0;r<16;++r)rli[r]=__builtin_amdgcn_rcpf(wsf[32+crow(r,hi)]);
  bf16*Ow=Oblk+(long)wid*QBLK*DM;
  { bf16*stg=(bf16*)(shm+LDS_OST)+wid*2048;
    #pragma unroll
    for(int r=0;r<16;++r){const int orow=crow(r,hi);
      #pragma unroll
      for(int d0=0;d0<2;++d0)stg[orow*64+d0*32+r32]=__float2bfloat16(o[d0][r]*rli[r]);}
    asm volatile("s_waitcnt lgkmcnt(0)":::"memory");
    #pragma unroll
    for(int i=0;i<4;++i){const int row=i*8+(lane>>3),ch=lane&7; const u32x4 v=*(const u32x4*)(stg+row*64+ch*8); const u32x4 z=*(const u32x4*)(Ow+(long)row*DM+ch*8); u32x4 w;
      #pragma unroll
      for(int e=0;e<4;++e){ const float a0=__uint_as_float(v[e]<<16),a1=__uint_as_float(v[e]&0xffff0000u),z0=__uint_as_float(z[e]<<16),z1=__uint_as_float(z[e]&0xffff0000u);
        w[e]=cvtpk_s(a0*z0/(1.f+__expf(-z0)),a1*z1/(1.f+__expf(-z1))); }
      ATTN_STORE16(Ow+(long)row*DM+ch*8,w);} }
  asm volatile("s_waitcnt lgkmcnt(0)\n\ts_barrier":::"memory");
  #undef DMA_K
  #undef DMA_V
  #undef CMASK
  #undef START
  #undef RESC
  #undef ROT
}
constexpr int ATTN_LDS_BYTES=LDS_BYTES;
}
typedef unsigned short u16;
#define LAS __attribute__((address_space(3)))
#define DI __device__ __forceinline__
typedef unsigned v4u __attribute__((ext_vector_type(4)));
typedef unsigned v2u __attribute__((ext_vector_type(2)));
typedef float v4f __attribute__((ext_vector_type(4)));

constexpr int T_TOK = 32768, P1P = 2048, P2P = 1536;
constexpr int P1_Z = 0, P1_Q = 1280, P1_K = 1792, P1_V = 1920;
constexpr int P2_AQ = 0, P2_AK = 128, P2_AV = 256, P2_GF = 512, P2_GB = 640, P2_BU = 768, P2_DU = 1024, P2_DV = 1280, P2_U = 1024;
constexpr size_t MiB = 1u << 20;
constexpr size_t WS_DFT = 256 * 1024, WS_BAR = 512 * 1024, BAR_BYTES = 16384;
constexpr size_t WS_MOD = 0, WS_WIN = 2 * MiB, WS_WOUT = 16 * MiB, WS_WF = 21 * MiB, WS_U0 = 22 * MiB, WS_HB = 86 * MiB, WS_P2 = 150 * MiB, WS_DEC = 246 * MiB, WS_END = 247 * MiB;
constexpr size_t HB_GS = 0, HB_KC = 16 * MiB, HB_VC = 24 * MiB, HB_TP = 32 * MiB;
constexpr int LDS_BYTES = 147456;
constexpr float EPSN = 1e-6f;
constexpr float ATT_C2 = 0.125f * 1.4426950408889634f;

struct Params {
    const float *xp, *xs, *cp, *cs, *ada_w, *ada_b, *pre_g, *post_g, *w_in, *wg2f, *bgf, *wg2b, *bgb, *onorm_g, *fnet_w, *qn_g, *kn_g, *sgu_ng, *sgu_w, *sgu_b, *w_out;
    float* out; unsigned char* ws;
};
typedef const float* cfp;
struct Ctx { float* out; unsigned char* ws; LAS cfp* tab; };

DI float bf2f(u16 v) { return __uint_as_float((unsigned)v << 16); }
DI float bflo(unsigned w) { return __uint_as_float(w << 16); }
DI float bfhi(unsigned w) { return __uint_as_float(w & 0xffff0000u); }
DI unsigned f2bf(float f) { unsigned u = __float_as_uint(f); return (u + 0x7fffu + ((u >> 16) & 1u)) >> 16; }
DI unsigned pk2(float lo, float hi) { return f2bf(lo) | (f2bf(hi) << 16); }
DI float wave_sum(float v) {
#pragma unroll
    for (int o = 1; o < 64; o <<= 1) v += __shfl_xor(v, o);
    return v;
}
using pg8::silu_f;
DI float logsig(float x) { return fminf(x, 0.f) - log1pf(__expf(-fabsf(x))); }
DI void seq_info(int s, int& row0, int& N) { if (s < 4) { row0 = s * 4096; N = 4096; } else { row0 = 16384 + (s - 4) * 8192; N = 8192; } }
DI int row_seq(int r) { return r < 16384 ? (r >> 12) : 4 + ((r - 16384) >> 13); }
DI void unpack8(const v4u r, float (&f)[8]) { f[0] = bflo(r.x); f[1] = bfhi(r.x); f[2] = bflo(r.y); f[3] = bfhi(r.y); f[4] = bflo(r.z); f[5] = bfhi(r.z); f[6] = bflo(r.w); f[7] = bfhi(r.w); }
DI v4u pack8(const float (&f)[8]) { v4u r; r.x = pk2(f[0], f[1]); r.y = pk2(f[2], f[3]); r.z = pk2(f[4], f[5]); r.w = pk2(f[6], f[7]); return r; }
#define LDS_WAIT() asm volatile("s_waitcnt lgkmcnt(0)" ::: "memory")


typedef short bf16x8_t __attribute__((ext_vector_type(8)));
typedef float f32x4_t __attribute__((ext_vector_type(4)));
DI bf16x8_t ldfrag(const LAS u16* base, int pitch, int row0, int k0, int lane) { return *(const LAS bf16x8_t*)(base + (row0 + (lane & 15)) * pitch + k0 + 8 * (lane >> 4)); }
#define MFMA16(a, b, c) __builtin_amdgcn_mfma_f32_16x16x32_bf16((a), (b), (c), 0, 0, 0)
DI float wave_prefix(float g, int lane) {
#pragma unroll
    for (int o = 1; o < 64; o <<= 1) { const float t = __shfl_up(g, o); if (lane >= o) g += t; }
    return g; }
DI float wave_suffix(float g, int lane) {
#pragma unroll
    for (int o = 1; o < 64; o <<= 1) { const float t = __shfl_down(g, o); if (lane + o < 64) g += t; }
    return g; }
DI int win_src_col(int j) {
    if (j < 1280) return 2080 + j;
    if (j < 1792) return 800 + (j - 1280);
    if (j < 1920) return 1312 + (j - 1792);
    if (j < 2048) return 1440 + (j - 1920);
    const int q = j - 2048;
    if (q < 512) return q;
    if (q < 768) return -1;
    if (q < 1024) return 544 + (q - 768);
    if (q < 1280) return 1568 + (q - 1024);
    return 1824 + (q - 1280);
}
DI void transpose_item(const float* W, int ldw, int src_n0, int K, u16* WT, int dst_n0, int k0, LAS float* scr, int lane) {
    float tv[32];
#pragma unroll
    for (int i = 0; i < 32; ++i) tv[i] = W[(size_t)(k0 + 2 * i + (lane >> 5)) * ldw + src_n0 + (lane & 31)];
#pragma unroll
    for (int i = 0; i < 32; ++i) scr[(2 * i + (lane >> 5)) * 33 + (lane & 31)] = tv[i];
    LDS_WAIT();
    const int c = lane & 7;
#pragma unroll
    for (int j = 0; j < 4; ++j) { const int n = (lane >> 3) + 8 * j; const LAS float* s = scr + (8 * c) * 33 + n;
        v4u o; o.x = pk2(s[0 * 33], s[1 * 33]); o.y = pk2(s[2 * 33], s[3 * 33]); o.z = pk2(s[4 * 33], s[5 * 33]); o.w = pk2(s[6 * 33], s[7 * 33]);
        *(v4u*)(WT + (size_t)(dst_n0 + n) * K + k0 + 8 * c) = o; }
    LDS_WAIT();
}
DI void phase0(const Ctx& p, LAS unsigned char* L) {
    const int tid = otid(), lane = tid & 63, wave = tid >> 6;
    const int gw = blockIdx.x * 8 + wave, NGW = gridDim.x * 8, gt = blockIdx.x * 512 + tid, NGT = gridDim.x * 512;
    LAS float* scr = (LAS float*)(L + wave * 16384);
    u16* WinT = (u16*)(p.ws + WS_WIN); u16* WoutT = (u16*)(p.ws + WS_WOUT); u16* WfT = (u16*)(p.ws + WS_WF); float* mod = (float*)(p.ws + WS_MOD);
    constexpr int I_IN = 16 * 112, I_OUT = 20 * 32, I_L = I_IN + I_OUT;
    for (int it = gw; it < 2 * I_L; it += NGW) {
        const int l = it / I_L; int r = it % I_L;
        if (r < I_IN) { const int kb = r / 112, nb = r % 112; const int src = win_src_col(nb * 32); if (src < 0) continue;
            transpose_item(p.tab[8] + (size_t)l * 1024 * 3360, 3360, src, 1024, WinT + (size_t)l * 3584 * 1024, nb * 32, kb * 64, scr, lane); }
        else { r -= I_IN; const int kb = r / 32, nb = r % 32;
            transpose_item(p.tab[20] + (size_t)l * 1280 * 1024, 1024, nb * 32, 1280, WoutT + (size_t)l * 1024 * 1280, nb * 32, kb * 64, scr, lane); }
    }
    for (int e = gt; e < 2 * 16 * 1024; e += NGT) { const int l = e >> 14, r = e & 16383, jg = r >> 10, k = r & 1023, dirb = jg >> 3, jj0 = (jg & 7) * 16;
        const float* wi = p.tab[8] + (size_t)l * 1024 * 3360 + (size_t)k * 3360 + 512 + dirb * 16; float wv[16];
#pragma unroll
        for (int r2 = 0; r2 < 16; ++r2) wv[r2] = wi[r2];
        const float* w2 = (dirb ? p.tab[11] : p.tab[9]) + l * 16 * 128 + jj0;
        for (int q = 0; q < 16; ++q) { float a = 0.f;
#pragma unroll
            for (int r2 = 0; r2 < 16; ++r2) a += wv[r2] * w2[r2 * 128 + q];
            WinT[(size_t)l * 3584 * 1024 + (size_t)(2560 + dirb * 128 + jj0 + q) * 1024 + k] = (u16)f2bf(a); } }
    { LAS float* trig = (LAS float*)(L + 126976);
        if (tid < 64) { trig[tid] = cospif((float)tid * (1.f / 32.f)); trig[64 + tid] = sinpif((float)tid * (1.f / 32.f)); }
        __syncthreads();
        for (int e = gt; e < 2 * 256 * 512; e += NGT) { const int l = e >> 17, r = e & 131071, n = r >> 9, kk = r & 511, im = kk >> 8, g = (kk & 255) >> 6, c = kk & 63;
            const float* fw = p.tab[14] + (size_t)l * 65536 + (size_t)(g * 64) * 256 + n; const LAS float* tb = trig + im * 64; float a = 0.f;
#pragma unroll 8
            for (int j2 = 0; j2 < 64; ++j2) a += tb[(j2 * c) & 63] * fw[j2 * 256];
            WfT[(size_t)l * 131072 + n * 512 + kk] = (u16)f2bf(a * 0.125f); } }
    { u16* dft = (u16*)(p.ws + WS_DFT);
        for (int e = gt; e < 4096; e += NGT) { const int k = e >> 6, n = e & 63; const float a = (float)((k * n) & 63) * (1.f / 32.f); dft[e] = (u16)f2bf(cospif(a)); dft[4096 + e] = (u16)f2bf(sinpif(a)); }
        for (int e = gt; e < 16384; e += NGT) { const int k = e >> 7, n = e & 127; const float a = (float)((k * n) & 127) * (1.f / 64.f); dft[8192 + e] = (u16)f2bf(cospif(a)); dft[8192 + 16384 + e] = (u16)f2bf(sinpif(a)); } }
    __syncthreads();
    LAS float* sc = (LAS float*)L;
    for (int e = tid; e < 6144; e += 512) { const int s = e >> 10, k = e & 1023; const float c = s < 4 ? p.tab[2][s * 1024 + k] : p.tab[3][(s - 4) * 1024 + k]; sc[e] = c / (1.f + expf(-c)); }
    __syncthreads();
    for (int unit = gw; unit < 768; unit += NGW) {
        const int ks = unit & 7, jb = (unit >> 3) % 48, l = unit / 384, j = jb * 64 + lane;
        float acc[6] = {0.f, 0.f, 0.f, 0.f, 0.f, 0.f};
        const float* aw = p.tab[4] + (size_t)l * 1024 * 3072 + (size_t)(ks * 128) * 3072 + j;
#pragma unroll 16
        for (int k = 0; k < 128; ++k) { const float w = aw[(size_t)k * 3072];
#pragma unroll
            for (int s = 0; s < 6; ++s) acc[s] += sc[s * 1024 + ks * 128 + k] * w; }
        if (ks == 0) { const float b = p.tab[5][l * 3072 + j];
#pragma unroll
            for (int s = 0; s < 6; ++s) acc[s] += b; }
#pragma unroll
        for (int s = 0; s < 6; ++s) atomicAdd(mod + (size_t)(l * 6 + s) * 3072 + j, acc[s]);
    }
}

DI void add_branch(v4f (&v)[4], const u16* urow, const float* gate, const float* pg, int lane) {
    v4f u[4]; float ss = 0.f;
#pragma unroll
    for (int j = 0; j < 4; ++j) { const v2u r = *(const v2u*)(urow + 256 * j + 4 * lane); u[j] = (v4f){bflo(r.x), bfhi(r.x), bflo(r.y), bfhi(r.y)};
        ss += (u[j].x * u[j].x + u[j].y * u[j].y) + (u[j].z * u[j].z + u[j].w * u[j].w); }
    const float rstd = 1.f / sqrtf(wave_sum(ss) * (1.f / 1024.f) + EPSN);
#pragma unroll
    for (int j = 0; j < 4; ++j) { const v4f g = *(const v4f*)(gate + 256 * j + 4 * lane), q = *(const v4f*)(pg + 256 * j + 4 * lane); v[j] += g * (u[j] * rstd * q); }
}
DI void phaseA(const Ctx& p, int l) {
    const int tid = otid(), lane = tid & 63, wave = tid >> 6, gw = blockIdx.x * 8 + wave, NGW = gridDim.x * 8;
    const float* mod = (const float*)(p.ws + WS_MOD); const u16* U0 = (const u16*)(p.ws + WS_U0); u16* HB = (u16*)(p.ws + WS_HB);
    for (int row = gw; row < T_TOK; row += NGW) {
        const int s = row_seq(row);
        const float* xr = row < 16384 ? p.tab[0] + (size_t)row * 1024 : p.tab[1] + (size_t)(row - 16384) * 1024;
        v4f v[4];
#pragma unroll
        for (int j = 0; j < 4; ++j) v[j] = *(const v4f*)(xr + 256 * j + 4 * lane);
        if (l >= 1) add_branch(v, U0 + (size_t)row * 1024, mod + (size_t)(0 * 6 + s) * 3072 + 2048, p.tab[7], lane);
        if (l == 2) { add_branch(v, HB + (size_t)row * 1024, mod + (size_t)(1 * 6 + s) * 3072 + 2048, p.tab[7] + 1024, lane);
            float* o = p.out + (size_t)row * 1024;
#pragma unroll
            for (int j = 0; j < 4; ++j) *(v4f*)(o + 256 * j + 4 * lane) = v[j];
            continue; }
        float ss = 0.f;
#pragma unroll
        for (int j = 0; j < 4; ++j) ss += (v[j].x * v[j].x + v[j].y * v[j].y) + (v[j].z * v[j].z + v[j].w * v[j].w);
        const float rstd = 1.f / sqrtf(wave_sum(ss) * (1.f / 1024.f) + EPSN);
        const float* md = mod + (size_t)(l * 6 + s) * 3072;
#pragma unroll
        for (int j = 0; j < 4; ++j) { const int col = 256 * j + 4 * lane;
            const v4f sh = *(const v4f*)(md + col), scl = *(const v4f*)(md + 1024 + col), g = *(const v4f*)(p.tab[6] + l * 1024 + col);
            const v4f h = v[j] * rstd * g * (scl + 1.f) + sh;
            v2u o; o.x = pk2(h.x, h.y); o.y = pk2(h.z, h.w); *(v2u*)(HB + (size_t)row * 1024 + col) = o; }
    }
}

DI void qk_prep(const Ctx& p, int l) {
    const int tid = otid(), lane = tid & 63, wave = tid >> 6, gw = blockIdx.x * 8 + wave, NGW = gridDim.x * 8;
    u16* P1 = (u16*)p.out; const int i = lane & 31; unsigned* KC = (unsigned*)(p.ws + WS_HB + HB_KC); unsigned* VC = (unsigned*)(p.ws + WS_HB + HB_VC);
    const float freq = exp2f(-(float)(i & 15) * (13.287712379549449f / 16.f));
    const float gq0 = p.tab[15][l * 64 + 2 * i], gq1 = p.tab[15][l * 64 + 2 * i + 1], gk0 = p.tab[16][l * 64 + 2 * i], gk1 = p.tab[16][l * 64 + 2 * i + 1];
    for (int rowb = gw * 2; rowb < T_TOK; rowb += NGW * 2) {
        unsigned wv[2][6];
#pragma unroll
        for (int r = 0; r < 2; ++r) { const unsigned* ptr = (const unsigned*)(P1 + (size_t)(rowb + r) * P1P + P1_Q);
#pragma unroll
            for (int it = 0; it < 6; ++it) wv[r][it] = ptr[it * 64 + lane]; }
#pragma unroll
        for (int r = 0; r < 2; ++r) { const int row = rowb + r;
            const int s = row_seq(row); int row0, N; seq_info(s, row0, N); const int pos = row - row0;
            const float coord = (i < 16) ? (float)(pos >> 6) : (float)(pos & 63);
            float sn, cs; sincosf(coord * freq, &sn, &cs);
            unsigned* ptr = (unsigned*)(P1 + (size_t)row * P1P + P1_Q);
            const size_t cidx = ((size_t)row0 * 2 + (size_t)(lane >> 5) * N + pos) * 32 + i;
#pragma unroll
            for (int it = 0; it < 5; ++it) { const bool isq = it < 4;
                const unsigned w = wv[r][it]; const float x0 = bflo(w), x1 = bfhi(w);
                float ss = x0 * x0 + x1 * x1;
#pragma unroll
                for (int o = 1; o < 32; o <<= 1) ss += __shfl_xor(ss, o);
                const float rstd = 1.f / sqrtf(ss * (1.f / 64.f) + EPSN);
                const float y0 = x0 * rstd * (isq ? gq0 : gk0), y1 = x1 * rstd * (isq ? gq1 : gk1);
                float o0 = y0 * cs - y1 * sn, o1 = y0 * sn + y1 * cs;
                if (isq) { ptr[it * 64 + lane] = pk2(o0 * ATT_C2, o1 * ATT_C2); } else { KC[cidx] = pk2(o0, o1); } }
            VC[cidx] = wv[r][5]; }
    }
}
DI void gla_scan_cols(LAS float* Gf, LAS float* Gb, int lane) {
    LAS float* G = (lane >> 5) ? Gb : Gf; const int d = lane & 31; float v[64];
#pragma unroll
    for (int i = 0; i < 64; ++i) v[i] = G[i * 33 + d];
    if (lane >> 5) {
#pragma unroll
        for (int i = 62; i >= 0; --i) v[i] += v[i + 1];
    } else {
#pragma unroll
        for (int i = 1; i < 64; ++i) v[i] += v[i - 1];
    }
#pragma unroll
    for (int i = 0; i < 64; ++i) G[i * 33 + d] = v[i];
}
DI void gla_local_item(const Ctx& p, int l, int item, LAS float* F) {
    const int tid = otid(), lane = tid & 63, w = tid >> 6; const int gc = item >> 2, h = item & 3; const size_t rb = (size_t)gc * 64;
    const u16* P2 = (const u16*)(p.ws + WS_P2);
    LAS float* Gf = F; LAS float* Gb = Gf + 2112; LAS float* Kx = Gb + 2112; LAS u16* KDT = (LAS u16*)(Kx + 2112); LAS u16* VT = KDT + 2 * 32 * 72;
    { const int t2 = tid & 255, i = t2 >> 2, c = t2 & 3; const u16* r = P2 + (rb + i) * P2P + h * 32 + c * 8; float f[8];
        const int dirb = tid >> 8; const float* bias = p.tab[dirb ? 12 : 10] + l * 128 + h * 32 + c * 8; LAS float* G = dirb ? Gb : Gf;
        unpack8(*(const v4u*)(r + (dirb ? P2_GB : P2_GF)), f);
#pragma unroll
        for (int q = 0; q < 8; ++q) G[i * 33 + c * 8 + q] = logsig(f[q] + bias[q]) * (1.f / 16.f);
        if (!dirb) { unpack8(*(const v4u*)(r + P2_AK), f);
#pragma unroll
            for (int q = 0; q < 8; ++q) Kx[i * 33 + c * 8 + q] = f[q]; } }
    { const int i = tid >> 3, c = tid & 7; const v4u raw = *(const v4u*)(P2 + (rb + i) * P2P + P2_AV + h * 64 + c * 8);
        const unsigned ww[4] = {raw.x, raw.y, raw.z, raw.w};
#pragma unroll
        for (int q = 0; q < 4; ++q) { VT[(c * 8 + 2 * q) * 72 + i] = (u16)(ww[q] & 0xffffu); VT[(c * 8 + 2 * q + 1) * 72 + i] = (u16)(ww[q] >> 16); } }
    __syncthreads();
    if (w == 0) gla_scan_cols(Gf, Gb, lane);
    __syncthreads();
    u16* GS = (u16*)(p.ws + WS_HB + HB_GS); float* DEC = (float*)(p.ws + WS_DEC); const size_t slot = (size_t)(gc * 4 + h) * 2;
#pragma unroll
    for (int r = 0; r < 8; ++r) { const int e = tid + r * 512, i = e & 63, d = (e >> 6) & 31, dir = e >> 11; const LAS float* G = dir ? Gb : Gf;
        const float bl = G[(dir ? 0 : 63) * 33 + d];
        KDT[(dir * 32 + d) * 72 + i] = (u16)f2bf(Kx[i * 33 + d] * __expf(bl - G[i * 33 + d])); }
    if (tid < 64) { const int dir = tid >> 5, d = tid & 31; DEC[(slot + dir) * 32 + d] = __expf((dir ? Gb : Gf)[(dir ? 0 : 63) * 33 + d]); }
    __syncthreads();
    { const int dir = w >> 2, mt = (w >> 1) & 1;
#pragma unroll
        for (int q = 0; q < 2; ++q) { const int nt = (w & 1) * 2 + q; f32x4_t acc = {0.f, 0.f, 0.f, 0.f};
#pragma unroll
            for (int ks = 0; ks < 2; ++ks) acc = MFMA16(ldfrag(KDT + dir * 32 * 72, 72, mt * 16, ks * 32, lane), ldfrag(VT, 72, nt * 16, ks * 32, lane), acc);
#pragma unroll
            for (int j = 0; j < 4; ++j) GS[(slot + dir) * 2048 + (mt * 16 + 4 * (lane >> 4) + j) * 64 + nt * 16 + (lane & 15)] = (u16)f2bf(acc[j]); } }
    __syncthreads();
}
DI void sgu_item(const Ctx& p, int l, int item, LAS float* F) {
    const int tid = otid(), lane = tid & 63, w = tid >> 6; const int ch = item >> 2, g = item & 3; const size_t rb = (size_t)ch * 128;
    const u16* P2 = (const u16*)(p.ws + WS_P2); u16* P1 = (u16*)p.out;
    LAS float* OUTF = F; LAS u16* WB = (LAS u16*)(F + 128 * 65); LAS u16* VNT = WB + 128 * 136;
    { const int row = tid >> 2, qt = tid & 3; const u16* dv = P2 + (rb + row) * P2P + P2_DV; float ss = 0.f; float f[8];
#pragma unroll
        for (int c = 0; c < 8; ++c) { unpack8(*(const v4u*)(dv + qt * 64 + c * 8), f);
#pragma unroll
            for (int q = 0; q < 8; ++q) ss += f[q] * f[q]; }
        ss += __shfl_xor(ss, 1); ss += __shfl_xor(ss, 2);
        const float rstd = 1.f / sqrtf(ss * (1.f / 256.f) + EPSN); const float* ng = p.tab[17] + l * 256 + g * 64 + qt * 16;
#pragma unroll
        for (int c = 0; c < 2; ++c) { unpack8(*(const v4u*)(dv + g * 64 + qt * 16 + c * 8), f);
#pragma unroll
            for (int q = 0; q < 8; ++q) VNT[(qt * 16 + c * 8 + q) * 136 + row] = (u16)f2bf(f[q] * rstd * ng[c * 8 + q]); } }
    { const float* wsrc = p.tab[18] + (size_t)(l * 4 + g) * 16384;
#pragma unroll
        for (int r = 0; r < 8; ++r) { const int idx = tid + r * 512, t = idx >> 5, s4 = (idx & 31) * 4; const v4f v = *(const v4f*)(wsrc + idx * 4);
            v2u o; o.x = pk2(v.x, v.y); o.y = pk2(v.z, v.w); *(LAS v2u*)(WB + t * 136 + s4) = o; } }
    __syncthreads();
    {
#pragma unroll
        for (int nt = 0; nt < 4; ++nt) { f32x4_t acc = {0.f, 0.f, 0.f, 0.f};
#pragma unroll
            for (int ks = 0; ks < 4; ++ks) acc = MFMA16(ldfrag(WB, 136, w * 16, ks * 32, lane), ldfrag(VNT, 136, nt * 16, ks * 32, lane), acc);
#pragma unroll
            for (int j = 0; j < 4; ++j) OUTF[(w * 16 + 4 * (lane >> 4) + j) * 65 + nt * 16 + (lane & 15)] = acc[j]; } }
    __syncthreads();
#pragma unroll
    for (int r = 0; r < 2; ++r) { const int task = tid + r * 512, t = task >> 3, c8 = (task & 7) * 8; float acc[8];
#pragma unroll
        for (int e = 0; e < 8; ++e) acc[e] = OUTF[t * 65 + c8 + e];
        const float bias = p.tab[19][(l * 4 + g) * 128 + t];
        float uu[8], zz[8]; unpack8(*(const v4u*)(P2 + (rb + t) * P2P + P2_DU + g * 64 + c8), uu);
        u16* mz = P1 + (rb + t) * P1P + 1024 + g * 64 + c8; unpack8(*(const v4u*)mz, zz);
#pragma unroll
        for (int e = 0; e < 8; ++e) acc[e] = (acc[e] + bias) * uu[e] * silu_f(zz[e]);
        *(v4u*)mz = pack8(acc); }
    __syncthreads();
}
template <int N1> DI void fnet1_body(const Ctx& p, int row0, int N, int n2, int cb, LAS float* F) {
    constexpr int PN = N1 + 8, MT = N1 / 16, NTW = MT;
    const int tid = otid(), lane = tid & 63, w = tid >> 6;
    const u16* P2 = (const u16*)(p.ws + WS_P2); u16* TP = (u16*)(p.ws + WS_HB + HB_TP);
    const u16* Cg = (const u16*)(p.ws + WS_DFT) + (N1 == 64 ? 0 : 8192); const u16* Sg = Cg + N1 * N1;
    LAS float* tw = F; LAS u16* XT = (LAS u16*)(F + 256); LAS u16* FC = XT + 128 * PN; LAS u16* FS = FC + N1 * PN; LAS u16* OUT = FC;
#pragma unroll
    for (int r = 0; r < N1 / 32; ++r) { const int idx = tid + r * 512, n1 = idx >> 4, c = idx & 15; const v4u raw = *(const v4u*)(P2 + (size_t)(row0 + n1 * 64 + n2) * P2P + P2_BU + cb * 128 + c * 8);
        const unsigned ww[4] = {raw.x, raw.y, raw.z, raw.w};
#pragma unroll
        for (int q = 0; q < 4; ++q) { XT[(c * 8 + 2 * q) * PN + n1] = (u16)(ww[q] & 0xffffu); XT[(c * 8 + 2 * q + 1) * PN + n1] = (u16)(ww[q] >> 16); } }
#pragma unroll
    for (int r = 0; r < N1 * N1 / 8 / 512; ++r) { const int idx = tid + r * 512, k1 = idx / (N1 / 8), c = idx % (N1 / 8);
        *(LAS v4u*)(FC + k1 * PN + c * 8) = *(const v4u*)(Cg + k1 * N1 + c * 8); *(LAS v4u*)(FS + k1 * PN + c * 8) = *(const v4u*)(Sg + k1 * N1 + c * 8); }
    if (tid < N1) { const float ph = 2.f * (float)((n2 * tid) & (N - 1)) / (float)N; tw[2 * tid] = cospif(ph); tw[2 * tid + 1] = sinpif(ph); }
    __syncthreads();
    f32x4_t ac[NTW], as[NTW];
#pragma unroll
    for (int q = 0; q < NTW; ++q) { const int id = w + 8 * q, mt = id % MT, nt = id / MT; ac[q] = (f32x4_t){0.f, 0.f, 0.f, 0.f}; as[q] = ac[q];
#pragma unroll
        for (int ks = 0; ks < N1 / 32; ++ks) { const bf16x8_t b = ldfrag(XT, PN, nt * 16, ks * 32, lane);
            ac[q] = MFMA16(ldfrag(FC, PN, mt * 16, ks * 32, lane), b, ac[q]); as[q] = MFMA16(ldfrag(FS, PN, mt * 16, ks * 32, lane), b, as[q]); } }
    __syncthreads();
    const float scale = 1.f / sqrtf((float)N1);
#pragma unroll
    for (int q = 0; q < NTW; ++q) { const int id = w + 8 * q, mt = id % MT, nt = id / MT;
#pragma unroll
        for (int j = 0; j < 4; ++j) { const int k1 = mt * 16 + 4 * (lane >> 4) + j, col = nt * 16 + (lane & 15); const float cw = tw[2 * k1], sw = tw[2 * k1 + 1];
            const float tr = ac[q][j], ti = -as[q][j];
            OUT[k1 * 256 + col] = (u16)f2bf((tr * cw + ti * sw) * scale); OUT[k1 * 256 + 128 + col] = (u16)f2bf((ti * cw - tr * sw) * scale); } }
    __syncthreads();
#pragma unroll
    for (int r = 0; r < N1 / 16; ++r) { const int idx = tid + r * 512, k1 = idx >> 5, c = idx & 31;
        const v4u v = *(const LAS v4u*)(OUT + k1 * 256 + c * 8);
        *(v4u*)(TP + (size_t)(row0 + k1 * 64 + n2) * 512 + (c >> 4) * 256 + cb * 128 + (c & 15) * 8) = v; }
    __syncthreads();
}
DI void fnet1_item(const Ctx& p, int item, LAS float* F) {
    const int s = item >> 7, r = item & 127, n2 = r >> 1, cb = r & 1; int row0, N; seq_info(s, row0, N);
    if (N == 4096) fnet1_body<64>(p, row0, N, n2, cb, F); else fnet1_body<128>(p, row0, N, n2, cb, F);
}
DI void fnet2_item(const Ctx& p, int item, LAS float* F) {
    const int tid = otid(), lane = tid & 63, w = tid >> 6; int s, k1; if (item < 256) { s = item >> 6; k1 = item & 63; } else { s = 4 + ((item - 256) >> 7); k1 = (item - 256) & 127; }
    int row0, N; seq_info(s, row0, N); const int N1 = N >> 6;
    u16* P2 = (u16*)(p.ws + WS_P2); const u16* TP = (const u16*)(p.ws + WS_HB + HB_TP); const u16* Cg = (const u16*)(p.ws + WS_DFT); const u16* Sg = Cg + 4096;
    LAS u16* BT = (LAS u16*)F; LAS u16* A1 = BT + 256 * 136; LAS u16* A2 = A1 + 64 * 136; LAS u16* OUT = BT;
#pragma unroll
    for (int r = 0; r < 8; ++r) { const int idx = tid + r * 512, n2 = idx >> 6, c = idx & 63; const v4u raw = *(const v4u*)(TP + (size_t)(row0 + k1 * 64 + n2) * 512 + c * 8);
        const unsigned ww[4] = {raw.x, raw.y, raw.z, raw.w}; const int col0 = (c & 31) * 8, kk = (c >> 5) * 64 + n2;
#pragma unroll
        for (int q = 0; q < 4; ++q) { BT[(col0 + 2 * q) * 136 + kk] = (u16)(ww[q] & 0xffffu); BT[(col0 + 2 * q + 1) * 136 + kk] = (u16)(ww[q] >> 16); } }
    { const int k2 = tid >> 3, c8 = (tid & 7) * 8; const v4u c = *(const v4u*)(Cg + k2 * 64 + c8), sv = *(const v4u*)(Sg + k2 * 64 + c8); const v4u ns = sv ^ (v4u){0x80008000u, 0x80008000u, 0x80008000u, 0x80008000u};
        *(LAS v4u*)(A1 + k2 * 136 + c8) = c; *(LAS v4u*)(A1 + k2 * 136 + 64 + c8) = sv; *(LAS v4u*)(A2 + k2 * 136 + c8) = ns; *(LAS v4u*)(A2 + k2 * 136 + 64 + c8) = c; }
    __syncthreads();
    f32x4_t acc[16]; const LAS u16* Aw = (w < 4) ? A1 : A2; const int mt = w & 3;
#pragma unroll
    for (int nt = 0; nt < 16; ++nt) { acc[nt] = (f32x4_t){0.f, 0.f, 0.f, 0.f};
#pragma unroll
        for (int ks = 0; ks < 4; ++ks) acc[nt] = MFMA16(ldfrag(Aw, 136, mt * 16, ks * 32, lane), ldfrag(BT, 136, nt * 16, ks * 32, lane), acc[nt]); }
    __syncthreads();
#pragma unroll
    for (int nt = 0; nt < 16; ++nt)
#pragma unroll
        for (int j = 0; j < 4; ++j) OUT[(mt * 16 + 4 * (lane >> 4) + j) * 512 + (w >> 2) * 256 + nt * 16 + (lane & 15)] = (u16)f2bf(acc[nt][j] * 0.125f);
    __syncthreads();
#pragma unroll
    for (int r = 0; r < 8; ++r) { const int idx = tid + r * 512, k2 = idx >> 6, c = idx & 63; const v4u v = *(const LAS v4u*)(OUT + k2 * 512 + c * 8);
        *(v4u*)(P2 + (size_t)(row0 + k1 + N1 * k2) * P2P + P2_U + c * 8) = v; }
    __syncthreads();
}
DI void gla_scan_item(const Ctx& p, int item) {
    const int tid = otid(); const int chain = item >> 2, e = (item & 3) * 512 + tid; const int s = chain >> 3, h = (chain >> 1) & 3, dir = chain & 1;
    int row0, N; seq_info(s, row0, N); const int NC = N >> 6, gc0 = row0 >> 6, d = e >> 6;
    u16* GS = (u16*)(p.ws + WS_HB + HB_GS); const float* DEC = (const float*)(p.ws + WS_DEC);
    float S = 0.f;
    for (int st = 0; st < NC; st += 32) { u16 tmp[32]; float dc[32];
#pragma unroll
        for (int u = 0; u < 32; ++u) { const int c = dir ? NC - 1 - (st + u) : st + u; const size_t slot = (size_t)((gc0 + c) * 4 + h) * 2 + dir; tmp[u] = GS[slot * 2048 + e]; dc[u] = DEC[slot * 32 + d]; }
#pragma unroll
        for (int u = 0; u < 32; ++u) { const int c = dir ? NC - 1 - (st + u) : st + u; const size_t slot = (size_t)((gc0 + c) * 4 + h) * 2 + dir; GS[slot * 2048 + e] = (u16)f2bf(S); S = dc[u] * S + bf2f(tmp[u]); } }
}
DI void gla_out_item(const Ctx& p, int l, int item, LAS float* F) {
    const int tid = otid(), lane = tid & 63, w = tid >> 6; const int gc = item >> 2, h = item & 3; const size_t rb = (size_t)gc * 64;
    const u16* P2 = (const u16*)(p.ws + WS_P2); u16* P1 = (u16*)p.out;
    LAS float* Gf = F; LAS float* Gb = Gf + 2112; LAS float* Qx = Gb + 2112; LAS float* Kx = Qx + 2112; LAS float* O = Kx + 2112;
    LAS u16* QF = (LAS u16*)(O + 64 * 65); LAS u16* KF = QF + 64 * 40; LAS u16* QB = KF + 64 * 40; LAS u16* KB = QB + 64 * 40;
    LAS u16* VT = KB + 64 * 40; LAS u16* SC = VT + 64 * 72; LAS u16* SFT = SC + 64 * 72; LAS u16* SBT = SFT + 64 * 40;
    const u16* GS = (const u16*)(p.ws + WS_HB + HB_GS); const size_t slot = (size_t)(gc * 4 + h) * 2;
    { const int t2 = tid & 255, i = t2 >> 2, c = t2 & 3; const u16* r = P2 + (rb + i) * P2P + h * 32 + c * 8; float f[8];
        const int dirb = tid >> 8; LAS float* d0 = dirb ? Kx : Qx; LAS float* d1 = dirb ? Gb : Gf; const float* bias = p.tab[dirb ? 12 : 10] + l * 128 + h * 32 + c * 8;
        unpack8(*(const v4u*)(r + (dirb ? P2_AK : P2_AQ)), f);
#pragma unroll
        for (int q = 0; q < 8; ++q) d0[i * 33 + c * 8 + q] = f[q];
        unpack8(*(const v4u*)(r + (dirb ? P2_GB : P2_GF)), f);
#pragma unroll
        for (int q = 0; q < 8; ++q) d1[i * 33 + c * 8 + q] = logsig(f[q] + bias[q]) * (1.f / 16.f); }
    { const int i = tid >> 3, c = tid & 7; const v4u raw = *(const v4u*)(P2 + (rb + i) * P2P + P2_AV + h * 64 + c * 8);
        const unsigned ww[4] = {raw.x, raw.y, raw.z, raw.w};
#pragma unroll
        for (int q = 0; q < 4; ++q) { VT[(c * 8 + 2 * q) * 72 + i] = (u16)(ww[q] & 0xffffu); VT[(c * 8 + 2 * q + 1) * 72 + i] = (u16)(ww[q] >> 16); } }
    { const int e4 = tid * 4, d = e4 >> 6, v = e4 & 63; const v2u a = *(const v2u*)(GS + slot * 2048 + e4), b = *(const v2u*)(GS + (slot + 1) * 2048 + e4);
        SFT[(v + 0) * 40 + d] = (u16)(a.x & 0xffffu); SFT[(v + 1) * 40 + d] = (u16)(a.x >> 16); SFT[(v + 2) * 40 + d] = (u16)(a.y & 0xffffu); SFT[(v + 3) * 40 + d] = (u16)(a.y >> 16);
        SBT[(v + 0) * 40 + d] = (u16)(b.x & 0xffffu); SBT[(v + 1) * 40 + d] = (u16)(b.x >> 16); SBT[(v + 2) * 40 + d] = (u16)(b.y & 0xffffu); SBT[(v + 3) * 40 + d] = (u16)(b.y >> 16); }
    __syncthreads();
    if (w == 0) gla_scan_cols(Gf, Gb, lane);
    __syncthreads();
#pragma unroll
    for (int r = 0; r < 4; ++r) { const int e = tid + r * 512, i = e & 63, d = e >> 6, a = i * 33 + d; const float q = Qx[a] * 0.17677669529663687f, k = Kx[a], bf = Gf[a], bb = Gb[a];
        QF[i * 40 + d] = (u16)f2bf(q * __expf(bf)); KF[i * 40 + d] = (u16)f2bf(k * __expf(-bf)); QB[i * 40 + d] = (u16)f2bf(q * __expf(bb)); KB[i * 40 + d] = (u16)f2bf(k * __expf(-bb)); }
    __syncthreads();
#pragma unroll
    for (int q = 0; q < 2; ++q) { const int id = 2 * w + q, ti = id >> 2, si = id & 3; const f32x4_t z4 = {0.f, 0.f, 0.f, 0.f}; f32x4_t acc;
        if (si < ti) acc = MFMA16(ldfrag(QF, 40, ti * 16, 0, lane), ldfrag(KF, 40, si * 16, 0, lane), z4);
        else if (si > ti) acc = MFMA16(ldfrag(QB, 40, ti * 16, 0, lane), ldfrag(KB, 40, si * 16, 0, lane), z4);
        else { const f32x4_t af = MFMA16(ldfrag(QF, 40, ti * 16, 0, lane), ldfrag(KF, 40, si * 16, 0, lane), z4), ab = MFMA16(ldfrag(QB, 40, ti * 16, 0, lane), ldfrag(KB, 40, si * 16, 0, lane), z4);
#pragma unroll
            for (int j = 0; j < 4; ++j) acc[j] = ((lane & 15) <= 4 * (lane >> 4) + j) ? af[j] : ab[j]; }
#pragma unroll
        for (int j = 0; j < 4; ++j) SC[(ti * 16 + 4 * (lane >> 4) + j) * 72 + si * 16 + (lane & 15)] = (u16)f2bf(acc[j]); }
    __syncthreads();
#pragma unroll
    for (int q = 0; q < 2; ++q) { const int id = 2 * w + q, ti = id >> 2, vi = id & 3; f32x4_t acc = {0.f, 0.f, 0.f, 0.f};
        acc = MFMA16(ldfrag(SC, 72, ti * 16, 0, lane), ldfrag(VT, 72, vi * 16, 0, lane), acc);
        acc = MFMA16(ldfrag(SC, 72, ti * 16, 32, lane), ldfrag(VT, 72, vi * 16, 32, lane), acc);
        acc = MFMA16(ldfrag(QF, 40, ti * 16, 0, lane), ldfrag(SFT, 40, vi * 16, 0, lane), acc);
        acc = MFMA16(ldfrag(QB, 40, ti * 16, 0, lane), ldfrag(SBT, 40, vi * 16, 0, lane), acc);
#pragma unroll
        for (int j = 0; j < 4; ++j) O[(ti * 16 + 4 * (lane >> 4) + j) * 65 + vi * 16 + (lane & 15)] = acc[j]; }
    __syncthreads();
    { const int t = tid >> 3, v8 = (tid & 7) * 8; float acc[8]; float ss = 0.f;
#pragma unroll
        for (int e = 0; e < 8; ++e) { acc[e] = O[t * 65 + v8 + e]; ss += acc[e] * acc[e]; }
        ss += __shfl_xor(ss, 1); ss += __shfl_xor(ss, 2); ss += __shfl_xor(ss, 4);
        const float rstd = 1.f / sqrtf(ss * (1.f / 64.f) + EPSN);
        u16* mz = P1 + (rb + t) * P1P + h * 64 + v8; float zz[8]; unpack8(*(const v4u*)mz, zz);
#pragma unroll
        for (int e = 0; e < 8; ++e) acc[e] = acc[e] * rstd * p.tab[13][l * 64 + v8 + e] * silu_f(zz[e]);
        *(v4u*)mz = pack8(acc); }
    __syncthreads();
}
#define XB_TMO      128
#define XB_XCNT(j)  (256  + 64 * (j))
#define XB_XSUB(j)  (1280 + 64 * (j))
#define XB_XGEN(j)  (2304 + 64 * (j))
#define XB_TOP      3328
#define XB_TOPGEN   3392
#define XCD_BAR_WORDS 3456
#define XB_SPIN_CAP (1u << 18)

__device__ __forceinline__ unsigned xb_ld(unsigned* p)              { return __hip_atomic_load(p, __ATOMIC_RELAXED, __HIP_MEMORY_SCOPE_AGENT); }
__device__ __forceinline__ unsigned xb_add(unsigned* p, unsigned v) { return __hip_atomic_fetch_add(p, v, __ATOMIC_RELAXED, __HIP_MEMORY_SCOPE_AGENT); }
__device__ __forceinline__ unsigned xb_xcc_id() { return (unsigned)__builtin_amdgcn_s_getreg((3 << 11) | 20) & 0xFu; }
#define XB_SPIN(cond, bar) do { unsigned _sp = 0; while (cond) { __builtin_amdgcn_s_sleep(1); \
    if ((++_sp & 255u) == 0u) { if (xb_ld(&(bar)[XB_TMO])) break; if (_sp > XB_SPIN_CAP) { atomicAdd(&(bar)[XB_TMO], 1u); break; } } } } while (0)

struct XcdBarrier {
    unsigned* bar; unsigned x;
    volatile LAS unsigned* st;
};

__device__ __forceinline__ XcdBarrier xcd_barrier_post(unsigned* bar, volatile LAS unsigned* st) {
    XcdBarrier b; b.bar = bar; b.x = xb_xcc_id(); b.st = st;
    if (threadIdx.x == 0) (void)xb_add(&bar[XB_XCNT(b.x)], 1u);
    return b;
}
__device__ __forceinline__ void xcd_barrier_complete(unsigned* bar, unsigned x, unsigned& nloc, unsigned& nx) {
    const unsigned G = gridDim.x * gridDim.y * gridDim.z;
    unsigned sum, cnt, mine, sp = 0u;
    for (;;) {
        sum = 0u; cnt = 0u; mine = 0u;
#pragma unroll
        for (unsigned j = 0; j < 16; ++j) { const unsigned c = xb_ld(&bar[XB_XCNT(j)]); sum += c; cnt += (c > 0u) ? 1u : 0u; mine = (j == x) ? c : mine; }
        if (sum == G) break;
        __builtin_amdgcn_s_sleep(1);
        if ((++sp & 255u) == 0u) { if (xb_ld(&bar[XB_TMO])) break; if (sp > XB_SPIN_CAP) { atomicAdd(&bar[XB_TMO], 1u); break; } }
    }
    nloc = mine > 0u ? mine : 1u; nx = cnt > 0u ? cnt : 1u;
}

__device__ __forceinline__ void xcd_barrier(const XcdBarrier& b) {
    asm volatile("s_waitcnt vmcnt(0)" ::: "memory");
    __syncthreads();
    if (threadIdx.x == 0) {
        unsigned* bar = b.bar;
        __builtin_amdgcn_s_waitcnt(0);
        unsigned nloc = b.st[0], nx = b.st[1];
        if (nloc == 0u) { xcd_barrier_complete(bar, b.x, nloc, nx); b.st[0] = nloc; b.st[1] = nx; }
        const unsigned old = xb_add(&bar[XB_XSUB(b.x)], 1u);
        const unsigned gen = old / nloc;
        if (old + 1u == (gen + 1u) * nloc) {
            __builtin_amdgcn_fence(__ATOMIC_RELEASE, "agent");
            asm volatile("s_waitcnt vmcnt(0)" ::: "memory");
            const unsigned og = xb_add(&bar[XB_TOP], 1u);
            const unsigned tg = og / nx;
            if (og + 1u == (tg + 1u) * nx) xb_add(&bar[XB_TOPGEN], 1u);
            else XB_SPIN(xb_ld(&bar[XB_TOPGEN]) == tg, bar);
            __builtin_amdgcn_fence(__ATOMIC_ACQUIRE, "agent");
            xb_add(&bar[XB_XGEN(b.x)], 1u);
            asm volatile("s_waitcnt vmcnt(0)" ::: "memory");
        } else {
            XB_SPIN(xb_ld(&bar[XB_XGEN(b.x)]) == gen, bar);
            __builtin_amdgcn_fence(__ATOMIC_ACQUIRE, "agent");
            asm volatile("s_waitcnt vmcnt(0)" ::: "memory");
        }
    }
    __syncthreads();
}


#ifndef GM
#define GM 7
#endif
#ifndef PH
#define PH 1023
#endif
__global__ void __launch_bounds__(512, 2) fwd_kernel(Params kp) {
    extern __shared__ __attribute__((aligned(16))) unsigned char lds[];
    cg::grid_group grid = cg::this_grid();
    LAS unsigned char* L = (LAS unsigned char*)lds; LAS float* F = (LAS float*)lds;
    const int G = gridDim.x, bid = blockIdx.x;
    Ctx p; p.out = kp.out; p.ws = kp.ws; p.tab = (LAS cfp*)(L + 131072);
    if (otid() == 0) { p.tab[0] = kp.xp; p.tab[1] = kp.xs; p.tab[2] = kp.cp; p.tab[3] = kp.cs; p.tab[4] = kp.ada_w; p.tab[5] = kp.ada_b; p.tab[6] = kp.pre_g; p.tab[7] = kp.post_g; p.tab[8] = kp.w_in;
        p.tab[9] = kp.wg2f; p.tab[10] = kp.bgf; p.tab[11] = kp.wg2b; p.tab[12] = kp.bgb; p.tab[13] = kp.onorm_g; p.tab[14] = kp.fnet_w; p.tab[15] = kp.qn_g; p.tab[16] = kp.kn_g; p.tab[17] = kp.sgu_ng;
        p.tab[18] = kp.sgu_w; p.tab[19] = kp.sgu_b; p.tab[20] = kp.w_out; }
    volatile LAS unsigned* bst = (volatile LAS unsigned*)(L + 131072 + 256);
    if (otid() < 4) bst[otid()] = 0u;
    __syncthreads();
    const XcdBarrier xbar = xcd_barrier_post((unsigned*)(p.ws + WS_BAR), bst);
    u16* P1 = (u16*)p.out; u16* P2 = (u16*)(p.ws + WS_P2); u16* HB = (u16*)(p.ws + WS_HB); u16* U0 = (u16*)(p.ws + WS_U0);


#if PH & 1
    phase0(p, L);
#endif
    grid.sync();
    for (int step = 0; step < 12; ++step) {
        const int l = step / 6, ph = step % 6;
        bool do_gemm = false; pg8::Gemm g{nullptr, nullptr, T_TOK, 0, 0, 0, 0}; pg8::EpiX E{0, nullptr, 0, nullptr, 0, 0};
        if (ph == 0) {
#if PH & 2
            phaseA(p, l);
#endif
        } else if (ph == 1) {
            g.A = HB; g.Bt = (const u16*)(p.ws + WS_WIN) + (size_t)l * 3584 * 1024; g.N = 3584; g.K = 1024; g.lda = 1024; g.ldb = 1024;
            E.mode = 0; E.O1 = P1; E.ld1 = P1P; E.O2 = P2; E.ld2 = P2P; do_gemm = true;
        } else if (ph == 2) {
#if PH & 4
            qk_prep(p, l);
#endif
#if PH & 8
            for (int it = bid; it < 2048; it += G) gla_local_item(p, l, it, F);
#endif
#if PH & 16
            for (int it = bid; it < 1024; it += G) sgu_item(p, l, it, F);
#endif
#if PH & 32
            for (int it = bid; it < 768; it += G) fnet1_item(p, it, F);
#endif
        } else if (ph == 3) {
#if PH & 64
            for (int it = bid; it < 192; it += G) gla_scan_item(p, it);
#endif
#if PH & 128
            for (int it = bid; it < 512; it += G) fnet2_item(p, it, F);
#endif
            __syncthreads();
#ifndef SKIP_ATTN
            for (int u = ((G & 7) == 0 ? (bid & 7) * (G >> 3) + (bid >> 3) : bid); u < 1024; u += G) {
                int s, h, qb;
                if (u < 512) { s = u >> 7; const int r = u & 127; h = r >> 4; qb = r & 15; } else { const int u2 = u - 512; s = 4 + (u2 >> 8); const int r = u2 & 255; h = r >> 5; qb = r & 31; }
                int row0, N; seq_info(s, row0, N);
                const attn_body::bf16* Pb = (const attn_body::bf16*)P1;
                const attn_body::bf16* KCb = (const attn_body::bf16*)(p.ws + WS_HB + HB_KC) + ((size_t)row0 * 2 + (size_t)(h >> 2) * N) * 64;
                const attn_body::bf16* VCb = (const attn_body::bf16*)(p.ws + WS_HB + HB_VC) + ((size_t)row0 * 2 + (size_t)(h >> 2) * N) * 64;
                attn_body::attn_unit<8>(Pb + (size_t)(row0 + qb * 256) * P1P + P1_Q + h * 64, KCb, VCb,
                                        (attn_body::bf16*)P1 + (size_t)(row0 + qb * 256) * P1P + 512 + h * 64, N >> 6, (char*)lds);
            }
#endif
        } else if (ph == 4) {
#if PH & 256
            for (int it = bid; it < 2048; it += G) gla_out_item(p, l, it, F);
#endif
            g.A = P2 + P2_U; g.Bt = (const u16*)(p.ws + WS_WF) + (size_t)l * 131072; g.N = 256; g.K = 512; g.lda = P2P; g.ldb = 512;
            E.mode = 2; E.O1 = P1; E.ld1 = P1P; E.col_off = 256; do_gemm = true;
        } else {
            g.A = P1; g.Bt = (const u16*)(p.ws + WS_WOUT) + (size_t)l * 1024 * 1280; g.N = 1024; g.K = 1280; g.lda = P1P; g.ldb = 1280;
            E.mode = 1; E.O1 = (l == 0) ? U0 : HB; E.ld1 = 1024; do_gemm = true;
        }
#if GM
        if (do_gemm) { pg8::StaticOrder S; S.init(T_TOK, g.N, G, bid); pg8::gemm_phase<pg8::EpiX, pg8::StaticOrder, PG8_ALIGN, PG8_SP2>(L, g, S, E); }
#endif
        xcd_barrier(xbar);
    }
#if PH & 2
    phaseA(p, 2);
#endif
}

extern "C" void kernel_launch(void* const* d_in, const int* in_sizes, int n_in, void* d_out, int out_size, void* d_ws, size_t ws_size, hipStream_t stream) {
    static int grid = 0;
    if (grid == 0) {
        if (n_in != 21 || out_size != T_TOK * 1024 || ws_size < WS_END) { fprintf(stderr, "kernel_launch: unexpected sizes n_in %d out %d ws %zu\n", n_in, out_size, ws_size); grid = -1; return; }
        int dev = 0, cus = 0, per_cu = 0;
        (void)hipGetDevice(&dev); (void)hipDeviceGetAttribute(&cus, hipDeviceAttributeMultiprocessorCount, dev);
        if (hipFuncSetAttribute((const void*)fwd_kernel, hipFuncAttributeMaxDynamicSharedMemorySize, LDS_BYTES) != hipSuccess) { fprintf(stderr, "kernel_launch: hipFuncSetAttribute failed\n"); grid = -1; return; }
        if (hipOccupancyMaxActiveBlocksPerMultiprocessor(&per_cu, (const void*)fwd_kernel, 512, LDS_BYTES) != hipSuccess || per_cu < 1) { fprintf(stderr, "kernel_launch: occupancy query gave %d\n", per_cu); per_cu = 1; }
        (void)hipGetLastError();
        grid = cus * 1;
        fprintf(stderr, "kernel_launch: grid %d (per_cu %d) ws %zu\n", grid, per_cu, ws_size);
    }
    if (grid < 0) return;
    Params p{};
    const float** pp = (const float**)&p;
    for (int i = 0; i < 21; ++i) pp[i] = (const float*)d_in[i];
    p.out = (float*)d_out; p.ws = (unsigned char*)d_ws;
    if (hipMemsetAsync((char*)d_ws + WS_MOD, 0, 2 * 6 * 3072 * sizeof(float), stream) != hipSuccess) { fprintf(stderr, "kernel_launch: memset failed\n"); return; }
    if (hipMemsetAsync((char*)d_ws + WS_BAR, 0, BAR_BYTES, stream) != hipSuccess) { fprintf(stderr, "kernel_launch: memset failed\n"); return; }
    void* args[] = {&p};
    hipError_t e = hipLaunchCooperativeKernel((const void*)fwd_kernel, dim3(grid), dim3(512), args, LDS_BYTES, stream);
    if (e != hipSuccess) fprintf(stderr, "cooperative launch failed: %s (grid %d)\n", hipGetErrorString(e), grid);
}
```

```cpp
#include <hip/hip_runtime.h>
#include <hip/hip_cooperative_groups.h>
#include <cstdio>
#include <cstdint>
namespace cg = cooperative_groups;
__device__ __forceinline__ int otid() { int t = threadIdx.x; asm volatile("" : "+v"(t)); return t; }
namespace pg8 {
#define PG8_LAS __attribute__((address_space(3)))
typedef unsigned short bf16_t;
typedef short bf16x8 __attribute__((ext_vector_type(8)));
typedef float f32x4 __attribute__((ext_vector_type(4)));
typedef unsigned u32x4 __attribute__((ext_vector_type(4)));
constexpr int BM = 256, BK = 64, HALF = 128, HTB = HALF * BK * 2  , STAGE_BYTES = 8 * HTB, NXCD = 8, WGM = 8;

__host__ __device__ __forceinline__ int lds_byte(int r, int c) { const int st = (r >> 4) * 2 + (c >> 5), rr = r & 15, cc = c & 31, ob = rr * 64 + cc * 2; return st * 1024 + (ob ^ (((ob >> 9) & 1) << 5)); }
__host__ __device__ __forceinline__ void stage_rc(int b, int& R, int& C) { const int st = b / 1024, sb = b % 1024, swz = sb ^ (((sb >> 9) & 1) << 5); R = (st >> 1) * 16 + swz / 64; C = (st & 1) * 32 + (swz % 64) / 2; }
__host__ __device__ __forceinline__ int perm32(int rho) { const int n = rho >> 4, i = rho & 15; return 8 * (i >> 2) + 4 * n + (i & 3); }

struct Unit { int pm, pn; };
struct Gemm { const bf16_t* A; const bf16_t* Bt; int M, N, K, lda, ldb; };

struct StaticOrder {
    int nM, nN, nwg, G, c;
    __host__ __device__ void init(int M, int N, int G_, int c_) { nM = M / BM; nN = N / BM; nwg = nM * nN; G = G_; c = c_; }
    __host__ __device__ bool next(int i, Unit& u) const {
        const long L = (long)i * G + c; if (L >= nwg) return false;
        int wgid = (int)L; { const int q = nwg / NXCD, r = nwg % NXCD, xcd = wgid % NXCD, off = wgid / NXCD; wgid = (xcd < r ? xcd * (q + 1) : r * (q + 1) + (xcd - r) * q) + off; }
        const int nig = WGM * nN, gid = wgid / nig, fm = gid * WGM, gsz = (nM - fm) < WGM ? (nM - fm) : WGM;
        u.pm = fm + ((wgid % nig) % gsz); u.pn = (wgid % nig) / gsz; return true;
    }
    __device__ __forceinline__ void a_ready(const Unit&) const {}
    __device__ __forceinline__ void done(const Unit&) const {}
};

__device__ __forceinline__ unsigned cvt_pk_bf16(float lo, float hi) { unsigned r; asm volatile("v_cvt_pk_bf16_f32 %0, %1, %2" : "=v"(r) : "v"(lo), "v"(hi)); return r; }
__device__ __forceinline__ float silu_f(float z) { return z / (1.f + __expf(-z)); }
struct EpiX {
    static constexpr bool PERM = true, AFTER_DRAIN = false;
    int mode; bf16_t* O1; int ld1; bf16_t* O2; int ld2; int col_off;
    __device__ __forceinline__ void operator()(const f32x4 (&acc)[2][2][4][2], const Unit& u, int wr, int wc, int fr, int fq) const {
        const int row0 = u.pm * BM + wr * 64 + fr;
        bf16_t* base; int ld, colt;
        if (mode == 0) { if (u.pn < 8) { base = O1; ld = ld1; colt = u.pn * BM; } else { base = O2; ld = ld2; colt = (u.pn - 8) * BM; } }
        else { base = O1; ld = ld1; colt = col_off + u.pn * BM; }
        const int col0 = colt + wc * 32 + 8 * fq;
#pragma unroll
        for (int ai = 0; ai < 2; ++ai)
#pragma unroll
            for (int m = 0; m < 4; ++m) { bf16_t* rowp = base + (size_t)(row0 + ai * HALF + m * 16) * ld + col0;
#pragma unroll
                for (int bj = 0; bj < 2; ++bj) { f32x4 v0 = acc[ai][bj][m][0], v1 = acc[ai][bj][m][1];
                    if (mode == 2) { const u32x4 z = *(const u32x4*)(rowp + bj * HALF);
                        v0[0] *= silu_f(__uint_as_float(z.x << 16)); v0[1] *= silu_f(__uint_as_float(z.x & 0xffff0000u));
                        v0[2] *= silu_f(__uint_as_float(z.y << 16)); v0[3] *= silu_f(__uint_as_float(z.y & 0xffff0000u));
                        v1[0] *= silu_f(__uint_as_float(z.z << 16)); v1[1] *= silu_f(__uint_as_float(z.z & 0xffff0000u));
                        v1[2] *= silu_f(__uint_as_float(z.w << 16)); v1[3] *= silu_f(__uint_as_float(z.w & 0xffff0000u)); }
                    u32x4 w; w.x = cvt_pk_bf16(v0[0], v0[1]); w.y = cvt_pk_bf16(v0[2], v0[3]); w.z = cvt_pk_bf16(v1[0], v1[1]); w.w = cvt_pk_bf16(v1[2], v1[3]);
                    *(u32x4*)(rowp + bj * HALF) = w; } }
    }
};
#ifndef PG8_SP2
#define PG8_SP2 true
#endif
#ifndef PG8_ALIGN
#define PG8_ALIGN true
#endif
template <class Epi, class Sched, bool ALIGN_EPI = false, bool SP2 = false>
__device__ __forceinline__ void gemm_phase(PG8_LAS unsigned char* lds, const Gemm g, const Sched& S, const Epi& E) {
    const int tid = otid(), wid = __builtin_amdgcn_readfirstlane(tid >> 6), lane = tid & 63, wr = wid >> 2, wc = wid & 3, fr = lane & 15, fq = lane >> 4;
    const int K = g.K, nt = K / BK;
    unsigned voffA[2], voffB[2];
#pragma unroll
    for (int i = 0; i < 2; ++i) { int R, C; stage_rc(tid * 16 + i * 8192, R, C); const int Rb = Epi::PERM ? ((R & ~31) + perm32(R & 31)) : R;
        voffA[i] = (unsigned)(R * g.lda + C) * 2u; voffB[i] = (unsigned)(Rb * g.ldb + C) * 2u; }
    const size_t kstep = (size_t)(BK * 2);
    const size_t hstepA = (size_t)HALF * g.lda * 2, hstepB = (size_t)HALF * g.ldb * 2;
    const size_t tstepA = 2 * hstepA, tstepB = 2 * hstepB;
    const unsigned ldsw = (unsigned)wid * 1024u;
    const int aoff = lds_byte(wr * 64 + fr, fq * 8), boff = lds_byte(wc * 32 + fr, fq * 8);
#define PG8_SA(b, h) (((b) * 2 + (h)) * HTB)
#define PG8_SB(b, h) ((4 + (b) * 2 + (h)) * HTB)
#define PG8_STAGE(bufoff, gbase, voff) do { _Pragma("unroll") for (int _i = 0; _i < 2; ++_i) \
        __builtin_amdgcn_global_load_lds((const unsigned*)((const char*)(gbase) + (voff)[_i]), (PG8_LAS unsigned*)(lds + (bufoff) + ldsw + _i * 8192), 16, 0, 0); } while (0)
#define PG8_LDA(dst, b, h) do { _Pragma("unroll") for (int m = 0; m < 4; ++m) _Pragma("unroll") for (int k = 0; k < 2; ++k) dst[m][k] = *(const PG8_LAS bf16x8*)(lds + PG8_SA(b, h) + aoff + m * 2048 + k * 1024); } while (0)
#define PG8_LDB(dst, b, h) do { _Pragma("unroll") for (int n = 0; n < 2; ++n) _Pragma("unroll") for (int k = 0; k < 2; ++k) dst[n][k] = *(const PG8_LAS bf16x8*)(lds + PG8_SB(b, h) + boff + n * 2048 + k * 1024); } while (0)
#define PG8_MMA(ai, bj, At, Bt) do { __builtin_amdgcn_s_setprio(1); _Pragma("unroll") for (int m = 0; m < 4; ++m) _Pragma("unroll") for (int n = 0; n < 2; ++n) _Pragma("unroll") for (int k = 0; k < 2; ++k) \
        acc[ai][bj][m][n] = __builtin_amdgcn_mfma_f32_16x16x32_bf16(Bt[n][k], At[m][k], acc[ai][bj][m][n], 0, 0, 0); __builtin_amdgcn_s_setprio(0); } while (0)
#define PG8_WAIT_V(n) asm volatile("s_waitcnt vmcnt(" #n ")" ::: "memory")
#define PG8_WAIT_L(n) asm volatile("s_waitcnt lgkmcnt(" #n ")" ::: "memory")
#define PG8_BAR __builtin_amdgcn_s_barrier()
#define PG8_SCHED __builtin_amdgcn_sched_barrier(0)
    Unit cur, nxt; int ui = 0;
    if (!S.next(0, cur)) return;
    f32x4 acc[2][2][4][2];
#pragma unroll
    for (int a = 0; a < 2; ++a)
#pragma unroll
        for (int b = 0; b < 2; ++b)
#pragma unroll
            for (int m = 0; m < 4; ++m)
#pragma unroll
                for (int n = 0; n < 2; ++n) acc[a][b][m][n] = (f32x4){0.f, 0.f, 0.f, 0.f};
    bf16x8 At[4][2], B0[2][2], B1[2][2];
    const char* cA = (const char*)g.A + (size_t)cur.pm * tstepA; const char* cB = (const char*)g.Bt + (size_t)cur.pn * tstepB;
    S.a_ready(cur);
    if constexpr (SP2) {
        PG8_STAGE(PG8_SB(0, 0), cB, voffB); PG8_STAGE(PG8_SB(0, 1), cB + hstepB, voffB); PG8_STAGE(PG8_SA(0, 0), cA, voffA); PG8_STAGE(PG8_SA(0, 1), cA + hstepA, voffA);
        if (wr == 1) PG8_BAR;
        PG8_WAIT_V(2); PG8_BAR;
        PG8_STAGE(PG8_SB(1, 0), cB + kstep, voffB); PG8_STAGE(PG8_SA(1, 0), cA + kstep, voffA); PG8_STAGE(PG8_SB(1, 1), cB + hstepB + kstep, voffB);
        PG8_WAIT_V(6); PG8_BAR;
    } else {
        PG8_STAGE(PG8_SB(0, 0), cB, voffB); PG8_STAGE(PG8_SA(0, 0), cA, voffA); PG8_STAGE(PG8_SB(0, 1), cB + hstepB, voffB); PG8_STAGE(PG8_SA(0, 1), cA + hstepA, voffA);
        if (wr == 1) PG8_BAR;
        PG8_WAIT_V(4); PG8_BAR;
        PG8_STAGE(PG8_SB(1, 0), cB + kstep, voffB); PG8_STAGE(PG8_SA(1, 0), cA + kstep, voffA); PG8_STAGE(PG8_SB(1, 1), cB + hstepB + kstep, voffB);
        PG8_WAIT_V(6); PG8_BAR;
    }
    for (;;) {
        const bool has_next = S.next(ui + 1, nxt);
        const char* nA = has_next ? (const char*)g.A + (size_t)nxt.pm * tstepA : cA; const char* nB = has_next ? (const char*)g.Bt + (size_t)nxt.pn * tstepB : cB;
        for (int t = 0; t < nt; t += 2) {
            const bool last = (t == nt - 2);
            const char* a1 = cA + (size_t)(t + 1) * kstep;
            const char* a2 = last ? nA : cA + (size_t)(t + 2) * kstep; const char* b2 = last ? nB : cB + (size_t)(t + 2) * kstep;
            const char* a3 = a2 + kstep; const char* b3 = b2 + kstep;
            if (last && has_next) S.a_ready(nxt);
            if constexpr (SP2) {
            PG8_LDB(B0, 0, 0); PG8_LDB(B1, 0, 1); PG8_SCHED; PG8_LDA(At, 0, 0); PG8_STAGE(PG8_SA(1, 1), a1 + hstepA, voffA);
            PG8_WAIT_V(8); PG8_WAIT_L(0); PG8_BAR; PG8_MMA(0, 0, At, B0); PG8_MMA(0, 1, At, B1); PG8_BAR; PG8_SCHED;
            PG8_LDA(At, 0, 1); PG8_STAGE(PG8_SB(0, 0), b2, voffB); PG8_STAGE(PG8_SB(0, 1), b2 + hstepB, voffB); PG8_STAGE(PG8_SA(0, 0), a2, voffA);
            PG8_WAIT_V(8); PG8_WAIT_L(0); PG8_BAR; PG8_MMA(1, 0, At, B0); PG8_MMA(1, 1, At, B1); PG8_BAR; PG8_SCHED;
            PG8_LDB(B0, 1, 0); PG8_LDB(B1, 1, 1); PG8_SCHED; PG8_LDA(At, 1, 0); PG8_STAGE(PG8_SA(0, 1), a2 + hstepA, voffA);
            PG8_WAIT_V(8); PG8_WAIT_L(0); PG8_BAR; PG8_MMA(0, 0, At, B0); PG8_MMA(0, 1, At, B1); PG8_BAR; PG8_SCHED;
            PG8_LDA(At, 1, 1); PG8_STAGE(PG8_SB(1, 0), b3, voffB); PG8_STAGE(PG8_SB(1, 1), b3 + hstepB, voffB); PG8_STAGE(PG8_SA(1, 0), a3, voffA);
            PG8_WAIT_V(8); PG8_WAIT_L(0); PG8_BAR; PG8_MMA(1, 0, At, B0); PG8_MMA(1, 1, At, B1); PG8_BAR; PG8_SCHED;
            } else {
            PG8_LDB(B0, 0, 0); PG8_SCHED; PG8_LDA(At, 0, 0); PG8_STAGE(PG8_SA(1, 1), a1 + hstepA, voffA);
            PG8_WAIT_L(8); PG8_BAR; PG8_WAIT_L(0); PG8_MMA(0, 0, At, B0); PG8_BAR; PG8_SCHED;
            PG8_LDB(B1, 0, 1); PG8_STAGE(PG8_SB(0, 0), b2, voffB);
            PG8_BAR; PG8_WAIT_L(0); PG8_MMA(0, 1, At, B1); PG8_BAR;
            PG8_LDA(At, 0, 1); PG8_STAGE(PG8_SA(0, 0), a2, voffA);
            PG8_BAR; PG8_WAIT_L(0); PG8_MMA(1, 0, At, B0); PG8_BAR; PG8_SCHED;
            PG8_STAGE(PG8_SB(0, 1), b2 + hstepB, voffB);
            PG8_WAIT_V(6); PG8_BAR; PG8_MMA(1, 1, At, B1); PG8_BAR;
            PG8_LDB(B0, 1, 0); PG8_SCHED; PG8_LDA(At, 1, 0); PG8_STAGE(PG8_SA(0, 1), a2 + hstepA, voffA);
            PG8_WAIT_L(8); PG8_BAR; PG8_WAIT_L(0); PG8_MMA(0, 0, At, B0); PG8_BAR; PG8_SCHED;
            PG8_LDB(B1, 1, 1); PG8_STAGE(PG8_SB(1, 0), b3, voffB);
            PG8_BAR; PG8_WAIT_L(0); PG8_MMA(0, 1, At, B1); PG8_BAR;
            PG8_LDA(At, 1, 1); PG8_STAGE(PG8_SA(1, 0), a3, voffA);
            PG8_BAR; PG8_WAIT_L(0); PG8_MMA(1, 0, At, B0); PG8_BAR; PG8_SCHED;
            PG8_STAGE(PG8_SB(1, 1), b3 + hstepB, voffB);
            PG8_WAIT_V(6); PG8_BAR; PG8_MMA(1, 1, At, B1); PG8_BAR;
            }
        }
        if constexpr (ALIGN_EPI) { if (wr == 0) PG8_BAR; }
        if constexpr (!Epi::AFTER_DRAIN) { E(acc, cur, wr, wc, fr, fq); S.done(cur); }
        if (!has_next) break;
#pragma unroll
        for (int a = 0; a < 2; ++a)
#pragma unroll
            for (int b = 0; b < 2; ++b)
#pragma unroll
                for (int m = 0; m < 4; ++m)
#pragma unroll
                    for (int n = 0; n < 2; ++n) acc[a][b][m][n] = (f32x4){0.f, 0.f, 0.f, 0.f};
        cur = nxt; cA = nA; cB = nB; ++ui;
        if constexpr (ALIGN_EPI) { if (wr == 1) PG8_BAR; }
    }
    PG8_WAIT_V(0);
    if constexpr (!ALIGN_EPI) { if (wr == 0) PG8_BAR; }
    PG8_BAR;
    if constexpr (Epi::AFTER_DRAIN) { E.fused(acc, cur, wr, wc, fr, fq, lds, wid, lane); S.done(cur); }
#undef PG8_SA
#undef PG8_SB
#undef PG8_STAGE
#undef PG8_LDA
#undef PG8_LDB
#undef PG8_MMA
#undef PG8_WAIT_V
#undef PG8_WAIT_L
#undef PG8_BAR
#undef PG8_SCHED
}
}
#include <hip/hip_bf16.h>
#include <cmath>
namespace attn_body {
using bf16=__hip_bfloat16;
using bf16x8=__attribute__((ext_vector_type(8)))short;
using s16x4=__attribute__((ext_vector_type(4)))short;
using f32x16=__attribute__((ext_vector_type(16)))float;
using u32x4=__attribute__((ext_vector_type(4)))unsigned;
constexpr int D=64,DM=2048,KDM=64;
constexpr int NW=8,QBLK=32,QB=QBLK*NW,KVBLK=64;
constexpr int ATTN_PITCH=DM, ATTN_UNIT_ROWS=QB;
__device__ __forceinline__ int crow(int r,int hi){return (r&3)+8*(r>>2)+4*hi;}
#define SBAR() __builtin_amdgcn_sched_barrier(0)
__device__ __forceinline__ void cmask(f32x16&p0,f32x16&p1,int jb,int qrel,int hi){
  const float NEG=-INFINITY; int kb=64*jb+4*hi;
  #pragma unroll
  for(int r=0;r<16;++r){int kv=kb+(r&3)+8*(r>>2); if(kv>qrel)p0[r]=NEG; if(kv+32>qrel)p1[r]=NEG;}
}

constexpr int NSLOT=3, SLOTB=8192;
constexpr int LDS_K=0, LDS_V=NSLOT*SLOTB, LDS_WS=2*NSLOT*SLOTB, LDS_OST=LDS_WS+NW*64*4, LDS_BYTES=LDS_OST+NW*4096;
constexpr float C2=0.125f*1.4426950408889634f;
__device__ __forceinline__ void glds16(const void*gsrc,unsigned lds_dst){unsigned keep;
  asm volatile("s_mov_b32 %0, m0\n\ts_mov_b32 m0, %2\n\ts_nop 0\n\tglobal_load_lds_dwordx4 %1, off\n\ts_mov_b32 m0, %0":"=&s"(keep):"v"(gsrc),"s"(lds_dst):"memory");}
__device__ __forceinline__ float max3f(float a,float b,float c){float r;asm("v_max3_f32 %0, %1, %2, %3":"=v"(r):"v"(a),"v"(b),"v"(c));return r;}
__device__ __forceinline__ float max2f(float a,float b){float r;asm("v_max_f32_e32 %0, %1, %2":"=v"(r):"v"(a),"v"(b));return r;}
__device__ __forceinline__ float fadd_s(float a,float b){float r;asm("v_add_f32_e32 %0, %1, %2":"=v"(r):"v"(a),"v"(b));return r;}
__device__ __forceinline__ float fsub_s(float a,float b){float r;asm("v_sub_f32_e32 %0, %1, %2":"=v"(r):"v"(a),"v"(b));return r;}
typedef float f32x2_t __attribute__((ext_vector_type(2))); typedef __bf16 bf16x2_t __attribute__((ext_vector_type(2)));
__device__ __forceinline__ unsigned cvtpk_s(float lo,float hi){f32x2_t v={lo,hi};bf16x2_t b=__builtin_convertvector(v,bf16x2_t);return __builtin_bit_cast(unsigned,b);}
#define WAIT_BAR(N) asm volatile("s_waitcnt vmcnt(" #N ") lgkmcnt(0)\n\ts_barrier":::"memory")

__device__ __forceinline__ void qkt(f32x16&p0,f32x16&p1,const char*Kslot,const bf16x8*qr,const f32x16&negm,int r32,int hi){
  const char*kb=Kslot+hi*1024+r32*16;
  #pragma unroll
  for(int d0=0;d0<4;++d0){
    const bf16x8 b0=*reinterpret_cast<const bf16x8*>(kb+d0*2048);
    const bf16x8 b1=*reinterpret_cast<const bf16x8*>(kb+d0*2048+512);
    if(d0==0){p0=__builtin_amdgcn_mfma_f32_32x32x16_bf16(b0,qr[0],negm,0,0,0);p1=__builtin_amdgcn_mfma_f32_32x32x16_bf16(b1,qr[0],negm,0,0,0);}
    else{p0=__builtin_amdgcn_mfma_f32_32x32x16_bf16(b0,qr[d0],p0,0,0,0);p1=__builtin_amdgcn_mfma_f32_32x32x16_bf16(b1,qr[d0],p1,0,0,0);}}
}
typedef __attribute__((address_space(3))) const char* lds_cptr;
typedef short v4i16_t __attribute__((ext_vector_type(4)));
__device__ __forceinline__ void kload8(bf16x8*kf,lds_cptr kp){
  kf[0]=*(const __attribute__((address_space(3))) bf16x8*)(kp);      kf[1]=*(const __attribute__((address_space(3))) bf16x8*)(kp+512);
  kf[2]=*(const __attribute__((address_space(3))) bf16x8*)(kp+2048); kf[3]=*(const __attribute__((address_space(3))) bf16x8*)(kp+2560);
  kf[4]=*(const __attribute__((address_space(3))) bf16x8*)(kp+4096); kf[5]=*(const __attribute__((address_space(3))) bf16x8*)(kp+4608);
  kf[6]=*(const __attribute__((address_space(3))) bf16x8*)(kp+6144); kf[7]=*(const __attribute__((address_space(3))) bf16x8*)(kp+6656);
}
__device__ __forceinline__ void kload2(bf16x8*kf,lds_cptr kp,int j){ kf[2*j]=*(const __attribute__((address_space(3))) bf16x8*)(kp+j*2048); kf[2*j+1]=*(const __attribute__((address_space(3))) bf16x8*)(kp+j*2048+512); }
__device__ __forceinline__ s16x4 vtr(lds_cptr p){ return __builtin_bit_cast(s16x4,__builtin_amdgcn_ds_read_tr16_b64_v4i16((__attribute__((address_space(3))) v4i16_t*)p)); }
__device__ __forceinline__ float rowmax(const f32x16&p0,const f32x16&p1){
  float a=max3f(p0[0],p0[1],p1[0]),b=max3f(p0[2],p0[3],p1[1]);a=max3f(a,p1[2],p1[3]);
  #pragma unroll
  for(int r=4;r<16;r+=4){a=max3f(a,p0[r],p0[r+1]);b=max3f(b,p0[r+2],p0[r+3]);a=max3f(a,p1[r],p1[r+1]);b=max3f(b,p1[r+2],p1[r+3]);}
  const float m=max2f(a,b);
  auto rr=__builtin_amdgcn_permlane32_swap(__float_as_uint(m),__float_as_uint(m),false,false);
  return max2f(__uint_as_float(rr[0]),__uint_as_float(rr[1]));
}
__device__ __forceinline__ void pv(f32x16*o,int vb,bf16x8 pa0,bf16x8 pa1,bf16x8 pa2,bf16x8 pa3){
  #pragma unroll
  for(int d0=0;d0<2;++d0){s16x4 lo[4],hi[4];
    #pragma unroll
    for(int ks=0;ks<4;++ks){
      asm volatile("ds_read_b64_tr_b16 %0,%1 offset:%c2":"=&v"(lo[ks]):"v"(vb),"i"(d0*4096+ks*1024):"memory");
      asm volatile("ds_read_b64_tr_b16 %0,%1 offset:%c2":"=&v"(hi[ks]):"v"(vb),"i"(d0*4096+ks*1024+512):"memory");}
    asm volatile("s_waitcnt lgkmcnt(0)":::"memory");SBAR();
    #define PK(k) (bf16x8){lo[k][0],lo[k][1],lo[k][2],lo[k][3],hi[k][0],hi[k][1],hi[k][2],hi[k][3]}
    o[d0]=__builtin_amdgcn_mfma_f32_32x32x16_bf16(pa0,PK(0),o[d0],0,0,0);
    o[d0]=__builtin_amdgcn_mfma_f32_32x32x16_bf16(pa1,PK(1),o[d0],0,0,0);
    o[d0]=__builtin_amdgcn_mfma_f32_32x32x16_bf16(pa2,PK(2),o[d0],0,0,0);
    o[d0]=__builtin_amdgcn_mfma_f32_32x32x16_bf16(pa3,PK(3),o[d0],0,0,0);
    #undef PK
  }
}

#ifndef ATTN_STORE16
#define ATTN_STORE16(p,v) (*(u32x4*)(p)=(v))
#endif
template<int THRL> __device__ __forceinline__ void attn_unit(const bf16*Qblk,const bf16*__restrict__ Kh,const bf16*__restrict__ Vh,bf16*Oblk,const int NT,char*shm){
  const int tid=otid(),lane=tid&63,r32=lane&31,hi=lane>>5; const int wid=__builtin_amdgcn_readfirstlane(tid>>6);
  const bf16*Qw=Qblk+(long)wid*QBLK*DM;
  const unsigned lds0=(unsigned)(uintptr_t)shm;
  float*wsf=(float*)(shm+LDS_WS)+wid*64;
  const bf16*ksrc=Kh+(long)lane*KDM+wid*8;
  const bf16*vsrc=Vh+(long)(16*(wid&3)+(lane>>2))*KDM+(wid>>2)*32+(lane&3)*8;
  const unsigned kdst=lds0+LDS_K+wid*1024, vdst=lds0+LDS_V+wid*1024;
  #define DMA_K(t,slot) glds16(ksrc+(long)(t)*KVBLK*KDM,(unsigned)__builtin_amdgcn_readfirstlane(kdst+(slot)))
  #define DMA_V(t,slot) glds16(vsrc+(long)(t)*KVBLK*KDM,(unsigned)__builtin_amdgcn_readfirstlane(vdst+(slot)))
  const int vb0=(int)(lds0+LDS_V)+((lane>>4)&1)*32+(lane&3)*8+(4*hi+((lane&15)>>2))*64;
  const char*Kbase=shm+LDS_K; bf16x8 kf[8];
  const lds_cptr shm3=(lds_cptr)shm; const lds_cptr kp0=shm3+LDS_K+hi*1024+r32*16; const lds_cptr vp0=shm3+LDS_V+((lane>>4)&1)*32+(lane&3)*8+(4*hi+((lane&15)>>2))*64;
  DMA_K(0,0);DMA_V(0,0);DMA_K(1,SLOTB);
  bf16x8 qr[4];
  #pragma unroll
  for(int d0=0;d0<4;++d0)qr[d0]=*reinterpret_cast<const bf16x8*>(&Qw[(long)r32*DM+d0*16+hi*8]);
  float mhat=0.f,l_reg=0.f;f32x16 o[2];o[0]=f32x16{};o[1]=f32x16{};f32x16 negm=f32x16{};asm volatile("":"+v"(negm));
  #define CMASK(P0,P1,t) do{}while(0)
  bool resc=false;
  #define START(P0,P1) do{ const float rm=rowmax(P0,P1); resc=false; \
    { const float dl=rm; mhat=fadd_s(mhat,dl); \
      _Pragma("unroll") for(int r=0;r<16;++r){P0[r]=fsub_s(P0[r],dl);P1[r]=fsub_s(P1[r],dl);} \
      _Pragma("unroll") for(int r=0;r<16;++r)negm[r]=-mhat; asm volatile("":"+v"(negm)); } \
    _Pragma("unroll") for(int r=0;r<16;++r)P0[r]=__builtin_amdgcn_exp2f(P0[r]); }while(0)
  #define RESC() do{ if(resc){ asm volatile("s_waitcnt lgkmcnt(0)":::"memory"); \
      _Pragma("unroll") for(int d_=0;d_<2;++d_) _Pragma("unroll") for(int r=0;r<16;++r)o[d_][r]*=wsf[crow(r,hi)]; } }while(0)
  f32x16 pA0,pA1,pB0,pB1;
  int sl_prev=0,sl_cur=0,sl_next=SLOTB;
  #define ROT() do{sl_prev=sl_cur;sl_cur=sl_next;sl_next=(sl_next==(NSLOT-1)*SLOTB)?0:sl_next+SLOTB;}while(0)
  DMA_K(2,2*SLOTB);
  WAIT_BAR(3);
  qkt(pA0,pA1,Kbase,qr,negm,r32,hi);asm volatile("s_nop 15\n\ts_nop 7":"+v"(pA0),"+v"(pA1));CMASK(pA0,pA1,0);
  START(pA0,pA1);
  _Pragma("unroll") for(int r=0;r<16;++r)pA1[r]=__builtin_amdgcn_exp2f(pA1[r]);
  WAIT_BAR(0);
  DMA_K(3,0);DMA_V(1,SLOTB);
  ROT();
  kload8(kf,kp0+sl_cur);
  WAIT_BAR(2);
  s16x4 vlo[8],vhi[8]; u32x4 pw0,pw1,pw2,pw3;
  #define PKW(P,B) cvtpk_s(P[B],P[B+1])
  #define PAF(k) __builtin_bit_cast(bf16x8,pw##k)
  #define VFR(i) (bf16x8){vlo[i][0],vlo[i][1],vlo[i][2],vlo[i][3],vhi[i][0],vhi[i][1],vhi[i][2],vhi[i][3]}
  #define PIN(x) asm volatile("":"+v"(x))
  #define MX3(a,b,c) __builtin_fmaxf(__builtin_fmaxf((a),(b)),(c))
  #define GAPA(MF,A0,A1,A2,A3,W0,W1,PW) do{ MF; sacc+=A0; sacc+=A1; sacc+=A2; sacc+=A3; PIN(sacc); W0; W1; PIN(PW); SBAR(); }while(0)
  #define EX(v) __builtin_amdgcn_exp2f(v)
  #define GAPB(MF,X,B) do{ MF; X[B]=EX(X[B]); X[B+1]=EX(X[B+1]); X[B+2]=EX(X[B+2]); X[B+3]=EX(X[B+3]); PIN(X); SBAR(); }while(0)
  #define VRD(i) do{ vlo[i]=vtr(vp_+(((i)>>2)*4096+((i)&3)*1024)); vhi[i]=vtr(vp_+(((i)>>2)*4096+((i)&3)*1024+512)); }while(0)
  #define KRD(G,j) do{ if(G){ kload2(kf,kp0+sl_next,j); SBAR(); } }while(0)
  #define STEP(C0,C1,P0,P1,t,GK,GV,GL) do{ SBAR(); \
    const lds_cptr vp_=vp0+sl_prev; \
    VRD(0); SBAR(); float sacc=(P0[0]+P0[1]); \
    GAPA(C0=__builtin_amdgcn_mfma_f32_32x32x16_bf16(kf[0],qr[0],negm,0,0,0), P0[2],P0[3],P0[4],P0[5],     pw0[0]=PKW(P0,0), pw0[1]=PKW(P0,2), pw0); \
    VRD(4); SBAR(); GAPA(C1=__builtin_amdgcn_mfma_f32_32x32x16_bf16(kf[1],qr[0],negm,0,0,0), P0[6],P0[7],P0[8],P0[9],     pw0[2]=PKW(P0,4), pw0[3]=PKW(P0,6), pw0); \
    VRD(1); SBAR(); GAPA(C0=__builtin_amdgcn_mfma_f32_32x32x16_bf16(kf[2],qr[1],C0,0,0,0),   P0[10],P0[11],P0[12],P0[13], pw1[0]=PKW(P0,8), pw1[1]=PKW(P0,10), pw1); \
    VRD(5); SBAR(); GAPA(C1=__builtin_amdgcn_mfma_f32_32x32x16_bf16(kf[3],qr[1],C1,0,0,0),   P0[14],P0[15],P1[0],P1[1],   pw1[2]=PKW(P0,12),pw1[3]=PKW(P0,14), pw1); \
    VRD(2); SBAR(); GAPA(C0=__builtin_amdgcn_mfma_f32_32x32x16_bf16(kf[4],qr[2],C0,0,0,0),   P1[2],P1[3],P1[4],P1[5],     pw2[0]=PKW(P1,0), pw2[1]=PKW(P1,2), pw2); \
    VRD(6); SBAR(); GAPA(C1=__builtin_amdgcn_mfma_f32_32x32x16_bf16(kf[5],qr[2],C1,0,0,0),   P1[6],P1[7],P1[8],P1[9],     pw2[2]=PKW(P1,4), pw2[3]=PKW(P1,6), pw2); \
    VRD(3); SBAR(); GAPA(C0=__builtin_amdgcn_mfma_f32_32x32x16_bf16(kf[6],qr[3],C0,0,0,0),   P1[10],P1[11],P1[12],P1[13], pw3[0]=PKW(P1,8), pw3[1]=PKW(P1,10), pw3); \
    VRD(7); SBAR(); GAPA(C1=__builtin_amdgcn_mfma_f32_32x32x16_bf16(kf[7],qr[3],C1,0,0,0),   P1[14],P1[15],0.f,0.f,       pw3[2]=PKW(P1,12),pw3[3]=PKW(P1,14), pw3); \
    l_reg+=sacc; \
    if(GK){DMA_K((t)+3,sl_cur);} if(GV){DMA_V((t)+1,sl_next);} \
    CMASK(C0,C1,t); \
    { float a=MX3(C0[0],C0[1],C1[0]),b=MX3(C0[2],C0[3],C1[1]); a=MX3(a,C1[2],C1[3]); \
      _Pragma("unroll") for(int r=4;r<16;r+=4){a=MX3(a,C0[r],C0[r+1]);b=MX3(b,C0[r+2],C0[r+3]);a=MX3(a,C1[r],C1[r+1]);b=MX3(b,C1[r+2],C1[r+3]);} \
      float rm=__builtin_fmaxf(a,b); { auto rr=__builtin_amdgcn_permlane32_swap(__float_as_uint(rm),__float_as_uint(rm),false,false); rm=__builtin_fmaxf(__uint_as_float(rr[0]),__uint_as_float(rr[1])); } \
      resc=false; \
      if(__builtin_expect(__any(rm>(float)THRL),0)){ const float dl=__builtin_fmaxf(rm,0.f); mhat+=dl; \
        _Pragma("unroll") for(int r=0;r<16;++r){C0[r]-=dl;C1[r]-=dl;} \
        _Pragma("unroll") for(int r=0;r<16;++r)negm[r]=-mhat; asm volatile("":"+v"(negm)); \
        const float f=__builtin_amdgcn_exp2f(-dl); l_reg*=f; if(hi==0)wsf[r32]=f; resc=true; } } \
    SBAR(); \
    GAPB(o[0]=__builtin_amdgcn_mfma_f32_32x32x16_bf16(PAF(0),VFR(0),o[0],0,0,0), C0,0); \
    GAPB(o[1]=__builtin_amdgcn_mfma_f32_32x32x16_bf16(PAF(0),VFR(4),o[1],0,0,0), C0,4); \
    KRD(GL,0); GAPB(o[0]=__builtin_amdgcn_mfma_f32_32x32x16_bf16(PAF(1),VFR(1),o[0],0,0,0), C0,8); \
    KRD(GL,1); GAPB(o[1]=__builtin_amdgcn_mfma_f32_32x32x16_bf16(PAF(1),VFR(5),o[1],0,0,0), C0,12); \
    KRD(GL,2); GAPB(o[0]=__builtin_amdgcn_mfma_f32_32x32x16_bf16(PAF(2),VFR(2),o[0],0,0,0), C1,0); \
    KRD(GL,3); GAPB(o[1]=__builtin_amdgcn_mfma_f32_32x32x16_bf16(PAF(2),VFR(6),o[1],0,0,0), C1,4); \
    GAPB(o[0]=__builtin_amdgcn_mfma_f32_32x32x16_bf16(PAF(3),VFR(3),o[0],0,0,0), C1,8); \
    GAPB(o[1]=__builtin_amdgcn_mfma_f32_32x32x16_bf16(PAF(3),VFR(7),o[1],0,0,0), C1,12); \
    }while(0)
  int t=1;
  #undef CMASK
  #define CMASK(P0,P1,t) do{}while(0)
  for(;t+5<NT;t+=2){
    STEP(pB0,pB1,pA0,pA1,t,true,true,true);     WAIT_BAR(2); RESC(); ROT();
    STEP(pA0,pA1,pB0,pB1,t+1,true,true,true);   WAIT_BAR(2); RESC(); ROT();
  }
  #undef CMASK
  #define CMASK(P0,P1,t) do{}while(0)
  #define ENDW(tt) do{ if((tt)+3<NT){WAIT_BAR(2);} else if((tt)+2<NT){WAIT_BAR(1);} else {WAIT_BAR(0);} }while(0)
  for(;t+1<NT;t+=2){
    STEP(pB0,pB1,pA0,pA1,t,(t+3<NT),(t+1<NT),(t+1<NT));       ENDW(t);   RESC(); ROT();
    STEP(pA0,pA1,pB0,pB1,t+1,(t+4<NT),(t+2<NT),(t+2<NT));     ENDW(t+1); RESC(); ROT();
  }
  STEP(pB0,pB1,pA0,pA1,NT-1,false,false,false); RESC();
  { float sacc=pB0[0]+pB0[1]; _Pragma("unroll") for(int r=2;r<16;++r)sacc+=pB0[r]; _Pragma("unroll") for(int r=0;r<16;++r)sacc+=pB1[r]; l_reg+=sacc;
    pw0=(u32x4){PKW(pB0,0),PKW(pB0,2),PKW(pB0,4),PKW(pB0,6)};pw1=(u32x4){PKW(pB0,8),PKW(pB0,10),PKW(pB0,12),PKW(pB0,14)};pw2=(u32x4){PKW(pB1,0),PKW(pB1,2),PKW(pB1,4),PKW(pB1,6)};pw3=(u32x4){PKW(pB1,8),PKW(pB1,10),PKW(pB1,12),PKW(pB1,14)};
    SBAR(); pv(o,vb0+sl_cur,PAF(0),PAF(1),PAF(2),PAF(3)); }
  #undef PKW
  #undef PAF
  #undef VFR
  #undef PIN
  #undef MX3
  #undef GAPA
  #undef GAPB
  #undef EX
  #undef VRD
  #undef KRD
  #undef STEP
  #undef ENDW
  {auto rr=__builtin_amdgcn_permlane32_swap(__float_as_uint(l_reg),__float_as_uint(l_reg),false,false);l_reg=__uint_as_float(rr[0])+__uint_as_float(rr[1]);}
  if(hi==0)wsf[32+r32]=l_reg;asm volatile("s_waitcnt lgkmcnt(0)":::"memory");
  float rli[16];
  #pragma unroll
  for(int r=0;r<16;++r)rli[r]=__builtin_amdgcn_rcpf(wsf[32+crow(r,hi)]);
  bf16*Ow=Oblk+(long)wid*QBLK*DM;
  { bf16*stg=(bf16*)(shm+LDS_OST)+wid*2048;
    #pragma unroll
    for(int r=0;r<16;++r){const int orow=crow(r,hi);
      #pragma unroll
      for(int d0=0;d0<2;++d0)stg[orow*64+d0*32+r32]=__float2bfloat16(o[d0][r]*rli[r]);}
    asm volatile("s_waitcnt lgkmcnt(0)":::"memory");
    #pragma unroll
    for(int i=0;i<4;++i){const int row=i*8+(lane>>3),ch=lane&7; const u32x4 v=*(const u32x4*)(stg+row*64+ch*8); const u32x4 z=*(const u32x4*)(Ow+(long)row*DM+ch*8); u32x4 w;
      #pragma unroll
      for(int e=0;e<4;++e){ const float a0=__uint_as_float(v[e]<<16),a1=__uint_as_float(v[e]&0xffff0000u),z0=__uint_as_float(z[e]<<16),z1=__uint_as_float(z[e]&0xffff0000u);
        w[e]=cvtpk_s(a0*z0/(1.f+__expf(-z0)),a1*z1/(1.f+__expf(-z1))); }
      ATTN_STORE16(Ow+(long)row*DM+ch*8,w);} }
  asm volatile("s_waitcnt lgkmcnt(0)\n\ts_barrier":::"memory");
  #undef DMA_K
  #undef DMA_V
  #undef CMASK
  #undef START
  #undef RESC
  #undef ROT
}
constexpr int ATTN_LDS_BYTES=LDS_BYTES;
}
typedef unsigned short u16;
#define LAS __attribute__((address_space(3)))
#define DI __device__ __forceinline__
typedef unsigned v4u __attribute__((ext_vector_type(4)));
typedef unsigned v2u __attribute__((ext_vector_type(2)));
typedef float v4f __attribute__((ext_vector_type(4)));

constexpr int T_TOK = 32768, P1P = 2048, P2P = 1536;
constexpr int P1_Z = 0, P1_Q = 1280, P1_K = 1792, P1_V = 1920;
constexpr int P2_AQ = 0, P2_AK = 128, P2_AV = 256, P2_GF = 512, P2_GB = 640, P2_BU = 768, P2_DU = 1024, P2_DV = 1280, P2_U = 1024;
constexpr size_t MiB = 1u << 20;
constexpr size_t WS_DFT = 256 * 1024, WS_BAR = 512 * 1024, BAR_BYTES = 16384;
constexpr size_t WS_MOD = 0, WS_WIN = 2 * MiB, WS_WOUT = 16 * MiB, WS_WF = 21 * MiB, WS_U0 = 22 * MiB, WS_HB = 86 * MiB, WS_P2 = 150 * MiB, WS_DEC = 246 * MiB, WS_END = 247 * MiB;
constexpr size_t HB_GS = 0, HB_KC = 16 * MiB, HB_VC = 24 * MiB, HB_TP = 32 * MiB;
constexpr int LDS_BYTES = 147456;
constexpr float EPSN = 1e-6f;
constexpr float ATT_C2 = 0.125f * 1.4426950408889634f;

struct Params {
    const float *xp, *xs, *cp, *cs, *ada_w, *ada_b, *pre_g, *post_g, *w_in, *wg2f, *bgf, *wg2b, *bgb, *onorm_g, *fnet_w, *qn_g, *kn_g, *sgu_ng, *sgu_w, *sgu_b, *w_out;
    float* out; unsigned char* ws;
};
typedef const float* cfp;
struct Ctx { float* out; unsigned char* ws; LAS cfp* tab; };

DI float bf2f(u16 v) { return __uint_as_float((unsigned)v << 16); }
DI float bflo(unsigned w) { return __uint_as_float(w << 16); }
DI float bfhi(unsigned w) { return __uint_as_float(w & 0xffff0000u); }
DI unsigned f2bf(float f) { unsigned u = __float_as_uint(f); return (u + 0x7fffu + ((u >> 16) & 1u)) >> 16; }
DI unsigned pk2(float lo, float hi) { return f2bf(lo) | (f2bf(hi) << 16); }
DI float wave_sum(float v) {
#pragma unroll
    for (int o = 1; o < 64; o <<= 1) v += __shfl_xor(v, o);
    return v;
}
using pg8::silu_f;
DI float logsig(float x) { return fminf(x, 0.f) - log1pf(__expf(-fabsf(x))); }
DI void seq_info(int s, int& row0, int& N) { if (s < 4) { row0 = s * 4096; N = 4096; } else { row0 = 16384 + (s - 4) * 8192; N = 8192; } }
DI int row_seq(int r) { return r < 16384 ? (r >> 12) : 4 + ((r - 16384) >> 13); }
DI void unpack8(const v4u r, float (&f)[8]) { f[0] = bflo(r.x); f[1] = bfhi(r.x); f[2] = bflo(r.y); f[3] = bfhi(r.y); f[4] = bflo(r.z); f[5] = bfhi(r.z); f[6] = bflo(r.w); f[7] = bfhi(r.w); }
DI v4u pack8(const float (&f)[8]) { v4u r; r.x = pk2(f[0], f[1]); r.y = pk2(f[2], f[3]); r.z = pk2(f[4], f[5]); r.w = pk2(f[6], f[7]); return r; }
#define LDS_WAIT() asm volatile("s_waitcnt lgkmcnt(0)" ::: "memory")


typedef short bf16x8_t __attribute__((ext_vector_type(8)));
typedef float f32x4_t __attribute__((ext_vector_type(4)));
DI bf16x8_t ldfrag(const LAS u16* base, int pitch, int row0, int k0, int lane) { return *(const LAS bf16x8_t*)(base + (row0 + (lane & 15)) * pitch + k0 + 8 * (lane >> 4)); }
typedef short s16x4_t __attribute__((ext_vector_type(4)));
DI bf16x8_t ldfrag_tr(const LAS u16* base, int pitch, int k0, int n0, int lane) {
    const LAS u16* a0 = base + (k0 + 8 * (lane >> 4) + ((lane & 15) >> 2)) * pitch + n0 + 4 * (lane & 3);
    const s16x4_t lo = __builtin_amdgcn_ds_read_tr16_b64_v4i16((LAS s16x4_t*)a0), hi = __builtin_amdgcn_ds_read_tr16_b64_v4i16((LAS s16x4_t*)(a0 + 4 * pitch));
    return (bf16x8_t){lo[0], lo[1], lo[2], lo[3], hi[0], hi[1], hi[2], hi[3]};
}
#define MFMA16(a, b, c) __builtin_amdgcn_mfma_f32_16x16x32_bf16((a), (b), (c), 0, 0, 0)
DI float wave_prefix(float g, int lane) {
#pragma unroll
    for (int o = 1; o < 64; o <<= 1) { const float t = __shfl_up(g, o); if (lane >= o) g += t; }
    return g; }
DI float wave_suffix(float g, int lane) {
#pragma unroll
    for (int o = 1; o < 64; o <<= 1) { const float t = __shfl_down(g, o); if (lane + o < 64) g += t; }
    return g; }
DI int win_src_col(int j) {
    if (j < 1280) return 2080 + j;
    if (j < 1792) return 800 + (j - 1280);
    if (j < 1920) return 1312 + (j - 1792);
    if (j < 2048) return 1440 + (j - 1920);
    const int q = j - 2048;
    if (q < 512) return q;
    if (q < 768) return -1;
    if (q < 1024) return 544 + (q - 768);
    if (q < 1280) return 1568 + (q - 1024);
    return 1824 + (q - 1280);
}
DI void transpose_item(const float* W, int ldw, int src_n0, int K, u16* WT, int dst_n0, int k0, LAS float* scr, int lane) {
    float tv[32];
#pragma unroll
    for (int i = 0; i < 32; ++i) tv[i] = W[(size_t)(k0 + 2 * i + (lane >> 5)) * ldw + src_n0 + (lane & 31)];
#pragma unroll
    for (int i = 0; i < 32; ++i) scr[(2 * i + (lane >> 5)) * 33 + (lane & 31)] = tv[i];
    LDS_WAIT();
    const int c = lane & 7;
#pragma unroll
    for (int j = 0; j < 4; ++j) { const int n = (lane >> 3) + 8 * j; const LAS float* s = scr + (8 * c) * 33 + n;
        v4u o; o.x = pk2(s[0 * 33], s[1 * 33]); o.y = pk2(s[2 * 33], s[3 * 33]); o.z = pk2(s[4 * 33], s[5 * 33]); o.w = pk2(s[6 * 33], s[7 * 33]);
        *(v4u*)(WT + (size_t)(dst_n0 + n) * K + k0 + 8 * c) = o; }
    LDS_WAIT();
}
DI void phase0(const Ctx& p, LAS unsigned char* L) {
    const int tid = otid(), lane = tid & 63, wave = tid >> 6;
    const int gw = blockIdx.x * 8 + wave, NGW = gridDim.x * 8, gt = blockIdx.x * 512 + tid, NGT = gridDim.x * 512;
    LAS float* scr = (LAS float*)(L + wave * 16384);
    u16* WinT = (u16*)(p.ws + WS_WIN); u16* WoutT = (u16*)(p.ws + WS_WOUT); u16* WfT = (u16*)(p.ws + WS_WF); float* mod = (float*)(p.ws + WS_MOD);
    constexpr int I_IN = 16 * 112, I_OUT = 20 * 32, I_L = I_IN + I_OUT;
    for (int it = gw; it < 2 * I_L; it += NGW) {
        const int l = it / I_L; int r = it % I_L;
        if (r < I_IN) { const int kb = r / 112, nb = r % 112; const int src = win_src_col(nb * 32); if (src < 0) continue;
            transpose_item(p.tab[8] + (size_t)l * 1024 * 3360, 3360, src, 1024, WinT + (size_t)l * 3584 * 1024, nb * 32, kb * 64, scr, lane); }
        else { r -= I_IN; const int kb = r / 32, nb = r % 32;
            transpose_item(p.tab[20] + (size_t)l * 1280 * 1024, 1024, nb * 32, 1280, WoutT + (size_t)l * 1024 * 1280, nb * 32, kb * 64, scr, lane); }
    }
    for (int e = gt; e < 2 * 16 * 1024; e += NGT) { const int l = e >> 14, r = e & 16383, jg = r >> 10, k = r & 1023, dirb = jg >> 3, jj0 = (jg & 7) * 16;
        const float* wi = p.tab[8] + (size_t)l * 1024 * 3360 + (size_t)k * 3360 + 512 + dirb * 16; float wv[16];
#pragma unroll
        for (int r2 = 0; r2 < 16; ++r2) wv[r2] = wi[r2];
        const float* w2 = (dirb ? p.tab[11] : p.tab[9]) + l * 16 * 128 + jj0;
        for (int q = 0; q < 16; ++q) { float a = 0.f;
#pragma unroll
            for (int r2 = 0; r2 < 16; ++r2) a += wv[r2] * w2[r2 * 128 + q];
            WinT[(size_t)l * 3584 * 1024 + (size_t)(2560 + dirb * 128 + jj0 + q) * 1024 + k] = (u16)f2bf(a); } }
    { LAS float* trig = (LAS float*)(L + 126976);
        if (tid < 64) { trig[tid] = cospif((float)tid * (1.f / 32.f)); trig[64 + tid] = sinpif((float)tid * (1.f / 32.f)); }
        __syncthreads();
        for (int e = gt; e < 2 * 256 * 512; e += NGT) { const int l = e >> 17, r = e & 131071, n = r >> 9, kk = r & 511, im = kk >> 8, g = (kk & 255) >> 6, c = kk & 63;
            const float* fw = p.tab[14] + (size_t)l * 65536 + (size_t)(g * 64) * 256 + n; const LAS float* tb = trig + im * 64; float a = 0.f;
#pragma unroll 8
            for (int j2 = 0; j2 < 64; ++j2) a += tb[(j2 * c) & 63] * fw[j2 * 256];
            WfT[(size_t)l * 131072 + n * 512 + kk] = (u16)f2bf(a * 0.125f); } }
    { u16* dft = (u16*)(p.ws + WS_DFT);
        for (int e = gt; e < 4096; e += NGT) { const int k = e >> 6, n = e & 63; const float a = (float)((k * n) & 63) * (1.f / 32.f); dft[e] = (u16)f2bf(cospif(a)); dft[4096 + e] = (u16)f2bf(sinpif(a)); }
        for (int e = gt; e < 16384; e += NGT) { const int k = e >> 7, n = e & 127; const float a = (float)((k * n) & 127) * (1.f / 64.f); dft[8192 + e] = (u16)f2bf(cospif(a)); dft[8192 + 16384 + e] = (u16)f2bf(sinpif(a)); } }
    __syncthreads();
    LAS float* sc = (LAS float*)L;
    for (int e = tid; e < 6144; e += 512) { const int s = e >> 10, k = e & 1023; const float c = s < 4 ? p.tab[2][s * 1024 + k] : p.tab[3][(s - 4) * 1024 + k]; sc[e] = c / (1.f + expf(-c)); }
    __syncthreads();
    for (int unit = gw; unit < 768; unit += NGW) {
        const int ks = unit & 7, jb = (unit >> 3) % 48, l = unit / 384, j = jb * 64 + lane;
        float acc[6] = {0.f, 0.f, 0.f, 0.f, 0.f, 0.f};
        const float* aw = p.tab[4] + (size_t)l * 1024 * 3072 + (size_t)(ks * 128) * 3072 + j;
#pragma unroll 16
        for (int k = 0; k < 128; ++k) { const float w = aw[(size_t)k * 3072];
#pragma unroll
            for (int s = 0; s < 6; ++s) acc[s] += sc[s * 1024 + ks * 128 + k] * w; }
        if (ks == 0) { const float b = p.tab[5][l * 3072 + j];
#pragma unroll
            for (int s = 0; s < 6; ++s) acc[s] += b; }
#pragma unroll
        for (int s = 0; s < 6; ++s) atomicAdd(mod + (size_t)(l * 6 + s) * 3072 + j, acc[s]);
    }
}

DI void add_branch(v4f (&v)[4], const u16* urow, const float* gate, const float* pg, int lane) {
    v4f u[4]; float ss = 0.f;
#pragma unroll
    for (int j = 0; j < 4; ++j) { const v2u r = *(const v2u*)(urow + 256 * j + 4 * lane); u[j] = (v4f){bflo(r.x), bfhi(r.x), bflo(r.y), bfhi(r.y)};
        ss += (u[j].x * u[j].x + u[j].y * u[j].y) + (u[j].z * u[j].z + u[j].w * u[j].w); }
    const float rstd = 1.f / sqrtf(wave_sum(ss) * (1.f / 1024.f) + EPSN);
#pragma unroll
    for (int j = 0; j < 4; ++j) { const v4f g = *(const v4f*)(gate + 256 * j + 4 * lane), q = *(const v4f*)(pg + 256 * j + 4 * lane); v[j] += g * (u[j] * rstd * q); }
}
DI void phaseA(const Ctx& p, int l) {
    const int tid = otid(), lane = tid & 63, wave = tid >> 6, gw = blockIdx.x * 8 + wave, NGW = gridDim.x * 8;
    const float* mod = (const float*)(p.ws + WS_MOD); const u16* U0 = (const u16*)(p.ws + WS_U0); u16* HB = (u16*)(p.ws + WS_HB);
    for (int row = gw; row < T_TOK; row += NGW) {
        const int s = row_seq(row);
        const float* xr = row < 16384 ? p.tab[0] + (size_t)row * 1024 : p.tab[1] + (size_t)(row - 16384) * 1024;
        v4f v[4];
#pragma unroll
        for (int j = 0; j < 4; ++j) v[j] = *(const v4f*)(xr + 256 * j + 4 * lane);
        if (l >= 1) add_branch(v, U0 + (size_t)row * 1024, mod + (size_t)(0 * 6 + s) * 3072 + 2048, p.tab[7], lane);
        if (l == 2) { add_branch(v, HB + (size_t)row * 1024, mod + (size_t)(1 * 6 + s) * 3072 + 2048, p.tab[7] + 1024, lane);
            float* o = p.out + (size_t)row * 1024;
#pragma unroll
            for (int j = 0; j < 4; ++j) *(v4f*)(o + 256 * j + 4 * lane) = v[j];
            continue; }
        float ss = 0.f;
#pragma unroll
        for (int j = 0; j < 4; ++j) ss += (v[j].x * v[j].x + v[j].y * v[j].y) + (v[j].z * v[j].z + v[j].w * v[j].w);
        const float rstd = 1.f / sqrtf(wave_sum(ss) * (1.f / 1024.f) + EPSN);
        const float* md = mod + (size_t)(l * 6 + s) * 3072;
#pragma unroll
        for (int j = 0; j < 4; ++j) { const int col = 256 * j + 4 * lane;
            const v4f sh = *(const v4f*)(md + col), scl = *(const v4f*)(md + 1024 + col), g = *(const v4f*)(p.tab[6] + l * 1024 + col);
            const v4f h = v[j] * rstd * g * (scl + 1.f) + sh;
            v2u o; o.x = pk2(h.x, h.y); o.y = pk2(h.z, h.w); *(v2u*)(HB + (size_t)row * 1024 + col) = o; }
    }
}

DI void qk_prep(const Ctx& p, int l) {
    const int tid = otid(), lane = tid & 63, wave = tid >> 6, gw = blockIdx.x * 8 + wave, NGW = gridDim.x * 8;
    u16* P1 = (u16*)p.out; const int i = lane & 31; unsigned* KC = (unsigned*)(p.ws + WS_HB + HB_KC); unsigned* VC = (unsigned*)(p.ws + WS_HB + HB_VC);
    const float freq = exp2f(-(float)(i & 15) * (13.287712379549449f / 16.f));
    const float gq0 = p.tab[15][l * 64 + 2 * i], gq1 = p.tab[15][l * 64 + 2 * i + 1], gk0 = p.tab[16][l * 64 + 2 * i], gk1 = p.tab[16][l * 64 + 2 * i + 1];
    for (int rowb = gw * 2; rowb < T_TOK; rowb += NGW * 2) {
        unsigned wv[2][6];
#pragma unroll
        for (int r = 0; r < 2; ++r) { const unsigned* ptr = (const unsigned*)(P1 + (size_t)(rowb + r) * P1P + P1_Q);
#pragma unroll
            for (int it = 0; it < 6; ++it) wv[r][it] = ptr[it * 64 + lane]; }
#pragma unroll
        for (int r = 0; r < 2; ++r) { const int row = rowb + r;
            const int s = row_seq(row); int row0, N; seq_info(s, row0, N); const int pos = row - row0;
            const float coord = (i < 16) ? (float)(pos >> 6) : (float)(pos & 63);
            float sn, cs; sincosf(coord * freq, &sn, &cs);
            unsigned* ptr = (unsigned*)(P1 + (size_t)row * P1P + P1_Q);
            const size_t cidx = ((size_t)row0 * 2 + (size_t)(lane >> 5) * N + pos) * 32 + i;
#pragma unroll
            for (int it = 0; it < 5; ++it) { const bool isq = it < 4;
                const unsigned w = wv[r][it]; const float x0 = bflo(w), x1 = bfhi(w);
                float ss = x0 * x0 + x1 * x1;
#pragma unroll
                for (int o = 1; o < 32; o <<= 1) ss += __shfl_xor(ss, o);
                const float rstd = 1.f / sqrtf(ss * (1.f / 64.f) + EPSN);
                const float y0 = x0 * rstd * (isq ? gq0 : gk0), y1 = x1 * rstd * (isq ? gq1 : gk1);
                float o0 = y0 * cs - y1 * sn, o1 = y0 * sn + y1 * cs;
                if (isq) { ptr[it * 64 + lane] = pk2(o0 * ATT_C2, o1 * ATT_C2); } else { KC[cidx] = pk2(o0, o1); } }
            VC[cidx] = wv[r][5]; }
    }
}
DI void gla_scan_cols(LAS float* Gf, LAS float* Gb, int lane) {
    LAS float* G = (lane >> 5) ? Gb : Gf; const int d = lane & 31; float v[64];
#pragma unroll
    for (int i = 0; i < 64; ++i) v[i] = G[i * 33 + d];
    if (lane >> 5) {
#pragma unroll
        for (int i = 62; i >= 0; --i) v[i] += v[i + 1];
    } else {
#pragma unroll
        for (int i = 1; i < 64; ++i) v[i] += v[i - 1];
    }
#pragma unroll
    for (int i = 0; i < 64; ++i) G[i * 33 + d] = v[i];
}
struct GLoad { v4u g, k, v; };
DI GLoad gla_local_load(const Ctx& p, int item) {
    const int tid = otid(); const int gc = item >> 2, h = item & 3; const size_t rb = (size_t)gc * 64; const u16* P2 = (const u16*)(p.ws + WS_P2); GLoad r;
    { const int t2 = tid & 255, i = t2 >> 2, c = t2 & 3; const u16* q = P2 + (rb + i) * P2P + h * 32 + c * 8; const int dirb = tid >> 8;
        r.g = *(const v4u*)(q + (dirb ? P2_GB : P2_GF)); r.k = *(const v4u*)(q + P2_AK); }
    { const int i = tid >> 3, c = tid & 7; r.v = *(const v4u*)(P2 + (rb + i) * P2P + P2_AV + h * 64 + c * 8); }
    return r;
}
DI void gla_local_item(const Ctx& p, int l, int item, LAS float* F, const GLoad ld) {
    const int tid = otid(), lane = tid & 63, w = tid >> 6; const int gc = item >> 2, h = item & 3; const size_t rb = (size_t)gc * 64;
    const u16* P2 = (const u16*)(p.ws + WS_P2);
    LAS float* Gf = F; LAS float* Gb = Gf + 2112; LAS float* Kx = Gb + 2112; LAS u16* KDT = (LAS u16*)(Kx + 2112); LAS u16* VT = KDT + 2 * 32 * 72;
    { const int t2 = tid & 255, i = t2 >> 2, c = t2 & 3; const u16* r = P2 + (rb + i) * P2P + h * 32 + c * 8; float f[8];
        const int dirb = tid >> 8; const float* bias = p.tab[dirb ? 12 : 10] + l * 128 + h * 32 + c * 8; LAS float* G = dirb ? Gb : Gf;
        unpack8(ld.g, f);
#pragma unroll
        for (int q = 0; q < 8; ++q) G[i * 33 + c * 8 + q] = logsig(f[q] + bias[q]) * (1.f / 16.f);
        if (!dirb) { unpack8(ld.k, f);
#pragma unroll
            for (int q = 0; q < 8; ++q) Kx[i * 33 + c * 8 + q] = f[q]; } }
    { const int i = tid >> 3, c = tid & 7; const v4u raw = ld.v;
        const unsigned ww[4] = {raw.x, raw.y, raw.z, raw.w};
#pragma unroll
        for (int q = 0; q < 4; ++q) { VT[(c * 8 + 2 * q) * 72 + i] = (u16)(ww[q] & 0xffffu); VT[(c * 8 + 2 * q + 1) * 72 + i] = (u16)(ww[q] >> 16); } }
    __syncthreads();
    if (w == 0) gla_scan_cols(Gf, Gb, lane);
    __syncthreads();
    u16* GS = (u16*)(p.ws + WS_HB + HB_GS); float* DEC = (float*)(p.ws + WS_DEC); const size_t slot = (size_t)(gc * 4 + h) * 2;
#pragma unroll
    for (int r = 0; r < 8; ++r) { const int e = tid + r * 512, i = e & 63, d = (e >> 6) & 31, dir = e >> 11; const LAS float* G = dir ? Gb : Gf;
        const float bl = G[(dir ? 0 : 63) * 33 + d];
        KDT[(dir * 32 + d) * 72 + i] = (u16)f2bf(Kx[i * 33 + d] * __expf(bl - G[i * 33 + d])); }
    if (tid < 64) { const int dir = tid >> 5, d = tid & 31; DEC[(slot + dir) * 32 + d] = __expf((dir ? Gb : Gf)[(dir ? 0 : 63) * 33 + d]); }
    __syncthreads();
    { const int dir = w >> 2, mt = (w >> 1) & 1;
#pragma unroll
        for (int q = 0; q < 2; ++q) { const int nt = (w & 1) * 2 + q; f32x4_t acc = {0.f, 0.f, 0.f, 0.f};
#pragma unroll
            for (int ks = 0; ks < 2; ++ks) acc = MFMA16(ldfrag(KDT + dir * 32 * 72, 72, mt * 16, ks * 32, lane), ldfrag(VT, 72, nt * 16, ks * 32, lane), acc);
#pragma unroll
            for (int j = 0; j < 4; ++j) GS[(slot + dir) * 2048 + (mt * 16 + 4 * (lane >> 4) + j) * 64 + nt * 16 + (lane & 15)] = (u16)f2bf(acc[j]); } }
    __syncthreads();
}
DI void sgu_item(const Ctx& p, int l, int item, LAS float* F) {
    const int tid = otid(), lane = tid & 63, w = tid >> 6; const int ch = item >> 2, g = item & 3; const size_t rb = (size_t)ch * 128;
    const u16* P2 = (const u16*)(p.ws + WS_P2); u16* P1 = (u16*)p.out;
    LAS float* OUTF = F; LAS u16* WB = (LAS u16*)(F + 128 * 65); LAS u16* VNT = WB + 128 * 136;
    v4u pu[2], pz[2];
#pragma unroll
    for (int r = 0; r < 2; ++r) { const int task = tid + r * 512, t = task >> 3, c8 = (task & 7) * 8; pu[r] = *(const v4u*)(P2 + (rb + t) * P2P + P2_DU + g * 64 + c8); pz[r] = *(const v4u*)(P1 + (rb + t) * P1P + 1024 + g * 64 + c8); }
    { const int row = tid >> 2, qt = tid & 3; const u16* dv = P2 + (rb + row) * P2P + P2_DV; float ss = 0.f; float f[8];
#pragma unroll
        for (int c = 0; c < 8; ++c) { unpack8(*(const v4u*)(dv + qt * 64 + c * 8), f);
#pragma unroll
            for (int q = 0; q < 8; ++q) ss += f[q] * f[q]; }
        ss += __shfl_xor(ss, 1); ss += __shfl_xor(ss, 2);
        const float rstd = 1.f / sqrtf(ss * (1.f / 256.f) + EPSN); const float* ng = p.tab[17] + l * 256 + g * 64 + qt * 16;
#pragma unroll
        for (int c = 0; c < 2; ++c) { unpack8(*(const v4u*)(dv + g * 64 + qt * 16 + c * 8), f);
#pragma unroll
            for (int q = 0; q < 8; ++q) VNT[(qt * 16 + c * 8 + q) * 136 + row] = (u16)f2bf(f[q] * rstd * ng[c * 8 + q]); } }
    { const float* wsrc = p.tab[18] + (size_t)(l * 4 + g) * 16384;
#pragma unroll
        for (int r = 0; r < 8; ++r) { const int idx = tid + r * 512, t = idx >> 5, s4 = (idx & 31) * 4; const v4f v = *(const v4f*)(wsrc + idx * 4);
            v2u o; o.x = pk2(v.x, v.y); o.y = pk2(v.z, v.w); *(LAS v2u*)(WB + t * 136 + s4) = o; } }
    __syncthreads();
    {
#pragma unroll
        for (int nt = 0; nt < 4; ++nt) { f32x4_t acc = {0.f, 0.f, 0.f, 0.f};
#pragma unroll
            for (int ks = 0; ks < 4; ++ks) acc = MFMA16(ldfrag(WB, 136, w * 16, ks * 32, lane), ldfrag(VNT, 136, nt * 16, ks * 32, lane), acc);
#pragma unroll
            for (int j = 0; j < 4; ++j) OUTF[(w * 16 + 4 * (lane >> 4) + j) * 65 + nt * 16 + (lane & 15)] = acc[j]; } }
    __syncthreads();
#pragma unroll
    for (int r = 0; r < 2; ++r) { const int task = tid + r * 512, t = task >> 3, c8 = (task & 7) * 8; float acc[8];
#pragma unroll
        for (int e = 0; e < 8; ++e) acc[e] = OUTF[t * 65 + c8 + e];
        const float bias = p.tab[19][(l * 4 + g) * 128 + t];
        float uu[8], zz[8]; unpack8(pu[r], uu);
        u16* mz = P1 + (rb + t) * P1P + 1024 + g * 64 + c8; unpack8(pz[r], zz);
#pragma unroll
        for (int e = 0; e < 8; ++e) acc[e] = (acc[e] + bias) * uu[e] * silu_f(zz[e]);
        *(v4u*)mz = pack8(acc); }
    __syncthreads();
}
template <int N1> DI void fnet1_body(const Ctx& p, int row0, int N, int n2, int cb, LAS float* F) {
    constexpr int PN = N1 + 8, MT = N1 / 16, NTW = MT;
    const int tid = otid(), lane = tid & 63, w = tid >> 6;
    const u16* P2 = (const u16*)(p.ws + WS_P2); u16* TP = (u16*)(p.ws + WS_HB + HB_TP);
    const u16* Cg = (const u16*)(p.ws + WS_DFT) + (N1 == 64 ? 0 : 8192); const u16* Sg = Cg + N1 * N1;
    LAS float* tw = F; LAS u16* XT = (LAS u16*)(F + 256); LAS u16* FC = XT + N1 * 136; LAS u16* FS = FC + N1 * PN; LAS u16* OUT = FC;
#pragma unroll
    for (int r = 0; r < N1 / 32; ++r) { const int idx = tid + r * 512, n1 = idx >> 4, c = idx & 15; const v4u raw = *(const v4u*)(P2 + (size_t)(row0 + n1 * 64 + n2) * P2P + P2_BU + cb * 128 + c * 8);
        *(LAS v4u*)(XT + n1 * 136 + c * 8) = raw; }
#pragma unroll
    for (int r = 0; r < N1 * N1 / 8 / 512; ++r) { const int idx = tid + r * 512, k1 = idx / (N1 / 8), c = idx % (N1 / 8);
        *(LAS v4u*)(FC + k1 * PN + c * 8) = *(const v4u*)(Cg + k1 * N1 + c * 8); *(LAS v4u*)(FS + k1 * PN + c * 8) = *(const v4u*)(Sg + k1 * N1 + c * 8); }
    if (tid < N1) { const float ph = 2.f * (float)((n2 * tid) & (N - 1)) / (float)N; tw[2 * tid] = cospif(ph); tw[2 * tid + 1] = sinpif(ph); }
    __syncthreads();
    f32x4_t ac[NTW], as[NTW];
#pragma unroll
    for (int q = 0; q < NTW; ++q) { const int id = w + 8 * q, mt = id % MT, nt = id / MT; ac[q] = (f32x4_t){0.f, 0.f, 0.f, 0.f}; as[q] = ac[q];
#pragma unroll
        for (int ks = 0; ks < N1 / 32; ++ks) { const bf16x8_t b = ldfrag_tr(XT, 136, ks * 32, nt * 16, lane);
            ac[q] = MFMA16(ldfrag(FC, PN, mt * 16, ks * 32, lane), b, ac[q]); as[q] = MFMA16(ldfrag(FS, PN, mt * 16, ks * 32, lane), b, as[q]); } }
    __syncthreads();
    const float scale = 1.f / sqrtf((float)N1);
#pragma unroll
    for (int q = 0; q < NTW; ++q) { const int id = w + 8 * q, mt = id % MT, nt = id / MT;
#pragma unroll
        for (int j = 0; j < 4; ++j) { const int k1 = mt * 16 + 4 * (lane >> 4) + j, col = nt * 16 + (lane & 15); const float cw = tw[2 * k1], sw = tw[2 * k1 + 1];
            const float tr = ac[q][j], ti = -as[q][j];
            OUT[k1 * 256 + col] = (u16)f2bf((tr * cw + ti * sw) * scale); OUT[k1 * 256 + 128 + col] = (u16)f2bf((ti * cw - tr * sw) * scale); } }
    __syncthreads();
#pragma unroll
    for (int r = 0; r < N1 / 16; ++r) { const int idx = tid + r * 512, k1 = idx >> 5, c = idx & 31;
        const v4u v = *(const LAS v4u*)(OUT + k1 * 256 + c * 8);
        *(v4u*)(TP + (size_t)(row0 + k1 * 64 + n2) * 512 + (c >> 4) * 256 + cb * 128 + (c & 15) * 8) = v; }
    __syncthreads();
}
DI void fnet1_item(const Ctx& p, int item, LAS float* F) {
    const int s = item >> 7, r = item & 127, n2 = r >> 1, cb = r & 1; int row0, N; seq_info(s, row0, N);
    if (N == 4096) fnet1_body<64>(p, row0, N, n2, cb, F); else fnet1_body<128>(p, row0, N, n2, cb, F);
}
DI void fnet2_item(const Ctx& p, int item, LAS float* F) {
    const int tid = otid(), lane = tid & 63, w = tid >> 6; int s, k1; if (item < 256) { s = item >> 6; k1 = item & 63; } else { s = 4 + ((item - 256) >> 7); k1 = (item - 256) & 127; }
    int row0, N; seq_info(s, row0, N); const int N1 = N >> 6;
    u16* P2 = (u16*)(p.ws + WS_P2); const u16* TP = (const u16*)(p.ws + WS_HB + HB_TP); const u16* Cg = (const u16*)(p.ws + WS_DFT); const u16* Sg = Cg + 4096;
    LAS u16* BT = (LAS u16*)F; LAS u16* A1 = BT + 128 * 264; LAS u16* A2 = A1 + 64 * 136; LAS u16* OUT = BT;
#pragma unroll
    for (int r = 0; r < 8; ++r) { const int idx = tid + r * 512, n2 = idx >> 6, c = idx & 63; const v4u raw = *(const v4u*)(TP + (size_t)(row0 + k1 * 64 + n2) * 512 + c * 8);
        *(LAS v4u*)(BT + ((c >> 5) * 64 + n2) * 264 + (c & 31) * 8) = raw; }
    { const int k2 = tid >> 3, c8 = (tid & 7) * 8; const v4u c = *(const v4u*)(Cg + k2 * 64 + c8), sv = *(const v4u*)(Sg + k2 * 64 + c8); const v4u ns = sv ^ (v4u){0x80008000u, 0x80008000u, 0x80008000u, 0x80008000u};
        *(LAS v4u*)(A1 + k2 * 136 + c8) = c; *(LAS v4u*)(A1 + k2 * 136 + 64 + c8) = sv; *(LAS v4u*)(A2 + k2 * 136 + c8) = ns; *(LAS v4u*)(A2 + k2 * 136 + 64 + c8) = c; }
    __syncthreads();
    f32x4_t acc[16]; const LAS u16* Aw = (w < 4) ? A1 : A2; const int mt = w & 3;
#pragma unroll
    for (int nt = 0; nt < 16; ++nt) { acc[nt] = (f32x4_t){0.f, 0.f, 0.f, 0.f};
#pragma unroll
        for (int ks = 0; ks < 4; ++ks) acc[nt] = MFMA16(ldfrag(Aw, 136, mt * 16, ks * 32, lane), ldfrag_tr(BT, 264, ks * 32, nt * 16, lane), acc[nt]); }
    __syncthreads();
#pragma unroll
    for (int nt = 0; nt < 16; ++nt)
#pragma unroll
        for (int j = 0; j < 4; ++j) OUT[(mt * 16 + 4 * (lane >> 4) + j) * 512 + (w >> 2) * 256 + nt * 16 + (lane & 15)] = (u16)f2bf(acc[nt][j] * 0.125f);
    __syncthreads();
#pragma unroll
    for (int r = 0; r < 8; ++r) { const int idx = tid + r * 512, k2 = idx >> 6, c = idx & 63; const v4u v = *(const LAS v4u*)(OUT + k2 * 512 + c * 8);
        *(v4u*)(P2 + (size_t)(row0 + k1 + N1 * k2) * P2P + P2_U + c * 8) = v; }
    __syncthreads();
}
DI void gla_scan_item(const Ctx& p, int item) {
    const int tid = otid(); const int chain = item >> 2, e = (item & 3) * 512 + tid; const int s = chain >> 3, h = (chain >> 1) & 3, dir = chain & 1;
    int row0, N; seq_info(s, row0, N); const int NC = N >> 6, gc0 = row0 >> 6, d = e >> 6;
    u16* GS = (u16*)(p.ws + WS_HB + HB_GS); const float* DEC = (const float*)(p.ws + WS_DEC);
    float S = 0.f;
    for (int st = 0; st < NC; st += 32) { u16 tmp[32]; float dc[32];
#pragma unroll
        for (int u = 0; u < 32; ++u) { const int c = dir ? NC - 1 - (st + u) : st + u; const size_t slot = (size_t)((gc0 + c) * 4 + h) * 2 + dir; tmp[u] = GS[slot * 2048 + e]; dc[u] = DEC[slot * 32 + d]; }
#pragma unroll
        for (int u = 0; u < 32; ++u) { const int c = dir ? NC - 1 - (st + u) : st + u; const size_t slot = (size_t)((gc0 + c) * 4 + h) * 2 + dir; GS[slot * 2048 + e] = (u16)f2bf(S); S = dc[u] * S + bf2f(tmp[u]); } }
}
struct OLoad { v4u qk, g, v, z; v2u sf, sb; };
DI OLoad gla_out_load(const Ctx& p, int item) {
    const int tid = otid(); const int gc = item >> 2, h = item & 3; const size_t rb = (size_t)gc * 64; const u16* P2 = (const u16*)(p.ws + WS_P2); const u16* P1 = (const u16*)p.out; OLoad r;
    { const int t2 = tid & 255, i = t2 >> 2, c = t2 & 3; const u16* q = P2 + (rb + i) * P2P + h * 32 + c * 8; const int dirb = tid >> 8;
        r.qk = *(const v4u*)(q + (dirb ? P2_AK : P2_AQ)); r.g = *(const v4u*)(q + (dirb ? P2_GB : P2_GF)); }
    { const int i = tid >> 3, c = tid & 7; r.v = *(const v4u*)(P2 + (rb + i) * P2P + P2_AV + h * 64 + c * 8); r.z = *(const v4u*)(P1 + (rb + i) * P1P + h * 64 + c * 8); }
    { const u16* GS = (const u16*)(p.ws + WS_HB + HB_GS); const size_t slot = (size_t)(gc * 4 + h) * 2; const int e4 = tid * 4; r.sf = *(const v2u*)(GS + slot * 2048 + e4); r.sb = *(const v2u*)(GS + (slot + 1) * 2048 + e4); }
    return r;
}
DI void gla_out_item(const Ctx& p, int l, int item, LAS float* F, const OLoad ld) {
    const int tid = otid(), lane = tid & 63, w = tid >> 6; const int gc = item >> 2, h = item & 3; const size_t rb = (size_t)gc * 64;
    const u16* P2 = (const u16*)(p.ws + WS_P2); u16* P1 = (u16*)p.out;
    LAS float* Gf = F; LAS float* Gb = Gf + 2112; LAS float* Qx = Gb + 2112; LAS float* Kx = Qx + 2112; LAS float* O = Kx + 2112;
    LAS u16* QF = (LAS u16*)(O + 64 * 65); LAS u16* KF = QF + 64 * 40; LAS u16* QB = KF + 64 * 40; LAS u16* KB = QB + 64 * 40;
    LAS u16* VT = KB + 64 * 40; LAS u16* SC = VT + 64 * 72; LAS u16* SFT = SC + 64 * 72; LAS u16* SBT = SFT + 64 * 40;
    const u16* GS = (const u16*)(p.ws + WS_HB + HB_GS); const size_t slot = (size_t)(gc * 4 + h) * 2;
    { const int t2 = tid & 255, i = t2 >> 2, c = t2 & 3; const u16* r = P2 + (rb + i) * P2P + h * 32 + c * 8; float f[8];
        const int dirb = tid >> 8; LAS float* d0 = dirb ? Kx : Qx; LAS float* d1 = dirb ? Gb : Gf; const float* bias = p.tab[dirb ? 12 : 10] + l * 128 + h * 32 + c * 8;
        unpack8(ld.qk, f);
#pragma unroll
        for (int q = 0; q < 8; ++q) d0[i * 33 + c * 8 + q] = f[q];
        unpack8(ld.g, f);
#pragma unroll
        for (int q = 0; q < 8; ++q) d1[i * 33 + c * 8 + q] = logsig(f[q] + bias[q]) * (1.f / 16.f); }
    { const int i = tid >> 3, c = tid & 7; const v4u raw = ld.v;
        const unsigned ww[4] = {raw.x, raw.y, raw.z, raw.w};
#pragma unroll
        for (int q = 0; q < 4; ++q) { VT[(c * 8 + 2 * q) * 72 + i] = (u16)(ww[q] & 0xffffu); VT[(c * 8 + 2 * q + 1) * 72 + i] = (u16)(ww[q] >> 16); } }
    { const int e4 = tid * 4, d = e4 >> 6, v = e4 & 63; const v2u a = ld.sf, b = ld.sb;
        SFT[(v + 0) * 40 + d] = (u16)(a.x & 0xffffu); SFT[(v + 1) * 40 + d] = (u16)(a.x >> 16); SFT[(v + 2) * 40 + d] = (u16)(a.y & 0xffffu); SFT[(v + 3) * 40 + d] = (u16)(a.y >> 16);
        SBT[(v + 0) * 40 + d] = (u16)(b.x & 0xffffu); SBT[(v + 1) * 40 + d] = (u16)(b.x >> 16); SBT[(v + 2) * 40 + d] = (u16)(b.y & 0xffffu); SBT[(v + 3) * 40 + d] = (u16)(b.y >> 16); }
    __syncthreads();
    if (w == 0) gla_scan_cols(Gf, Gb, lane);
    __syncthreads();
#pragma unroll
    for (int r = 0; r < 4; ++r) { const int e = tid + r * 512, i = e & 63, d = e >> 6, a = i * 33 + d; const float q = Qx[a] * 0.17677669529663687f, k = Kx[a], bf = Gf[a], bb = Gb[a];
        QF[i * 40 + d] = (u16)f2bf(q * __expf(bf)); KF[i * 40 + d] = (u16)f2bf(k * __expf(-bf)); QB[i * 40 + d] = (u16)f2bf(q * __expf(bb)); KB[i * 40 + d] = (u16)f2bf(k * __expf(-bb)); }
    __syncthreads();
#pragma unroll
    for (int q = 0; q < 2; ++q) { const int id = 2 * w + q, ti = id >> 2, si = id & 3; const f32x4_t z4 = {0.f, 0.f, 0.f, 0.f}; f32x4_t acc;
        if (si < ti) acc = MFMA16(ldfrag(QF, 40, ti * 16, 0, lane), ldfrag(KF, 40, si * 16, 0, lane), z4);
        else if (si > ti) acc = MFMA16(ldfrag(QB, 40, ti * 16, 0, lane), ldfrag(KB, 40, si * 16, 0, lane), z4);
        else { const f32x4_t af = MFMA16(ldfrag(QF, 40, ti * 16, 0, lane), ldfrag(KF, 40, si * 16, 0, lane), z4), ab = MFMA16(ldfrag(QB, 40, ti * 16, 0, lane), ldfrag(KB, 40, si * 16, 0, lane), z4);
#pragma unroll
            for (int j = 0; j < 4; ++j) acc[j] = ((lane & 15) <= 4 * (lane >> 4) + j) ? af[j] : ab[j]; }
#pragma unroll
        for (int j = 0; j < 4; ++j) SC[(ti * 16 + 4 * (lane >> 4) + j) * 72 + si * 16 + (lane & 15)] = (u16)f2bf(acc[j]); }
    __syncthreads();
#pragma unroll
    for (int q = 0; q < 2; ++q) { const int id = 2 * w + q, ti = id >> 2, vi = id & 3; f32x4_t acc = {0.f, 0.f, 0.f, 0.f};
        acc = MFMA16(ldfrag(SC, 72, ti * 16, 0, lane), ldfrag(VT, 72, vi * 16, 0, lane), acc);
        acc = MFMA16(ldfrag(SC, 72, ti * 16, 32, lane), ldfrag(VT, 72, vi * 16, 32, lane), acc);
        acc = MFMA16(ldfrag(QF, 40, ti * 16, 0, lane), ldfrag(SFT, 40, vi * 16, 0, lane), acc);
        acc = MFMA16(ldfrag(QB, 40, ti * 16, 0, lane), ldfrag(SBT, 40, vi * 16, 0, lane), acc);
#pragma unroll
        for (int j = 0; j < 4; ++j) O[(ti * 16 + 4 * (lane >> 4) + j) * 65 + vi * 16 + (lane & 15)] = acc[j]; }
    __syncthreads();
    { const int t = tid >> 3, v8 = (tid & 7) * 8; float acc[8]; float ss = 0.f;
#pragma unroll
        for (int e = 0; e < 8; ++e) { acc[e] = O[t * 65 + v8 + e]; ss += acc[e] * acc[e]; }
        ss += __shfl_xor(ss, 1); ss += __shfl_xor(ss, 2); ss += __shfl_xor(ss, 4);
        const float rstd = 1.f / sqrtf(ss * (1.f / 64.f) + EPSN);
        u16* mz = P1 + (rb + t) * P1P + h * 64 + v8; float zz[8]; unpack8(ld.z, zz);
#pragma unroll
        for (int e = 0; e < 8; ++e) acc[e] = acc[e] * rstd * p.tab[13][l * 64 + v8 + e] * silu_f(zz[e]);
        *(v4u*)mz = pack8(acc); }
    __syncthreads();
}
#define XB_TMO      128
#define XB_XCNT(j)  (256  + 64 * (j))
#define XB_XSUB(j)  (1280 + 64 * (j))
#define XB_XGEN(j)  (2304 + 64 * (j))
#define XB_TOP      3328
#define XB_TOPGEN   3392
#define XCD_BAR_WORDS 3456
#define XB_SPIN_CAP (1u << 18)

__device__ __forceinline__ unsigned xb_ld(unsigned* p)              { return __hip_atomic_load(p, __ATOMIC_RELAXED, __HIP_MEMORY_SCOPE_AGENT); }
__device__ __forceinline__ unsigned xb_add(unsigned* p, unsigned v) { return __hip_atomic_fetch_add(p, v, __ATOMIC_RELAXED, __HIP_MEMORY_SCOPE_AGENT); }
__device__ __forceinline__ unsigned xb_xcc_id() { return (unsigned)__builtin_amdgcn_s_getreg((3 << 11) | 20) & 0xFu; }
#define XB_SPIN(cond, bar) do { unsigned _sp = 0; while (cond) { __builtin_amdgcn_s_sleep(1); \
    if ((++_sp & 255u) == 0u) { if (xb_ld(&(bar)[XB_TMO])) break; if (_sp > XB_SPIN_CAP) { atomicAdd(&(bar)[XB_TMO], 1u); break; } } } } while (0)

struct XcdBarrier {
    unsigned* bar; unsigned x;
    volatile LAS unsigned* st;
};

__device__ __forceinline__ XcdBarrier xcd_barrier_post(unsigned* bar, volatile LAS unsigned* st) {
    XcdBarrier b; b.bar = bar; b.x = xb_xcc_id(); b.st = st;
    if (threadIdx.x == 0) (void)xb_add(&bar[XB_XCNT(b.x)], 1u);
    return b;
}
__device__ __forceinline__ void xcd_barrier_complete(unsigned* bar, unsigned x, unsigned& nloc, unsigned& nx) {
    const unsigned G = gridDim.x * gridDim.y * gridDim.z;
    unsigned sum, cnt, mine, sp = 0u;
    for (;;) {
        sum = 0u; cnt = 0u; mine = 0u;
#pragma unroll
        for (unsigned j = 0; j < 16; ++j) { const unsigned c = xb_ld(&bar[XB_XCNT(j)]); sum += c; cnt += (c > 0u) ? 1u : 0u; mine = (j == x) ? c : mine; }
        if (sum == G) break;
        __builtin_amdgcn_s_sleep(1);
        if ((++sp & 255u) == 0u) { if (xb_ld(&bar[XB_TMO])) break; if (sp > XB_SPIN_CAP) { atomicAdd(&bar[XB_TMO], 1u); break; } }
    }
    nloc = mine > 0u ? mine : 1u; nx = cnt > 0u ? cnt : 1u;
}

__device__ __forceinline__ void xcd_barrier(const XcdBarrier& b) {
    asm volatile("s_waitcnt vmcnt(0)" ::: "memory");
    __syncthreads();
    if (threadIdx.x == 0) {
        unsigned* bar = b.bar;
        __builtin_amdgcn_s_waitcnt(0);
        unsigned nloc = b.st[0], nx = b.st[1];
        if (nloc == 0u) { xcd_barrier_complete(bar, b.x, nloc, nx); b.st[0] = nloc; b.st[1] = nx; }
        const unsigned old = xb_add(&bar[XB_XSUB(b.x)], 1u);
        const unsigned gen = old / nloc;
        if (old + 1u == (gen + 1u) * nloc) {
            __builtin_amdgcn_fence(__ATOMIC_RELEASE, "agent");
            asm volatile("s_waitcnt vmcnt(0)" ::: "memory");
            const unsigned og = xb_add(&bar[XB_TOP], 1u);
            const unsigned tg = og / nx;
            if (og + 1u == (tg + 1u) * nx) xb_add(&bar[XB_TOPGEN], 1u);
            else XB_SPIN(xb_ld(&bar[XB_TOPGEN]) == tg, bar);
            __builtin_amdgcn_fence(__ATOMIC_ACQUIRE, "agent");
            xb_add(&bar[XB_XGEN(b.x)], 1u);
            asm volatile("s_waitcnt vmcnt(0)" ::: "memory");
        } else {
            XB_SPIN(xb_ld(&bar[XB_XGEN(b.x)]) == gen, bar);
            __builtin_amdgcn_fence(__ATOMIC_ACQUIRE, "agent");
            asm volatile("s_waitcnt vmcnt(0)" ::: "memory");
        }
    }
    __syncthreads();
}


#ifndef GM
#define GM 7
#endif
#ifndef PH
#define PH 1023
#endif
__global__ void __launch_bounds__(512, 2) fwd_kernel(Params kp) {
    extern __shared__ __attribute__((aligned(16))) unsigned char lds[];
    cg::grid_group grid = cg::this_grid();
    LAS unsigned char* L = (LAS unsigned char*)lds; LAS float* F = (LAS float*)lds;
    const int G = gridDim.x, bid = blockIdx.x;
    Ctx p; p.out = kp.out; p.ws = kp.ws; p.tab = (LAS cfp*)(L + 131072);
    if (otid() == 0) { p.tab[0] = kp.xp; p.tab[1] = kp.xs; p.tab[2] = kp.cp; p.tab[3] = kp.cs; p.tab[4] = kp.ada_w; p.tab[5] = kp.ada_b; p.tab[6] = kp.pre_g; p.tab[7] = kp.post_g; p.tab[8] = kp.w_in;
        p.tab[9] = kp.wg2f; p.tab[10] = kp.bgf; p.tab[11] = kp.wg2b; p.tab[12] = kp.bgb; p.tab[13] = kp.onorm_g; p.tab[14] = kp.fnet_w; p.tab[15] = kp.qn_g; p.tab[16] = kp.kn_g; p.tab[17] = kp.sgu_ng;
        p.tab[18] = kp.sgu_w; p.tab[19] = kp.sgu_b; p.tab[20] = kp.w_out; }
    volatile LAS unsigned* bst = (volatile LAS unsigned*)(L + 131072 + 256);
    if (otid() < 4) bst[otid()] = 0u;
    __syncthreads();
    const XcdBarrier xbar = xcd_barrier_post((unsigned*)(p.ws + WS_BAR), bst);
    u16* P1 = (u16*)p.out; u16* P2 = (u16*)(p.ws + WS_P2); u16* HB = (u16*)(p.ws + WS_HB); u16* U0 = (u16*)(p.ws + WS_U0);


#if PH & 1
    phase0(p, L);
#endif
    grid.sync();
    for (int step = 0; step < 12; ++step) {
        const int l = step / 6, ph = step % 6;
        bool do_gemm = false; pg8::Gemm g{nullptr, nullptr, T_TOK, 0, 0, 0, 0}; pg8::EpiX E{0, nullptr, 0, nullptr, 0, 0};
        if (ph == 0) {
#if PH & 2
            phaseA(p, l);
#endif
        } else if (ph == 1) {
            g.A = HB; g.Bt = (const u16*)(p.ws + WS_WIN) + (size_t)l * 3584 * 1024; g.N = 3584; g.K = 1024; g.lda = 1024; g.ldb = 1024;
            E.mode = 0; E.O1 = P1; E.ld1 = P1P; E.O2 = P2; E.ld2 = P2P; do_gemm = true;
        } else if (ph == 2) {
#if PH & 4
            qk_prep(p, l);
#endif
#if PH & 8
            { GLoad nx = gla_local_load(p, bid < 2048 ? bid : 0); for (int it = bid; it < 2048; it += G) { const GLoad cur = nx; if (it + G < 2048) nx = gla_local_load(p, it + G); gla_local_item(p, l, it, F, cur); } }
#endif
#if PH & 16
            for (int it = bid; it < 1024; it += G) sgu_item(p, l, it, F);
#endif
#if PH & 32
            for (int it = bid; it < 768; it += G) fnet1_item(p, it, F);
#endif
        } else if (ph == 3) {
#if PH & 64
            for (int it = bid; it < 192; it += G) gla_scan_item(p, it);
#endif
#if PH & 128
            for (int it = bid; it < 512; it += G) fnet2_item(p, it, F);
#endif
            __syncthreads();
#ifndef SKIP_ATTN
            for (int u = ((G & 7) == 0 ? (bid & 7) * (G >> 3) + (bid >> 3) : bid); u < 1024; u += G) {
                int s, h, qb;
                if (u < 512) { s = u >> 7; const int r = u & 127; h = r >> 4; qb = r & 15; } else { const int u2 = u - 512; s = 4 + (u2 >> 8); const int r = u2 & 255; h = r >> 5; qb = r & 31; }
                int row0, N; seq_info(s, row0, N);
                const attn_body::bf16* Pb = (const attn_body::bf16*)P1;
                const attn_body::bf16* KCb = (const attn_body::bf16*)(p.ws + WS_HB + HB_KC) + ((size_t)row0 * 2 + (size_t)(h >> 2) * N) * 64;
                const attn_body::bf16* VCb = (const attn_body::bf16*)(p.ws + WS_HB + HB_VC) + ((size_t)row0 * 2 + (size_t)(h >> 2) * N) * 64;
                attn_body::attn_unit<8>(Pb + (size_t)(row0 + qb * 256) * P1P + P1_Q + h * 64, KCb, VCb,
                                        (attn_body::bf16*)P1 + (size_t)(row0 + qb * 256) * P1P + 512 + h * 64, N >> 6, (char*)lds);
            }
#endif
        } else if (ph == 4) {
#if PH & 256
            { OLoad nx = gla_out_load(p, bid < 2048 ? bid : 0); for (int it = bid; it < 2048; it += G) { const OLoad cur = nx; if (it + G < 2048) nx = gla_out_load(p, it + G); gla_out_item(p, l, it, F, cur); } }
#endif
            g.A = P2 + P2_U; g.Bt = (const u16*)(p.ws + WS_WF) + (size_t)l * 131072; g.N = 256; g.K = 512; g.lda = P2P; g.ldb = 512;
            E.mode = 2; E.O1 = P1; E.ld1 = P1P; E.col_off = 256; do_gemm = true;
        } else {
            g.A = P1; g.Bt = (const u16*)(p.ws + WS_WOUT) + (size_t)l * 1024 * 1280; g.N = 1024; g.K = 1280; g.lda = P1P; g.ldb = 1280;
            E.mode = 1; E.O1 = (l == 0) ? U0 : HB; E.ld1 = 1024; do_gemm = true;
        }
#if GM
        if (do_gemm) { pg8::StaticOrder S; S.init(T_TOK, g.N, G, bid); pg8::gemm_phase<pg8::EpiX, pg8::StaticOrder, PG8_ALIGN, PG8_SP2>(L, g, S, E); }
#endif
        xcd_barrier(xbar);
    }
#if PH & 2
    phaseA(p, 2);
#endif
}

extern "C" void kernel_launch(void* const* d_in, const int* in_sizes, int n_in, void* d_out, int out_size, void* d_ws, size_t ws_size, hipStream_t stream) {
    static int grid = 0;
    if (grid == 0) {
        if (n_in != 21 || out_size != T_TOK * 1024 || ws_size < WS_END) { fprintf(stderr, "kernel_launch: unexpected sizes n_in %d out %d ws %zu\n", n_in, out_size, ws_size); grid = -1; return; }
        int dev = 0, cus = 0, per_cu = 0;
        (void)hipGetDevice(&dev); (void)hipDeviceGetAttribute(&cus, hipDeviceAttributeMultiprocessorCount, dev);
        if (hipFuncSetAttribute((const void*)fwd_kernel, hipFuncAttributeMaxDynamicSharedMemorySize, LDS_BYTES) != hipSuccess) { fprintf(stderr, "kernel_launch: hipFuncSetAttribute failed\n"); grid = -1; return; }
        if (hipOccupancyMaxActiveBlocksPerMultiprocessor(&per_cu, (const void*)fwd_kernel, 512, LDS_BYTES) != hipSuccess || per_cu < 1) { fprintf(stderr, "kernel_launch: occupancy query gave %d\n", per_cu); per_cu = 1; }
        (void)hipGetLastError();
        grid = cus * 1;
        fprintf(stderr, "kernel_launch: grid %d (per_cu %d) ws %zu\n", grid, per_cu, ws_size);
    }
    if (grid < 0) return;
    Params p{};
    const float** pp = (const float**)&p;
    for (int i = 0; i < 21; ++i) pp[i] = (const float*)d_in[i];
    p.out = (float*)d_out; p.ws = (unsigned char*)d_ws;
    if (hipMemsetAsync((char*)d_ws + WS_MOD, 0, 2 * 6 * 3072 * sizeof(float), stream) != hipSuccess) { fprintf(stderr, "kernel_launch: memset failed\n"); return; }
    if (hipMemsetAsync((char*)d_ws + WS_BAR, 0, BAR_BYTES, stream) != hipSuccess) { fprintf(stderr, "kernel_launch: memset failed\n"); return; }
    void* args[] = {&p};
    hipError_t e = hipLaunchCooperativeKernel((const void*)fwd_kernel, dim3(grid), dim3(512), args, LDS_BYTES, stream);
    if (e != hipSuccess) fprintf(stderr, "cooperative launch failed: %s (grid %d)\n", hipGetErrorString(e), grid);
}
```

```cpp
#include <hip/hip_runtime.h>
#include <hip/hip_cooperative_groups.h>
#include <cstdio>
#include <cstdint>
namespace cg = cooperative_groups;
__device__ __forceinline__ int otid() { int t = threadIdx.x; asm volatile("" : "+v"(t)); return t; }
namespace pg8 {
#define PG8_LAS __attribute__((address_space(3)))
typedef unsigned short bf16_t;
typedef short bf16x8 __attribute__((ext_vector_type(8)));
typedef float f32x4 __attribute__((ext_vector_type(4)));
typedef unsigned u32x4 __attribute__((ext_vector_type(4)));
constexpr int BM = 256, BK = 64, HALF = 128, HTB = HALF * BK * 2  , STAGE_BYTES = 8 * HTB, NXCD = 8, WGM = 8;

__host__ __device__ __forceinline__ int lds_byte(int r, int c) { const int st = (r >> 4) * 2 + (c >> 5), rr = r & 15, cc = c & 31, ob = rr * 64 + cc * 2; return st * 1024 + (ob ^ (((ob >> 9) & 1) << 5)); }
__host__ __device__ __forceinline__ void stage_rc(int b, int& R, int& C) { const int st = b / 1024, sb = b % 1024, swz = sb ^ (((sb >> 9) & 1) << 5); R = (st >> 1) * 16 + swz / 64; C = (st & 1) * 32 + (swz % 64) / 2; }
__host__ __device__ __forceinline__ int perm32(int rho) { const int n = rho >> 4, i = rho & 15; return 8 * (i >> 2) + 4 * n + (i & 3); }

struct Unit { int pm, pn; };
struct Gemm { const bf16_t* A; const bf16_t* Bt; int M, N, K, lda, ldb; };

struct StaticOrder {
    int nM, nN, nwg, G, c;
    __host__ __device__ void init(int M, int N, int G_, int c_) { nM = M / BM; nN = N / BM; nwg = nM * nN; G = G_; c = c_; }
    __host__ __device__ bool next(int i, Unit& u) const {
        const long L = (long)i * G + c; if (L >= nwg) return false;
        int wgid = (int)L; { const int q = nwg / NXCD, r = nwg % NXCD, xcd = wgid % NXCD, off = wgid / NXCD; wgid = (xcd < r ? xcd * (q + 1) : r * (q + 1) + (xcd - r) * q) + off; }
        const int nig = WGM * nN, gid = wgid / nig, fm = gid * WGM, gsz = (nM - fm) < WGM ? (nM - fm) : WGM;
        u.pm = fm + ((wgid % nig) % gsz); u.pn = (wgid % nig) / gsz; return true;
    }
    __device__ __forceinline__ void a_ready(const Unit&) const {}
    __device__ __forceinline__ void done(const Unit&) const {}
};

__device__ __forceinline__ unsigned cvt_pk_bf16(float lo, float hi) { unsigned r; asm volatile("v_cvt_pk_bf16_f32 %0, %1, %2" : "=v"(r) : "v"(lo), "v"(hi)); return r; }
__device__ __forceinline__ float silu_f(float z) { return z / (1.f + __expf(-z)); }
struct EpiX {
    static constexpr bool PERM = true, AFTER_DRAIN = false;
    int mode; bf16_t* O1; int ld1; bf16_t* O2; int ld2; int col_off;
    __device__ __forceinline__ void operator()(const f32x4 (&acc)[2][2][4][2], const Unit& u, int wr, int wc, int fr, int fq) const {
        const int row0 = u.pm * BM + wr * 64 + fr;
        bf16_t* base; int ld, colt;
        if (mode == 0) { if (u.pn < 8) { base = O1; ld = ld1; colt = u.pn * BM; } else { base = O2; ld = ld2; colt = (u.pn - 8) * BM; } }
        else { base = O1; ld = ld1; colt = col_off + u.pn * BM; }
        const int col0 = colt + wc * 32 + 8 * fq;
#pragma unroll
        for (int ai = 0; ai < 2; ++ai)
#pragma unroll
            for (int m = 0; m < 4; ++m) { bf16_t* rowp = base + (size_t)(row0 + ai * HALF + m * 16) * ld + col0;
#pragma unroll
                for (int bj = 0; bj < 2; ++bj) { f32x4 v0 = acc[ai][bj][m][0], v1 = acc[ai][bj][m][1];
                    if (mode == 2) { const u32x4 z = *(const u32x4*)(rowp + bj * HALF);
                        v0[0] *= silu_f(__uint_as_float(z.x << 16)); v0[1] *= silu_f(__uint_as_float(z.x & 0xffff0000u));
                        v0[2] *= silu_f(__uint_as_float(z.y << 16)); v0[3] *= silu_f(__uint_as_float(z.y & 0xffff0000u));
                        v1[0] *= silu_f(__uint_as_float(z.z << 16)); v1[1] *= silu_f(__uint_as_float(z.z & 0xffff0000u));
                        v1[2] *= silu_f(__uint_as_float(z.w << 16)); v1[3] *= silu_f(__uint_as_float(z.w & 0xffff0000u)); }
                    u32x4 w; w.x = cvt_pk_bf16(v0[0], v0[1]); w.y = cvt_pk_bf16(v0[2], v0[3]); w.z = cvt_pk_bf16(v1[0], v1[1]); w.w = cvt_pk_bf16(v1[2], v1[3]);
                    *(u32x4*)(rowp + bj * HALF) = w; } }
    }
};
#ifndef PG8_SP2
#define PG8_SP2 true
#endif
#ifndef PG8_ALIGN
#define PG8_ALIGN true
#endif
template <class Epi, class Sched, bool ALIGN_EPI = false, bool SP2 = false>
__device__ __forceinline__ void gemm_phase(PG8_LAS unsigned char* lds, const Gemm g, const Sched& S, const Epi& E) {
    const int tid = otid(), wid = __builtin_amdgcn_readfirstlane(tid >> 6), lane = tid & 63, wr = wid >> 2, wc = wid & 3, fr = lane & 15, fq = lane >> 4;
    const int K = g.K, nt = K / BK;
    unsigned voffA[2], voffB[2];
#pragma unroll
    for (int i = 0; i < 2; ++i) { int R, C; stage_rc(tid * 16 + i * 8192, R, C); const int Rb = Epi::PERM ? ((R & ~31) + perm32(R & 31)) : R;
        voffA[i] = (unsigned)(R * g.lda + C) * 2u; voffB[i] = (unsigned)(Rb * g.ldb + C) * 2u; }
    const size_t kstep = (size_t)(BK * 2);
    const size_t hstepA = (size_t)HALF * g.lda * 2, hstepB = (size_t)HALF * g.ldb * 2;
    const size_t tstepA = 2 * hstepA, tstepB = 2 * hstepB;
    const unsigned ldsw = (unsigned)wid * 1024u;
    const int aoff = lds_byte(wr * 64 + fr, fq * 8), boff = lds_byte(wc * 32 + fr, fq * 8);
#define PG8_SA(b, h) (((b) * 2 + (h)) * HTB)
#define PG8_SB(b, h) ((4 + (b) * 2 + (h)) * HTB)
#define PG8_STAGE(bufoff, gbase, voff) do { _Pragma("unroll") for (int _i = 0; _i < 2; ++_i) \
        __builtin_amdgcn_global_load_lds((const unsigned*)((const char*)(gbase) + (voff)[_i]), (PG8_LAS unsigned*)(lds + (bufoff) + ldsw + _i * 8192), 16, 0, 0); } while (0)
#define PG8_LDA(dst, b, h) do { _Pragma("unroll") for (int m = 0; m < 4; ++m) _Pragma("unroll") for (int k = 0; k < 2; ++k) dst[m][k] = *(const PG8_LAS bf16x8*)(lds + PG8_SA(b, h) + aoff + m * 2048 + k * 1024); } while (0)
#define PG8_LDB(dst, b, h) do { _Pragma("unroll") for (int n = 0; n < 2; ++n) _Pragma("unroll") for (int k = 0; k < 2; ++k) dst[n][k] = *(const PG8_LAS bf16x8*)(lds + PG8_SB(b, h) + boff + n * 2048 + k * 1024); } while (0)
#define PG8_MMA(ai, bj, At, Bt) do { __builtin_amdgcn_s_setprio(1); _Pragma("unroll") for (int m = 0; m < 4; ++m) _Pragma("unroll") for (int n = 0; n < 2; ++n) _Pragma("unroll") for (int k = 0; k < 2; ++k) \
        acc[ai][bj][m][n] = __builtin_amdgcn_mfma_f32_16x16x32_bf16(Bt[n][k], At[m][k], acc[ai][bj][m][n], 0, 0, 0); __builtin_amdgcn_s_setprio(0); } while (0)
#define PG8_WAIT_V(n) asm volatile("s_waitcnt vmcnt(" #n ")" ::: "memory")
#define PG8_WAIT_L(n) asm volatile("s_waitcnt lgkmcnt(" #n ")" ::: "memory")
#define PG8_BAR __builtin_amdgcn_s_barrier()
#define PG8_SCHED __builtin_amdgcn_sched_barrier(0)
    Unit cur, nxt; int ui = 0;
    if (!S.next(0, cur)) return;
    f32x4 acc[2][2][4][2];
#pragma unroll
    for (int a = 0; a < 2; ++a)
#pragma unroll
        for (int b = 0; b < 2; ++b)
#pragma unroll
            for (int m = 0; m < 4; ++m)
#pragma unroll
                for (int n = 0; n < 2; ++n) acc[a][b][m][n] = (f32x4){0.f, 0.f, 0.f, 0.f};
    bf16x8 At[4][2], B0[2][2], B1[2][2];
    const char* cA = (const char*)g.A + (size_t)cur.pm * tstepA; const char* cB = (const char*)g.Bt + (size_t)cur.pn * tstepB;
    S.a_ready(cur);
    if constexpr (SP2) {
        PG8_STAGE(PG8_SB(0, 0), cB, voffB); PG8_STAGE(PG8_SB(0, 1), cB + hstepB, voffB); PG8_STAGE(PG8_SA(0, 0), cA, voffA); PG8_STAGE(PG8_SA(0, 1), cA + hstepA, voffA);
        if (wr == 1) PG8_BAR;
        PG8_WAIT_V(2); PG8_BAR;
        PG8_STAGE(PG8_SB(1, 0), cB + kstep, voffB); PG8_STAGE(PG8_SA(1, 0), cA + kstep, voffA); PG8_STAGE(PG8_SB(1, 1), cB + hstepB + kstep, voffB);
        PG8_WAIT_V(6); PG8_BAR;
    } else {
        PG8_STAGE(PG8_SB(0, 0), cB, voffB); PG8_STAGE(PG8_SA(0, 0), cA, voffA); PG8_STAGE(PG8_SB(0, 1), cB + hstepB, voffB); PG8_STAGE(PG8_SA(0, 1), cA + hstepA, voffA);
        if (wr == 1) PG8_BAR;
        PG8_WAIT_V(4); PG8_BAR;
        PG8_STAGE(PG8_SB(1, 0), cB + kstep, voffB); PG8_STAGE(PG8_SA(1, 0), cA + kstep, voffA); PG8_STAGE(PG8_SB(1, 1), cB + hstepB + kstep, voffB);
        PG8_WAIT_V(6); PG8_BAR;
    }
    for (;;) {
        const bool has_next = S.next(ui + 1, nxt);
        const char* nA = has_next ? (const char*)g.A + (size_t)nxt.pm * tstepA : cA; const char* nB = has_next ? (const char*)g.Bt + (size_t)nxt.pn * tstepB : cB;
        for (int t = 0; t < nt; t += 2) {
            const bool last = (t == nt - 2);
            const char* a1 = cA + (size_t)(t + 1) * kstep;
            const char* a2 = last ? nA : cA + (size_t)(t + 2) * kstep; const char* b2 = last ? nB : cB + (size_t)(t + 2) * kstep;
            const char* a3 = a2 + kstep; const char* b3 = b2 + kstep;
            if (last && has_next) S.a_ready(nxt);
            if constexpr (SP2) {
            PG8_LDB(B0, 0, 0); PG8_LDB(B1, 0, 1); PG8_SCHED; PG8_LDA(At, 0, 0); PG8_STAGE(PG8_SA(1, 1), a1 + hstepA, voffA);
            PG8_WAIT_V(8); PG8_WAIT_L(0); PG8_BAR; PG8_MMA(0, 0, At, B0); PG8_MMA(0, 1, At, B1); PG8_BAR; PG8_SCHED;
            PG8_LDA(At, 0, 1); PG8_STAGE(PG8_SB(0, 0), b2, voffB); PG8_STAGE(PG8_SB(0, 1), b2 + hstepB, voffB); PG8_STAGE(PG8_SA(0, 0), a2, voffA);
            PG8_WAIT_V(8); PG8_WAIT_L(0); PG8_BAR; PG8_MMA(1, 0, At, B0); PG8_MMA(1, 1, At, B1); PG8_BAR; PG8_SCHED;
            PG8_LDB(B0, 1, 0); PG8_LDB(B1, 1, 1); PG8_SCHED; PG8_LDA(At, 1, 0); PG8_STAGE(PG8_SA(0, 1), a2 + hstepA, voffA);
            PG8_WAIT_V(8); PG8_WAIT_L(0); PG8_BAR; PG8_MMA(0, 0, At, B0); PG8_MMA(0, 1, At, B1); PG8_BAR; PG8_SCHED;
            PG8_LDA(At, 1, 1); PG8_STAGE(PG8_SB(1, 0), b3, voffB); PG8_STAGE(PG8_SB(1, 1), b3 + hstepB, voffB); PG8_STAGE(PG8_SA(1, 0), a3, voffA);
            PG8_WAIT_V(8); PG8_WAIT_L(0); PG8_BAR; PG8_MMA(1, 0, At, B0); PG8_MMA(1, 1, At, B1); PG8_BAR; PG8_SCHED;
            } else {
            PG8_LDB(B0, 0, 0); PG8_SCHED; PG8_LDA(At, 0, 0); PG8_STAGE(PG8_SA(1, 1), a1 + hstepA, voffA);
            PG8_WAIT_L(8); PG8_BAR; PG8_WAIT_L(0); PG8_MMA(0, 0, At, B0); PG8_BAR; PG8_SCHED;
            PG8_LDB(B1, 0, 1); PG8_STAGE(PG8_SB(0, 0), b2, voffB);
            PG8_BAR; PG8_WAIT_L(0); PG8_MMA(0, 1, At, B1); PG8_BAR;
            PG8_LDA(At, 0, 1); PG8_STAGE(PG8_SA(0, 0), a2, voffA);
            PG8_BAR; PG8_WAIT_L(0); PG8_MMA(1, 0, At, B0); PG8_BAR; PG8_SCHED;
            PG8_STAGE(PG8_SB(0, 1), b2 + hstepB, voffB);
            PG8_WAIT_V(6); PG8_BAR; PG8_MMA(1, 1, At, B1); PG8_BAR;
            PG8_LDB(B0, 1, 0); PG8_SCHED; PG8_LDA(At, 1, 0); PG8_STAGE(PG8_SA(0, 1), a2 + hstepA, voffA);
            PG8_WAIT_L(8); PG8_BAR; PG8_WAIT_L(0); PG8_MMA(0, 0, At, B0); PG8_BAR; PG8_SCHED;
            PG8_LDB(B1, 1, 1); PG8_STAGE(PG8_SB(1, 0), b3, voffB);
            PG8_BAR; PG8_WAIT_L(0); PG8_MMA(0, 1, At, B1); PG8_BAR;
            PG8_LDA(At, 1, 1); PG8_STAGE(PG8_SA(1, 0), a3, voffA);
            PG8_BAR; PG8_WAIT_L(0); PG8_MMA(1, 0, At, B0); PG8_BAR; PG8_SCHED;
            PG8_STAGE(PG8_SB(1, 1), b3 + hstepB, voffB);
            PG8_WAIT_V(6); PG8_BAR; PG8_MMA(1, 1, At, B1); PG8_BAR;
            }
        }
        if constexpr (ALIGN_EPI) { if (wr == 0) PG8_BAR; }
        if constexpr (!Epi::AFTER_DRAIN) { E(acc, cur, wr, wc, fr, fq); S.done(cur); }
        if (!has_next) break;
#pragma unroll
        for (int a = 0; a < 2; ++a)
#pragma unroll
            for (int b = 0; b < 2; ++b)
#pragma unroll
                for (int m = 0; m < 4; ++m)
#pragma unroll
                    for (int n = 0; n < 2; ++n) acc[a][b][m][n] = (f32x4){0.f, 0.f, 0.f, 0.f};
        cur = nxt; cA = nA; cB = nB; ++ui;
        if constexpr (ALIGN_EPI) { if (wr == 1) PG8_BAR; }
    }
    PG8_WAIT_V(0);
    if constexpr (!ALIGN_EPI) { if (wr == 0) PG8_BAR; }
    PG8_BAR;
    if constexpr (Epi::AFTER_DRAIN) { E.fused(acc, cur, wr, wc, fr, fq, lds, wid, lane); S.done(cur); }
#undef PG8_SA
#undef PG8_SB
#undef PG8_STAGE
#undef PG8_LDA
#undef PG8_LDB
#undef PG8_MMA
#undef PG8_WAIT_V
#undef PG8_WAIT_L
#undef PG8_BAR
#undef PG8_SCHED
}
}
#include <hip/hip_bf16.h>
#include <cmath>
namespace attn_body {
using bf16=__hip_bfloat16;
using bf16x8=__attribute__((ext_vector_type(8)))short;
using s16x4=__attribute__((ext_vector_type(4)))short;
using f32x16=__attribute__((ext_vector_type(16)))float;
using u32x4=__attribute__((ext_vector_type(4)))unsigned;
constexpr int D=64,DM=2048,KDM=64;
constexpr int NW=8,QBLK=32,QB=QBLK*NW,KVBLK=64;
constexpr int ATTN_PITCH=DM, ATTN_UNIT_ROWS=QB;
__device__ __forceinline__ int crow(int r,int hi){return (r&3)+8*(r>>2)+4*hi;}
#define SBAR() __builtin_amdgcn_sched_barrier(0)
__device__ __forceinline__ void cmask(f32x16&p0,f32x16&p1,int jb,int qrel,int hi){
  const float NEG=-INFINITY; int kb=64*jb+4*hi;
  #pragma unroll
  for(int r=0;r<16;++r){int kv=kb+(r&3)+8*(r>>2); if(kv>qrel)p0[r]=NEG; if(kv+32>qrel)p1[r]=NEG;}
}

constexpr int NSLOT=3, SLOTB=8192;
constexpr int LDS_K=0, LDS_V=NSLOT*SLOTB, LDS_WS=2*NSLOT*SLOTB, LDS_OST=LDS_WS+NW*64*4, LDS_BYTES=LDS_OST+NW*4096;
constexpr float C2=0.125f*1.4426950408889634f;
__device__ __forceinline__ void glds16(const void*gsrc,unsigned lds_dst){unsigned keep;
  asm volatile("s_mov_b32 %0, m0\n\ts_mov_b32 m0, %2\n\ts_nop 0\n\tglobal_load_lds_dwordx4 %1, off\n\ts_mov_b32 m0, %0":"=&s"(keep):"v"(gsrc),"s"(lds_dst):"memory");}
__device__ __forceinline__ float max3f(float a,float b,float c){float r;asm("v_max3_f32 %0, %1, %2, %3":"=v"(r):"v"(a),"v"(b),"v"(c));return r;}
__device__ __forceinline__ float max2f(float a,float b){float r;asm("v_max_f32_e32 %0, %1, %2":"=v"(r):"v"(a),"v"(b));return r;}
__device__ __forceinline__ float fadd_s(float a,float b){float r;asm("v_add_f32_e32 %0, %1, %2":"=v"(r):"v"(a),"v"(b));return r;}
__device__ __forceinline__ float fsub_s(float a,float b){float r;asm("v_sub_f32_e32 %0, %1, %2":"=v"(r):"v"(a),"v"(b));return r;}
typedef float f32x2_t __attribute__((ext_vector_type(2))); typedef __bf16 bf16x2_t __attribute__((ext_vector_type(2)));
__device__ __forceinline__ unsigned cvtpk_s(float lo,float hi){f32x2_t v={lo,hi};bf16x2_t b=__builtin_convertvector(v,bf16x2_t);return __builtin_bit_cast(unsigned,b);}
#define WAIT_BAR(N) asm volatile("s_waitcnt vmcnt(" #N ") lgkmcnt(0)\n\ts_barrier":::"memory")

__device__ __forceinline__ void qkt(f32x16&p0,f32x16&p1,const char*Kslot,const bf16x8*qr,const f32x16&negm,int r32,int hi){
  const char*kb=Kslot+hi*1024+r32*16;
  #pragma unroll
  for(int d0=0;d0<4;++d0){
    const bf16x8 b0=*reinterpret_cast<const bf16x8*>(kb+d0*2048);
    const bf16x8 b1=*reinterpret_cast<const bf16x8*>(kb+d0*2048+512);
    if(d0==0){p0=__builtin_amdgcn_mfma_f32_32x32x16_bf16(b0,qr[0],negm,0,0,0);p1=__builtin_amdgcn_mfma_f32_32x32x16_bf16(b1,qr[0],negm,0,0,0);}
    else{p0=__builtin_amdgcn_mfma_f32_32x32x16_bf16(b0,qr[d0],p0,0,0,0);p1=__builtin_amdgcn_mfma_f32_32x32x16_bf16(b1,qr[d0],p1,0,0,0);}}
}
typedef __attribute__((address_space(3))) const char* lds_cptr;
typedef short v4i16_t __attribute__((ext_vector_type(4)));
__device__ __forceinline__ void kload8(bf16x8*kf,lds_cptr kp){
  kf[0]=*(const __attribute__((address_space(3))) bf16x8*)(kp);      kf[1]=*(const __attribute__((address_space(3))) bf16x8*)(kp+512);
  kf[2]=*(const __attribute__((address_space(3))) bf16x8*)(kp+2048); kf[3]=*(const __attribute__((address_space(3))) bf16x8*)(kp+2560);
  kf[4]=*(const __attribute__((address_space(3))) bf16x8*)(kp+4096); kf[5]=*(const __attribute__((address_space(3))) bf16x8*)(kp+4608);
  kf[6]=*(const __attribute__((address_space(3))) bf16x8*)(kp+6144); kf[7]=*(const __attribute__((address_space(3))) bf16x8*)(kp+6656);
}
__device__ __forceinline__ void kload2(bf16x8*kf,lds_cptr kp,int j){ kf[2*j]=*(const __attribute__((address_space(3))) bf16x8*)(kp+j*2048); kf[2*j+1]=*(const __attribute__((address_space(3))) bf16x8*)(kp+j*2048+512); }
__device__ __forceinline__ s16x4 vtr(lds_cptr p){ return __builtin_bit_cast(s16x4,__builtin_amdgcn_ds_read_tr16_b64_v4i16((__attribute__((address_space(3))) v4i16_t*)p)); }
__device__ __forceinline__ float rowmax(const f32x16&p0,const f32x16&p1){
  float a=max3f(p0[0],p0[1],p1[0]),b=max3f(p0[2],p0[3],p1[1]);a=max3f(a,p1[2],p1[3]);
  #pragma unroll
  for(int r=4;r<16;r+=4){a=max3f(a,p0[r],p0[r+1]);b=max3f(b,p0[r+2],p0[r+3]);a=max3f(a,p1[r],p1[r+1]);b=max3f(b,p1[r+2],p1[r+3]);}
  const float m=max2f(a,b);
  auto rr=__builtin_amdgcn_permlane32_swap(__float_as_uint(m),__float_as_uint(m),false,false);
  return max2f(__uint_as_float(rr[0]),__uint_as_float(rr[1]));
}
__device__ __forceinline__ void pv(f32x16*o,int vb,bf16x8 pa0,bf16x8 pa1,bf16x8 pa2,bf16x8 pa3){
  #pragma unroll
  for(int d0=0;d0<2;++d0){s16x4 lo[4],hi[4];
    #pragma unroll
    for(int ks=0;ks<4;++ks){
      asm volatile("ds_read_b64_tr_b16 %0,%1 offset:%c2":"=&v"(lo[ks]):"v"(vb),"i"(d0*4096+ks*1024):"memory");
      asm volatile("ds_read_b64_tr_b16 %0,%1 offset:%c2":"=&v"(hi[ks]):"v"(vb),"i"(d0*4096+ks*1024+512):"memory");}
    asm volatile("s_waitcnt lgkmcnt(0)":::"memory");SBAR();
    #define PK(k) (bf16x8){lo[k][0],lo[k][1],lo[k][2],lo[k][3],hi[k][0],hi[k][1],hi[k][2],hi[k][3]}
    o[d0]=__builtin_amdgcn_mfma_f32_32x32x16_bf16(pa0,PK(0),o[d0],0,0,0);
    o[d0]=__builtin_amdgcn_mfma_f32_32x32x16_bf16(pa1,PK(1),o[d0],0,0,0);
    o[d0]=__builtin_amdgcn_mfma_f32_32x32x16_bf16(pa2,PK(2),o[d0],0,0,0);
    o[d0]=__builtin_amdgcn_mfma_f32_32x32x16_bf16(pa3,PK(3),o[d0],0,0,0);
    #undef PK
  }
}

#ifndef ATTN_STORE16
#define ATTN_STORE16(p,v) (*(u32x4*)(p)=(v))
#endif
template<int THRL> __device__ __forceinline__ void attn_unit(const bf16*Qblk,const bf16*__restrict__ Kh,const bf16*__restrict__ Vh,bf16*Oblk,const int NT,char*shm){
  const int tid=otid(),lane=tid&63,r32=lane&31,hi=lane>>5; const int wid=__builtin_amdgcn_readfirstlane(tid>>6);
  const bf16*Qw=Qblk+(long)wid*QBLK*DM;
  const unsigned lds0=(unsigned)(uintptr_t)shm;
  float*wsf=(float*)(shm+LDS_WS)+wid*64;
  const bf16*ksrc=Kh+(long)lane*KDM+wid*8;
  const bf16*vsrc=Vh+(long)(16*(wid&3)+(lane>>2))*KDM+(wid>>2)*32+(lane&3)*8;
  const unsigned kdst=lds0+LDS_K+wid*1024, vdst=lds0+LDS_V+wid*1024;
  #define DMA_K(t,slot) glds16(ksrc+(long)(t)*KVBLK*KDM,(unsigned)__builtin_amdgcn_readfirstlane(kdst+(slot)))
  #define DMA_V(t,slot) glds16(vsrc+(long)(t)*KVBLK*KDM,(unsigned)__builtin_amdgcn_readfirstlane(vdst+(slot)))
  const int vb0=(int)(lds0+LDS_V)+((lane>>4)&1)*32+(lane&3)*8+(4*hi+((lane&15)>>2))*64;
  const char*Kbase=shm+LDS_K; bf16x8 kf[8];
  const lds_cptr shm3=(lds_cptr)shm; const lds_cptr kp0=shm3+LDS_K+hi*1024+r32*16; const lds_cptr vp0=shm3+LDS_V+((lane>>4)&1)*32+(lane&3)*8+(4*hi+((lane&15)>>2))*64;
  DMA_K(0,0);DMA_V(0,0);DMA_K(1,SLOTB);
  bf16x8 qr[4];
  #pragma unroll
  for(int d0=0;d0<4;++d0)qr[d0]=*reinterpret_cast<const bf16x8*>(&Qw[(long)r32*DM+d0*16+hi*8]);
  float mhat=0.f,l_reg=0.f;f32x16 o[2];o[0]=f32x16{};o[1]=f32x16{};f32x16 negm=f32x16{};asm volatile("":"+v"(negm));
  #define CMASK(P0,P1,t) do{}while(0)
  bool resc=false;
  #define START(P0,P1) do{ const float rm=rowmax(P0,P1); resc=false; \
    { const float dl=rm; mhat=fadd_s(mhat,dl); \
      _Pragma("unroll") for(int r=0;r<16;++r){P0[r]=fsub_s(P0[r],dl);P1[r]=fsub_s(P1[r],dl);} \
      _Pragma("unroll") for(int r=0;r<16;++r)negm[r]=-mhat; asm volatile("":"+v"(negm)); } \
    _Pragma("unroll") for(int r=0;r<16;++r)P0[r]=__builtin_amdgcn_exp2f(P0[r]); }while(0)
  #define RESC() do{ if(resc){ asm volatile("s_waitcnt lgkmcnt(0)":::"memory"); \
      _Pragma("unroll") for(int d_=0;d_<2;++d_) _Pragma("unroll") for(int r=0;r<16;++r)o[d_][r]*=wsf[crow(r,hi)]; } }while(0)
  f32x16 pA0,pA1,pB0,pB1;
  int sl_prev=0,sl_cur=0,sl_next=SLOTB;
  #define ROT() do{sl_prev=sl_cur;sl_cur=sl_next;sl_next=(sl_next==(NSLOT-1)*SLOTB)?0:sl_next+SLOTB;}while(0)
  DMA_K(2,2*SLOTB);
  WAIT_BAR(3);
  qkt(pA0,pA1,Kbase,qr,negm,r32,hi);asm volatile("s_nop 15\n\ts_nop 7":"+v"(pA0),"+v"(pA1));CMASK(pA0,pA1,0);
  START(pA0,pA1);
  _Pragma("unroll") for(int r=0;r<16;++r)pA1[r]=__builtin_amdgcn_exp2f(pA1[r]);
  WAIT_BAR(0);
  DMA_K(3,0);DMA_V(1,SLOTB);
  ROT();
  kload8(kf,kp0+sl_cur);
  WAIT_BAR(2);
  s16x4 vlo[8],vhi[8]; u32x4 pw0,pw1,pw2,pw3;
  #define PKW(P,B) cvtpk_s(P[B],P[B+1])
  #define PAF(k) __builtin_bit_cast(bf16x8,pw##k)
  #define VFR(i) (bf16x8){vlo[i][0],vlo[i][1],vlo[i][2],vlo[i][3],vhi[i][0],vhi[i][1],vhi[i][2],vhi[i][3]}
  #define PIN(x) asm volatile("":"+v"(x))
  #define MX3(a,b,c) __builtin_fmaxf(__builtin_fmaxf((a),(b)),(c))
  #define GAPA(MF,A0,A1,A2,A3,W0,W1,PW) do{ MF; sacc+=A0; sacc+=A1; sacc+=A2; sacc+=A3; PIN(sacc); W0; W1; PIN(PW); SBAR(); }while(0)
  #define EX(v) __builtin_amdgcn_exp2f(v)
  #define GAPB(MF,X,B) do{ MF; X[B]=EX(X[B]); X[B+1]=EX(X[B+1]); X[B+2]=EX(X[B+2]); X[B+3]=EX(X[B+3]); PIN(X); SBAR(); }while(0)
  #define VRD(i) do{ vlo[i]=vtr(vp_+(((i)>>2)*4096+((i)&3)*1024)); vhi[i]=vtr(vp_+(((i)>>2)*4096+((i)&3)*1024+512)); }while(0)
  #define KRD(G,j) do{ if(G){ kload2(kf,kp0+sl_next,j); SBAR(); } }while(0)
  #define STEP(C0,C1,P0,P1,t,GK,GV,GL) do{ SBAR(); \
    const lds_cptr vp_=vp0+sl_prev; \
    VRD(0); SBAR(); float sacc=(P0[0]+P0[1]); \
    GAPA(C0=__builtin_amdgcn_mfma_f32_32x32x16_bf16(kf[0],qr[0],negm,0,0,0), P0[2],P0[3],P0[4],P0[5],     pw0[0]=PKW(P0,0), pw0[1]=PKW(P0,2), pw0); \
    VRD(4); SBAR(); GAPA(C1=__builtin_amdgcn_mfma_f32_32x32x16_bf16(kf[1],qr[0],negm,0,0,0), P0[6],P0[7],P0[8],P0[9],     pw0[2]=PKW(P0,4), pw0[3]=PKW(P0,6), pw0); \
    VRD(1); SBAR(); GAPA(C0=__builtin_amdgcn_mfma_f32_32x32x16_bf16(kf[2],qr[1],C0,0,0,0),   P0[10],P0[11],P0[12],P0[13], pw1[0]=PKW(P0,8), pw1[1]=PKW(P0,10), pw1); \
    VRD(5); SBAR(); GAPA(C1=__builtin_amdgcn_mfma_f32_32x32x16_bf16(kf[3],qr[1],C1,0,0,0),   P0[14],P0[15],P1[0],P1[1],   pw1[2]=PKW(P0,12),pw1[3]=PKW(P0,14), pw1); \
    VRD(2); SBAR(); GAPA(C0=__builtin_amdgcn_mfma_f32_32x32x16_bf16(kf[4],qr[2],C0,0,0,0),   P1[2],P1[3],P1[4],P1[5],     pw2[0]=PKW(P1,0), pw2[1]=PKW(P1,2), pw2); \
    VRD(6); SBAR(); GAPA(C1=__builtin_amdgcn_mfma_f32_32x32x16_bf16(kf[5],qr[2],C1,0,0,0),   P1[6],P1[7],P1[8],P1[9],     pw2[2]=PKW(P1,4), pw2[3]=PKW(P1,6), pw2); \
    VRD(3); SBAR(); GAPA(C0=__builtin_amdgcn_mfma_f32_32x32x16_bf16(kf[6],qr[3],C0,0,0,0),   P1[10],P1[11],P1[12],P1[13], pw3[0]=PKW(P1,8), pw3[1]=PKW(P1,10), pw3); \
    VRD(7); SBAR(); GAPA(C1=__builtin_amdgcn_mfma_f32_32x32x16_bf16(kf[7],qr[3],C1,0,0,0),   P1[14],P1[15],0.f,0.f,       pw3[2]=PKW(P1,12),pw3[3]=PKW(P1,14), pw3); \
    l_reg+=sacc; \
    if(GK){DMA_K((t)+3,sl_cur);} if(GV){DMA_V((t)+1,sl_next);} \
    CMASK(C0,C1,t); \
    { float a=MX3(C0[0],C0[1],C1[0]),b=MX3(C0[2],C0[3],C1[1]); a=MX3(a,C1[2],C1[3]); \
      _Pragma("unroll") for(int r=4;r<16;r+=4){a=MX3(a,C0[r],C0[r+1]);b=MX3(b,C0[r+2],C0[r+3]);a=MX3(a,C1[r],C1[r+1]);b=MX3(b,C1[r+2],C1[r+3]);} \
      float rm=__builtin_fmaxf(a,b); { auto rr=__builtin_amdgcn_permlane32_swap(__float_as_uint(rm),__float_as_uint(rm),false,false); rm=__builtin_fmaxf(__uint_as_float(rr[0]),__uint_as_float(rr[1])); } \
      resc=false; \
      if(__builtin_expect(__any(rm>(float)THRL),0)){ const float dl=__builtin_fmaxf(rm,0.f); mhat+=dl; \
        _Pragma("unroll") for(int r=0;r<16;++r){C0[r]-=dl;C1[r]-=dl;} \
        _Pragma("unroll") for(int r=0;r<16;++r)negm[r]=-mhat; asm volatile("":"+v"(negm)); \
        const float f=__builtin_amdgcn_exp2f(-dl); l_reg*=f; if(hi==0)wsf[r32]=f; resc=true; } } \
    SBAR(); \
    GAPB(o[0]=__builtin_amdgcn_mfma_f32_32x32x16_bf16(PAF(0),VFR(0),o[0],0,0,0), C0,0); \
    GAPB(o[1]=__builtin_amdgcn_mfma_f32_32x32x16_bf16(PAF(0),VFR(4),o[1],0,0,0), C0,4); \
    KRD(GL,0); GAPB(o[0]=__builtin_amdgcn_mfma_f32_32x32x16_bf16(PAF(1),VFR(1),o[0],0,0,0), C0,8); \
    KRD(GL,1); GAPB(o[1]=__builtin_amdgcn_mfma_f32_32x32x16_bf16(PAF(1),VFR(5),o[1],0,0,0), C0,12); \
    KRD(GL,2); GAPB(o[0]=__builtin_amdgcn_mfma_f32_32x32x16_bf16(PAF(2),VFR(2),o[0],0,0,0), C1,0); \
    KRD(GL,3); GAPB(o[1]=__builtin_amdgcn_mfma_f32_32x32x16_bf16(PAF(2),VFR(6),o[1],0,0,0), C1,4); \
    GAPB(o[0]=__builtin_amdgcn_mfma_f32_32x32x16_bf16(PAF(3),VFR(3),o[0],0,0,0), C1,8); \
    GAPB(o[1]=__builtin_amdgcn_mfma_f32_32x32x16_bf16(PAF(3),VFR(7),o[1],0,0,0), C1,12); \
    }while(0)
  int t=1;
  #undef CMASK
  #define CMASK(P0,P1,t) do{}while(0)
  for(;t+5<NT;t+=2){
    STEP(pB0,pB1,pA0,pA1,t,true,true,true);     WAIT_BAR(2); RESC(); ROT();
    STEP(pA0,pA1,pB0,pB1,t+1,true,true,true);   WAIT_BAR(2); RESC(); ROT();
  }
  #undef CMASK
  #define CMASK(P0,P1,t) do{}while(0)
  #define ENDW(tt) do{ if((tt)+3<NT){WAIT_BAR(2);} else if((tt)+2<NT){WAIT_BAR(1);} else {WAIT_BAR(0);} }while(0)
  for(;t+1<NT;t+=2){
    STEP(pB0,pB1,pA0,pA1,t,(t+3<NT),(t+1<NT),(t+1<NT));       ENDW(t);   RESC(); ROT();
    STEP(pA0,pA1,pB0,pB1,t+1,(t+4<NT),(t+2<NT),(t+2<NT));     ENDW(t+1); RESC(); ROT();
  }
  STEP(pB0,pB1,pA0,pA1,NT-1,false,false,false); RESC();
  { float sacc=pB0[0]+pB0[1]; _Pragma("unroll") for(int r=2;r<16;++r)sacc+=pB0[r]; _Pragma("unroll") for(int r=0;r<16;++r)sacc+=pB1[r]; l_reg+=sacc;
    pw0=(u32x4){PKW(pB0,0),PKW(pB0,2),PKW(pB0,4),PKW(pB0,6)};pw1=(u32x4){PKW(pB0,8),PKW(pB0,10),PKW(pB0,12),PKW(pB0,14)};pw2=(u32x4){PKW(pB1,0),PKW(pB1,2),PKW(pB1,4),PKW(pB1,6)};pw3=(u32x4){PKW(pB1,8),PKW(pB1,10),PKW(pB1,12),PKW(pB1,14)};
    SBAR(); pv(o,vb0+sl_cur,PAF(0),PAF(1),PAF(2),PAF(3)); }
  #undef PKW
  #undef PAF
  #undef VFR
  #undef PIN
  #undef MX3
  #undef GAPA
  #undef GAPB
  #undef EX
  #undef VRD
  #undef KRD
  #undef STEP
  #undef ENDW
  {auto rr=__builtin_amdgcn_permlane32_swap(__float_as_uint(l_reg),__float_as_uint(l_reg),false,false);l_reg=__uint_as_float(rr[0])+__uint_as_float(rr[1]);}
  if(hi==0)wsf[32+r32]=l_reg;asm volatile("s_waitcnt lgkmcnt(0)":::"memory");
  float rli[16];
  #pragma unroll
  for(int r=0;r<16;++r)rli[r]=__builtin_amdgcn_rcpf(wsf[32+crow(r,hi)]);
  bf16*Ow=Oblk+(long)wid*QBLK*DM;
  { bf16*stg=(bf16*)(shm+LDS_OST)+wid*2048;
    #pragma unroll
    for(int r=0;r<16;++r){const int orow=crow(r,hi);
      #pragma unroll
      for(int d0=0;d0<2;++d0)stg[orow*64+d0*32+r32]=__float2bfloat16(o[d0][r]*rli[r]);}
    asm volatile("s_waitcnt lgkmcnt(0)":::"memory");
    #pragma unroll
    for(int i=0;i<4;++i){const int row=i*8+(lane>>3),ch=lane&7; const u32x4 v=*(const u32x4*)(stg+row*64+ch*8); const u32x4 z=*(const u32x4*)(Ow+(long)row*DM+ch*8); u32x4 w;
      #pragma unroll
      for(int e=0;e<4;++e){ const float a0=__uint_as_float(v[e]<<16),a1=__uint_as_float(v[e]&0xffff0000u),z0=__uint_as_float(z[e]<<16),z1=__uint_as_float(z[e]&0xffff0000u);
        w[e]=cvtpk_s(a0*z0/(1.f+__expf(-z0)),a1*z1/(1.f+__expf(-z1))); }
      ATTN_STORE16(Ow+(long)row*DM+ch*8,w);} }
  asm volatile("s_waitcnt lgkmcnt(0)\n\ts_barrier":::"memory");
  #undef DMA_K
  #undef DMA_V
  #undef CMASK
  #undef START
  #undef RESC
  #undef ROT
}
constexpr int ATTN_LDS_BYTES=LDS_BYTES;
}
typedef unsigned short u16;
#define LAS __attribute__((address_space(3)))
#define DI __device__ __forceinline__
typedef unsigned v4u __attribute__((ext_vector_type(4)));
typedef unsigned v2u __attribute__((ext_vector_type(2)));
typedef float v4f __attribute__((ext_vector_type(4)));

constexpr int T_TOK = 32768, P1P = 2048, P2P = 1536;
constexpr int P1_Z = 0, P1_Q = 1280, P1_K = 1792, P1_V = 1920;
constexpr int P2_AQ = 0, P2_AK = 128, P2_AV = 256, P2_GF = 512, P2_GB = 640, P2_BU = 768, P2_DU = 1024, P2_DV = 1280, P2_U = 1024;
constexpr size_t MiB = 1u << 20;
constexpr size_t WS_DFT = 256 * 1024, WS_BAR = 512 * 1024, BAR_BYTES = 16384;
constexpr size_t WS_MOD = 0, WS_WIN = 2 * MiB, WS_WOUT = 16 * MiB, WS_WF = 21 * MiB, WS_U0 = 22 * MiB, WS_HB = 86 * MiB, WS_P2 = 150 * MiB, WS_DEC = 246 * MiB, WS_END = 247 * MiB;
constexpr size_t HB_GS = 0, HB_KC = 16 * MiB, HB_VC = 24 * MiB, HB_TP = 32 * MiB;
constexpr int LDS_BYTES = 147456;
constexpr float EPSN = 1e-6f;
constexpr float ATT_C2 = 0.125f * 1.4426950408889634f;

struct Params {
    const float *xp, *xs, *cp, *cs, *ada_w, *ada_b, *pre_g, *post_g, *w_in, *wg2f, *bgf, *wg2b, *bgb, *onorm_g, *fnet_w, *qn_g, *kn_g, *sgu_ng, *sgu_w, *sgu_b, *w_out;
    float* out; unsigned char* ws;
};
typedef const float* cfp;
struct Ctx { float* out; unsigned char* ws; LAS cfp* tab; };

DI float bf2f(u16 v) { return __uint_as_float((unsigned)v << 16); }
DI float bflo(unsigned w) { return __uint_as_float(w << 16); }
DI float bfhi(unsigned w) { return __uint_as_float(w & 0xffff0000u); }
DI unsigned f2bf(float f) { unsigned u = __float_as_uint(f); return (u + 0x7fffu + ((u >> 16) & 1u)) >> 16; }
DI unsigned pk2(float lo, float hi) { return f2bf(lo) | (f2bf(hi) << 16); }
DI float wave_sum(float v) {
#pragma unroll
    for (int o = 1; o < 64; o <<= 1) v += __shfl_xor(v, o);
    return v;
}
using pg8::silu_f;
DI float logsig(float x) { return fminf(x, 0.f) - log1pf(__expf(-fabsf(x))); }
DI void seq_info(int s, int& row0, int& N) { if (s < 4) { row0 = s * 4096; N = 4096; } else { row0 = 16384 + (s - 4) * 8192; N = 8192; } }
DI int row_seq(int r) { return r < 16384 ? (r >> 12) : 4 + ((r - 16384) >> 13); }
DI void unpack8(const v4u r, float (&f)[8]) { f[0] = bflo(r.x); f[1] = bfhi(r.x); f[2] = bflo(r.y); f[3] = bfhi(r.y); f[4] = bflo(r.z); f[5] = bfhi(r.z); f[6] = bflo(r.w); f[7] = bfhi(r.w); }
DI v4u pack8(const float (&f)[8]) { v4u r; r.x = pk2(f[0], f[1]); r.y = pk2(f[2], f[3]); r.z = pk2(f[4], f[5]); r.w = pk2(f[6], f[7]); return r; }
#define LDS_WAIT() asm volatile("s_waitcnt lgkmcnt(0)" ::: "memory")


typedef short bf16x8_t __attribute__((ext_vector_type(8)));
typedef float f32x4_t __attribute__((ext_vector_type(4)));
DI bf16x8_t ldfrag(const LAS u16* base, int pitch, int row0, int k0, int lane) { return *(const LAS bf16x8_t*)(base + (row0 + (lane & 15)) * pitch + k0 + 8 * (lane >> 4)); }
typedef short s16x4_t __attribute__((ext_vector_type(4)));
DI bf16x8_t ldfrag_tr(const LAS u16* base, int pitch, int k0, int n0, int lane) {
    const LAS u16* a0 = base + (k0 + 8 * (lane >> 4) + ((lane & 15) >> 2)) * pitch + n0 + 4 * (lane & 3);
    const s16x4_t lo = __builtin_amdgcn_ds_read_tr16_b64_v4i16((LAS s16x4_t*)a0), hi = __builtin_amdgcn_ds_read_tr16_b64_v4i16((LAS s16x4_t*)(a0 + 4 * pitch));
    return (bf16x8_t){lo[0], lo[1], lo[2], lo[3], hi[0], hi[1], hi[2], hi[3]};
}
#define MFMA16(a, b, c) __builtin_amdgcn_mfma_f32_16x16x32_bf16((a), (b), (c), 0, 0, 0)
DI float wave_prefix(float g, int lane) {
#pragma unroll
    for (int o = 1; o < 64; o <<= 1) { const float t = __shfl_up(g, o); if (lane >= o) g += t; }
    return g; }
DI float wave_suffix(float g, int lane) {
#pragma unroll
    for (int o = 1; o < 64; o <<= 1) { const float t = __shfl_down(g, o); if (lane + o < 64) g += t; }
    return g; }
DI int win_src_col(int j) {
    if (j < 1280) return 2080 + j;
    if (j < 1792) return 800 + (j - 1280);
    if (j < 1920) return 1312 + (j - 1792);
    if (j < 2048) return 1440 + (j - 1920);
    const int q = j - 2048;
    if (q < 512) return q;
    if (q < 768) return -1;
    if (q < 1024) return 544 + (q - 768);
    if (q < 1280) return 1568 + (q - 1024);
    return 1824 + (q - 1280);
}
DI void transpose_item(const float* W, int ldw, int src_n0, int K, u16* WT, int dst_n0, int k0, LAS float* scr, int lane) {
    float tv[32];
#pragma unroll
    for (int i = 0; i < 32; ++i) tv[i] = W[(size_t)(k0 + 2 * i + (lane >> 5)) * ldw + src_n0 + (lane & 31)];
#pragma unroll
    for (int i = 0; i < 32; ++i) scr[(2 * i + (lane >> 5)) * 33 + (lane & 31)] = tv[i];
    LDS_WAIT();
    const int c = lane & 7;
#pragma unroll
    for (int j = 0; j < 4; ++j) { const int n = (lane >> 3) + 8 * j; const LAS float* s = scr + (8 * c) * 33 + n;
        v4u o; o.x = pk2(s[0 * 33], s[1 * 33]); o.y = pk2(s[2 * 33], s[3 * 33]); o.z = pk2(s[4 * 33], s[5 * 33]); o.w = pk2(s[6 * 33], s[7 * 33]);
        *(v4u*)(WT + (size_t)(dst_n0 + n) * K + k0 + 8 * c) = o; }
    LDS_WAIT();
}
DI void phase0(const Ctx& p, LAS unsigned char* L) {
    const int tid = otid(), lane = tid & 63, wave = tid >> 6;
    const int gw = blockIdx.x * 8 + wave, NGW = gridDim.x * 8, gt = blockIdx.x * 512 + tid, NGT = gridDim.x * 512;
    LAS float* scr = (LAS float*)(L + wave * 16384);
    u16* WinT = (u16*)(p.ws + WS_WIN); u16* WoutT = (u16*)(p.ws + WS_WOUT); u16* WfT = (u16*)(p.ws + WS_WF); float* mod = (float*)(p.ws + WS_MOD);
    constexpr int I_IN = 16 * 112, I_OUT = 20 * 32, I_L = I_IN + I_OUT;
    for (int it = gw; it < 2 * I_L; it += NGW) {
        const int l = it / I_L; int r = it % I_L;
        if (r < I_IN) { const int kb = r / 112, nb = r % 112; const int src = win_src_col(nb * 32); if (src < 0) continue;
            transpose_item(p.tab[8] + (size_t)l * 1024 * 3360, 3360, src, 1024, WinT + (size_t)l * 3584 * 1024, nb * 32, kb * 64, scr, lane); }
        else { r -= I_IN; const int kb = r / 32, nb = r % 32;
            transpose_item(p.tab[20] + (size_t)l * 1280 * 1024, 1024, nb * 32, 1280, WoutT + (size_t)l * 1024 * 1280, nb * 32, kb * 64, scr, lane); }
    }
    for (int e = gt; e < 2 * 16 * 1024; e += NGT) { const int l = e >> 14, r = e & 16383, jg = r >> 10, k = r & 1023, dirb = jg >> 3, jj0 = (jg & 7) * 16;
        const float* wi = p.tab[8] + (size_t)l * 1024 * 3360 + (size_t)k * 3360 + 512 + dirb * 16; float wv[16];
#pragma unroll
        for (int r2 = 0; r2 < 16; ++r2) wv[r2] = wi[r2];
        const float* w2 = (dirb ? p.tab[11] : p.tab[9]) + l * 16 * 128 + jj0;
        for (int q = 0; q < 16; ++q) { float a = 0.f;
#pragma unroll
            for (int r2 = 0; r2 < 16; ++r2) a += wv[r2] * w2[r2 * 128 + q];
            WinT[(size_t)l * 3584 * 1024 + (size_t)(2560 + dirb * 128 + jj0 + q) * 1024 + k] = (u16)f2bf(a); } }
    { LAS float* trig = (LAS float*)(L + 126976);
        if (tid < 64) { trig[tid] = cospif((float)tid * (1.f / 32.f)); trig[64 + tid] = sinpif((float)tid * (1.f / 32.f)); }
        __syncthreads();
        for (int e = gt; e < 2 * 256 * 512; e += NGT) { const int l = e >> 17, r = e & 131071, n = r >> 9, kk = r & 511, im = kk >> 8, g = (kk & 255) >> 6, c = kk & 63;
            const float* fw = p.tab[14] + (size_t)l * 65536 + (size_t)(g * 64) * 256 + n; const LAS float* tb = trig + im * 64; float a = 0.f;
#pragma unroll 8
            for (int j2 = 0; j2 < 64; ++j2) a += tb[(j2 * c) & 63] * fw[j2 * 256];
            WfT[(size_t)l * 131072 + n * 512 + kk] = (u16)f2bf(a * 0.125f); } }
    { u16* dft = (u16*)(p.ws + WS_DFT);
        for (int e = gt; e < 4096; e += NGT) { const int k = e >> 6, n = e & 63; const float a = (float)((k * n) & 63) * (1.f / 32.f); dft[e] = (u16)f2bf(cospif(a)); dft[4096 + e] = (u16)f2bf(sinpif(a)); }
        for (int e = gt; e < 16384; e += NGT) { const int k = e >> 7, n = e & 127; const float a = (float)((k * n) & 127) * (1.f / 64.f); dft[8192 + e] = (u16)f2bf(cospif(a)); dft[8192 + 16384 + e] = (u16)f2bf(sinpif(a)); } }
    __syncthreads();
    LAS float* sc = (LAS float*)L;
    for (int e = tid; e < 6144; e += 512) { const int s = e >> 10, k = e & 1023; const float c = s < 4 ? p.tab[2][s * 1024 + k] : p.tab[3][(s - 4) * 1024 + k]; sc[e] = c / (1.f + expf(-c)); }
    __syncthreads();
    for (int unit = gw; unit < 768; unit += NGW) {
        const int ks = unit & 7, jb = (unit >> 3) % 48, l = unit / 384, j = jb * 64 + lane;
        float acc[6] = {0.f, 0.f, 0.f, 0.f, 0.f, 0.f};
        const float* aw = p.tab[4] + (size_t)l * 1024 * 3072 + (size_t)(ks * 128) * 3072 + j;
#pragma unroll 16
        for (int k = 0; k < 128; ++k) { const float w = aw[(size_t)k * 3072];
#pragma unroll
            for (int s = 0; s < 6; ++s) acc[s] += sc[s * 1024 + ks * 128 + k] * w; }
        if (ks == 0) { const float b = p.tab[5][l * 3072 + j];
#pragma unroll
            for (int s = 0; s < 6; ++s) acc[s] += b; }
#pragma unroll
        for (int s = 0; s < 6; ++s) atomicAdd(mod + (size_t)(l * 6 + s) * 3072 + j, acc[s]);
    }
}

DI void add_branch(v4f (&v)[4], const u16* urow, const float* gate, const float* pg, int lane) {
    v4f u[4]; float ss = 0.f;
#pragma unroll
    for (int j = 0; j < 4; ++j) { const v2u r = *(const v2u*)(urow + 256 * j + 4 * lane); u[j] = (v4f){bflo(r.x), bfhi(r.x), bflo(r.y), bfhi(r.y)};
        ss += (u[j].x * u[j].x + u[j].y * u[j].y) + (u[j].z * u[j].z + u[j].w * u[j].w); }
    const float rstd = 1.f / sqrtf(wave_sum(ss) * (1.f / 1024.f) + EPSN);
#pragma unroll
    for (int j = 0; j < 4; ++j) { const v4f g = *(const v4f*)(gate + 256 * j + 4 * lane), q = *(const v4f*)(pg + 256 * j + 4 * lane); v[j] += g * (u[j] * rstd * q); }
}
DI void phaseA(const Ctx& p, int l) {
    const int tid = otid(), lane = tid & 63, wave = tid >> 6, gw = blockIdx.x * 8 + wave, NGW = gridDim.x * 8;
    const float* mod = (const float*)(p.ws + WS_MOD); const u16* U0 = (const u16*)(p.ws + WS_U0); u16* HB = (u16*)(p.ws + WS_HB);
    for (int row = gw; row < T_TOK; row += NGW) {
        const int s = row_seq(row);
        const float* xr = row < 16384 ? p.tab[0] + (size_t)row * 1024 : p.tab[1] + (size_t)(row - 16384) * 1024;
        v4f v[4];
#pragma unroll
        for (int j = 0; j < 4; ++j) v[j] = *(const v4f*)(xr + 256 * j + 4 * lane);
        if (l >= 1) add_branch(v, U0 + (size_t)row * 1024, mod + (size_t)(0 * 6 + s) * 3072 + 2048, p.tab[7], lane);
        if (l == 2) { add_branch(v, HB + (size_t)row * 1024, mod + (size_t)(1 * 6 + s) * 3072 + 2048, p.tab[7] + 1024, lane);
            float* o = p.out + (size_t)row * 1024;
#pragma unroll
            for (int j = 0; j < 4; ++j) *(v4f*)(o + 256 * j + 4 * lane) = v[j];
            continue; }
        float ss = 0.f;
#pragma unroll
        for (int j = 0; j < 4; ++j) ss += (v[j].x * v[j].x + v[j].y * v[j].y) + (v[j].z * v[j].z + v[j].w * v[j].w);
        const float rstd = 1.f / sqrtf(wave_sum(ss) * (1.f / 1024.f) + EPSN);
        const float* md = mod + (size_t)(l * 6 + s) * 3072;
#pragma unroll
        for (int j = 0; j < 4; ++j) { const int col = 256 * j + 4 * lane;
            const v4f sh = *(const v4f*)(md + col), scl = *(const v4f*)(md + 1024 + col), g = *(const v4f*)(p.tab[6] + l * 1024 + col);
            const v4f h = v[j] * rstd * g * (scl + 1.f) + sh;
            v2u o; o.x = pk2(h.x, h.y); o.y = pk2(h.z, h.w); *(v2u*)(HB + (size_t)row * 1024 + col) = o; }
    }
}

DI void qk_prep(const Ctx& p, int l) {
    const int tid = otid(), lane = tid & 63, wave = tid >> 6, gw = blockIdx.x * 8 + wave, NGW = gridDim.x * 8;
    u16* P1 = (u16*)p.out; const int i = lane & 31; unsigned* KC = (unsigned*)(p.ws + WS_HB + HB_KC); unsigned* VC = (unsigned*)(p.ws + WS_HB + HB_VC);
    const float freq = exp2f(-(float)(i & 15) * (13.287712379549449f / 16.f));
    const float gq0 = p.tab[15][l * 64 + 2 * i], gq1 = p.tab[15][l * 64 + 2 * i + 1], gk0 = p.tab[16][l * 64 + 2 * i], gk1 = p.tab[16][l * 64 + 2 * i + 1];
    for (int rowb = gw * 2; rowb < T_TOK; rowb += NGW * 2) {
        unsigned wv[2][6];
#pragma unroll
        for (int r = 0; r < 2; ++r) { const unsigned* ptr = (const unsigned*)(P1 + (size_t)(rowb + r) * P1P + P1_Q);
#pragma unroll
            for (int it = 0; it < 6; ++it) wv[r][it] = ptr[it * 64 + lane]; }
#pragma unroll
        for (int r = 0; r < 2; ++r) { const int row = rowb + r;
            const int s = row_seq(row); int row0, N; seq_info(s, row0, N); const int pos = row - row0;
            const float coord = (i < 16) ? (float)(pos >> 6) : (float)(pos & 63);
            float sn, cs; sincosf(coord * freq, &sn, &cs);
            unsigned* ptr = (unsigned*)(P1 + (size_t)row * P1P + P1_Q);
            const size_t cidx = ((size_t)row0 * 2 + (size_t)(lane >> 5) * N + pos) * 32 + i;
#pragma unroll
            for (int it = 0; it < 5; ++it) { const bool isq = it < 4;
                const unsigned w = wv[r][it]; const float x0 = bflo(w), x1 = bfhi(w);
                float ss = x0 * x0 + x1 * x1;
#pragma unroll
                for (int o = 1; o < 32; o <<= 1) ss += __shfl_xor(ss, o);
                const float rstd = 1.f / sqrtf(ss * (1.f / 64.f) + EPSN);
                const float y0 = x0 * rstd * (isq ? gq0 : gk0), y1 = x1 * rstd * (isq ? gq1 : gk1);
                float o0 = y0 * cs - y1 * sn, o1 = y0 * sn + y1 * cs;
                if (isq) { ptr[it * 64 + lane] = pk2(o0 * ATT_C2, o1 * ATT_C2); } else { KC[cidx] = pk2(o0, o1); } }
            VC[cidx] = wv[r][5]; }
    }
}
DI void gla_scan_cols(LAS float* Gf, LAS float* Gb, int lane) {
    LAS float* G = (lane >> 5) ? Gb : Gf; const int d = lane & 31; float v[64];
#pragma unroll
    for (int i = 0; i < 64; ++i) v[i] = G[i * 33 + d];
    if (lane >> 5) {
#pragma unroll
        for (int i = 62; i >= 0; --i) v[i] += v[i + 1];
    } else {
#pragma unroll
        for (int i = 1; i < 64; ++i) v[i] += v[i - 1];
    }
#pragma unroll
    for (int i = 0; i < 64; ++i) G[i * 33 + d] = v[i];
}
struct GLoad { v4u g, k, v; };
DI GLoad gla_local_load(const Ctx& p, int item) {
    const int tid = otid(); const int gc = item >> 2, h = item & 3; const size_t rb = (size_t)gc * 64; const u16* P2 = (const u16*)(p.ws + WS_P2); GLoad r;
    { const int t2 = tid & 255, i = t2 >> 2, c = t2 & 3; const u16* q = P2 + (rb + i) * P2P + h * 32 + c * 8; const int dirb = tid >> 8;
        r.g = *(const v4u*)(q + (dirb ? P2_GB : P2_GF)); r.k = *(const v4u*)(q + P2_AK); }
    { const int i = tid >> 3, c = tid & 7; r.v = *(const v4u*)(P2 + (rb + i) * P2P + P2_AV + h * 64 + c * 8); }
    return r;
}
DI void gla_local_item(const Ctx& p, int l, int item, LAS float* F, const GLoad ld) {
    const int tid = otid(), lane = tid & 63, w = tid >> 6; const int gc = item >> 2, h = item & 3; const size_t rb = (size_t)gc * 64;
    const u16* P2 = (const u16*)(p.ws + WS_P2);
    LAS float* Gf = F; LAS float* Gb = Gf + 2112; LAS float* Kx = Gb + 2112; LAS u16* KDT = (LAS u16*)(Kx + 2112); LAS u16* VT = KDT + 2 * 64 * 40;
    { const int t2 = tid & 255, i = t2 >> 2, c = t2 & 3; const u16* r = P2 + (rb + i) * P2P + h * 32 + c * 8; float f[8];
        const int dirb = tid >> 8; const float* bias = p.tab[dirb ? 12 : 10] + l * 128 + h * 32 + c * 8; LAS float* G = dirb ? Gb : Gf;
        unpack8(ld.g, f);
#pragma unroll
        for (int q = 0; q < 8; ++q) G[i * 33 + c * 8 + q] = logsig(f[q] + bias[q]) * (1.f / 16.f);
        if (!dirb) { unpack8(ld.k, f);
#pragma unroll
            for (int q = 0; q < 8; ++q) Kx[i * 33 + c * 8 + q] = f[q]; } }
    { const int i = tid >> 3, c = tid & 7; *(LAS v4u*)(VT + i * 72 + c * 8) = ld.v; }
    __syncthreads();
    if (w == 0) gla_scan_cols(Gf, Gb, lane);
    __syncthreads();
    u16* GS = (u16*)(p.ws + WS_HB + HB_GS); float* DEC = (float*)(p.ws + WS_DEC); const size_t slot = (size_t)(gc * 4 + h) * 2;
#pragma unroll
    for (int r = 0; r < 8; ++r) { const int e = tid + r * 512, d = e & 31, i = (e >> 5) & 63, dir = e >> 11; const LAS float* G = dir ? Gb : Gf;
        const float bl = G[(dir ? 0 : 63) * 33 + d];
        KDT[(dir * 64 + i) * 40 + d] = (u16)f2bf(Kx[i * 33 + d] * __expf(bl - G[i * 33 + d])); }
    if (tid < 64) { const int dir = tid >> 5, d = tid & 31; DEC[(slot + dir) * 32 + d] = __expf((dir ? Gb : Gf)[(dir ? 0 : 63) * 33 + d]); }
    __syncthreads();
    { const int dir = w >> 2, mt = (w >> 1) & 1;
#pragma unroll
        for (int q = 0; q < 2; ++q) { const int nt = (w & 1) * 2 + q; f32x4_t acc = {0.f, 0.f, 0.f, 0.f};
#pragma unroll
            for (int ks = 0; ks < 2; ++ks) acc = MFMA16(ldfrag_tr(KDT + dir * 64 * 40, 40, ks * 32, mt * 16, lane), ldfrag_tr(VT, 72, ks * 32, nt * 16, lane), acc);
#pragma unroll
            for (int j = 0; j < 4; ++j) GS[(slot + dir) * 2048 + (mt * 16 + 4 * (lane >> 4) + j) * 64 + nt * 16 + (lane & 15)] = (u16)f2bf(acc[j]); } }
    __syncthreads();
}
DI void sgu_item(const Ctx& p, int l, int item, LAS float* F) {
    const int tid = otid(), lane = tid & 63, w = tid >> 6; const int ch = item >> 2, g = item & 3; const size_t rb = (size_t)ch * 128;
    const u16* P2 = (const u16*)(p.ws + WS_P2); u16* P1 = (u16*)p.out;
    LAS float* OUTF = F; LAS u16* WB = (LAS u16*)(F + 128 * 65); LAS u16* VNT = WB + 128 * 136;
    v4u pu[2], pz[2];
#pragma unroll
    for (int r = 0; r < 2; ++r) { const int task = tid + r * 512, t = task >> 3, c8 = (task & 7) * 8; pu[r] = *(const v4u*)(P2 + (rb + t) * P2P + P2_DU + g * 64 + c8); pz[r] = *(const v4u*)(P1 + (rb + t) * P1P + 1024 + g * 64 + c8); }
    { const int row = tid >> 2, qt = tid & 3; const u16* dv = P2 + (rb + row) * P2P + P2_DV; float ss = 0.f; float f[8];
#pragma unroll
        for (int c = 0; c < 8; ++c) { unpack8(*(const v4u*)(dv + qt * 64 + c * 8), f);
#pragma unroll
            for (int q = 0; q < 8; ++q) ss += f[q] * f[q]; }
        ss += __shfl_xor(ss, 1); ss += __shfl_xor(ss, 2);
        const float rstd = 1.f / sqrtf(ss * (1.f / 256.f) + EPSN); const float* ng = p.tab[17] + l * 256 + g * 64 + qt * 16;
#pragma unroll
        for (int c = 0; c < 2; ++c) { unpack8(*(const v4u*)(dv + g * 64 + qt * 16 + c * 8), f);
#pragma unroll
            for (int q = 0; q < 8; ++q) f[q] = f[q] * rstd * ng[c * 8 + q];
            *(LAS v4u*)(VNT + row * 72 + qt * 16 + c * 8) = pack8(f); } }
    { const float* wsrc = p.tab[18] + (size_t)(l * 4 + g) * 16384;
#pragma unroll
        for (int r = 0; r < 8; ++r) { const int idx = tid + r * 512, t = idx >> 5, s4 = (idx & 31) * 4; const v4f v = *(const v4f*)(wsrc + idx * 4);
            v2u o; o.x = pk2(v.x, v.y); o.y = pk2(v.z, v.w); *(LAS v2u*)(WB + t * 136 + s4) = o; } }
    __syncthreads();
    {
#pragma unroll
        for (int nt = 0; nt < 4; ++nt) { f32x4_t acc = {0.f, 0.f, 0.f, 0.f};
#pragma unroll
            for (int ks = 0; ks < 4; ++ks) acc = MFMA16(ldfrag(WB, 136, w * 16, ks * 32, lane), ldfrag_tr(VNT, 72, ks * 32, nt * 16, lane), acc);
#pragma unroll
            for (int j = 0; j < 4; ++j) OUTF[(w * 16 + 4 * (lane >> 4) + j) * 65 + nt * 16 + (lane & 15)] = acc[j]; } }
    __syncthreads();
#pragma unroll
    for (int r = 0; r < 2; ++r) { const int task = tid + r * 512, t = task >> 3, c8 = (task & 7) * 8; float acc[8];
#pragma unroll
        for (int e = 0; e < 8; ++e) acc[e] = OUTF[t * 65 + c8 + e];
        const float bias = p.tab[19][(l * 4 + g) * 128 + t];
        float uu[8], zz[8]; unpack8(pu[r], uu);
        u16* mz = P1 + (rb + t) * P1P + 1024 + g * 64 + c8; unpack8(pz[r], zz);
#pragma unroll
        for (int e = 0; e < 8; ++e) acc[e] = (acc[e] + bias) * uu[e] * silu_f(zz[e]);
        *(v4u*)mz = pack8(acc); }
    __syncthreads();
}
template <int N1> DI void fnet1_body(const Ctx& p, int row0, int N, int n2, int cb, LAS float* F) {
    constexpr int PN = N1 + 8, MT = N1 / 16, NTW = MT;
    const int tid = otid(), lane = tid & 63, w = tid >> 6;
    const u16* P2 = (const u16*)(p.ws + WS_P2); u16* TP = (u16*)(p.ws + WS_HB + HB_TP);
    const u16* Cg = (const u16*)(p.ws + WS_DFT) + (N1 == 64 ? 0 : 8192); const u16* Sg = Cg + N1 * N1;
    LAS float* tw = F; LAS u16* XT = (LAS u16*)(F + 256); LAS u16* FC = XT + N1 * 136; LAS u16* FS = FC + N1 * PN; LAS u16* OUT = FC;
#pragma unroll
    for (int r = 0; r < N1 / 32; ++r) { const int idx = tid + r * 512, n1 = idx >> 4, c = idx & 15; const v4u raw = *(const v4u*)(P2 + (size_t)(row0 + n1 * 64 + n2) * P2P + P2_BU + cb * 128 + c * 8);
        *(LAS v4u*)(XT + n1 * 136 + c * 8) = raw; }
#pragma unroll
    for (int r = 0; r < N1 * N1 / 8 / 512; ++r) { const int idx = tid + r * 512, k1 = idx / (N1 / 8), c = idx % (N1 / 8);
        *(LAS v4u*)(FC + k1 * PN + c * 8) = *(const v4u*)(Cg + k1 * N1 + c * 8); *(LAS v4u*)(FS + k1 * PN + c * 8) = *(const v4u*)(Sg + k1 * N1 + c * 8); }
    if (tid < N1) { const float ph = 2.f * (float)((n2 * tid) & (N - 1)) / (float)N; tw[2 * tid] = cospif(ph); tw[2 * tid + 1] = sinpif(ph); }
    __syncthreads();
    f32x4_t ac[NTW], as[NTW];
#pragma unroll
    for (int q = 0; q < NTW; ++q) { const int id = w + 8 * q, mt = id % MT, nt = id / MT; ac[q] = (f32x4_t){0.f, 0.f, 0.f, 0.f}; as[q] = ac[q];
#pragma unroll
        for (int ks = 0; ks < N1 / 32; ++ks) { const bf16x8_t b = ldfrag_tr(XT, 136, ks * 32, nt * 16, lane);
            ac[q] = MFMA16(ldfrag(FC, PN, mt * 16, ks * 32, lane), b, ac[q]); as[q] = MFMA16(ldfrag(FS, PN, mt * 16, ks * 32, lane), b, as[q]); } }
    __syncthreads();
    const float scale = 1.f / sqrtf((float)N1);
#pragma unroll
    for (int q = 0; q < NTW; ++q) { const int id = w + 8 * q, mt = id % MT, nt = id / MT;
#pragma unroll
        for (int j = 0; j < 4; ++j) { const int k1 = mt * 16 + 4 * (lane >> 4) + j, col = nt * 16 + (lane & 15); const float cw = tw[2 * k1], sw = tw[2 * k1 + 1];
            const float tr = ac[q][j], ti = -as[q][j];
            OUT[k1 * 256 + col] = (u16)f2bf((tr * cw + ti * sw) * scale); OUT[k1 * 256 + 128 + col] = (u16)f2bf((ti * cw - tr * sw) * scale); } }
    __syncthreads();
#pragma unroll
    for (int r = 0; r < N1 / 16; ++r) { const int idx = tid + r * 512, k1 = idx >> 5, c = idx & 31;
        const v4u v = *(const LAS v4u*)(OUT + k1 * 256 + c * 8);
        *(v4u*)(TP + (size_t)(row0 + k1 * 64 + n2) * 512 + (c >> 4) * 256 + cb * 128 + (c & 15) * 8) = v; }
    __syncthreads();
}
DI void fnet1_item(const Ctx& p, int item, LAS float* F) {
    const int s = item >> 7, r = item & 127, n2 = r >> 1, cb = r & 1; int row0, N; seq_info(s, row0, N);
    if (N == 4096) fnet1_body<64>(p, row0, N, n2, cb, F); else fnet1_body<128>(p, row0, N, n2, cb, F);
}
DI void fnet2_item(const Ctx& p, int item, LAS float* F) {
    const int tid = otid(), lane = tid & 63, w = tid >> 6; int s, k1; if (item < 256) { s = item >> 6; k1 = item & 63; } else { s = 4 + ((item - 256) >> 7); k1 = (item - 256) & 127; }
    int row0, N; seq_info(s, row0, N); const int N1 = N >> 6;
    u16* P2 = (u16*)(p.ws + WS_P2); const u16* TP = (const u16*)(p.ws + WS_HB + HB_TP); const u16* Cg = (const u16*)(p.ws + WS_DFT); const u16* Sg = Cg + 4096;
    LAS u16* BT = (LAS u16*)F; LAS u16* A1 = BT + 128 * 264; LAS u16* A2 = A1 + 64 * 136; LAS u16* OUT = BT;
#pragma unroll
    for (int r = 0; r < 8; ++r) { const int idx = tid + r * 512, n2 = idx >> 6, c = idx & 63; const v4u raw = *(const v4u*)(TP + (size_t)(row0 + k1 * 64 + n2) * 512 + c * 8);
        *(LAS v4u*)(BT + ((c >> 5) * 64 + n2) * 264 + (c & 31) * 8) = raw; }
    { const int k2 = tid >> 3, c8 = (tid & 7) * 8; const v4u c = *(const v4u*)(Cg + k2 * 64 + c8), sv = *(const v4u*)(Sg + k2 * 64 + c8); const v4u ns = sv ^ (v4u){0x80008000u, 0x80008000u, 0x80008000u, 0x80008000u};
        *(LAS v4u*)(A1 + k2 * 136 + c8) = c; *(LAS v4u*)(A1 + k2 * 136 + 64 + c8) = sv; *(LAS v4u*)(A2 + k2 * 136 + c8) = ns; *(LAS v4u*)(A2 + k2 * 136 + 64 + c8) = c; }
    __syncthreads();
    f32x4_t acc[16]; const LAS u16* Aw = (w < 4) ? A1 : A2; const int mt = w & 3;
#pragma unroll
    for (int nt = 0; nt < 16; ++nt) { acc[nt] = (f32x4_t){0.f, 0.f, 0.f, 0.f};
#pragma unroll
        for (int ks = 0; ks < 4; ++ks) acc[nt] = MFMA16(ldfrag(Aw, 136, mt * 16, ks * 32, lane), ldfrag_tr(BT, 264, ks * 32, nt * 16, lane), acc[nt]); }
    __syncthreads();
#pragma unroll
    for (int nt = 0; nt < 16; ++nt)
#pragma unroll
        for (int j = 0; j < 4; ++j) OUT[(mt * 16 + 4 * (lane >> 4) + j) * 512 + (w >> 2) * 256 + nt * 16 + (lane & 15)] = (u16)f2bf(acc[nt][j] * 0.125f);
    __syncthreads();
#pragma unroll
    for (int r = 0; r < 8; ++r) { const int idx = tid + r * 512, k2 = idx >> 6, c = idx & 63; const v4u v = *(const LAS v4u*)(OUT + k2 * 512 + c * 8);
        *(v4u*)(P2 + (size_t)(row0 + k1 + N1 * k2) * P2P + P2_U + c * 8) = v; }
    __syncthreads();
}
DI void gla_scan_item(const Ctx& p, int item) {
    const int tid = otid(); const int chain = item >> 2, e = (item & 3) * 512 + tid; const int s = chain >> 3, h = (chain >> 1) & 3, dir = chain & 1;
    int row0, N; seq_info(s, row0, N); const int NC = N >> 6, gc0 = row0 >> 6, d = e >> 6;
    u16* GS = (u16*)(p.ws + WS_HB + HB_GS); const float* DEC = (const float*)(p.ws + WS_DEC);
    float S = 0.f;
    for (int st = 0; st < NC; st += 32) { u16 tmp[32]; float dc[32];
#pragma unroll
        for (int u = 0; u < 32; ++u) { const int c = dir ? NC - 1 - (st + u) : st + u; const size_t slot = (size_t)((gc0 + c) * 4 + h) * 2 + dir; tmp[u] = GS[slot * 2048 + e]; dc[u] = DEC[slot * 32 + d]; }
#pragma unroll
        for (int u = 0; u < 32; ++u) { const int c = dir ? NC - 1 - (st + u) : st + u; const size_t slot = (size_t)((gc0 + c) * 4 + h) * 2 + dir; GS[slot * 2048 + e] = (u16)f2bf(S); S = dc[u] * S + bf2f(tmp[u]); } }
}
struct OLoad { v4u qk, g, v, z; v2u sf, sb; };
DI OLoad gla_out_load(const Ctx& p, int item) {
    const int tid = otid(); const int gc = item >> 2, h = item & 3; const size_t rb = (size_t)gc * 64; const u16* P2 = (const u16*)(p.ws + WS_P2); const u16* P1 = (const u16*)p.out; OLoad r;
    { const int t2 = tid & 255, i = t2 >> 2, c = t2 & 3; const u16* q = P2 + (rb + i) * P2P + h * 32 + c * 8; const int dirb = tid >> 8;
        r.qk = *(const v4u*)(q + (dirb ? P2_AK : P2_AQ)); r.g = *(const v4u*)(q + (dirb ? P2_GB : P2_GF)); }
    { const int i = tid >> 3, c = tid & 7; r.v = *(const v4u*)(P2 + (rb + i) * P2P + P2_AV + h * 64 + c * 8); r.z = *(const v4u*)(P1 + (rb + i) * P1P + h * 64 + c * 8); }
    { const u16* GS = (const u16*)(p.ws + WS_HB + HB_GS); const size_t slot = (size_t)(gc * 4 + h) * 2; const int e4 = tid * 4; r.sf = *(const v2u*)(GS + slot * 2048 + e4); r.sb = *(const v2u*)(GS + (slot + 1) * 2048 + e4); }
    return r;
}
DI void gla_out_item(const Ctx& p, int l, int item, LAS float* F, const OLoad ld) {
    const int tid = otid(), lane = tid & 63, w = tid >> 6; const int gc = item >> 2, h = item & 3; const size_t rb = (size_t)gc * 64;
    const u16* P2 = (const u16*)(p.ws + WS_P2); u16* P1 = (u16*)p.out;
    LAS float* Gf = F; LAS float* Gb = Gf + 2112; LAS float* Qx = Gb + 2112; LAS float* Kx = Qx + 2112; LAS float* O = Kx + 2112;
    LAS u16* QF = (LAS u16*)(O + 64 * 65); LAS u16* KF = QF + 64 * 40; LAS u16* QB = KF + 64 * 40; LAS u16* KB = QB + 64 * 40;
    LAS u16* VT = KB + 64 * 40; LAS u16* SC = VT + 64 * 72; LAS u16* SFT = SC + 64 * 72; LAS u16* SBT = SFT + 32 * 72;
    const u16* GS = (const u16*)(p.ws + WS_HB + HB_GS); const size_t slot = (size_t)(gc * 4 + h) * 2;
    { const int t2 = tid & 255, i = t2 >> 2, c = t2 & 3; const u16* r = P2 + (rb + i) * P2P + h * 32 + c * 8; float f[8];
        const int dirb = tid >> 8; LAS float* d0 = dirb ? Kx : Qx; LAS float* d1 = dirb ? Gb : Gf; const float* bias = p.tab[dirb ? 12 : 10] + l * 128 + h * 32 + c * 8;
        unpack8(ld.qk, f);
#pragma unroll
        for (int q = 0; q < 8; ++q) d0[i * 33 + c * 8 + q] = f[q];
        unpack8(ld.g, f);
#pragma unroll
        for (int q = 0; q < 8; ++q) d1[i * 33 + c * 8 + q] = logsig(f[q] + bias[q]) * (1.f / 16.f); }
    { const int i = tid >> 3, c = tid & 7; *(LAS v4u*)(VT + i * 72 + c * 8) = ld.v; }
    { const int e4 = tid * 4, d = e4 >> 6, v = e4 & 63; *(LAS v2u*)(SFT + d * 72 + v) = ld.sf; *(LAS v2u*)(SBT + d * 72 + v) = ld.sb; }
    __syncthreads();
    if (w == 0) gla_scan_cols(Gf, Gb, lane);
    __syncthreads();
#pragma unroll
    for (int r = 0; r < 4; ++r) { const int e = tid + r * 512, d = e & 31, i = e >> 5, a = i * 33 + d; const float q = Qx[a] * 0.17677669529663687f, k = Kx[a], bf = Gf[a], bb = Gb[a];
        QF[i * 40 + d] = (u16)f2bf(q * __expf(bf)); KF[i * 40 + d] = (u16)f2bf(k * __expf(-bf)); QB[i * 40 + d] = (u16)f2bf(q * __expf(bb)); KB[i * 40 + d] = (u16)f2bf(k * __expf(-bb)); }
    __syncthreads();
#pragma unroll
    for (int q = 0; q < 2; ++q) { const int id = 2 * w + q, ti = id >> 2, si = id & 3; const f32x4_t z4 = {0.f, 0.f, 0.f, 0.f}; f32x4_t acc;
        if (si < ti) acc = MFMA16(ldfrag(QF, 40, ti * 16, 0, lane), ldfrag(KF, 40, si * 16, 0, lane), z4);
        else if (si > ti) acc = MFMA16(ldfrag(QB, 40, ti * 16, 0, lane), ldfrag(KB, 40, si * 16, 0, lane), z4);
        else { const f32x4_t af = MFMA16(ldfrag(QF, 40, ti * 16, 0, lane), ldfrag(KF, 40, si * 16, 0, lane), z4), ab = MFMA16(ldfrag(QB, 40, ti * 16, 0, lane), ldfrag(KB, 40, si * 16, 0, lane), z4);
#pragma unroll
            for (int j = 0; j < 4; ++j) acc[j] = ((lane & 15) <= 4 * (lane >> 4) + j) ? af[j] : ab[j]; }
#pragma unroll
        for (int j = 0; j < 4; ++j) SC[(ti * 16 + 4 * (lane >> 4) + j) * 72 + si * 16 + (lane & 15)] = (u16)f2bf(acc[j]); }
    __syncthreads();
#pragma unroll
    for (int q = 0; q < 2; ++q) { const int id = 2 * w + q, ti = id >> 2, vi = id & 3; f32x4_t acc = {0.f, 0.f, 0.f, 0.f};
        acc = MFMA16(ldfrag(SC, 72, ti * 16, 0, lane), ldfrag_tr(VT, 72, 0, vi * 16, lane), acc);
        acc = MFMA16(ldfrag(SC, 72, ti * 16, 32, lane), ldfrag_tr(VT, 72, 32, vi * 16, lane), acc);
        acc = MFMA16(ldfrag(QF, 40, ti * 16, 0, lane), ldfrag_tr(SFT, 72, 0, vi * 16, lane), acc);
        acc = MFMA16(ldfrag(QB, 40, ti * 16, 0, lane), ldfrag_tr(SBT, 72, 0, vi * 16, lane), acc);
#pragma unroll
        for (int j = 0; j < 4; ++j) O[(ti * 16 + 4 * (lane >> 4) + j) * 65 + vi * 16 + (lane & 15)] = acc[j]; }
    __syncthreads();
    { const int t = tid >> 3, v8 = (tid & 7) * 8; float acc[8]; float ss = 0.f;
#pragma unroll
        for (int e = 0; e < 8; ++e) { acc[e] = O[t * 65 + v8 + e]; ss += acc[e] * acc[e]; }
        ss += __shfl_xor(ss, 1); ss += __shfl_xor(ss, 2); ss += __shfl_xor(ss, 4);
        const float rstd = 1.f / sqrtf(ss * (1.f / 64.f) + EPSN);
        u16* mz = P1 + (rb + t) * P1P + h * 64 + v8; float zz[8]; unpack8(ld.z, zz);
#pragma unroll
        for (int e = 0; e < 8; ++e) acc[e] = acc[e] * rstd * p.tab[13][l * 64 + v8 + e] * silu_f(zz[e]);
        *(v4u*)mz = pack8(acc); }
    __syncthreads();
}
#define XB_TMO      128
#define XB_XCNT(j)  (256  + 64 * (j))
#define XB_XSUB(j)  (1280 + 64 * (j))
#define XB_XGEN(j)  (2304 + 64 * (j))
#define XB_TOP      3328
#define XB_TOPGEN   3392
#define XCD_BAR_WORDS 3456
#define XB_SPIN_CAP (1u << 18)

__device__ __forceinline__ unsigned xb_ld(unsigned* p)              { return __hip_atomic_load(p, __ATOMIC_RELAXED, __HIP_MEMORY_SCOPE_AGENT); }
__device__ __forceinline__ unsigned xb_add(unsigned* p, unsigned v) { return __hip_atomic_fetch_add(p, v, __ATOMIC_RELAXED, __HIP_MEMORY_SCOPE_AGENT); }
__device__ __forceinline__ unsigned xb_xcc_id() { return (unsigned)__builtin_amdgcn_s_getreg((3 << 11) | 20) & 0xFu; }
#define XB_SPIN(cond, bar) do { unsigned _sp = 0; while (cond) { __builtin_amdgcn_s_sleep(1); \
    if ((++_sp & 255u) == 0u) { if (xb_ld(&(bar)[XB_TMO])) break; if (_sp > XB_SPIN_CAP) { atomicAdd(&(bar)[XB_TMO], 1u); break; } } } } while (0)

struct XcdBarrier {
    unsigned* bar; unsigned x;
    volatile LAS unsigned* st;
};

__device__ __forceinline__ XcdBarrier xcd_barrier_post(unsigned* bar, volatile LAS unsigned* st) {
    XcdBarrier b; b.bar = bar; b.x = xb_xcc_id(); b.st = st;
    if (threadIdx.x == 0) (void)xb_add(&bar[XB_XCNT(b.x)], 1u);
    return b;
}
__device__ __forceinline__ void xcd_barrier_complete(unsigned* bar, unsigned x, unsigned& nloc, unsigned& nx) {
    const unsigned G = gridDim.x * gridDim.y * gridDim.z;
    unsigned sum, cnt, mine, sp = 0u;
    for (;;) {
        sum = 0u; cnt = 0u; mine = 0u;
#pragma unroll
        for (unsigned j = 0; j < 16; ++j) { const unsigned c = xb_ld(&bar[XB_XCNT(j)]); sum += c; cnt += (c > 0u) ? 1u : 0u; mine = (j == x) ? c : mine; }
        if (sum == G) break;
        __builtin_amdgcn_s_sleep(1);
        if ((++sp & 255u) == 0u) { if (xb_ld(&bar[XB_TMO])) break; if (sp > XB_SPIN_CAP) { atomicAdd(&bar[XB_TMO], 1u); break; } }
    }
    nloc = mine > 0u ? mine : 1u; nx = cnt > 0u ? cnt : 1u;
}

__device__ __forceinline__ void xcd_barrier(const XcdBarrier& b) {
    asm volatile("s_waitcnt vmcnt(0)" ::: "memory");
    __syncthreads();
    if (threadIdx.x == 0) {
        unsigned* bar = b.bar;
        __builtin_amdgcn_s_waitcnt(0);
        unsigned nloc = b.st[0], nx = b.st[1];
        if (nloc == 0u) { xcd_barrier_complete(bar, b.x, nloc, nx); b.st[0] = nloc; b.st[1] = nx; }
        const unsigned old = xb_add(&bar[XB_XSUB(b.x)], 1u);
        const unsigned gen = old / nloc;
        if (old + 1u == (gen + 1u) * nloc) {
            __builtin_amdgcn_fence(__ATOMIC_RELEASE, "agent");
            asm volatile("s_waitcnt vmcnt(0)" ::: "memory");
            const unsigned og = xb_add(&bar[XB_TOP], 1u);
            const unsigned tg = og / nx;
            if (og + 1u == (tg + 1u) * nx) xb_add(&bar[XB_TOPGEN], 1u);
            else XB_SPIN(xb_ld(&bar[XB_TOPGEN]) == tg, bar);
            __builtin_amdgcn_fence(__ATOMIC_ACQUIRE, "agent");
            xb_add(&bar[XB_XGEN(b.x)], 1u);
            asm volatile("s_waitcnt vmcnt(0)" ::: "memory");
        } else {
            XB_SPIN(xb_ld(&bar[XB_XGEN(b.x)]) == gen, bar);
            __builtin_amdgcn_fence(__ATOMIC_ACQUIRE, "agent");
            asm volatile("s_waitcnt vmcnt(0)" ::: "memory");
        }
    }
    __syncthreads();
}


#ifndef GM
#define GM 7
#endif
#ifndef PH
#define PH 1023
#endif
__global__ void __launch_bounds__(512, 2) fwd_kernel(Params kp) {
    extern __shared__ __attribute__((aligned(16))) unsigned char lds[];
    cg::grid_group grid = cg::this_grid();
    LAS unsigned char* L = (LAS unsigned char*)lds; LAS float* F = (LAS float*)lds;
    const int G = gridDim.x, bid = blockIdx.x;
    Ctx p; p.out = kp.out; p.ws = kp.ws; p.tab = (LAS cfp*)(L + 131072);
    if (otid() == 0) { p.tab[0] = kp.xp; p.tab[1] = kp.xs; p.tab[2] = kp.cp; p.tab[3] = kp.cs; p.tab[4] = kp.ada_w; p.tab[5] = kp.ada_b; p.tab[6] = kp.pre_g; p.tab[7] = kp.post_g; p.tab[8] = kp.w_in;
        p.tab[9] = kp.wg2f; p.tab[10] = kp.bgf; p.tab[11] = kp.wg2b; p.tab[12] = kp.bgb; p.tab[13] = kp.onorm_g; p.tab[14] = kp.fnet_w; p.tab[15] = kp.qn_g; p.tab[16] = kp.kn_g; p.tab[17] = kp.sgu_ng;
        p.tab[18] = kp.sgu_w; p.tab[19] = kp.sgu_b; p.tab[20] = kp.w_out; }
    volatile LAS unsigned* bst = (volatile LAS unsigned*)(L + 131072 + 256);
    if (otid() < 4) bst[otid()] = 0u;
    __syncthreads();
    const XcdBarrier xbar = xcd_barrier_post((unsigned*)(p.ws + WS_BAR), bst);
    u16* P1 = (u16*)p.out; u16* P2 = (u16*)(p.ws + WS_P2); u16* HB = (u16*)(p.ws + WS_HB); u16* U0 = (u16*)(p.ws + WS_U0);


#if PH & 1
    phase0(p, L);
#endif
    grid.sync();
    for (int step = 0; step < 12; ++step) {
        const int l = step / 6, ph = step % 6;
        bool do_gemm = false; pg8::Gemm g{nullptr, nullptr, T_TOK, 0, 0, 0, 0}; pg8::EpiX E{0, nullptr, 0, nullptr, 0, 0};
        if (ph == 0) {
#if PH & 2
            phaseA(p, l);
#endif
        } else if (ph == 1) {
            g.A = HB; g.Bt = (const u16*)(p.ws + WS_WIN) + (size_t)l * 3584 * 1024; g.N = 3584; g.K = 1024; g.lda = 1024; g.ldb = 1024;
            E.mode = 0; E.O1 = P1; E.ld1 = P1P; E.O2 = P2; E.ld2 = P2P; do_gemm = true;
        } else if (ph == 2) {
#if PH & 4
            qk_prep(p, l);
#endif
#if PH & 8
            { GLoad nx = gla_local_load(p, bid < 2048 ? bid : 0); for (int it = bid; it < 2048; it += G) { const GLoad cur = nx; if (it + G < 2048) nx = gla_local_load(p, it + G); gla_local_item(p, l, it, F, cur); } }
#endif
#if PH & 16
            for (int it = bid; it < 1024; it += G) sgu_item(p, l, it, F);
#endif
#if PH & 32
            for (int it = bid; it < 768; it += G) fnet1_item(p, it, F);
#endif
        } else if (ph == 3) {
#if PH & 64
            for (int it = bid; it < 192; it += G) gla_scan_item(p, it);
#endif
#if PH & 128
            for (int it = bid; it < 512; it += G) fnet2_item(p, it, F);
#endif
            __syncthreads();
#ifndef SKIP_ATTN
            for (int u = ((G & 7) == 0 ? (bid & 7) * (G >> 3) + (bid >> 3) : bid); u < 1024; u += G) {
                int s, h, qb;
                if (u < 512) { s = u >> 7; const int r = u & 127; h = r >> 4; qb = r & 15; } else { const int u2 = u - 512; s = 4 + (u2 >> 8); const int r = u2 & 255; h = r >> 5; qb = r & 31; }
                int row0, N; seq_info(s, row0, N);
                const attn_body::bf16* Pb = (const attn_body::bf16*)P1;
                const attn_body::bf16* KCb = (const attn_body::bf16*)(p.ws + WS_HB + HB_KC) + ((size_t)row0 * 2 + (size_t)(h >> 2) * N) * 64;
                const attn_body::bf16* VCb = (const attn_body::bf16*)(p.ws + WS_HB + HB_VC) + ((size_t)row0 * 2 + (size_t)(h >> 2) * N) * 64;
                attn_body::attn_unit<8>(Pb + (size_t)(row0 + qb * 256) * P1P + P1_Q + h * 64, KCb, VCb,
                                        (attn_body::bf16*)P1 + (size_t)(row0 + qb * 256) * P1P + 512 + h * 64, N >> 6, (char*)lds);
            }
#endif
        } else if (ph == 4) {
#if PH & 256
            { OLoad nx = gla_out_load(p, bid < 2048 ? bid : 0); for (int it = bid; it < 2048; it += G) { const OLoad cur = nx; if (it + G < 2048) nx = gla_out_load(p, it + G); gla_out_item(p, l, it, F, cur); } }
#endif
            g.A = P2 + P2_U; g.Bt = (const u16*)(p.ws + WS_WF) + (size_t)l * 131072; g.N = 256; g.K = 512; g.lda = P2P; g.ldb = 512;
            E.mode = 2; E.O1 = P1; E.ld1 = P1P; E.col_off = 256; do_gemm = true;
        } else {
            g.A = P1; g.Bt = (const u16*)(p.ws + WS_WOUT) + (size_t)l * 1024 * 1280; g.N = 1024; g.K = 1280; g.lda = P1P; g.ldb = 1280;
            E.mode = 1; E.O1 = (l == 0) ? U0 : HB; E.ld1 = 1024; do_gemm = true;
        }
#if GM
        if (do_gemm) { pg8::StaticOrder S; S.init(T_TOK, g.N, G, bid); pg8::gemm_phase<pg8::EpiX, pg8::StaticOrder, PG8_ALIGN, PG8_SP2>(L, g, S, E); }
#endif
        xcd_barrier(xbar);
    }
#if PH & 2
    phaseA(p, 2);
#endif
}

extern "C" void kernel_launch(void* const* d_in, const int* in_sizes, int n_in, void* d_out, int out_size, void* d_ws, size_t ws_size, hipStream_t stream) {
    static int grid = 0;
    if (grid == 0) {
        if (n_in != 21 || out_size != T_TOK * 1024 || ws_size < WS_END) { fprintf(stderr, "kernel_launch: unexpected sizes n_in %d out %d ws %zu\n", n_in, out_size, ws_size); grid = -1; return; }
        int dev = 0, cus = 0, per_cu = 0;
        (void)hipGetDevice(&dev); (void)hipDeviceGetAttribute(&cus, hipDeviceAttributeMultiprocessorCount, dev);
        if (hipFuncSetAttribute((const void*)fwd_kernel, hipFuncAttributeMaxDynamicSharedMemorySize, LDS_BYTES) != hipSuccess) { fprintf(stderr, "kernel_launch: hipFuncSetAttribute failed\n"); grid = -1; return; }
        if (hipOccupancyMaxActiveBlocksPerMultiprocessor(&per_cu, (const void*)fwd_kernel, 512, LDS_BYTES) != hipSuccess || per_cu < 1) { fprintf(stderr, "kernel_launch: occupancy query gave %d\n", per_cu); per_cu = 1; }
        (void)hipGetLastError();
        grid = cus * 1;
        fprintf(stderr, "kernel_launch: grid %d (per_cu %d) ws %zu\n", grid, per_cu, ws_size);
    }
    if (grid < 0) return;
    Params p{};
    const float** pp = (const float**)&p;
    for (int i = 0; i < 21; ++i) pp[i] = (const float*)d_in[i];
    p.out = (float*)d_out; p.ws = (unsigned char*)d_ws;
    if (hipMemsetAsync((char*)d_ws + WS_MOD, 0, 2 * 6 * 3072 * sizeof(float), stream) != hipSuccess) { fprintf(stderr, "kernel_launch: memset failed\n"); return; }
    if (hipMemsetAsync((char*)d_ws + WS_BAR, 0, BAR_BYTES, stream) != hipSuccess) { fprintf(stderr, "kernel_launch: memset failed\n"); return; }
    void* args[] = {&p};
    hipError_t e = hipLaunchCooperativeKernel((const void*)fwd_kernel, dim3(grid), dim3(512), args, LDS_BYTES, stream);
    if (e != hipSuccess) fprintf(stderr, "cooperative launch failed: %s (grid %d)\n", hipGetErrorString(e), grid);
}
```

```cpp
#include <hip/hip_runtime.h>
#include <hip/hip_cooperative_groups.h>
#include <cstdio>
#include <cstdint>
namespace cg = cooperative_groups;
__device__ __forceinline__ int otid() { int t = threadIdx.x; asm volatile("" : "+v"(t)); return t; }
namespace pg8 {
#define PG8_LAS __attribute__((address_space(3)))
typedef unsigned short bf16_t;
typedef short bf16x8 __attribute__((ext_vector_type(8)));
typedef float f32x4 __attribute__((ext_vector_type(4)));
typedef unsigned u32x4 __attribute__((ext_vector_type(4)));
constexpr int BM = 256, BK = 64, HALF = 128, HTB = HALF * BK * 2  , STAGE_BYTES = 8 * HTB, NXCD = 8, WGM = 8;

__host__ __device__ __forceinline__ int lds_byte(int r, int c) { const int st = (r >> 4) * 2 + (c >> 5), rr = r & 15, cc = c & 31, ob = rr * 64 + cc * 2; return st * 1024 + (ob ^ (((ob >> 9) & 1) << 5)); }
__host__ __device__ __forceinline__ void stage_rc(int b, int& R, int& C) { const int st = b / 1024, sb = b % 1024, swz = sb ^ (((sb >> 9) & 1) << 5); R = (st >> 1) * 16 + swz / 64; C = (st & 1) * 32 + (swz % 64) / 2; }
__host__ __device__ __forceinline__ int perm32(int rho) { const int n = rho >> 4, i = rho & 15; return 8 * (i >> 2) + 4 * n + (i & 3); }

struct Unit { int pm, pn; };
struct Gemm { const bf16_t* A; const bf16_t* Bt; int M, N, K, lda, ldb; };

struct StaticOrder {
    int nM, nN, nwg, G, c;
    __host__ __device__ void init(int M, int N, int G_, int c_) { nM = M / BM; nN = N / BM; nwg = nM * nN; G = G_; c = c_; }
    __host__ __device__ bool next(int i, Unit& u) const {
        const long L = (long)i * G + c; if (L >= nwg) return false;
        int wgid = (int)L; { const int q = nwg / NXCD, r = nwg % NXCD, xcd = wgid % NXCD, off = wgid / NXCD; wgid = (xcd < r ? xcd * (q + 1) : r * (q + 1) + (xcd - r) * q) + off; }
        const int nig = WGM * nN, gid = wgid / nig, fm = gid * WGM, gsz = (nM - fm) < WGM ? (nM - fm) : WGM;
        u.pm = fm + ((wgid % nig) % gsz); u.pn = (wgid % nig) / gsz; return true;
    }
    __device__ __forceinline__ void a_ready(const Unit&) const {}
    __device__ __forceinline__ void done(const Unit&) const {}
};

__device__ __forceinline__ unsigned cvt_pk_bf16(float lo, float hi) { unsigned r; asm volatile("v_cvt_pk_bf16_f32 %0, %1, %2" : "=v"(r) : "v"(lo), "v"(hi)); return r; }
__device__ __forceinline__ float silu_f(float z) { return z / (1.f + __expf(-z)); }
struct EpiX {
    static constexpr bool PERM = true, AFTER_DRAIN = false;
    int mode; bf16_t* O1; int ld1; bf16_t* O2; int ld2; int col_off;
    __device__ __forceinline__ void operator()(const f32x4 (&acc)[2][2][4][2], const Unit& u, int wr, int wc, int fr, int fq) const {
        const int row0 = u.pm * BM + wr * 64 + fr;
        bf16_t* base; int ld, colt;
        if (mode == 0) { if (u.pn < 8) { base = O1; ld = ld1; colt = u.pn * BM; } else { base = O2; ld = ld2; colt = (u.pn - 8) * BM; } }
        else { base = O1; ld = ld1; colt = col_off + u.pn * BM; }
        const int col0 = colt + wc * 32 + 8 * fq;
#pragma unroll
        for (int ai = 0; ai < 2; ++ai)
#pragma unroll
            for (int m = 0; m < 4; ++m) { bf16_t* rowp = base + (size_t)(row0 + ai * HALF + m * 16) * ld + col0;
#pragma unroll
                for (int bj = 0; bj < 2; ++bj) { f32x4 v0 = acc[ai][bj][m][0], v1 = acc[ai][bj][m][1];
                    if (mode == 2) { const u32x4 z = *(const u32x4*)(rowp + bj * HALF);
                        v0[0] *= silu_f(__uint_as_float(z.x << 16)); v0[1] *= silu_f(__uint_as_float(z.x & 0xffff0000u));
                        v0[2] *= silu_f(__uint_as_float(z.y << 16)); v0[3] *= silu_f(__uint_as_float(z.y & 0xffff0000u));
                        v1[0] *= silu_f(__uint_as_float(z.z << 16)); v1[1] *= silu_f(__uint_as_float(z.z & 0xffff0000u));
                        v1[2] *= silu_f(__uint_as_float(z.w << 16)); v1[3] *= silu_f(__uint_as_float(z.w & 0xffff0000u)); }
                    u32x4 w; w.x = cvt_pk_bf16(v0[0], v0[1]); w.y = cvt_pk_bf16(v0[2], v0[3]); w.z = cvt_pk_bf16(v1[0], v1[1]); w.w = cvt_pk_bf16(v1[2], v1[3]);
                    *(u32x4*)(rowp + bj * HALF) = w; } }
    }
};
#ifndef PG8_SP2
#define PG8_SP2 true
#endif
#ifndef PG8_ALIGN
#define PG8_ALIGN true
#endif
template <class Epi, class Sched, bool ALIGN_EPI = false, bool SP2 = false>
__device__ __forceinline__ void gemm_phase(PG8_LAS unsigned char* lds, const Gemm g, const Sched& S, const Epi& E) {
    const int tid = otid(), wid = __builtin_amdgcn_readfirstlane(tid >> 6), lane = tid & 63, wr = wid >> 2, wc = wid & 3, fr = lane & 15, fq = lane >> 4;
    const int K = g.K, nt = K / BK;
    unsigned voffA[2], voffB[2];
#pragma unroll
    for (int i = 0; i < 2; ++i) { int R, C; stage_rc(tid * 16 + i * 8192, R, C); const int Rb = Epi::PERM ? ((R & ~31) + perm32(R & 31)) : R;
        voffA[i] = (unsigned)(R * g.lda + C) * 2u; voffB[i] = (unsigned)(Rb * g.ldb + C) * 2u; }
    const size_t kstep = (size_t)(BK * 2);
    const size_t hstepA = (size_t)HALF * g.lda * 2, hstepB = (size_t)HALF * g.ldb * 2;
    const size_t tstepA = 2 * hstepA, tstepB = 2 * hstepB;
    const unsigned ldsw = (unsigned)wid * 1024u;
    const int aoff = lds_byte(wr * 64 + fr, fq * 8), boff = lds_byte(wc * 32 + fr, fq * 8);
#define PG8_SA(b, h) (((b) * 2 + (h)) * HTB)
#define PG8_SB(b, h) ((4 + (b) * 2 + (h)) * HTB)
#define PG8_STAGE(bufoff, gbase, voff) do { _Pragma("unroll") for (int _i = 0; _i < 2; ++_i) \
        __builtin_amdgcn_global_load_lds((const unsigned*)((const char*)(gbase) + (voff)[_i]), (PG8_LAS unsigned*)(lds + (bufoff) + ldsw + _i * 8192), 16, 0, 0); } while (0)
#define PG8_LDA(dst, b, h) do { _Pragma("unroll") for (int m = 0; m < 4; ++m) _Pragma("unroll") for (int k = 0; k < 2; ++k) dst[m][k] = *(const PG8_LAS bf16x8*)(lds + PG8_SA(b, h) + aoff + m * 2048 + k * 1024); } while (0)
#define PG8_LDB(dst, b, h) do { _Pragma("unroll") for (int n = 0; n < 2; ++n) _Pragma("unroll") for (int k = 0; k < 2; ++k) dst[n][k] = *(const PG8_LAS bf16x8*)(lds + PG8_SB(b, h) + boff + n * 2048 + k * 1024); } while (0)
#define PG8_MMA(ai, bj, At, Bt) do { __builtin_amdgcn_s_setprio(1); _Pragma("unroll") for (int m = 0; m < 4; ++m) _Pragma("unroll") for (int n = 0; n < 2; ++n) _Pragma("unroll") for (int k = 0; k < 2; ++k) \
        acc[ai][bj][m][n] = __builtin_amdgcn_mfma_f32_16x16x32_bf16(Bt[n][k], At[m][k], acc[ai][bj][m][n], 0, 0, 0); __builtin_amdgcn_s_setprio(0); } while (0)
#define PG8_WAIT_V(n) asm volatile("s_waitcnt vmcnt(" #n ")" ::: "memory")
#define PG8_WAIT_L(n) asm volatile("s_waitcnt lgkmcnt(" #n ")" ::: "memory")
#define PG8_BAR __builtin_amdgcn_s_barrier()
#define PG8_SCHED __builtin_amdgcn_sched_barrier(0)
    Unit cur, nxt; int ui = 0;
    if (!S.next(0, cur)) return;
    f32x4 acc[2][2][4][2];
#pragma unroll
    for (int a = 0; a < 2; ++a)
#pragma unroll
        for (int b = 0; b < 2; ++b)
#pragma unroll
            for (int m = 0; m < 4; ++m)
#pragma unroll
                for (int n = 0; n < 2; ++n) acc[a][b][m][n] = (f32x4){0.f, 0.f, 0.f, 0.f};
    bf16x8 At[4][2], B0[2][2], B1[2][2];
    const char* cA = (const char*)g.A + (size_t)cur.pm * tstepA; const char* cB = (const char*)g.Bt + (size_t)cur.pn * tstepB;
    S.a_ready(cur);
    if constexpr (SP2) {
        PG8_STAGE(PG8_SB(0, 0), cB, voffB); PG8_STAGE(PG8_SB(0, 1), cB + hstepB, voffB); PG8_STAGE(PG8_SA(0, 0), cA, voffA); PG8_STAGE(PG8_SA(0, 1), cA + hstepA, voffA);
        if (wr == 1) PG8_BAR;
        PG8_WAIT_V(2); PG8_BAR;
        PG8_STAGE(PG8_SB(1, 0), cB + kstep, voffB); PG8_STAGE(PG8_SA(1, 0), cA + kstep, voffA); PG8_STAGE(PG8_SB(1, 1), cB + hstepB + kstep, voffB);
        PG8_WAIT_V(6); PG8_BAR;
    } else {
        PG8_STAGE(PG8_SB(0, 0), cB, voffB); PG8_STAGE(PG8_SA(0, 0), cA, voffA); PG8_STAGE(PG8_SB(0, 1), cB + hstepB, voffB); PG8_STAGE(PG8_SA(0, 1), cA + hstepA, voffA);
        if (wr == 1) PG8_BAR;
        PG8_WAIT_V(4); PG8_BAR;
        PG8_STAGE(PG8_SB(1, 0), cB + kstep, voffB); PG8_STAGE(PG8_SA(1, 0), cA + kstep, voffA); PG8_STAGE(PG8_SB(1, 1), cB + hstepB + kstep, voffB);
        PG8_WAIT_V(6); PG8_BAR;
    }
    for (;;) {
        const bool has_next = S.next(ui + 1, nxt);
        const char* nA = has_next ? (const char*)g.A + (size_t)nxt.pm * tstepA : cA; const char* nB = has_next ? (const char*)g.Bt + (size_t)nxt.pn * tstepB : cB;
        for (int t = 0; t < nt; t += 2) {
            const bool last = (t == nt - 2);
            const char* a1 = cA + (size_t)(t + 1) * kstep;
            const char* a2 = last ? nA : cA + (size_t)(t + 2) * kstep; const char* b2 = last ? nB : cB + (size_t)(t + 2) * kstep;
            const char* a3 = a2 + kstep; const char* b3 = b2 + kstep;
            if (last && has_next) S.a_ready(nxt);
            if constexpr (SP2) {
            PG8_LDB(B0, 0, 0); PG8_LDB(B1, 0, 1); PG8_SCHED; PG8_LDA(At, 0, 0); PG8_STAGE(PG8_SA(1, 1), a1 + hstepA, voffA);
            PG8_WAIT_V(8); PG8_WAIT_L(0); PG8_BAR; PG8_MMA(0, 0, At, B0); PG8_MMA(0, 1, At, B1); PG8_BAR; PG8_SCHED;
            PG8_LDA(At, 0, 1); PG8_STAGE(PG8_SB(0, 0), b2, voffB); PG8_STAGE(PG8_SB(0, 1), b2 + hstepB, voffB); PG8_STAGE(PG8_SA(0, 0), a2, voffA);
            PG8_WAIT_V(8); PG8_WAIT_L(0); PG8_BAR; PG8_MMA(1, 0, At, B0); PG8_MMA(1, 1, At, B1); PG8_BAR; PG8_SCHED;
            PG8_LDB(B0, 1, 0); PG8_LDB(B1, 1, 1); PG8_SCHED; PG8_LDA(At, 1, 0); PG8_STAGE(PG8_SA(0, 1), a2 + hstepA, voffA);
            PG8_WAIT_V(8); PG8_WAIT_L(0); PG8_BAR; PG8_MMA(0, 0, At, B0); PG8_MMA(0, 1, At, B1); PG8_BAR; PG8_SCHED;
            PG8_LDA(At, 1, 1); PG8_STAGE(PG8_SB(1, 0), b3, voffB); PG8_STAGE(PG8_SB(1, 1), b3 + hstepB, voffB); PG8_STAGE(PG8_SA(1, 0), a3, voffA);
            PG8_WAIT_V(8); PG8_WAIT_L(0); PG8_BAR; PG8_MMA(1, 0, At, B0); PG8_MMA(1, 1, At, B1); PG8_BAR; PG8_SCHED;
            } else {
            PG8_LDB(B0, 0, 0); PG8_SCHED; PG8_LDA(At, 0, 0); PG8_STAGE(PG8_SA(1, 1), a1 + hstepA, voffA);
            PG8_WAIT_L(8); PG8_BAR; PG8_WAIT_L(0); PG8_MMA(0, 0, At, B0); PG8_BAR; PG8_SCHED;
            PG8_LDB(B1, 0, 1); PG8_STAGE(PG8_SB(0, 0), b2, voffB);
            PG8_BAR; PG8_WAIT_L(0); PG8_MMA(0, 1, At, B1); PG8_BAR;
            PG8_LDA(At, 0, 1); PG8_STAGE(PG8_SA(0, 0), a2, voffA);
            PG8_BAR; PG8_WAIT_L(0); PG8_MMA(1, 0, At, B0); PG8_BAR; PG8_SCHED;
            PG8_STAGE(PG8_SB(0, 1), b2 + hstepB, voffB);
            PG8_WAIT_V(6); PG8_BAR; PG8_MMA(1, 1, At, B1); PG8_BAR;
            PG8_LDB(B0, 1, 0); PG8_SCHED; PG8_LDA(At, 1, 0); PG8_STAGE(PG8_SA(0, 1), a2 + hstepA, voffA);
            PG8_WAIT_L(8); PG8_BAR; PG8_WAIT_L(0); PG8_MMA(0, 0, At, B0); PG8_BAR; PG8_SCHED;
            PG8_LDB(B1, 1, 1); PG8_STAGE(PG8_SB(1, 0), b3, voffB);
            PG8_BAR; PG8_WAIT_L(0); PG8_MMA(0, 1, At, B1); PG8_BAR;
            PG8_LDA(At, 1, 1); PG8_STAGE(PG8_SA(1, 0), a3, voffA);
            PG8_BAR; PG8_WAIT_L(0); PG8_MMA(1, 0, At, B0); PG8_BAR; PG8_SCHED;
            PG8_STAGE(PG8_SB(1, 1), b3 + hstepB, voffB);
            PG8_WAIT_V(6); PG8_BAR; PG8_MMA(1, 1, At, B1); PG8_BAR;
            }
        }
        if constexpr (ALIGN_EPI) { if (wr == 0) PG8_BAR; }
        if constexpr (!Epi::AFTER_DRAIN) { E(acc, cur, wr, wc, fr, fq); S.done(cur); }
        if (!has_next) break;
#pragma unroll
        for (int a = 0; a < 2; ++a)
#pragma unroll
            for (int b = 0; b < 2; ++b)
#pragma unroll
                for (int m = 0; m < 4; ++m)
#pragma unroll
                    for (int n = 0; n < 2; ++n) acc[a][b][m][n] = (f32x4){0.f, 0.f, 0.f, 0.f};
        cur = nxt; cA = nA; cB = nB; ++ui;
        if constexpr (ALIGN_EPI) { if (wr == 1) PG8_BAR; }
    }
    PG8_WAIT_V(0);
    if constexpr (!ALIGN_EPI) { if (wr == 0) PG8_BAR; }
    PG8_BAR;
    if constexpr (Epi::AFTER_DRAIN) { E.fused(acc, cur, wr, wc, fr, fq, lds, wid, lane); S.done(cur); }
#undef PG8_SA
#undef PG8_SB
#undef PG8_STAGE
#undef PG8_LDA
#undef PG8_LDB
#undef PG8_MMA
#undef PG8_WAIT_V
#undef PG8_WAIT_L
#undef PG8_BAR
#undef PG8_SCHED
}
}
#include <hip/hip_bf16.h>
#include <cmath>
namespace attn_body {
using bf16=__hip_bfloat16;
using bf16x8=__attribute__((ext_vector_type(8)))short;
using s16x4=__attribute__((ext_vector_type(4)))short;
using f32x16=__attribute__((ext_vector_type(16)))float;
using u32x4=__attribute__((ext_vector_type(4)))unsigned;
constexpr int D=64,DM=2048,KDM=64;
constexpr int NW=8,QBLK=32,QB=QBLK*NW,KVBLK=64;
constexpr int ATTN_PITCH=DM, ATTN_UNIT_ROWS=QB;
__device__ __forceinline__ int crow(int r,int hi){return (r&3)+8*(r>>2)+4*hi;}
#define SBAR() __builtin_amdgcn_sched_barrier(0)
__device__ __forceinline__ void cmask(f32x16&p0,f32x16&p1,int jb,int qrel,int hi){
  const float NEG=-INFINITY; int kb=64*jb+4*hi;
  #pragma unroll
  for(int r=0;r<16;++r){int kv=kb+(r&3)+8*(r>>2); if(kv>qrel)p0[r]=NEG; if(kv+32>qrel)p1[r]=NEG;}
}

constexpr int NSLOT=3, SLOTB=8192;
constexpr int LDS_K=0, LDS_V=NSLOT*SLOTB, LDS_WS=2*NSLOT*SLOTB, LDS_OST=LDS_WS+NW*64*4, LDS_BYTES=LDS_OST+NW*4096;
constexpr float C2=0.125f*1.4426950408889634f;
__device__ __forceinline__ void glds16(const void*gsrc,unsigned lds_dst){unsigned keep;
  asm volatile("s_mov_b32 %0, m0\n\ts_mov_b32 m0, %2\n\ts_nop 0\n\tglobal_load_lds_dwordx4 %1, off\n\ts_mov_b32 m0, %0":"=&s"(keep):"v"(gsrc),"s"(lds_dst):"memory");}
__device__ __forceinline__ float max3f(float a,float b,float c){float r;asm("v_max3_f32 %0, %1, %2, %3":"=v"(r):"v"(a),"v"(b),"v"(c));return r;}
__device__ __forceinline__ float max2f(float a,float b){float r;asm("v_max_f32_e32 %0, %1, %2":"=v"(r):"v"(a),"v"(b));return r;}
__device__ __forceinline__ float fadd_s(float a,float b){float r;asm("v_add_f32_e32 %0, %1, %2":"=v"(r):"v"(a),"v"(b));return r;}
__device__ __forceinline__ float fsub_s(float a,float b){float r;asm("v_sub_f32_e32 %0, %1, %2":"=v"(r):"v"(a),"v"(b));return r;}
typedef float f32x2_t __attribute__((ext_vector_type(2))); typedef __bf16 bf16x2_t __attribute__((ext_vector_type(2)));
__device__ __forceinline__ unsigned cvtpk_s(float lo,float hi){f32x2_t v={lo,hi};bf16x2_t b=__builtin_convertvector(v,bf16x2_t);return __builtin_bit_cast(unsigned,b);}
#define WAIT_BAR(N) asm volatile("s_waitcnt vmcnt(" #N ") lgkmcnt(0)\n\ts_barrier":::"memory")

__device__ __forceinline__ void qkt(f32x16&p0,f32x16&p1,const char*Kslot,const bf16x8*qr,const f32x16&negm,int r32,int hi){
  const char*kb=Kslot+hi*1024+r32*16;
  #pragma unroll
  for(int d0=0;d0<4;++d0){
    const bf16x8 b0=*reinterpret_cast<const bf16x8*>(kb+d0*2048);
    const bf16x8 b1=*reinterpret_cast<const bf16x8*>(kb+d0*2048+512);
    if(d0==0){p0=__builtin_amdgcn_mfma_f32_32x32x16_bf16(b0,qr[0],negm,0,0,0);p1=__builtin_amdgcn_mfma_f32_32x32x16_bf16(b1,qr[0],negm,0,0,0);}
    else{p0=__builtin_amdgcn_mfma_f32_32x32x16_bf16(b0,qr[d0],p0,0,0,0);p1=__builtin_amdgcn_mfma_f32_32x32x16_bf16(b1,qr[d0],p1,0,0,0);}}
}
typedef __attribute__((address_space(3))) const char* lds_cptr;
typedef short v4i16_t __attribute__((ext_vector_type(4)));
__device__ __forceinline__ void kload8(bf16x8*kf,lds_cptr kp){
  kf[0]=*(const __attribute__((address_space(3))) bf16x8*)(kp);      kf[1]=*(const __attribute__((address_space(3))) bf16x8*)(kp+512);
  kf[2]=*(const __attribute__((address_space(3))) bf16x8*)(kp+2048); kf[3]=*(const __attribute__((address_space(3))) bf16x8*)(kp+2560);
  kf[4]=*(const __attribute__((address_space(3))) bf16x8*)(kp+4096); kf[5]=*(const __attribute__((address_space(3))) bf16x8*)(kp+4608);
  kf[6]=*(const __attribute__((address_space(3))) bf16x8*)(kp+6144); kf[7]=*(const __attribute__((address_space(3))) bf16x8*)(kp+6656);
}
__device__ __forceinline__ void kload2(bf16x8*kf,lds_cptr kp,int j){ kf[2*j]=*(const __attribute__((address_space(3))) bf16x8*)(kp+j*2048); kf[2*j+1]=*(const __attribute__((address_space(3))) bf16x8*)(kp+j*2048+512); }
__device__ __forceinline__ s16x4 vtr(lds_cptr p){ return __builtin_bit_cast(s16x4,__builtin_amdgcn_ds_read_tr16_b64_v4i16((__attribute__((address_space(3))) v4i16_t*)p)); }
__device__ __forceinline__ float rowmax(const f32x16&p0,const f32x16&p1){
  float a=max3f(p0[0],p0[1],p1[0]),b=max3f(p0[2],p0[3],p1[1]);a=max3f(a,p1[2],p1[3]);
  #pragma unroll
  for(int r=4;r<16;r+=4){a=max3f(a,p0[r],p0[r+1]);b=max3f(b,p0[r+2],p0[r+3]);a=max3f(a,p1[r],p1[r+1]);b=max3f(b,p1[r+2],p1[r+3]);}
  const float m=max2f(a,b);
  auto rr=__builtin_amdgcn_permlane32_swap(__float_as_uint(m),__float_as_uint(m),false,false);
  return max2f(__uint_as_float(rr[0]),__uint_as_float(rr[1]));
}
__device__ __forceinline__ void pv(f32x16*o,int vb,bf16x8 pa0,bf16x8 pa1,bf16x8 pa2,bf16x8 pa3){
  #pragma unroll
  for(int d0=0;d0<2;++d0){s16x4 lo[4],hi[4];
    #pragma unroll
    for(int ks=0;ks<4;++ks){
      asm volatile("ds_read_b64_tr_b16 %0,%1 offset:%c2":"=&v"(lo[ks]):"v"(vb),"i"(d0*4096+ks*1024):"memory");
      asm volatile("ds_read_b64_tr_b16 %0,%1 offset:%c2":"=&v"(hi[ks]):"v"(vb),"i"(d0*4096+ks*1024+512):"memory");}
    asm volatile("s_waitcnt lgkmcnt(0)":::"memory");SBAR();
    #define PK(k) (bf16x8){lo[k][0],lo[k][1],lo[k][2],lo[k][3],hi[k][0],hi[k][1],hi[k][2],hi[k][3]}
    o[d0]=__builtin_amdgcn_mfma_f32_32x32x16_bf16(pa0,PK(0),o[d0],0,0,0);
    o[d0]=__builtin_amdgcn_mfma_f32_32x32x16_bf16(pa1,PK(1),o[d0],0,0,0);
    o[d0]=__builtin_amdgcn_mfma_f32_32x32x16_bf16(pa2,PK(2),o[d0],0,0,0);
    o[d0]=__builtin_amdgcn_mfma_f32_32x32x16_bf16(pa3,PK(3),o[d0],0,0,0);
    #undef PK
  }
}

#ifndef ATTN_STORE16
#define ATTN_STORE16(p,v) (*(u32x4*)(p)=(v))
#endif
template<int THRL> __device__ __forceinline__ void attn_unit(const bf16*Qblk,const bf16*__restrict__ Kh,const bf16*__restrict__ Vh,bf16*Oblk,const int NT,char*shm){
  const int tid=otid(),lane=tid&63,r32=lane&31,hi=lane>>5; const int wid=__builtin_amdgcn_readfirstlane(tid>>6);
  const bf16*Qw=Qblk+(long)wid*QBLK*DM;
  const unsigned lds0=(unsigned)(uintptr_t)shm;
  float*wsf=(float*)(shm+LDS_WS)+wid*64;
  const bf16*ksrc=Kh+(long)lane*KDM+wid*8;
  const bf16*vsrc=Vh+(long)(16*(wid&3)+(lane>>2))*KDM+(wid>>2)*32+(lane&3)*8;
  const unsigned kdst=lds0+LDS_K+wid*1024, vdst=lds0+LDS_V+wid*1024;
  #define DMA_K(t,slot) glds16(ksrc+(long)(t)*KVBLK*KDM,(unsigned)__builtin_amdgcn_readfirstlane(kdst+(slot)))
  #define DMA_V(t,slot) glds16(vsrc+(long)(t)*KVBLK*KDM,(unsigned)__builtin_amdgcn_readfirstlane(vdst+(slot)))
  const int vb0=(int)(lds0+LDS_V)+((lane>>4)&1)*32+(lane&3)*8+(4*hi+((lane&15)>>2))*64;
  const char*Kbase=shm+LDS_K; bf16x8 kf[8];
  const lds_cptr shm3=(lds_cptr)shm; const lds_cptr kp0=shm3+LDS_K+hi*1024+r32*16; const lds_cptr vp0=shm3+LDS_V+((lane>>4)&1)*32+(lane&3)*8+(4*hi+((lane&15)>>2))*64;
  DMA_K(0,0);DMA_V(0,0);DMA_K(1,SLOTB);
  bf16x8 qr[4];
  #pragma unroll
  for(int d0=0;d0<4;++d0)qr[d0]=*reinterpret_cast<const bf16x8*>(&Qw[(long)r32*DM+d0*16+hi*8]);
  float mhat=0.f,l_reg=0.f;f32x16 o[2];o[0]=f32x16{};o[1]=f32x16{};f32x16 negm=f32x16{};asm volatile("":"+v"(negm));
  #define CMASK(P0,P1,t) do{}while(0)
  bool resc=false;
  #define START(P0,P1) do{ const float rm=rowmax(P0,P1); resc=false; \
    { const float dl=rm; mhat=fadd_s(mhat,dl); \
      _Pragma("unroll") for(int r=0;r<16;++r){P0[r]=fsub_s(P0[r],dl);P1[r]=fsub_s(P1[r],dl);} \
      _Pragma("unroll") for(int r=0;r<16;++r)negm[r]=-mhat; asm volatile("":"+v"(negm)); } \
    _Pragma("unroll") for(int r=0;r<16;++r)P0[r]=__builtin_amdgcn_exp2f(P0[r]); }while(0)
  #define RESC() do{ if(resc){ asm volatile("s_waitcnt lgkmcnt(0)":::"memory"); \
      _Pragma("unroll") for(int d_=0;d_<2;++d_) _Pragma("unroll") for(int r=0;r<16;++r)o[d_][r]*=wsf[crow(r,hi)]; } }while(0)
  f32x16 pA0,pA1,pB0,pB1;
  int sl_prev=0,sl_cur=0,sl_next=SLOTB;
  #define ROT() do{sl_prev=sl_cur;sl_cur=sl_next;sl_next=(sl_next==(NSLOT-1)*SLOTB)?0:sl_next+SLOTB;}while(0)
  DMA_K(2,2*SLOTB);
  WAIT_BAR(3);
  qkt(pA0,pA1,Kbase,qr,negm,r32,hi);asm volatile("s_nop 15\n\ts_nop 7":"+v"(pA0),"+v"(pA1));CMASK(pA0,pA1,0);
  START(pA0,pA1);
  _Pragma("unroll") for(int r=0;r<16;++r)pA1[r]=__builtin_amdgcn_exp2f(pA1[r]);
  WAIT_BAR(0);
  DMA_K(3,0);DMA_V(1,SLOTB);
  ROT();
  kload8(kf,kp0+sl_cur);
  WAIT_BAR(2);
  s16x4 vlo[8],vhi[8]; u32x4 pw0,pw1,pw2,pw3;
  #define PKW(P,B) cvtpk_s(P[B],P[B+1])
  #define PAF(k) __builtin_bit_cast(bf16x8,pw##k)
  #define VFR(i) (bf16x8){vlo[i][0],vlo[i][1],vlo[i][2],vlo[i][3],vhi[i][0],vhi[i][1],vhi[i][2],vhi[i][3]}
  #define PIN(x) asm volatile("":"+v"(x))
  #define MX3(a,b,c) __builtin_fmaxf(__builtin_fmaxf((a),(b)),(c))
  #define GAPA(MF,A0,A1,A2,A3,W0,W1,PW) do{ MF; sacc+=A0; sacc+=A1; sacc+=A2; sacc+=A3; PIN(sacc); W0; W1; PIN(PW); SBAR(); }while(0)
  #define EX(v) __builtin_amdgcn_exp2f(v)
  #define GAPB(MF,X,B) do{ MF; X[B]=EX(X[B]); X[B+1]=EX(X[B+1]); X[B+2]=EX(X[B+2]); X[B+3]=EX(X[B+3]); PIN(X); SBAR(); }while(0)
  #define VRD(i) do{ vlo[i]=vtr(vp_+(((i)>>2)*4096+((i)&3)*1024)); vhi[i]=vtr(vp_+(((i)>>2)*4096+((i)&3)*1024+512)); }while(0)
  #define KRD(G,j) do{ if(G){ kload2(kf,kp0+sl_next,j); SBAR(); } }while(0)
  #define STEP(C0,C1,P0,P1,t,GK,GV,GL) do{ SBAR(); \
    const lds_cptr vp_=vp0+sl_prev; \
    VRD(0); SBAR(); float sacc=(P0[0]+P0[1]); \
    GAPA(C0=__builtin_amdgcn_mfma_f32_32x32x16_bf16(kf[0],qr[0],negm,0,0,0), P0[2],P0[3],P0[4],P0[5],     pw0[0]=PKW(P0,0), pw0[1]=PKW(P0,2), pw0); \
    VRD(4); SBAR(); GAPA(C1=__builtin_amdgcn_mfma_f32_32x32x16_bf16(kf[1],qr[0],negm,0,0,0), P0[6],P0[7],P0[8],P0[9],     pw0[2]=PKW(P0,4), pw0[3]=PKW(P0,6), pw0); \
    VRD(1); SBAR(); GAPA(C0=__builtin_amdgcn_mfma_f32_32x32x16_bf16(kf[2],qr[1],C0,0,0,0),   P0[10],P0[11],P0[12],P0[13], pw1[0]=PKW(P0,8), pw1[1]=PKW(P0,10), pw1); \
    VRD(5); SBAR(); GAPA(C1=__builtin_amdgcn_mfma_f32_32x32x16_bf16(kf[3],qr[1],C1,0,0,0),   P0[14],P0[15],P1[0],P1[1],   pw1[2]=PKW(P0,12),pw1[3]=PKW(P0,14), pw1); \
    VRD(2); SBAR(); GAPA(C0=__builtin_amdgcn_mfma_f32_32x32x16_bf16(kf[4],qr[2],C0,0,0,0),   P1[2],P1[3],P1[4],P1[5],     pw2[0]=PKW(P1,0), pw2[1]=PKW(P1,2), pw2); \
    VRD(6); SBAR(); GAPA(C1=__builtin_amdgcn_mfma_f32_32x32x16_bf16(kf[5],qr[2],C1,0,0,0),   P1[6],P1[7],P1[8],P1[9],     pw2[2]=PKW(P1,4), pw2[3]=PKW(P1,6), pw2); \
    VRD(3); SBAR(); GAPA(C0=__builtin_amdgcn_mfma_f32_32x32x16_bf16(kf[6],qr[3],C0,0,0,0),   P1[10],P1[11],P1[12],P1[13], pw3[0]=PKW(P1,8), pw3[1]=PKW(P1,10), pw3); \
    VRD(7); SBAR(); GAPA(C1=__builtin_amdgcn_mfma_f32_32x32x16_bf16(kf[7],qr[3],C1,0,0,0),   P1[14],P1[15],0.f,0.f,       pw3[2]=PKW(P1,12),pw3[3]=PKW(P1,14), pw3); \
    l_reg+=sacc; \
    if(GK){DMA_K((t)+3,sl_cur);} if(GV){DMA_V((t)+1,sl_next);} \
    CMASK(C0,C1,t); \
    { float a=MX3(C0[0],C0[1],C1[0]),b=MX3(C0[2],C0[3],C1[1]); a=MX3(a,C1[2],C1[3]); \
      _Pragma("unroll") for(int r=4;r<16;r+=4){a=MX3(a,C0[r],C0[r+1]);b=MX3(b,C0[r+2],C0[r+3]);a=MX3(a,C1[r],C1[r+1]);b=MX3(b,C1[r+2],C1[r+3]);} \
      float rm=__builtin_fmaxf(a,b); { auto rr=__builtin_amdgcn_permlane32_swap(__float_as_uint(rm),__float_as_uint(rm),false,false); rm=__builtin_fmaxf(__uint_as_float(rr[0]),__uint_as_float(rr[1])); } \
      resc=false; \
      if(__builtin_expect(__any(rm>(float)THRL),0)){ const float dl=__builtin_fmaxf(rm,0.f); mhat+=dl; \
        _Pragma("unroll") for(int r=0;r<16;++r){C0[r]-=dl;C1[r]-=dl;} \
        _Pragma("unroll") for(int r=0;r<16;++r)negm[r]=-mhat; asm volatile("":"+v"(negm)); \
        const float f=__builtin_amdgcn_exp2f(-dl); l_reg*=f; if(hi==0)wsf[r32]=f; resc=true; } } \
    SBAR(); \
    GAPB(o[0]=__builtin_amdgcn_mfma_f32_32x32x16_bf16(PAF(0),VFR(0),o[0],0,0,0), C0,0); \
    GAPB(o[1]=__builtin_amdgcn_mfma_f32_32x32x16_bf16(PAF(0),VFR(4),o[1],0,0,0), C0,4); \
    KRD(GL,0); GAPB(o[0]=__builtin_amdgcn_mfma_f32_32x32x16_bf16(PAF(1),VFR(1),o[0],0,0,0), C0,8); \
    KRD(GL,1); GAPB(o[1]=__builtin_amdgcn_mfma_f32_32x32x16_bf16(PAF(1),VFR(5),o[1],0,0,0), C0,12); \
    KRD(GL,2); GAPB(o[0]=__builtin_amdgcn_mfma_f32_32x32x16_bf16(PAF(2),VFR(2),o[0],0,0,0), C1,0); \
    KRD(GL,3); GAPB(o[1]=__builtin_amdgcn_mfma_f32_32x32x16_bf16(PAF(2),VFR(6),o[1],0,0,0), C1,4); \
    GAPB(o[0]=__builtin_amdgcn_mfma_f32_32x32x16_bf16(PAF(3),VFR(3),o[0],0,0,0), C1,8); \
    GAPB(o[1]=__builtin_amdgcn_mfma_f32_32x32x16_bf16(PAF(3),VFR(7),o[1],0,0,0), C1,12); \
    }while(0)
  int t=1;
  #undef CMASK
  #define CMASK(P0,P1,t) do{}while(0)
  for(;t+5<NT;t+=2){
    STEP(pB0,pB1,pA0,pA1,t,true,true,true);     WAIT_BAR(2); RESC(); ROT();
    STEP(pA0,pA1,pB0,pB1,t+1,true,true,true);   WAIT_BAR(2); RESC(); ROT();
  }
  #undef CMASK
  #define CMASK(P0,P1,t) do{}while(0)
  #define ENDW(tt) do{ if((tt)+3<NT){WAIT_BAR(2);} else if((tt)+2<NT){WAIT_BAR(1);} else {WAIT_BAR(0);} }while(0)
  for(;t+1<NT;t+=2){
    STEP(pB0,pB1,pA0,pA1,t,(t+3<NT),(t+1<NT),(t+1<NT));       ENDW(t);   RESC(); ROT();
    STEP(pA0,pA1,pB0,pB1,t+1,(t+4<NT),(t+2<NT),(t+2<NT));     ENDW(t+1); RESC(); ROT();
  }
  STEP(pB0,pB1,pA0,pA1,NT-1,false,false,false); RESC();
  { float sacc=pB0[0]+pB0[1]; _Pragma("unroll") for(int r=2;r<16;++r)sacc+=pB0[r]; _Pragma("unroll") for(int r=0;r<16;++r)sacc+=pB1[r]; l_reg+=sacc;
    pw0=(u32x4){PKW(pB0,0),PKW(pB0,2),PKW(pB0,4),PKW(pB0,6)};pw1=(u32x4){PKW(pB0,8),PKW(pB0,10),PKW(pB0,12),PKW(pB0,14)};pw2=(u32x4){PKW(pB1,0),PKW(pB1,2),PKW(pB1,4),PKW(pB1,6)};pw3=(u32x4){PKW(pB1,8),PKW(pB1,10),PKW(pB1,12),PKW(pB1,14)};
    SBAR(); pv(o,vb0+sl_cur,PAF(0),PAF(1),PAF(2),PAF(3)); }
  #undef PKW
  #undef PAF
  #undef VFR
  #undef PIN
  #undef MX3
  #undef GAPA
  #undef GAPB
  #undef EX
  #undef VRD
  #undef KRD
  #undef STEP
  #undef ENDW
  {auto rr=__builtin_amdgcn_permlane32_swap(__float_as_uint(l_reg),__float_as_uint(l_reg),false,false);l_reg=__uint_as_float(rr[0])+__uint_as_float(rr[1]);}
  if(hi==0)wsf[32+r32]=l_reg;asm volatile("s_waitcnt lgkmcnt(0)":::"memory");
  float rli[16];
  #pragma unroll
  for(int r=0;r<16;++r)rli[r]=__builtin_amdgcn_rcpf(wsf[32+crow(r,hi)]);
  bf16*Ow=Oblk+(long)wid*QBLK*DM;
  { bf16*stg=(bf16*)(shm+LDS_OST)+wid*2048;
    #pragma unroll
    for(int r=0;r<16;++r){const int orow=crow(r,hi);
      #pragma unroll
      for(int d0=0;d0<2;++d0)stg[orow*64+d0*32+r32]=__float2bfloat16(o[d0][r]*rli[r]);}
    asm volatile("s_waitcnt lgkmcnt(0)":::"memory");
    #pragma unroll
    for(int i=0;i<4;++i){const int row=i*8+(lane>>3),ch=lane&7; const u32x4 v=*(const u32x4*)(stg+row*64+ch*8); const u32x4 z=*(const u32x4*)(Ow+(long)row*DM+ch*8); u32x4 w;
      #pragma unroll
      for(int e=0;e<4;++e){ const float a0=__uint_as_float(v[e]<<16),a1=__uint_as_float(v[e]&0xffff0000u),z0=__uint_as_float(z[e]<<16),z1=__uint_as_float(z[e]&0xffff0000u);
        w[e]=cvtpk_s(a0*z0/(1.f+__expf(-z0)),a1*z1/(1.f+__expf(-z1))); }
      ATTN_STORE16(Ow+(long)row*DM+ch*8,w);} }
  asm volatile("s_waitcnt lgkmcnt(0)\n\ts_barrier":::"memory");
  #undef DMA_K
  #undef DMA_V
  #undef CMASK
  #undef START
  #undef RESC
  #undef ROT
}
constexpr int ATTN_LDS_BYTES=LDS_BYTES;
}
typedef unsigned short u16;
#define LAS __attribute__((address_space(3)))
#define DI __device__ __forceinline__
typedef unsigned v4u __attribute__((ext_vector_type(4)));
typedef unsigned v2u __attribute__((ext_vector_type(2)));
typedef float v4f __attribute__((ext_vector_type(4)));

constexpr int T_TOK = 32768, P1P = 2048, P2P = 1536;
constexpr int P1_Z = 0, P1_Q = 1280, P1_K = 1792, P1_V = 1920;
constexpr int P2_AQ = 0, P2_AK = 128, P2_AV = 256, P2_GF = 512, P2_GB = 640, P2_BU = 768, P2_DU = 1024, P2_DV = 1280, P2_U = 1024;
constexpr size_t MiB = 1u << 20;
constexpr size_t WS_DFT = 256 * 1024, WS_BAR = 512 * 1024, BAR_BYTES = 16384;
constexpr size_t WS_MOD = 0, WS_WIN = 2 * MiB, WS_WOUT = 16 * MiB, WS_WF = 21 * MiB, WS_U0 = 22 * MiB, WS_HB = 86 * MiB, WS_P2 = 150 * MiB, WS_DEC = 246 * MiB, WS_END = 247 * MiB;
constexpr size_t HB_GS = 0, HB_KC = 16 * MiB, HB_VC = 24 * MiB, HB_TP = 32 * MiB;
constexpr int LDS_BYTES = 147456;
constexpr float EPSN = 1e-6f;
constexpr float ATT_C2 = 0.125f * 1.4426950408889634f;

struct Params {
    const float *xp, *xs, *cp, *cs, *ada_w, *ada_b, *pre_g, *post_g, *w_in, *wg2f, *bgf, *wg2b, *bgb, *onorm_g, *fnet_w, *qn_g, *kn_g, *sgu_ng, *sgu_w, *sgu_b, *w_out;
    float* out; unsigned char* ws;
};
typedef const float* cfp;
struct Ctx { float* out; unsigned char* ws; LAS cfp* tab; };

DI float bf2f(u16 v) { return __uint_as_float((unsigned)v << 16); }
DI float bflo(unsigned w) { return __uint_as_float(w << 16); }
DI float bfhi(unsigned w) { return __uint_as_float(w & 0xffff0000u); }
DI unsigned f2bf(float f) { unsigned u = __float_as_uint(f); return (u + 0x7fffu + ((u >> 16) & 1u)) >> 16; }
DI unsigned pk2(float lo, float hi) { return f2bf(lo) | (f2bf(hi) << 16); }
DI float wave_sum(float v) {
#pragma unroll
    for (int o = 1; o < 64; o <<= 1) v += __shfl_xor(v, o);
    return v;
}
using pg8::silu_f;
DI float logsig(float x) { return fminf(x, 0.f) - log1pf(__expf(-fabsf(x))); }
DI void seq_info(int s, int& row0, int& N) { if (s < 4) { row0 = s * 4096; N = 4096; } else { row0 = 16384 + (s - 4) * 8192; N = 8192; } }
DI int row_seq(int r) { return r < 16384 ? (r >> 12) : 4 + ((r - 16384) >> 13); }
DI void unpack8(const v4u r, float (&f)[8]) { f[0] = bflo(r.x); f[1] = bfhi(r.x); f[2] = bflo(r.y); f[3] = bfhi(r.y); f[4] = bflo(r.z); f[5] = bfhi(r.z); f[6] = bflo(r.w); f[7] = bfhi(r.w); }
DI v4u pack8(const float (&f)[8]) { v4u r; r.x = pk2(f[0], f[1]); r.y = pk2(f[2], f[3]); r.z = pk2(f[4], f[5]); r.w = pk2(f[6], f[7]); return r; }
#define LDS_WAIT() asm volatile("s_waitcnt lgkmcnt(0)" ::: "memory")


typedef short bf16x8_t __attribute__((ext_vector_type(8)));
typedef float f32x4_t __attribute__((ext_vector_type(4)));
DI bf16x8_t ldfrag(const LAS u16* base, int pitch, int row0, int k0, int lane) { return *(const LAS bf16x8_t*)(base + (row0 + (lane & 15)) * pitch + k0 + 8 * (lane >> 4)); }
typedef short s16x4_t __attribute__((ext_vector_type(4)));
DI bf16x8_t ldfrag_tr(const LAS u16* base, int pitch, int k0, int n0, int lane) {
    const LAS u16* a0 = base + (k0 + 8 * (lane >> 4) + ((lane & 15) >> 2)) * pitch + n0 + 4 * (lane & 3);
    const s16x4_t lo = __builtin_amdgcn_ds_read_tr16_b64_v4i16((LAS s16x4_t*)a0), hi = __builtin_amdgcn_ds_read_tr16_b64_v4i16((LAS s16x4_t*)(a0 + 4 * pitch));
    return (bf16x8_t){lo[0], lo[1], lo[2], lo[3], hi[0], hi[1], hi[2], hi[3]};
}
#define MFMA16(a, b, c) __builtin_amdgcn_mfma_f32_16x16x32_bf16((a), (b), (c), 0, 0, 0)
DI float wave_prefix(float g, int lane) {
#pragma unroll
    for (int o = 1; o < 64; o <<= 1) { const float t = __shfl_up(g, o); if (lane >= o) g += t; }
    return g; }
DI float wave_suffix(float g, int lane) {
#pragma unroll
    for (int o = 1; o < 64; o <<= 1) { const float t = __shfl_down(g, o); if (lane + o < 64) g += t; }
    return g; }
DI int win_src_col(int j) {
    if (j < 1280) return 2080 + j;
    if (j < 1792) return 800 + (j - 1280);
    if (j < 1920) return 1312 + (j - 1792);
    if (j < 2048) return 1440 + (j - 1920);
    const int q = j - 2048;
    if (q < 512) return q;
    if (q < 768) return -1;
    if (q < 1024) return 544 + (q - 768);
    if (q < 1280) return 1568 + (q - 1024);
    return 1824 + (q - 1280);
}
DI void transpose_item(const float* W, int ldw, int src_n0, int K, u16* WT, int dst_n0, int k0, LAS float* scr, int lane) {
    float tv[32];
#pragma unroll
    for (int i = 0; i < 32; ++i) tv[i] = W[(size_t)(k0 + 2 * i + (lane >> 5)) * ldw + src_n0 + (lane & 31)];
#pragma unroll
    for (int i = 0; i < 32; ++i) scr[(2 * i + (lane >> 5)) * 33 + (lane & 31)] = tv[i];
    LDS_WAIT();
    const int c = lane & 7;
#pragma unroll
    for (int j = 0; j < 4; ++j) { const int n = (lane >> 3) + 8 * j; const LAS float* s = scr + (8 * c) * 33 + n;
        v4u o; o.x = pk2(s[0 * 33], s[1 * 33]); o.y = pk2(s[2 * 33], s[3 * 33]); o.z = pk2(s[4 * 33], s[5 * 33]); o.w = pk2(s[6 * 33], s[7 * 33]);
        *(v4u*)(WT + (size_t)(dst_n0 + n) * K + k0 + 8 * c) = o; }
    LDS_WAIT();
}
DI void phase0(const Ctx& p, LAS unsigned char* L) {
    const int tid = otid(), lane = tid & 63, wave = tid >> 6;
    const int gw = blockIdx.x * 8 + wave, NGW = gridDim.x * 8, gt = blockIdx.x * 512 + tid, NGT = gridDim.x * 512;
    LAS float* scr = (LAS float*)(L + wave * 16384);
    u16* WinT = (u16*)(p.ws + WS_WIN); u16* WoutT = (u16*)(p.ws + WS_WOUT); u16* WfT = (u16*)(p.ws + WS_WF); float* mod = (float*)(p.ws + WS_MOD);
    constexpr int I_IN = 16 * 112, I_OUT = 20 * 32, I_L = I_IN + I_OUT;
    for (int it = gw; it < 2 * I_L; it += NGW) {
        const int l = it / I_L; int r = it % I_L;
        if (r < I_IN) { const int kb = r / 112, nb = r % 112; const int src = win_src_col(nb * 32); if (src < 0) continue;
            transpose_item(p.tab[8] + (size_t)l * 1024 * 3360, 3360, src, 1024, WinT + (size_t)l * 3584 * 1024, nb * 32, kb * 64, scr, lane); }
        else { r -= I_IN; const int kb = r / 32, nb = r % 32;
            transpose_item(p.tab[20] + (size_t)l * 1280 * 1024, 1024, nb * 32, 1280, WoutT + (size_t)l * 1024 * 1280, nb * 32, kb * 64, scr, lane); }
    }
    for (int e = gt; e < 2 * 16 * 1024; e += NGT) { const int l = e >> 14, r = e & 16383, jg = r >> 10, k = r & 1023, dirb = jg >> 3, jj0 = (jg & 7) * 16;
        const float* wi = p.tab[8] + (size_t)l * 1024 * 3360 + (size_t)k * 3360 + 512 + dirb * 16; float wv[16];
#pragma unroll
        for (int r2 = 0; r2 < 16; ++r2) wv[r2] = wi[r2];
        const float* w2 = (dirb ? p.tab[11] : p.tab[9]) + l * 16 * 128 + jj0;
        for (int q = 0; q < 16; ++q) { float a = 0.f;
#pragma unroll
            for (int r2 = 0; r2 < 16; ++r2) a += wv[r2] * w2[r2 * 128 + q];
            WinT[(size_t)l * 3584 * 1024 + (size_t)(2560 + dirb * 128 + jj0 + q) * 1024 + k] = (u16)f2bf(a); } }
    { LAS float* trig = (LAS float*)(L + 126976);
        if (tid < 64) { trig[tid] = cospif((float)tid * (1.f / 32.f)); trig[64 + tid] = sinpif((float)tid * (1.f / 32.f)); }
        __syncthreads();
        for (int e = gt; e < 2 * 256 * 512; e += NGT) { const int l = e >> 17, r = e & 131071, n = r >> 9, kk = r & 511, im = kk >> 8, g = (kk & 255) >> 6, c = kk & 63;
            const float* fw = p.tab[14] + (size_t)l * 65536 + (size_t)(g * 64) * 256 + n; const LAS float* tb = trig + im * 64; float a = 0.f;
#pragma unroll 8
            for (int j2 = 0; j2 < 64; ++j2) a += tb[(j2 * c) & 63] * fw[j2 * 256];
            WfT[(size_t)l * 131072 + n * 512 + kk] = (u16)f2bf(a * 0.125f); } }
    { u16* dft = (u16*)(p.ws + WS_DFT);
        for (int e = gt; e < 4096; e += NGT) { const int k = e >> 6, n = e & 63; const float a = (float)((k * n) & 63) * (1.f / 32.f); dft[e] = (u16)f2bf(cospif(a)); dft[4096 + e] = (u16)f2bf(sinpif(a)); }
        for (int e = gt; e < 16384; e += NGT) { const int k = e >> 7, n = e & 127; const float a = (float)((k * n) & 127) * (1.f / 64.f); dft[8192 + e] = (u16)f2bf(cospif(a)); dft[8192 + 16384 + e] = (u16)f2bf(sinpif(a)); } }
    __syncthreads();
    LAS float* sc = (LAS float*)L;
    for (int e = tid; e < 6144; e += 512) { const int s = e >> 10, k = e & 1023; const float c = s < 4 ? p.tab[2][s * 1024 + k] : p.tab[3][(s - 4) * 1024 + k]; sc[e] = c / (1.f + expf(-c)); }
    __syncthreads();
    for (int unit = gw; unit < 768; unit += NGW) {
        const int ks = unit & 7, jb = (unit >> 3) % 48, l = unit / 384, j = jb * 64 + lane;
        float acc[6] = {0.f, 0.f, 0.f, 0.f, 0.f, 0.f};
        const float* aw = p.tab[4] + (size_t)l * 1024 * 3072 + (size_t)(ks * 128) * 3072 + j;
#pragma unroll 16
        for (int k = 0; k < 128; ++k) { const float w = aw[(size_t)k * 3072];
#pragma unroll
            for (int s = 0; s < 6; ++s) acc[s] += sc[s * 1024 + ks * 128 + k] * w; }
        if (ks == 0) { const float b = p.tab[5][l * 3072 + j];
#pragma unroll
            for (int s = 0; s < 6; ++s) acc[s] += b; }
#pragma unroll
        for (int s = 0; s < 6; ++s) atomicAdd(mod + (size_t)(l * 6 + s) * 3072 + j, acc[s]);
    }
}

DI void add_branch(v4f (&v)[4], const u16* urow, const float* gate, const float* pg, int lane) {
    v4f u[4]; float ss = 0.f;
#pragma unroll
    for (int j = 0; j < 4; ++j) { const v2u r = *(const v2u*)(urow + 256 * j + 4 * lane); u[j] = (v4f){bflo(r.x), bfhi(r.x), bflo(r.y), bfhi(r.y)};
        ss += (u[j].x * u[j].x + u[j].y * u[j].y) + (u[j].z * u[j].z + u[j].w * u[j].w); }
    const float rstd = 1.f / sqrtf(wave_sum(ss) * (1.f / 1024.f) + EPSN);
#pragma unroll
    for (int j = 0; j < 4; ++j) { const v4f g = *(const v4f*)(gate + 256 * j + 4 * lane), q = *(const v4f*)(pg + 256 * j + 4 * lane); v[j] += g * (u[j] * rstd * q); }
}
DI void phaseA(const Ctx& p, int l) {
    const int tid = otid(), lane = tid & 63, wave = tid >> 6, gw = blockIdx.x * 8 + wave, NGW = gridDim.x * 8;
    const float* mod = (const float*)(p.ws + WS_MOD); const u16* U0 = (const u16*)(p.ws + WS_U0); u16* HB = (u16*)(p.ws + WS_HB);
    for (int row = gw; row < T_TOK; row += NGW) {
        const int s = row_seq(row);
        const float* xr = row < 16384 ? p.tab[0] + (size_t)row * 1024 : p.tab[1] + (size_t)(row - 16384) * 1024;
        v4f v[4];
#pragma unroll
        for (int j = 0; j < 4; ++j) v[j] = *(const v4f*)(xr + 256 * j + 4 * lane);
        if (l >= 1) add_branch(v, U0 + (size_t)row * 1024, mod + (size_t)(0 * 6 + s) * 3072 + 2048, p.tab[7], lane);
        if (l == 2) { add_branch(v, HB + (size_t)row * 1024, mod + (size_t)(1 * 6 + s) * 3072 + 2048, p.tab[7] + 1024, lane);
            float* o = p.out + (size_t)row * 1024;
#pragma unroll
            for (int j = 0; j < 4; ++j) *(v4f*)(o + 256 * j + 4 * lane) = v[j];
            continue; }
        float ss = 0.f;
#pragma unroll
        for (int j = 0; j < 4; ++j) ss += (v[j].x * v[j].x + v[j].y * v[j].y) + (v[j].z * v[j].z + v[j].w * v[j].w);
        const float rstd = 1.f / sqrtf(wave_sum(ss) * (1.f / 1024.f) + EPSN);
        const float* md = mod + (size_t)(l * 6 + s) * 3072;
#pragma unroll
        for (int j = 0; j < 4; ++j) { const int col = 256 * j + 4 * lane;
            const v4f sh = *(const v4f*)(md + col), scl = *(const v4f*)(md + 1024 + col), g = *(const v4f*)(p.tab[6] + l * 1024 + col);
            const v4f h = v[j] * rstd * g * (scl + 1.f) + sh;
            v2u o; o.x = pk2(h.x, h.y); o.y = pk2(h.z, h.w); *(v2u*)(HB + (size_t)row * 1024 + col) = o; }
    }
}

DI void qk_prep(const Ctx& p, int l) {
    const int tid = otid(), lane = tid & 63, wave = tid >> 6, gw = blockIdx.x * 8 + wave, NGW = gridDim.x * 8;
    u16* P1 = (u16*)p.out; const int i = lane & 31; unsigned* KC = (unsigned*)(p.ws + WS_HB + HB_KC); unsigned* VC = (unsigned*)(p.ws + WS_HB + HB_VC);
    const float freq = exp2f(-(float)(i & 15) * (13.287712379549449f / 16.f));
    const float gq0 = p.tab[15][l * 64 + 2 * i], gq1 = p.tab[15][l * 64 + 2 * i + 1], gk0 = p.tab[16][l * 64 + 2 * i], gk1 = p.tab[16][l * 64 + 2 * i + 1];
    for (int rowb = gw * 4; rowb < T_TOK; rowb += NGW * 4) {
        unsigned wv[4][6];
#pragma unroll
        for (int r = 0; r < 4; ++r) { const unsigned* ptr = (const unsigned*)(P1 + (size_t)(rowb + r) * P1P + P1_Q);
#pragma unroll
            for (int it = 0; it < 6; ++it) wv[r][it] = ptr[it * 64 + lane]; }
#pragma unroll
        for (int r = 0; r < 4; ++r) { const int row = rowb + r;
            const int s = row_seq(row); int row0, N; seq_info(s, row0, N); const int pos = row - row0;
            const float coord = (i < 16) ? (float)(pos >> 6) : (float)(pos & 63);
            float sn, cs; sincosf(coord * freq, &sn, &cs);
            unsigned* ptr = (unsigned*)(P1 + (size_t)row * P1P + P1_Q);
            const size_t cidx = ((size_t)row0 * 2 + (size_t)(lane >> 5) * N + pos) * 32 + i;
#pragma unroll
            for (int it = 0; it < 5; ++it) { const bool isq = it < 4;
                const unsigned w = wv[r][it]; const float x0 = bflo(w), x1 = bfhi(w);
                float ss = x0 * x0 + x1 * x1;
#pragma unroll
                for (int o = 1; o < 32; o <<= 1) ss += __shfl_xor(ss, o);
                const float rstd = 1.f / sqrtf(ss * (1.f / 64.f) + EPSN);
                const float y0 = x0 * rstd * (isq ? gq0 : gk0), y1 = x1 * rstd * (isq ? gq1 : gk1);
                float o0 = y0 * cs - y1 * sn, o1 = y0 * sn + y1 * cs;
                if (isq) { ptr[it * 64 + lane] = pk2(o0 * ATT_C2, o1 * ATT_C2); } else { KC[cidx] = pk2(o0, o1); } }
            VC[cidx] = wv[r][5]; }
    }
}
DI void gla_scan_cols(LAS float* Gf, LAS float* Gb, int lane) {
    LAS float* G = (lane >> 5) ? Gb : Gf; const int d = lane & 31; float v[64];
#pragma unroll
    for (int i = 0; i < 64; ++i) v[i] = G[i * 33 + d];
    if (lane >> 5) {
#pragma unroll
        for (int i = 62; i >= 0; --i) v[i] += v[i + 1];
    } else {
#pragma unroll
        for (int i = 1; i < 64; ++i) v[i] += v[i - 1];
    }
#pragma unroll
    for (int i = 0; i < 64; ++i) G[i * 33 + d] = v[i];
}
struct GLoad { v4u g, k, v; };
DI GLoad gla_local_load(const Ctx& p, int item) {
    const int tid = otid(); const int gc = item >> 2, h = item & 3; const size_t rb = (size_t)gc * 64; const u16* P2 = (const u16*)(p.ws + WS_P2); GLoad r;
    { const int t2 = tid & 255, i = t2 >> 2, c = t2 & 3; const u16* q = P2 + (rb + i) * P2P + h * 32 + c * 8; const int dirb = tid >> 8;
        r.g = *(const v4u*)(q + (dirb ? P2_GB : P2_GF)); r.k = *(const v4u*)(q + P2_AK); }
    { const int i = tid >> 3, c = tid & 7; r.v = *(const v4u*)(P2 + (rb + i) * P2P + P2_AV + h * 64 + c * 8); }
    return r;
}
DI void gla_local_item(const Ctx& p, int l, int item, LAS float* F, const GLoad ld) {
    const int tid = otid(), lane = tid & 63, w = tid >> 6; const int gc = item >> 2, h = item & 3; const size_t rb = (size_t)gc * 64;
    const u16* P2 = (const u16*)(p.ws + WS_P2);
    LAS float* Gf = F; LAS float* Gb = Gf + 2112; LAS float* Kx = Gb + 2112; LAS u16* KDT = (LAS u16*)(Kx + 2112); LAS u16* VT = KDT + 2 * 64 * 40;
    { const int t2 = tid & 255, i = t2 >> 2, c = t2 & 3; const u16* r = P2 + (rb + i) * P2P + h * 32 + c * 8; float f[8];
        const int dirb = tid >> 8; const float* bias = p.tab[dirb ? 12 : 10] + l * 128 + h * 32 + c * 8; LAS float* G = dirb ? Gb : Gf;
        unpack8(ld.g, f);
#pragma unroll
        for (int q = 0; q < 8; ++q) G[i * 33 + c * 8 + q] = logsig(f[q] + bias[q]) * (1.f / 16.f);
        if (!dirb) { unpack8(ld.k, f);
#pragma unroll
            for (int q = 0; q < 8; ++q) Kx[i * 33 + c * 8 + q] = f[q]; } }
    { const int i = tid >> 3, c = tid & 7; *(LAS v4u*)(VT + i * 72 + c * 8) = ld.v; }
    __syncthreads();
    if (w == 0) gla_scan_cols(Gf, Gb, lane);
    __syncthreads();
    u16* GS = (u16*)(p.ws + WS_HB + HB_GS); float* DEC = (float*)(p.ws + WS_DEC); const size_t slot = (size_t)(gc * 4 + h) * 2;
#pragma unroll
    for (int r = 0; r < 8; ++r) { const int e = tid + r * 512, d = e & 31, i = (e >> 5) & 63, dir = e >> 11; const LAS float* G = dir ? Gb : Gf;
        const float bl = G[(dir ? 0 : 63) * 33 + d];
        KDT[(dir * 64 + i) * 40 + d] = (u16)f2bf(Kx[i * 33 + d] * __expf(bl - G[i * 33 + d])); }
    if (tid < 64) { const int dir = tid >> 5, d = tid & 31; DEC[(slot + dir) * 32 + d] = __expf((dir ? Gb : Gf)[(dir ? 0 : 63) * 33 + d]); }
    __syncthreads();
    { const int dir = w >> 2, mt = (w >> 1) & 1;
#pragma unroll
        for (int q = 0; q < 2; ++q) { const int nt = (w & 1) * 2 + q; f32x4_t acc = {0.f, 0.f, 0.f, 0.f};
#pragma unroll
            for (int ks = 0; ks < 2; ++ks) acc = MFMA16(ldfrag_tr(KDT + dir * 64 * 40, 40, ks * 32, mt * 16, lane), ldfrag_tr(VT, 72, ks * 32, nt * 16, lane), acc);
#pragma unroll
            for (int j = 0; j < 4; ++j) GS[(slot + dir) * 2048 + (mt * 16 + 4 * (lane >> 4) + j) * 64 + nt * 16 + (lane & 15)] = (u16)f2bf(acc[j]); } }
    __syncthreads();
}
DI void sgu_item(const Ctx& p, int l, int item, LAS float* F) {
    const int tid = otid(), lane = tid & 63, w = tid >> 6; const int ch = item >> 2, g = item & 3; const size_t rb = (size_t)ch * 128;
    const u16* P2 = (const u16*)(p.ws + WS_P2); u16* P1 = (u16*)p.out;
    LAS float* OUTF = F; LAS u16* WB = (LAS u16*)(F + 128 * 65); LAS u16* VNT = WB + 128 * 136;
    v4u pu[2], pz[2];
#pragma unroll
    for (int r = 0; r < 2; ++r) { const int task = tid + r * 512, t = task >> 3, c8 = (task & 7) * 8; pu[r] = *(const v4u*)(P2 + (rb + t) * P2P + P2_DU + g * 64 + c8); pz[r] = *(const v4u*)(P1 + (rb + t) * P1P + 1024 + g * 64 + c8); }
    { const int row = tid >> 2, qt = tid & 3; const u16* dv = P2 + (rb + row) * P2P + P2_DV; float ss = 0.f; float f[8];
#pragma unroll
        for (int c = 0; c < 8; ++c) { unpack8(*(const v4u*)(dv + qt * 64 + c * 8), f);
#pragma unroll
            for (int q = 0; q < 8; ++q) ss += f[q] * f[q]; }
        ss += __shfl_xor(ss, 1); ss += __shfl_xor(ss, 2);
        const float rstd = 1.f / sqrtf(ss * (1.f / 256.f) + EPSN); const float* ng = p.tab[17] + l * 256 + g * 64 + qt * 16;
#pragma unroll
        for (int c = 0; c < 2; ++c) { unpack8(*(const v4u*)(dv + g * 64 + qt * 16 + c * 8), f);
#pragma unroll
            for (int q = 0; q < 8; ++q) f[q] = f[q] * rstd * ng[c * 8 + q];
            *(LAS v4u*)(VNT + row * 72 + qt * 16 + c * 8) = pack8(f); } }
    { const float* wsrc = p.tab[18] + (size_t)(l * 4 + g) * 16384;
#pragma unroll
        for (int r = 0; r < 8; ++r) { const int idx = tid + r * 512, t = idx >> 5, s4 = (idx & 31) * 4; const v4f v = *(const v4f*)(wsrc + idx * 4);
            v2u o; o.x = pk2(v.x, v.y); o.y = pk2(v.z, v.w); *(LAS v2u*)(WB + t * 136 + s4) = o; } }
    __syncthreads();
    {
#pragma unroll
        for (int nt = 0; nt < 4; ++nt) { f32x4_t acc = {0.f, 0.f, 0.f, 0.f};
#pragma unroll
            for (int ks = 0; ks < 4; ++ks) acc = MFMA16(ldfrag(WB, 136, w * 16, ks * 32, lane), ldfrag_tr(VNT, 72, ks * 32, nt * 16, lane), acc);
#pragma unroll
            for (int j = 0; j < 4; ++j) OUTF[(w * 16 + 4 * (lane >> 4) + j) * 65 + nt * 16 + (lane & 15)] = acc[j]; } }
    __syncthreads();
#pragma unroll
    for (int r = 0; r < 2; ++r) { const int task = tid + r * 512, t = task >> 3, c8 = (task & 7) * 8; float acc[8];
#pragma unroll
        for (int e = 0; e < 8; ++e) acc[e] = OUTF[t * 65 + c8 + e];
        const float bias = p.tab[19][(l * 4 + g) * 128 + t];
        float uu[8], zz[8]; unpack8(pu[r], uu);
        u16* mz = P1 + (rb + t) * P1P + 1024 + g * 64 + c8; unpack8(pz[r], zz);
#pragma unroll
        for (int e = 0; e < 8; ++e) acc[e] = (acc[e] + bias) * uu[e] * silu_f(zz[e]);
        *(v4u*)mz = pack8(acc); }
    __syncthreads();
}
template <int N1> DI void fnet1_body(const Ctx& p, int row0, int N, int n2, int cb, LAS float* F) {
    constexpr int PN = N1 + 8, MT = N1 / 16, NTW = MT;
    const int tid = otid(), lane = tid & 63, w = tid >> 6;
    const u16* P2 = (const u16*)(p.ws + WS_P2); u16* TP = (u16*)(p.ws + WS_HB + HB_TP);
    const u16* Cg = (const u16*)(p.ws + WS_DFT) + (N1 == 64 ? 0 : 8192); const u16* Sg = Cg + N1 * N1;
    LAS float* tw = F; LAS u16* XT = (LAS u16*)(F + 256); LAS u16* FC = XT + N1 * 136; LAS u16* FS = FC + N1 * PN; LAS u16* OUT = FC;
#pragma unroll
    for (int r = 0; r < N1 / 32; ++r) { const int idx = tid + r * 512, n1 = idx >> 4, c = idx & 15; const v4u raw = *(const v4u*)(P2 + (size_t)(row0 + n1 * 64 + n2) * P2P + P2_BU + cb * 128 + c * 8);
        *(LAS v4u*)(XT + n1 * 136 + c * 8) = raw; }
#pragma unroll
    for (int r = 0; r < N1 * N1 / 8 / 512; ++r) { const int idx = tid + r * 512, k1 = idx / (N1 / 8), c = idx % (N1 / 8);
        *(LAS v4u*)(FC + k1 * PN + c * 8) = *(const v4u*)(Cg + k1 * N1 + c * 8); *(LAS v4u*)(FS + k1 * PN + c * 8) = *(const v4u*)(Sg + k1 * N1 + c * 8); }
    if (tid < N1) { const float ph = 2.f * (float)((n2 * tid) & (N - 1)) / (float)N; tw[2 * tid] = cospif(ph); tw[2 * tid + 1] = sinpif(ph); }
    __syncthreads();
    f32x4_t ac[NTW], as[NTW];
#pragma unroll
    for (int q = 0; q < NTW; ++q) { const int id = w + 8 * q, mt = id % MT, nt = id / MT; ac[q] = (f32x4_t){0.f, 0.f, 0.f, 0.f}; as[q] = ac[q];
#pragma unroll
        for (int ks = 0; ks < N1 / 32; ++ks) { const bf16x8_t b = ldfrag_tr(XT, 136, ks * 32, nt * 16, lane);
            ac[q] = MFMA16(ldfrag(FC, PN, mt * 16, ks * 32, lane), b, ac[q]); as[q] = MFMA16(ldfrag(FS, PN, mt * 16, ks * 32, lane), b, as[q]); } }
    __syncthreads();
    const float scale = 1.f / sqrtf((float)N1);
#pragma unroll
    for (int q = 0; q < NTW; ++q) { const int id = w + 8 * q, mt = id % MT, nt = id / MT;
#pragma unroll
        for (int j = 0; j < 4; ++j) { const int k1 = mt * 16 + 4 * (lane >> 4) + j, col = nt * 16 + (lane & 15); const float cw = tw[2 * k1], sw = tw[2 * k1 + 1];
            const float tr = ac[q][j], ti = -as[q][j];
            OUT[k1 * 256 + col] = (u16)f2bf((tr * cw + ti * sw) * scale); OUT[k1 * 256 + 128 + col] = (u16)f2bf((ti * cw - tr * sw) * scale); } }
    __syncthreads();
#pragma unroll
    for (int r = 0; r < N1 / 16; ++r) { const int idx = tid + r * 512, k1 = idx >> 5, c = idx & 31;
        const v4u v = *(const LAS v4u*)(OUT + k1 * 256 + c * 8);
        *(v4u*)(TP + (size_t)(row0 + k1 * 64 + n2) * 512 + (c >> 4) * 256 + cb * 128 + (c & 15) * 8) = v; }
    __syncthreads();
}
DI void fnet1_item(const Ctx& p, int item, LAS float* F) {
    const int s = item >> 7, r = item & 127, n2 = r >> 1, cb = r & 1; int row0, N; seq_info(s, row0, N);
    if (N == 4096) fnet1_body<64>(p, row0, N, n2, cb, F); else fnet1_body<128>(p, row0, N, n2, cb, F);
}
struct F2Load { v4u t[8]; };
DI F2Load fnet2_load(const Ctx& p, int item) {
    const int tid = otid(); int s, k1; if (item < 256) { s = item >> 6; k1 = item & 63; } else { s = 4 + ((item - 256) >> 7); k1 = (item - 256) & 127; }
    int row0, N; seq_info(s, row0, N); const u16* TP = (const u16*)(p.ws + WS_HB + HB_TP); F2Load r;
#pragma unroll
    for (int q = 0; q < 8; ++q) { const int idx = tid + q * 512, n2 = idx >> 6, c = idx & 63; r.t[q] = *(const v4u*)(TP + (size_t)(row0 + k1 * 64 + n2) * 512 + c * 8); }
    return r;
}
DI void fnet2_item(const Ctx& p, int item, LAS float* F, const F2Load ld) {
    const int tid = otid(), lane = tid & 63, w = tid >> 6; int s, k1; if (item < 256) { s = item >> 6; k1 = item & 63; } else { s = 4 + ((item - 256) >> 7); k1 = (item - 256) & 127; }
    int row0, N; seq_info(s, row0, N); const int N1 = N >> 6;
    u16* P2 = (u16*)(p.ws + WS_P2); const u16* TP = (const u16*)(p.ws + WS_HB + HB_TP); const u16* Cg = (const u16*)(p.ws + WS_DFT); const u16* Sg = Cg + 4096;
    LAS u16* BT = (LAS u16*)F; LAS u16* A1 = BT + 128 * 264; LAS u16* A2 = A1 + 64 * 136; LAS u16* OUT = BT;
#pragma unroll
    for (int r = 0; r < 8; ++r) { const int idx = tid + r * 512, n2 = idx >> 6, c = idx & 63; *(LAS v4u*)(BT + ((c >> 5) * 64 + n2) * 264 + (c & 31) * 8) = ld.t[r]; }
    { const int k2 = tid >> 3, c8 = (tid & 7) * 8; const v4u c = *(const v4u*)(Cg + k2 * 64 + c8), sv = *(const v4u*)(Sg + k2 * 64 + c8); const v4u ns = sv ^ (v4u){0x80008000u, 0x80008000u, 0x80008000u, 0x80008000u};
        *(LAS v4u*)(A1 + k2 * 136 + c8) = c; *(LAS v4u*)(A1 + k2 * 136 + 64 + c8) = sv; *(LAS v4u*)(A2 + k2 * 136 + c8) = ns; *(LAS v4u*)(A2 + k2 * 136 + 64 + c8) = c; }
    __syncthreads();
    f32x4_t acc[16]; const LAS u16* Aw = (w < 4) ? A1 : A2; const int mt = w & 3;
#pragma unroll
    for (int nt = 0; nt < 16; ++nt) { acc[nt] = (f32x4_t){0.f, 0.f, 0.f, 0.f};
#pragma unroll
        for (int ks = 0; ks < 4; ++ks) acc[nt] = MFMA16(ldfrag(Aw, 136, mt * 16, ks * 32, lane), ldfrag_tr(BT, 264, ks * 32, nt * 16, lane), acc[nt]); }
    __syncthreads();
#pragma unroll
    for (int nt = 0; nt < 16; ++nt)
#pragma unroll
        for (int j = 0; j < 4; ++j) OUT[(mt * 16 + 4 * (lane >> 4) + j) * 512 + (w >> 2) * 256 + nt * 16 + (lane & 15)] = (u16)f2bf(acc[nt][j] * 0.125f);
    __syncthreads();
#pragma unroll
    for (int r = 0; r < 8; ++r) { const int idx = tid + r * 512, k2 = idx >> 6, c = idx & 63; const v4u v = *(const LAS v4u*)(OUT + k2 * 512 + c * 8);
        *(v4u*)(P2 + (size_t)(row0 + k1 + N1 * k2) * P2P + P2_U + c * 8) = v; }
    __syncthreads();
}
DI void gla_scan_item(const Ctx& p, int item) {
    const int tid = otid(); const int chain = item >> 2, e = (item & 3) * 512 + tid; const int s = chain >> 3, h = (chain >> 1) & 3, dir = chain & 1;
    int row0, N; seq_info(s, row0, N); const int NC = N >> 6, gc0 = row0 >> 6, d = e >> 6;
    u16* GS = (u16*)(p.ws + WS_HB + HB_GS); const float* DEC = (const float*)(p.ws + WS_DEC);
    float S = 0.f;
    for (int st = 0; st < NC; st += 32) { u16 tmp[32]; float dc[32];
#pragma unroll
        for (int u = 0; u < 32; ++u) { const int c = dir ? NC - 1 - (st + u) : st + u; const size_t slot = (size_t)((gc0 + c) * 4 + h) * 2 + dir; tmp[u] = GS[slot * 2048 + e]; dc[u] = DEC[slot * 32 + d]; }
#pragma unroll
        for (int u = 0; u < 32; ++u) { const int c = dir ? NC - 1 - (st + u) : st + u; const size_t slot = (size_t)((gc0 + c) * 4 + h) * 2 + dir; GS[slot * 2048 + e] = (u16)f2bf(S); S = dc[u] * S + bf2f(tmp[u]); } }
}
struct OLoad { v4u qk, g, v, z; v2u sf, sb; };
DI OLoad gla_out_load(const Ctx& p, int item) {
    const int tid = otid(); const int gc = item >> 2, h = item & 3; const size_t rb = (size_t)gc * 64; const u16* P2 = (const u16*)(p.ws + WS_P2); const u16* P1 = (const u16*)p.out; OLoad r;
    { const int t2 = tid & 255, i = t2 >> 2, c = t2 & 3; const u16* q = P2 + (rb + i) * P2P + h * 32 + c * 8; const int dirb = tid >> 8;
        r.qk = *(const v4u*)(q + (dirb ? P2_AK : P2_AQ)); r.g = *(const v4u*)(q + (dirb ? P2_GB : P2_GF)); }
    { const int i = tid >> 3, c = tid & 7; r.v = *(const v4u*)(P2 + (rb + i) * P2P + P2_AV + h * 64 + c * 8); r.z = *(const v4u*)(P1 + (rb + i) * P1P + h * 64 + c * 8); }
    { const u16* GS = (const u16*)(p.ws + WS_HB + HB_GS); const size_t slot = (size_t)(gc * 4 + h) * 2; const int e4 = tid * 4; r.sf = *(const v2u*)(GS + slot * 2048 + e4); r.sb = *(const v2u*)(GS + (slot + 1) * 2048 + e4); }
    return r;
}
DI void gla_out_item(const Ctx& p, int l, int item, LAS float* F, const OLoad ld) {
    const int tid = otid(), lane = tid & 63, w = tid >> 6; const int gc = item >> 2, h = item & 3; const size_t rb = (size_t)gc * 64;
    const u16* P2 = (const u16*)(p.ws + WS_P2); u16* P1 = (u16*)p.out;
    LAS float* Gf = F; LAS float* Gb = Gf + 2112; LAS float* Qx = Gb + 2112; LAS float* Kx = Qx + 2112; LAS float* O = Kx + 2112;
    LAS u16* QF = (LAS u16*)(O + 64 * 65); LAS u16* KF = QF + 64 * 40; LAS u16* QB = KF + 64 * 40; LAS u16* KB = QB + 64 * 40;
    LAS u16* VT = KB + 64 * 40; LAS u16* SC = VT + 64 * 72; LAS u16* SFT = SC + 64 * 72; LAS u16* SBT = SFT + 32 * 72;
    const u16* GS = (const u16*)(p.ws + WS_HB + HB_GS); const size_t slot = (size_t)(gc * 4 + h) * 2;
    { const int t2 = tid & 255, i = t2 >> 2, c = t2 & 3; const u16* r = P2 + (rb + i) * P2P + h * 32 + c * 8; float f[8];
        const int dirb = tid >> 8; LAS float* d0 = dirb ? Kx : Qx; LAS float* d1 = dirb ? Gb : Gf; const float* bias = p.tab[dirb ? 12 : 10] + l * 128 + h * 32 + c * 8;
        unpack8(ld.qk, f);
#pragma unroll
        for (int q = 0; q < 8; ++q) d0[i * 33 + c * 8 + q] = f[q];
        unpack8(ld.g, f);
#pragma unroll
        for (int q = 0; q < 8; ++q) d1[i * 33 + c * 8 + q] = logsig(f[q] + bias[q]) * (1.f / 16.f); }
    { const int i = tid >> 3, c = tid & 7; *(LAS v4u*)(VT + i * 72 + c * 8) = ld.v; }
    { const int e4 = tid * 4, d = e4 >> 6, v = e4 & 63; *(LAS v2u*)(SFT + d * 72 + v) = ld.sf; *(LAS v2u*)(SBT + d * 72 + v) = ld.sb; }
    __syncthreads();
    if (w == 0) gla_scan_cols(Gf, Gb, lane);
    __syncthreads();
#pragma unroll
    for (int r = 0; r < 4; ++r) { const int e = tid + r * 512, d = e & 31, i = e >> 5, a = i * 33 + d; const float q = Qx[a] * 0.17677669529663687f, k = Kx[a], bf = Gf[a], bb = Gb[a];
        QF[i * 40 + d] = (u16)f2bf(q * __expf(bf)); KF[i * 40 + d] = (u16)f2bf(k * __expf(-bf)); QB[i * 40 + d] = (u16)f2bf(q * __expf(bb)); KB[i * 40 + d] = (u16)f2bf(k * __expf(-bb)); }
    __syncthreads();
#pragma unroll
    for (int q = 0; q < 2; ++q) { const int id = 2 * w + q, ti = id >> 2, si = id & 3; const f32x4_t z4 = {0.f, 0.f, 0.f, 0.f}; f32x4_t acc;
        if (si < ti) acc = MFMA16(ldfrag(QF, 40, ti * 16, 0, lane), ldfrag(KF, 40, si * 16, 0, lane), z4);
        else if (si > ti) acc = MFMA16(ldfrag(QB, 40, ti * 16, 0, lane), ldfrag(KB, 40, si * 16, 0, lane), z4);
        else { const f32x4_t af = MFMA16(ldfrag(QF, 40, ti * 16, 0, lane), ldfrag(KF, 40, si * 16, 0, lane), z4), ab = MFMA16(ldfrag(QB, 40, ti * 16, 0, lane), ldfrag(KB, 40, si * 16, 0, lane), z4);
#pragma unroll
            for (int j = 0; j < 4; ++j) acc[j] = ((lane & 15) <= 4 * (lane >> 4) + j) ? af[j] : ab[j]; }
#pragma unroll
        for (int j = 0; j < 4; ++j) SC[(ti * 16 + 4 * (lane >> 4) + j) * 72 + si * 16 + (lane & 15)] = (u16)f2bf(acc[j]); }
    __syncthreads();
#pragma unroll
    for (int q = 0; q < 2; ++q) { const int id = 2 * w + q, ti = id >> 2, vi = id & 3; f32x4_t acc = {0.f, 0.f, 0.f, 0.f};
        acc = MFMA16(ldfrag(SC, 72, ti * 16, 0, lane), ldfrag_tr(VT, 72, 0, vi * 16, lane), acc);
        acc = MFMA16(ldfrag(SC, 72, ti * 16, 32, lane), ldfrag_tr(VT, 72, 32, vi * 16, lane), acc);
        acc = MFMA16(ldfrag(QF, 40, ti * 16, 0, lane), ldfrag_tr(SFT, 72, 0, vi * 16, lane), acc);
        acc = MFMA16(ldfrag(QB, 40, ti * 16, 0, lane), ldfrag_tr(SBT, 72, 0, vi * 16, lane), acc);
#pragma unroll
        for (int j = 0; j < 4; ++j) O[(ti * 16 + 4 * (lane >> 4) + j) * 65 + vi * 16 + (lane & 15)] = acc[j]; }
    __syncthreads();
    { const int t = tid >> 3, v8 = (tid & 7) * 8; float acc[8]; float ss = 0.f;
#pragma unroll
        for (int e = 0; e < 8; ++e) { acc[e] = O[t * 65 + v8 + e]; ss += acc[e] * acc[e]; }
        ss += __shfl_xor(ss, 1); ss += __shfl_xor(ss, 2); ss += __shfl_xor(ss, 4);
        const float rstd = 1.f / sqrtf(ss * (1.f / 64.f) + EPSN);
        u16* mz = P1 + (rb + t) * P1P + h * 64 + v8; float zz[8]; unpack8(ld.z, zz);
#pragma unroll
        for (int e = 0; e < 8; ++e) acc[e] = acc[e] * rstd * p.tab[13][l * 64 + v8 + e] * silu_f(zz[e]);
        *(v4u*)mz = pack8(acc); }
    __syncthreads();
}
#define XB_TMO      128
#define XB_XCNT(j)  (256  + 64 * (j))
#define XB_XSUB(j)  (1280 + 64 * (j))
#define XB_XGEN(j)  (2304 + 64 * (j))
#define XB_TOP      3328
#define XB_TOPGEN   3392
#define XCD_BAR_WORDS 3456
#define XB_SPIN_CAP (1u << 18)

__device__ __forceinline__ unsigned xb_ld(unsigned* p)              { return __hip_atomic_load(p, __ATOMIC_RELAXED, __HIP_MEMORY_SCOPE_AGENT); }
__device__ __forceinline__ unsigned xb_add(unsigned* p, unsigned v) { return __hip_atomic_fetch_add(p, v, __ATOMIC_RELAXED, __HIP_MEMORY_SCOPE_AGENT); }
__device__ __forceinline__ unsigned xb_xcc_id() { return (unsigned)__builtin_amdgcn_s_getreg((3 << 11) | 20) & 0xFu; }
#define XB_SPIN(cond, bar) do { unsigned _sp = 0; while (cond) { __builtin_amdgcn_s_sleep(1); \
    if ((++_sp & 255u) == 0u) { if (xb_ld(&(bar)[XB_TMO])) break; if (_sp > XB_SPIN_CAP) { atomicAdd(&(bar)[XB_TMO], 1u); break; } } } } while (0)

struct XcdBarrier {
    unsigned* bar; unsigned x;
    volatile LAS unsigned* st;
};

__device__ __forceinline__ XcdBarrier xcd_barrier_post(unsigned* bar, volatile LAS unsigned* st) {
    XcdBarrier b; b.bar = bar; b.x = xb_xcc_id(); b.st = st;
    if (threadIdx.x == 0) (void)xb_add(&bar[XB_XCNT(b.x)], 1u);
    return b;
}
__device__ __forceinline__ void xcd_barrier_complete(unsigned* bar, unsigned x, unsigned& nloc, unsigned& nx) {
    const unsigned G = gridDim.x * gridDim.y * gridDim.z;
    unsigned sum, cnt, mine, sp = 0u;
    for (;;) {
        sum = 0u; cnt = 0u; mine = 0u;
#pragma unroll
        for (unsigned j = 0; j < 16; ++j) { const unsigned c = xb_ld(&bar[XB_XCNT(j)]); sum += c; cnt += (c > 0u) ? 1u : 0u; mine = (j == x) ? c : mine; }
        if (sum == G) break;
        __builtin_amdgcn_s_sleep(1);
        if ((++sp & 255u) == 0u) { if (xb_ld(&bar[XB_TMO])) break; if (sp > XB_SPIN_CAP) { atomicAdd(&bar[XB_TMO], 1u); break; } }
    }
    nloc = mine > 0u ? mine : 1u; nx = cnt > 0u ? cnt : 1u;
}

__device__ __forceinline__ void xcd_barrier(const XcdBarrier& b) {
    asm volatile("s_waitcnt vmcnt(0)" ::: "memory");
    __syncthreads();
    if (threadIdx.x == 0) {
        unsigned* bar = b.bar;
        __builtin_amdgcn_s_waitcnt(0);
        unsigned nloc = b.st[0], nx = b.st[1];
        if (nloc == 0u) { xcd_barrier_complete(bar, b.x, nloc, nx); b.st[0] = nloc; b.st[1] = nx; }
        const unsigned old = xb_add(&bar[XB_XSUB(b.x)], 1u);
        const unsigned gen = old / nloc;
        if (old + 1u == (gen + 1u) * nloc) {
            __builtin_amdgcn_fence(__ATOMIC_RELEASE, "agent");
            asm volatile("s_waitcnt vmcnt(0)" ::: "memory");
            const unsigned og = xb_add(&bar[XB_TOP], 1u);
            const unsigned tg = og / nx;
            if (og + 1u == (tg + 1u) * nx) xb_add(&bar[XB_TOPGEN], 1u);
            else XB_SPIN(xb_ld(&bar[XB_TOPGEN]) == tg, bar);
            __builtin_amdgcn_fence(__ATOMIC_ACQUIRE, "agent");
            xb_add(&bar[XB_XGEN(b.x)], 1u);
            asm volatile("s_waitcnt vmcnt(0)" ::: "memory");
        } else {
            XB_SPIN(xb_ld(&bar[XB_XGEN(b.x)]) == gen, bar);
            __builtin_amdgcn_fence(__ATOMIC_ACQUIRE, "agent");
            asm volatile("s_waitcnt vmcnt(0)" ::: "memory");
        }
    }
    __syncthreads();
}


#ifndef GM
#define GM 7
#endif
#ifndef PH
#define PH 1023
#endif
__global__ void __launch_bounds__(512, 2) fwd_kernel(Params kp) {
    extern __shared__ __attribute__((aligned(16))) unsigned char lds[];
    cg::grid_group grid = cg::this_grid();
    LAS unsigned char* L = (LAS unsigned char*)lds; LAS float* F = (LAS float*)lds;
    const int G = gridDim.x, bid = blockIdx.x;
    Ctx p; p.out = kp.out; p.ws = kp.ws; p.tab = (LAS cfp*)(L + 131072);
    if (otid() == 0) { p.tab[0] = kp.xp; p.tab[1] = kp.xs; p.tab[2] = kp.cp; p.tab[3] = kp.cs; p.tab[4] = kp.ada_w; p.tab[5] = kp.ada_b; p.tab[6] = kp.pre_g; p.tab[7] = kp.post_g; p.tab[8] = kp.w_in;
        p.tab[9] = kp.wg2f; p.tab[10] = kp.bgf; p.tab[11] = kp.wg2b; p.tab[12] = kp.bgb; p.tab[13] = kp.onorm_g; p.tab[14] = kp.fnet_w; p.tab[15] = kp.qn_g; p.tab[16] = kp.kn_g; p.tab[17] = kp.sgu_ng;
        p.tab[18] = kp.sgu_w; p.tab[19] = kp.sgu_b; p.tab[20] = kp.w_out; }
    volatile LAS unsigned* bst = (volatile LAS unsigned*)(L + 131072 + 256);
    if (otid() < 4) bst[otid()] = 0u;
    __syncthreads();
    const XcdBarrier xbar = xcd_barrier_post((unsigned*)(p.ws + WS_BAR), bst);
    u16* P1 = (u16*)p.out; u16* P2 = (u16*)(p.ws + WS_P2); u16* HB = (u16*)(p.ws + WS_HB); u16* U0 = (u16*)(p.ws + WS_U0);


#if PH & 1
    phase0(p, L);
#endif
    grid.sync();
    for (int step = 0; step < 12; ++step) {
        const int l = step / 6, ph = step % 6;
        bool do_gemm = false; pg8::Gemm g{nullptr, nullptr, T_TOK, 0, 0, 0, 0}; pg8::EpiX E{0, nullptr, 0, nullptr, 0, 0};
        if (ph == 0) {
#if PH & 2
            phaseA(p, l);
#endif
        } else if (ph == 1) {
            g.A = HB; g.Bt = (const u16*)(p.ws + WS_WIN) + (size_t)l * 3584 * 1024; g.N = 3584; g.K = 1024; g.lda = 1024; g.ldb = 1024;
            E.mode = 0; E.O1 = P1; E.ld1 = P1P; E.O2 = P2; E.ld2 = P2P; do_gemm = true;
        } else if (ph == 2) {
#if PH & 4
            qk_prep(p, l);
#endif
#if PH & 8
            { GLoad nx = gla_local_load(p, bid < 2048 ? bid : 0); for (int it = bid; it < 2048; it += G) { const GLoad cur = nx; if (it + G < 2048) nx = gla_local_load(p, it + G); gla_local_item(p, l, it, F, cur); } }
#endif
#if PH & 16
            for (int it = bid; it < 1024; it += G) sgu_item(p, l, it, F);
#endif
#if PH & 32
            for (int it = bid; it < 768; it += G) fnet1_item(p, it, F);
#endif
        } else if (ph == 3) {
#if PH & 64
            for (int it = bid; it < 192; it += G) gla_scan_item(p, it);
#endif
#if PH & 128
            { F2Load nx = fnet2_load(p, bid < 512 ? bid : 0); for (int it = bid; it < 512; it += G) { const F2Load cur = nx; if (it + G < 512) nx = fnet2_load(p, it + G); fnet2_item(p, it, F, cur); } }
#endif
            __syncthreads();
#ifndef SKIP_ATTN
            for (int u = ((G & 7) == 0 ? (bid & 7) * (G >> 3) + (bid >> 3) : bid); u < 1024; u += G) {
                int s, h, qb;
                if (u < 512) { s = u >> 7; const int r = u & 127; h = r >> 4; qb = r & 15; } else { const int u2 = u - 512; s = 4 + (u2 >> 8); const int r = u2 & 255; h = r >> 5; qb = r & 31; }
                int row0, N; seq_info(s, row0, N);
                const attn_body::bf16* Pb = (const attn_body::bf16*)P1;
                const attn_body::bf16* KCb = (const attn_body::bf16*)(p.ws + WS_HB + HB_KC) + ((size_t)row0 * 2 + (size_t)(h >> 2) * N) * 64;
                const attn_body::bf16* VCb = (const attn_body::bf16*)(p.ws + WS_HB + HB_VC) + ((size_t)row0 * 2 + (size_t)(h >> 2) * N) * 64;
                attn_body::attn_unit<8>(Pb + (size_t)(row0 + qb * 256) * P1P + P1_Q + h * 64, KCb, VCb,
                                        (attn_body::bf16*)P1 + (size_t)(row0 + qb * 256) * P1P + 512 + h * 64, N >> 6, (char*)lds);
            }
#endif
        } else if (ph == 4) {
#if PH & 256
            if (G == 256) { const int i0 = bid < 128 ? bid * 7 : 896 + (bid - 128) * 9, i1 = i0 + (bid < 128 ? 7 : 9);
                OLoad nx = gla_out_load(p, i0); for (int it = i0; it < i1; ++it) { const OLoad cur = nx; if (it + 1 < i1) nx = gla_out_load(p, it + 1); gla_out_item(p, l, it, F, cur); } }
            else { OLoad nx = gla_out_load(p, bid < 2048 ? bid : 0); for (int it = bid; it < 2048; it += G) { const OLoad cur = nx; if (it + G < 2048) nx = gla_out_load(p, it + G); gla_out_item(p, l, it, F, cur); } }
#endif
            g.A = P2 + P2_U; g.Bt = (const u16*)(p.ws + WS_WF) + (size_t)l * 131072; g.N = 256; g.K = 512; g.lda = P2P; g.ldb = 512;
            E.mode = 2; E.O1 = P1; E.ld1 = P1P; E.col_off = 256; do_gemm = true;
        } else {
            g.A = P1; g.Bt = (const u16*)(p.ws + WS_WOUT) + (size_t)l * 1024 * 1280; g.N = 1024; g.K = 1280; g.lda = P1P; g.ldb = 1280;
            E.mode = 1; E.O1 = (l == 0) ? U0 : HB; E.ld1 = 1024; do_gemm = true;
        }
#if GM
        if (do_gemm) { pg8::StaticOrder S; S.init(T_TOK, g.N, G, bid); pg8::gemm_phase<pg8::EpiX, pg8::StaticOrder, PG8_ALIGN, PG8_SP2>(L, g, S, E); }
#endif
        xcd_barrier(xbar);
    }
#if PH & 2
    phaseA(p, 2);
#endif
}

extern "C" void kernel_launch(void* const* d_in, const int* in_sizes, int n_in, void* d_out, int out_size, void* d_ws, size_t ws_size, hipStream_t stream) {
    static int grid = 0;
    if (grid == 0) {
        if (n_in != 21 || out_size != T_TOK * 1024 || ws_size < WS_END) { fprintf(stderr, "kernel_launch: unexpected sizes n_in %d out %d ws %zu\n", n_in, out_size, ws_size); grid = -1; return; }
        int dev = 0, cus = 0, per_cu = 0;
        (void)hipGetDevice(&dev); (void)hipDeviceGetAttribute(&cus, hipDeviceAttributeMultiprocessorCount, dev);
        if (hipFuncSetAttribute((const void*)fwd_kernel, hipFuncAttributeMaxDynamicSharedMemorySize, LDS_BYTES) != hipSuccess) { fprintf(stderr, "kernel_launch: hipFuncSetAttribute failed\n"); grid = -1; return; }
        if (hipOccupancyMaxActiveBlocksPerMultiprocessor(&per_cu, (const void*)fwd_kernel, 512, LDS_BYTES) != hipSuccess || per_cu < 1) { fprintf(stderr, "kernel_launch: occupancy query gave %d\n", per_cu); per_cu = 1; }
        (void)hipGetLastError();
        grid = cus * 1;
        fprintf(stderr, "kernel_launch: grid %d (per_cu %d) ws %zu\n", grid, per_cu, ws_size);
    }
    if (grid < 0) return;
    Params p{};
    const float** pp = (const float**)&p;
    for (int i = 0; i < 21; ++i) pp[i] = (const float*)d_in[i];
    p.out = (float*)d_out; p.ws = (unsigned char*)d_ws;
    if (hipMemsetAsync((char*)d_ws + WS_MOD, 0, 2 * 6 * 3072 * sizeof(float), stream) != hipSuccess) { fprintf(stderr, "kernel_launch: memset failed\n"); return; }
    if (hipMemsetAsync((char*)d_ws + WS_BAR, 0, BAR_BYTES, stream) != hipSuccess) { fprintf(stderr, "kernel_launch: memset failed\n"); return; }
    void* args[] = {&p};
    hipError_t e = hipLaunchCooperativeKernel((const void*)fwd_kernel, dim3(grid), dim3(512), args, LDS_BYTES, stream);
    if (e != hipSuccess) fprintf(stderr, "cooperative launch failed: %s (grid %d)\n", hipGetErrorString(e), grid);
}
```

```cpp
#include <hip/hip_runtime.h>
#include <hip/hip_cooperative_groups.h>
#include <cstdio>
#include <cstdint>
namespace cg = cooperative_groups;
__device__ __forceinline__ int otid() { int t = threadIdx.x; asm volatile("" : "+v"(t)); return t; }
namespace pg8 {
#define PG8_LAS __attribute__((address_space(3)))
typedef unsigned short bf16_t;
typedef short bf16x8 __attribute__((ext_vector_type(8)));
typedef float f32x4 __attribute__((ext_vector_type(4)));
typedef unsigned u32x4 __attribute__((ext_vector_type(4)));
constexpr int BM = 256, BK = 64, HALF = 128, HTB = HALF * BK * 2  , STAGE_BYTES = 8 * HTB, NXCD = 8, WGM = 8;

__host__ __device__ __forceinline__ int lds_byte(int r, int c) { const int st = (r >> 4) * 2 + (c >> 5), rr = r & 15, cc = c & 31, ob = rr * 64 + cc * 2; return st * 1024 + (ob ^ (((ob >> 9) & 1) << 5)); }
__host__ __device__ __forceinline__ void stage_rc(int b, int& R, int& C) { const int st = b / 1024, sb = b % 1024, swz = sb ^ (((sb >> 9) & 1) << 5); R = (st >> 1) * 16 + swz / 64; C = (st & 1) * 32 + (swz % 64) / 2; }
__host__ __device__ __forceinline__ int perm32(int rho) { const int n = rho >> 4, i = rho & 15; return 8 * (i >> 2) + 4 * n + (i & 3); }

struct Unit { int pm, pn; };
struct Gemm { const bf16_t* A; const bf16_t* Bt; int M, N, K, lda, ldb; };

struct StaticOrder {
    int nM, nN, nwg, G, c;
    __host__ __device__ void init(int M, int N, int G_, int c_) { nM = M / BM; nN = N / BM; nwg = nM * nN; G = G_; c = c_; }
    __host__ __device__ bool next(int i, Unit& u) const {
        const long L = (long)i * G + c; if (L >= nwg) return false;
        int wgid = (int)L; { const int q = nwg / NXCD, r = nwg % NXCD, xcd = wgid % NXCD, off = wgid / NXCD; wgid = (xcd < r ? xcd * (q + 1) : r * (q + 1) + (xcd - r) * q) + off; }
        const int nig = WGM * nN, gid = wgid / nig, fm = gid * WGM, gsz = (nM - fm) < WGM ? (nM - fm) : WGM;
        u.pm = fm + ((wgid % nig) % gsz); u.pn = (wgid % nig) / gsz; return true;
    }
    __device__ __forceinline__ void a_ready(const Unit&) const {}
    __device__ __forceinline__ void done(const Unit&) const {}
};

__device__ __forceinline__ unsigned cvt_pk_bf16(float lo, float hi) { unsigned r; asm volatile("v_cvt_pk_bf16_f32 %0, %1, %2" : "=v"(r) : "v"(lo), "v"(hi)); return r; }
__device__ __forceinline__ float silu_f(float z) { return z / (1.f + __expf(-z)); }
struct EpiX {
    static constexpr bool PERM = true, AFTER_DRAIN = false;
    int mode; bf16_t* O1; int ld1; bf16_t* O2; int ld2; int col_off;
    __device__ __forceinline__ void operator()(const f32x4 (&acc)[2][2][4][2], const Unit& u, int wr, int wc, int fr, int fq) const {
        const int row0 = u.pm * BM + wr * 64 + fr;
        bf16_t* base; int ld, colt;
        if (mode == 0) { if (u.pn < 8) { base = O1; ld = ld1; colt = u.pn * BM; } else { base = O2; ld = ld2; colt = (u.pn - 8) * BM; } }
        else { base = O1; ld = ld1; colt = col_off + u.pn * BM; }
        const int col0 = colt + wc * 32 + 8 * fq;
#pragma unroll
        for (int ai = 0; ai < 2; ++ai)
#pragma unroll
            for (int m = 0; m < 4; ++m) { bf16_t* rowp = base + (size_t)(row0 + ai * HALF + m * 16) * ld + col0;
#pragma unroll
                for (int bj = 0; bj < 2; ++bj) { f32x4 v0 = acc[ai][bj][m][0], v1 = acc[ai][bj][m][1];
                    if (mode == 2) { const u32x4 z = *(const u32x4*)(rowp + bj * HALF);
                        v0[0] *= silu_f(__uint_as_float(z.x << 16)); v0[1] *= silu_f(__uint_as_float(z.x & 0xffff0000u));
                        v0[2] *= silu_f(__uint_as_float(z.y << 16)); v0[3] *= silu_f(__uint_as_float(z.y & 0xffff0000u));
                        v1[0] *= silu_f(__uint_as_float(z.z << 16)); v1[1] *= silu_f(__uint_as_float(z.z & 0xffff0000u));
                        v1[2] *= silu_f(__uint_as_float(z.w << 16)); v1[3] *= silu_f(__uint_as_float(z.w & 0xffff0000u)); }
                    u32x4 w; w.x = cvt_pk_bf16(v0[0], v0[1]); w.y = cvt_pk_bf16(v0[2], v0[3]); w.z = cvt_pk_bf16(v1[0], v1[1]); w.w = cvt_pk_bf16(v1[2], v1[3]);
                    *(u32x4*)(rowp + bj * HALF) = w; } }
    }
};
#ifndef PG8_SP2
#define PG8_SP2 true
#endif
#ifndef PG8_ALIGN
#define PG8_ALIGN true
#endif
template <class Epi, class Sched, bool ALIGN_EPI = false, bool SP2 = false>
__device__ __forceinline__ void gemm_phase(PG8_LAS unsigned char* lds, const Gemm g, const Sched& S, const Epi& E) {
    const int tid = otid(), wid = __builtin_amdgcn_readfirstlane(tid >> 6), lane = tid & 63, wr = wid >> 2, wc = wid & 3, fr = lane & 15, fq = lane >> 4;
    const int K = g.K, nt = K / BK;
    unsigned voffA[2], voffB[2];
#pragma unroll
    for (int i = 0; i < 2; ++i) { int R, C; stage_rc(tid * 16 + i * 8192, R, C); const int Rb = Epi::PERM ? ((R & ~31) + perm32(R & 31)) : R;
        voffA[i] = (unsigned)(R * g.lda + C) * 2u; voffB[i] = (unsigned)(Rb * g.ldb + C) * 2u; }
    const size_t kstep = (size_t)(BK * 2);
    const size_t hstepA = (size_t)HALF * g.lda * 2, hstepB = (size_t)HALF * g.ldb * 2;
    const size_t tstepA = 2 * hstepA, tstepB = 2 * hstepB;
    const unsigned ldsw = (unsigned)wid * 1024u;
    const int aoff = lds_byte(wr * 64 + fr, fq * 8), boff = lds_byte(wc * 32 + fr, fq * 8);
#define PG8_SA(b, h) (((b) * 2 + (h)) * HTB)
#define PG8_SB(b, h) ((4 + (b) * 2 + (h)) * HTB)
#define PG8_STAGE(bufoff, gbase, voff) do { _Pragma("unroll") for (int _i = 0; _i < 2; ++_i) \
        __builtin_amdgcn_global_load_lds((const unsigned*)((const char*)(gbase) + (voff)[_i]), (PG8_LAS unsigned*)(lds + (bufoff) + ldsw + _i * 8192), 16, 0, 0); } while (0)
#define PG8_LDA(dst, b, h) do { _Pragma("unroll") for (int m = 0; m < 4; ++m) _Pragma("unroll") for (int k = 0; k < 2; ++k) dst[m][k] = *(const PG8_LAS bf16x8*)(lds + PG8_SA(b, h) + aoff + m * 2048 + k * 1024); } while (0)
#define PG8_LDB(dst, b, h) do { _Pragma("unroll") for (int n = 0; n < 2; ++n) _Pragma("unroll") for (int k = 0; k < 2; ++k) dst[n][k] = *(const PG8_LAS bf16x8*)(lds + PG8_SB(b, h) + boff + n * 2048 + k * 1024); } while (0)
#define PG8_MMA(ai, bj, At, Bt) do { __builtin_amdgcn_s_setprio(1); _Pragma("unroll") for (int m = 0; m < 4; ++m) _Pragma("unroll") for (int n = 0; n < 2; ++n) _Pragma("unroll") for (int k = 0; k < 2; ++k) \
        acc[ai][bj][m][n] = __builtin_amdgcn_mfma_f32_16x16x32_bf16(Bt[n][k], At[m][k], acc[ai][bj][m][n], 0, 0, 0); __builtin_amdgcn_s_setprio(0); } while (0)
#define PG8_WAIT_V(n) asm volatile("s_waitcnt vmcnt(" #n ")" ::: "memory")
#define PG8_WAIT_L(n) asm volatile("s_waitcnt lgkmcnt(" #n ")" ::: "memory")
#define PG8_BAR __builtin_amdgcn_s_barrier()
#define PG8_SCHED __builtin_amdgcn_sched_barrier(0)
    Unit cur, nxt; int ui = 0;
    if (!S.next(0, cur)) return;
    f32x4 acc[2][2][4][2];
#pragma unroll
    for (int a = 0; a < 2; ++a)
#pragma unroll
        for (int b = 0; b < 2; ++b)
#pragma unroll
            for (int m = 0; m < 4; ++m)
#pragma unroll
                for (int n = 0; n < 2; ++n) acc[a][b][m][n] = (f32x4){0.f, 0.f, 0.f, 0.f};
    bf16x8 At[4][2], B0[2][2], B1[2][2];
    const char* cA = (const char*)g.A + (size_t)cur.pm * tstepA; const char* cB = (const char*)g.Bt + (size_t)cur.pn * tstepB;
    S.a_ready(cur);
    if constexpr (SP2) {
        PG8_STAGE(PG8_SB(0, 0), cB, voffB); PG8_STAGE(PG8_SB(0, 1), cB + hstepB, voffB); PG8_STAGE(PG8_SA(0, 0), cA, voffA); PG8_STAGE(PG8_SA(0, 1), cA + hstepA, voffA);
        if (wr == 1) PG8_BAR;
        PG8_WAIT_V(2); PG8_BAR;
        PG8_STAGE(PG8_SB(1, 0), cB + kstep, voffB); PG8_STAGE(PG8_SA(1, 0), cA + kstep, voffA); PG8_STAGE(PG8_SB(1, 1), cB + hstepB + kstep, voffB);
        PG8_WAIT_V(6); PG8_BAR;
    } else {
        PG8_STAGE(PG8_SB(0, 0), cB, voffB); PG8_STAGE(PG8_SA(0, 0), cA, voffA); PG8_STAGE(PG8_SB(0, 1), cB + hstepB, voffB); PG8_STAGE(PG8_SA(0, 1), cA + hstepA, voffA);
        if (wr == 1) PG8_BAR;
        PG8_WAIT_V(4); PG8_BAR;
        PG8_STAGE(PG8_SB(1, 0), cB + kstep, voffB); PG8_STAGE(PG8_SA(1, 0), cA + kstep, voffA); PG8_STAGE(PG8_SB(1, 1), cB + hstepB + kstep, voffB);
        PG8_WAIT_V(6); PG8_BAR;
    }
    for (;;) {
        const bool has_next = S.next(ui + 1, nxt);
        const char* nA = has_next ? (const char*)g.A + (size_t)nxt.pm * tstepA : cA; const char* nB = has_next ? (const char*)g.Bt + (size_t)nxt.pn * tstepB : cB;
        for (int t = 0; t < nt; t += 2) {
            const bool last = (t == nt - 2);
            const char* a1 = cA + (size_t)(t + 1) * kstep;
            const char* a2 = last ? nA : cA + (size_t)(t + 2) * kstep; const char* b2 = last ? nB : cB + (size_t)(t + 2) * kstep;
            const char* a3 = a2 + kstep; const char* b3 = b2 + kstep;
            if (last && has_next) S.a_ready(nxt);
            if constexpr (SP2) {
            PG8_LDB(B0, 0, 0); PG8_LDB(B1, 0, 1); PG8_SCHED; PG8_LDA(At, 0, 0); PG8_STAGE(PG8_SA(1, 1), a1 + hstepA, voffA);
            PG8_WAIT_V(8); PG8_WAIT_L(0); PG8_BAR; PG8_MMA(0, 0, At, B0); PG8_MMA(0, 1, At, B1); PG8_BAR; PG8_SCHED;
            PG8_LDA(At, 0, 1); PG8_STAGE(PG8_SB(0, 0), b2, voffB); PG8_STAGE(PG8_SB(0, 1), b2 + hstepB, voffB); PG8_STAGE(PG8_SA(0, 0), a2, voffA);
            PG8_WAIT_V(8); PG8_WAIT_L(0); PG8_BAR; PG8_MMA(1, 0, At, B0); PG8_MMA(1, 1, At, B1); PG8_BAR; PG8_SCHED;
            PG8_LDB(B0, 1, 0); PG8_LDB(B1, 1, 1); PG8_SCHED; PG8_LDA(At, 1, 0); PG8_STAGE(PG8_SA(0, 1), a2 + hstepA, voffA);
            PG8_WAIT_V(8); PG8_WAIT_L(0); PG8_BAR; PG8_MMA(0, 0, At, B0); PG8_MMA(0, 1, At, B1); PG8_BAR; PG8_SCHED;
            PG8_LDA(At, 1, 1); PG8_STAGE(PG8_SB(1, 0), b3, voffB); PG8_STAGE(PG8_SB(1, 1), b3 + hstepB, voffB); PG8_STAGE(PG8_SA(1, 0), a3, voffA);
            PG8_WAIT_V(8); PG8_WAIT_L(0); PG8_BAR; PG8_MMA(1, 0, At, B0); PG8_MMA(1, 1, At, B1); PG8_BAR; PG8_SCHED;
            } else {
            PG8_LDB(B0, 0, 0); PG8_SCHED; PG8_LDA(At, 0, 0); PG8_STAGE(PG8_SA(1, 1), a1 + hstepA, voffA);
            PG8_WAIT_L(8); PG8_BAR; PG8_WAIT_L(0); PG8_MMA(0, 0, At, B0); PG8_BAR; PG8_SCHED;
            PG8_LDB(B1, 0, 1); PG8_STAGE(PG8_SB(0, 0), b2, voffB);
            PG8_BAR; PG8_WAIT_L(0); PG8_MMA(0, 1, At, B1); PG8_BAR;
            PG8_LDA(At, 0, 1); PG8_STAGE(PG8_SA(0, 0), a2, voffA);
            PG8_BAR; PG8_WAIT_L(0); PG8_MMA(1, 0, At, B0); PG8_BAR; PG8_SCHED;
            PG8_STAGE(PG8_SB(0, 1), b2 + hstepB, voffB);
            PG8_WAIT_V(6); PG8_BAR; PG8_MMA(1, 1, At, B1); PG8_BAR;
            PG8_LDB(B0, 1, 0); PG8_SCHED; PG8_LDA(At, 1, 0); PG8_STAGE(PG8_SA(0, 1), a2 + hstepA, voffA);
            PG8_WAIT_L(8); PG8_BAR; PG8_WAIT_L(0); PG8_MMA(0, 0, At, B0); PG8_BAR; PG8_SCHED;
            PG8_LDB(B1, 1, 1); PG8_STAGE(PG8_SB(1, 0), b3, voffB);
            PG8_BAR; PG8_WAIT_L(0); PG8_MMA(0, 1, At, B1); PG8_BAR;
            PG8_LDA(At, 1, 1); PG8_STAGE(PG8_SA(1, 0), a3, voffA);
            PG8_BAR; PG8_WAIT_L(0); PG8_MMA(1, 0, At, B0); PG8_BAR; PG8_SCHED;
            PG8_STAGE(PG8_SB(1, 1), b3 + hstepB, voffB);
            PG8_WAIT_V(6); PG8_BAR; PG8_MMA(1, 1, At, B1); PG8_BAR;
            }
        }
        if constexpr (ALIGN_EPI) { if (wr == 0) PG8_BAR; }
        if constexpr (!Epi::AFTER_DRAIN) { E(acc, cur, wr, wc, fr, fq); S.done(cur); }
        if (!has_next) break;
#pragma unroll
        for (int a = 0; a < 2; ++a)
#pragma unroll
            for (int b = 0; b < 2; ++b)
#pragma unroll
                for (int m = 0; m < 4; ++m)
#pragma unroll
                    for (int n = 0; n < 2; ++n) acc[a][b][m][n] = (f32x4){0.f, 0.f, 0.f, 0.f};
        cur = nxt; cA = nA; cB = nB; ++ui;
        if constexpr (ALIGN_EPI) { if (wr == 1) PG8_BAR; }
    }
    PG8_WAIT_V(0);
    if constexpr (!ALIGN_EPI) { if (wr == 0) PG8_BAR; }
    PG8_BAR;
    if constexpr (Epi::AFTER_DRAIN) { E.fused(acc, cur, wr, wc, fr, fq, lds, wid, lane); S.done(cur); }
#undef PG8_SA
#undef PG8_SB
#undef PG8_STAGE
#undef PG8_LDA
#undef PG8_LDB
#undef PG8_MMA
#undef PG8_WAIT_V
#undef PG8_WAIT_L
#undef PG8_BAR
#undef PG8_SCHED
}
}
#include <hip/hip_bf16.h>
#include <cmath>
namespace attn_body {
using bf16=__hip_bfloat16;
using bf16x8=__attribute__((ext_vector_type(8)))short;
using s16x4=__attribute__((ext_vector_type(4)))short;
using f32x16=__attribute__((ext_vector_type(16)))float;
using u32x4=__attribute__((ext_vector_type(4)))unsigned;
constexpr int D=64,DM=2048,KDM=64;
constexpr int NW=8,QBLK=32,QB=QBLK*NW,KVBLK=64;
constexpr int ATTN_PITCH=DM, ATTN_UNIT_ROWS=QB;
__device__ __forceinline__ int crow(int r,int hi){return (r&3)+8*(r>>2)+4*hi;}
#define SBAR() __builtin_amdgcn_sched_barrier(0)
__device__ __forceinline__ void cmask(f32x16&p0,f32x16&p1,int jb,int qrel,int hi){
  const float NEG=-INFINITY; int kb=64*jb+4*hi;
  #pragma unroll
  for(int r=0;r<16;++r){int kv=kb+(r&3)+8*(r>>2); if(kv>qrel)p0[r]=NEG; if(kv+32>qrel)p1[r]=NEG;}
}

constexpr int NSLOT=3, SLOTB=8192;
constexpr int LDS_K=0, LDS_V=NSLOT*SLOTB, LDS_WS=2*NSLOT*SLOTB, LDS_OST=LDS_WS+NW*64*4, LDS_BYTES=LDS_OST+NW*4096;
constexpr float C2=0.125f*1.4426950408889634f;
__device__ __forceinline__ void glds16(const void*gsrc,unsigned lds_dst){unsigned keep;
  asm volatile("s_mov_b32 %0, m0\n\ts_mov_b32 m0, %2\n\ts_nop 0\n\tglobal_load_lds_dwordx4 %1, off\n\ts_mov_b32 m0, %0":"=&s"(keep):"v"(gsrc),"s"(lds_dst):"memory");}
__device__ __forceinline__ float max3f(float a,float b,float c){float r;asm("v_max3_f32 %0, %1, %2, %3":"=v"(r):"v"(a),"v"(b),"v"(c));return r;}
__device__ __forceinline__ float max2f(float a,float b){float r;asm("v_max_f32_e32 %0, %1, %2":"=v"(r):"v"(a),"v"(b));return r;}
__device__ __forceinline__ float fadd_s(float a,float b){float r;asm("v_add_f32_e32 %0, %1, %2":"=v"(r):"v"(a),"v"(b));return r;}
__device__ __forceinline__ float fsub_s(float a,float b){float r;asm("v_sub_f32_e32 %0, %1, %2":"=v"(r):"v"(a),"v"(b));return r;}
typedef float f32x2_t __attribute__((ext_vector_type(2))); typedef __bf16 bf16x2_t __attribute__((ext_vector_type(2)));
__device__ __forceinline__ unsigned cvtpk_s(float lo,float hi){f32x2_t v={lo,hi};bf16x2_t b=__builtin_convertvector(v,bf16x2_t);return __builtin_bit_cast(unsigned,b);}
#define WAIT_BAR(N) asm volatile("s_waitcnt vmcnt(" #N ") lgkmcnt(0)\n\ts_barrier":::"memory")

__device__ __forceinline__ void qkt(f32x16&p0,f32x16&p1,const char*Kslot,const bf16x8*qr,const f32x16&negm,int r32,int hi){
  const char*kb=Kslot+hi*1024+r32*16;
  #pragma unroll
  for(int d0=0;d0<4;++d0){
    const bf16x8 b0=*reinterpret_cast<const bf16x8*>(kb+d0*2048);
    const bf16x8 b1=*reinterpret_cast<const bf16x8*>(kb+d0*2048+512);
    if(d0==0){p0=__builtin_amdgcn_mfma_f32_32x32x16_bf16(b0,qr[0],negm,0,0,0);p1=__builtin_amdgcn_mfma_f32_32x32x16_bf16(b1,qr[0],negm,0,0,0);}
    else{p0=__builtin_amdgcn_mfma_f32_32x32x16_bf16(b0,qr[d0],p0,0,0,0);p1=__builtin_amdgcn_mfma_f32_32x32x16_bf16(b1,qr[d0],p1,0,0,0);}}
}
typedef __attribute__((address_space(3))) const char* lds_cptr;
typedef short v4i16_t __attribute__((ext_vector_type(4)));
__device__ __forceinline__ void kload8(bf16x8*kf,lds_cptr kp){
  kf[0]=*(const __attribute__((address_space(3))) bf16x8*)(kp);      kf[1]=*(const __attribute__((address_space(3))) bf16x8*)(kp+512);
  kf[2]=*(const __attribute__((address_space(3))) bf16x8*)(kp+2048); kf[3]=*(const __attribute__((address_space(3))) bf16x8*)(kp+2560);
  kf[4]=*(const __attribute__((address_space(3))) bf16x8*)(kp+4096); kf[5]=*(const __attribute__((address_space(3))) bf16x8*)(kp+4608);
  kf[6]=*(const __attribute__((address_space(3))) bf16x8*)(kp+6144); kf[7]=*(const __attribute__((address_space(3))) bf16x8*)(kp+6656);
}
__device__ __forceinline__ void kload2(bf16x8*kf,lds_cptr kp,int j){ kf[2*j]=*(const __attribute__((address_space(3))) bf16x8*)(kp+j*2048); kf[2*j+1]=*(const __attribute__((address_space(3))) bf16x8*)(kp+j*2048+512); }
__device__ __forceinline__ s16x4 vtr(lds_cptr p){ return __builtin_bit_cast(s16x4,__builtin_amdgcn_ds_read_tr16_b64_v4i16((__attribute__((address_space(3))) v4i16_t*)p)); }
__device__ __forceinline__ float rowmax(const f32x16&p0,const f32x16&p1){
  float a=max3f(p0[0],p0[1],p1[0]),b=max3f(p0[2],p0[3],p1[1]);a=max3f(a,p1[2],p1[3]);
  #pragma unroll
  for(int r=4;r<16;r+=4){a=max3f(a,p0[r],p0[r+1]);b=max3f(b,p0[r+2],p0[r+3]);a=max3f(a,p1[r],p1[r+1]);b=max3f(b,p1[r+2],p1[r+3]);}
  const float m=max2f(a,b);
  auto rr=__builtin_amdgcn_permlane32_swap(__float_as_uint(m),__float_as_uint(m),false,false);
  return max2f(__uint_as_float(rr[0]),__uint_as_float(rr[1]));
}
__device__ __forceinline__ void pv(f32x16*o,int vb,bf16x8 pa0,bf16x8 pa1,bf16x8 pa2,bf16x8 pa3){
  #pragma unroll
  for(int d0=0;d0<2;++d0){s16x4 lo[4],hi[4];
    #pragma unroll
    for(int ks=0;ks<4;++ks){
      asm volatile("ds_read_b64_tr_b16 %0,%1 offset:%c2":"=&v"(lo[ks]):"v"(vb),"i"(d0*4096+ks*1024):"memory");
      asm volatile("ds_read_b64_tr_b16 %0,%1 offset:%c2":"=&v"(hi[ks]):"v"(vb),"i"(d0*4096+ks*1024+512):"memory");}
    asm volatile("s_waitcnt lgkmcnt(0)":::"memory");SBAR();
    #define PK(k) (bf16x8){lo[k][0],lo[k][1],lo[k][2],lo[k][3],hi[k][0],hi[k][1],hi[k][2],hi[k][3]}
    o[d0]=__builtin_amdgcn_mfma_f32_32x32x16_bf16(pa0,PK(0),o[d0],0,0,0);
    o[d0]=__builtin_amdgcn_mfma_f32_32x32x16_bf16(pa1,PK(1),o[d0],0,0,0);
    o[d0]=__builtin_amdgcn_mfma_f32_32x32x16_bf16(pa2,PK(2),o[d0],0,0,0);
    o[d0]=__builtin_amdgcn_mfma_f32_32x32x16_bf16(pa3,PK(3),o[d0],0,0,0);
    #undef PK
  }
}

#ifndef ATTN_STORE16
#define ATTN_STORE16(p,v) (*(u32x4*)(p)=(v))
#endif
template<int THRL> __device__ __forceinline__ void attn_unit(const bf16*Qblk,const bf16*__restrict__ Kh,const bf16*__restrict__ Vh,bf16*Oblk,const int NT,char*shm,const int qpos0,const float*__restrict__ qgain){
  const int tid=otid(),lane=tid&63,r32=lane&31,hi=lane>>5; const int wid=__builtin_amdgcn_readfirstlane(tid>>6);
  const bf16*Qw=Qblk+(long)wid*QBLK*DM;
  const unsigned lds0=(unsigned)(uintptr_t)shm;
  float*wsf=(float*)(shm+LDS_WS)+wid*64;
  const bf16*ksrc=Kh+(long)lane*KDM+wid*8;
  const bf16*vsrc=Vh+(long)(16*(wid&3)+(lane>>2))*KDM+(wid>>2)*32+(lane&3)*8;
  const unsigned kdst=lds0+LDS_K+wid*1024, vdst=lds0+LDS_V+wid*1024;
  #define DMA_K(t,slot) glds16(ksrc+(long)(t)*KVBLK*KDM,(unsigned)__builtin_amdgcn_readfirstlane(kdst+(slot)))
  #define DMA_V(t,slot) glds16(vsrc+(long)(t)*KVBLK*KDM,(unsigned)__builtin_amdgcn_readfirstlane(vdst+(slot)))
  const int vb0=(int)(lds0+LDS_V)+((lane>>4)&1)*32+(lane&3)*8+(4*hi+((lane&15)>>2))*64;
  const char*Kbase=shm+LDS_K; bf16x8 kf[8];
  const lds_cptr shm3=(lds_cptr)shm; const lds_cptr kp0=shm3+LDS_K+hi*1024+r32*16; const lds_cptr vp0=shm3+LDS_V+((lane>>4)&1)*32+(lane&3)*8+(4*hi+((lane&15)>>2))*64;
  DMA_K(0,0);DMA_V(0,0);DMA_K(1,SLOTB);
  bf16x8 qr[4];
  { float qf[4][8]; float ss=0.f;
    #pragma unroll
    for(int d0=0;d0<4;++d0){ const bf16x8 raw=*reinterpret_cast<const bf16x8*>(&Qw[(long)r32*DM+d0*16+hi*8]);
      #pragma unroll
      for(int j=0;j<8;++j){ qf[d0][j]=__uint_as_float(((unsigned)(unsigned short)raw[j])<<16); ss+=qf[d0][j]*qf[d0][j]; } }
    ss+=__shfl_xor(ss,32);
    const float rstd=1.0f/sqrtf(ss*(1.f/64.f)+1e-6f)*C2;
    const int pos=qpos0+wid*QBLK+r32; const float prow=(float)(pos>>6),pcol=(float)(pos&63);
    #pragma unroll
    for(int d0=0;d0<4;++d0){ u32x4 pk;
      #pragma unroll
      for(int jp=0;jp<4;++jp){ const int d=16*d0+8*hi+2*jp; const int m=8*(d0&1)+4*hi+jp;
        const float fr=__builtin_amdgcn_exp2f(-(float)m*(13.287712379549449f/16.f)); const float ang=((d0<2)?prow:pcol)*fr;
        const float sn=__sinf(ang),cs=__cosf(ang);
        const float y0=qf[d0][2*jp]*rstd*qgain[d],y1=qf[d0][2*jp+1]*rstd*qgain[d+1];
        pk[jp]=cvtpk_s(y0*cs-y1*sn,y0*sn+y1*cs); }
      qr[d0]=__builtin_bit_cast(bf16x8,pk); } }
  float mhat=0.f,l_reg=0.f;f32x16 o[2];o[0]=f32x16{};o[1]=f32x16{};f32x16 negm=f32x16{};asm volatile("":"+v"(negm));
  #define CMASK(P0,P1,t) do{}while(0)
  bool resc=false;
  #define START(P0,P1) do{ const float rm=rowmax(P0,P1); resc=false; \
    { const float dl=rm; mhat=fadd_s(mhat,dl); \
      _Pragma("unroll") for(int r=0;r<16;++r){P0[r]=fsub_s(P0[r],dl);P1[r]=fsub_s(P1[r],dl);} \
      _Pragma("unroll") for(int r=0;r<16;++r)negm[r]=-mhat; asm volatile("":"+v"(negm)); } \
    _Pragma("unroll") for(int r=0;r<16;++r)P0[r]=__builtin_amdgcn_exp2f(P0[r]); }while(0)
  #define RESC() do{ if(resc){ asm volatile("s_waitcnt lgkmcnt(0)":::"memory"); \
      _Pragma("unroll") for(int d_=0;d_<2;++d_) _Pragma("unroll") for(int r=0;r<16;++r)o[d_][r]*=wsf[crow(r,hi)]; } }while(0)
  f32x16 pA0,pA1,pB0,pB1;
  int sl_prev=0,sl_cur=0,sl_next=SLOTB;
  #define ROT() do{sl_prev=sl_cur;sl_cur=sl_next;sl_next=(sl_next==(NSLOT-1)*SLOTB)?0:sl_next+SLOTB;}while(0)
  DMA_K(2,2*SLOTB);
  WAIT_BAR(3);
  qkt(pA0,pA1,Kbase,qr,negm,r32,hi);asm volatile("s_nop 15\n\ts_nop 7":"+v"(pA0),"+v"(pA1));CMASK(pA0,pA1,0);
  START(pA0,pA1);
  _Pragma("unroll") for(int r=0;r<16;++r)pA1[r]=__builtin_amdgcn_exp2f(pA1[r]);
  WAIT_BAR(0);
  DMA_K(3,0);DMA_V(1,SLOTB);
  ROT();
  kload8(kf,kp0+sl_cur);
  WAIT_BAR(2);
  s16x4 vlo[8],vhi[8]; u32x4 pw0,pw1,pw2,pw3;
  #define PKW(P,B) cvtpk_s(P[B],P[B+1])
  #define PAF(k) __builtin_bit_cast(bf16x8,pw##k)
  #define VFR(i) (bf16x8){vlo[i][0],vlo[i][1],vlo[i][2],vlo[i][3],vhi[i][0],vhi[i][1],vhi[i][2],vhi[i][3]}
  #define PIN(x) asm volatile("":"+v"(x))
  #define MX3(a,b,c) __builtin_fmaxf(__builtin_fmaxf((a),(b)),(c))
  #define GAPA(MF,A0,A1,A2,A3,W0,W1,PW) do{ MF; sacc+=A0; sacc+=A1; sacc+=A2; sacc+=A3; PIN(sacc); W0; W1; PIN(PW); SBAR(); }while(0)
  #define EX(v) __builtin_amdgcn_exp2f(v)
  #define GAPB(MF,X,B) do{ MF; X[B]=EX(X[B]); X[B+1]=EX(X[B+1]); X[B+2]=EX(X[B+2]); X[B+3]=EX(X[B+3]); PIN(X); SBAR(); }while(0)
  #define VRD(i) do{ vlo[i]=vtr(vp_+(((i)>>2)*4096+((i)&3)*1024)); vhi[i]=vtr(vp_+(((i)>>2)*4096+((i)&3)*1024+512)); }while(0)
  #define KRD(G,j) do{ if(G){ kload2(kf,kp0+sl_next,j); SBAR(); } }while(0)
  #define STEP(C0,C1,P0,P1,t,GK,GV,GL) do{ SBAR(); \
    const lds_cptr vp_=vp0+sl_prev; \
    VRD(0); SBAR(); float sacc=(P0[0]+P0[1]); \
    GAPA(C0=__builtin_amdgcn_mfma_f32_32x32x16_bf16(kf[0],qr[0],negm,0,0,0), P0[2],P0[3],P0[4],P0[5],     pw0[0]=PKW(P0,0), pw0[1]=PKW(P0,2), pw0); \
    VRD(4); SBAR(); GAPA(C1=__builtin_amdgcn_mfma_f32_32x32x16_bf16(kf[1],qr[0],negm,0,0,0), P0[6],P0[7],P0[8],P0[9],     pw0[2]=PKW(P0,4), pw0[3]=PKW(P0,6), pw0); \
    VRD(1); SBAR(); GAPA(C0=__builtin_amdgcn_mfma_f32_32x32x16_bf16(kf[2],qr[1],C0,0,0,0),   P0[10],P0[11],P0[12],P0[13], pw1[0]=PKW(P0,8), pw1[1]=PKW(P0,10), pw1); \
    VRD(5); SBAR(); GAPA(C1=__builtin_amdgcn_mfma_f32_32x32x16_bf16(kf[3],qr[1],C1,0,0,0),   P0[14],P0[15],P1[0],P1[1],   pw1[2]=PKW(P0,12),pw1[3]=PKW(P0,14), pw1); \
    VRD(2); SBAR(); GAPA(C0=__builtin_amdgcn_mfma_f32_32x32x16_bf16(kf[4],qr[2],C0,0,0,0),   P1[2],P1[3],P1[4],P1[5],     pw2[0]=PKW(P1,0), pw2[1]=PKW(P1,2), pw2); \
    VRD(6); SBAR(); GAPA(C1=__builtin_amdgcn_mfma_f32_32x32x16_bf16(kf[5],qr[2],C1,0,0,0),   P1[6],P1[7],P1[8],P1[9],     pw2[2]=PKW(P1,4), pw2[3]=PKW(P1,6), pw2); \
    VRD(3); SBAR(); GAPA(C0=__builtin_amdgcn_mfma_f32_32x32x16_bf16(kf[6],qr[3],C0,0,0,0),   P1[10],P1[11],P1[12],P1[13], pw3[0]=PKW(P1,8), pw3[1]=PKW(P1,10), pw3); \
    VRD(7); SBAR(); GAPA(C1=__builtin_amdgcn_mfma_f32_32x32x16_bf16(kf[7],qr[3],C1,0,0,0),   P1[14],P1[15],0.f,0.f,       pw3[2]=PKW(P1,12),pw3[3]=PKW(P1,14), pw3); \
    l_reg+=sacc; \
    if(GK){DMA_K((t)+3,sl_cur);} if(GV){DMA_V((t)+1,sl_next);} \
    CMASK(C0,C1,t); \
    { float a=MX3(C0[0],C0[1],C1[0]),b=MX3(C0[2],C0[3],C1[1]); a=MX3(a,C1[2],C1[3]); \
      _Pragma("unroll") for(int r=4;r<16;r+=4){a=MX3(a,C0[r],C0[r+1]);b=MX3(b,C0[r+2],C0[r+3]);a=MX3(a,C1[r],C1[r+1]);b=MX3(b,C1[r+2],C1[r+3]);} \
      float rm=__builtin_fmaxf(a,b); { auto rr=__builtin_amdgcn_permlane32_swap(__float_as_uint(rm),__float_as_uint(rm),false,false); rm=__builtin_fmaxf(__uint_as_float(rr[0]),__uint_as_float(rr[1])); } \
      resc=false; \
      if(__builtin_expect(__any(rm>(float)THRL),0)){ const float dl=__builtin_fmaxf(rm,0.f); mhat+=dl; \
        _Pragma("unroll") for(int r=0;r<16;++r){C0[r]-=dl;C1[r]-=dl;} \
        _Pragma("unroll") for(int r=0;r<16;++r)negm[r]=-mhat; asm volatile("":"+v"(negm)); \
        const float f=__builtin_amdgcn_exp2f(-dl); l_reg*=f; if(hi==0)wsf[r32]=f; resc=true; } } \
    SBAR(); \
    GAPB(o[0]=__builtin_amdgcn_mfma_f32_32x32x16_bf16(PAF(0),VFR(0),o[0],0,0,0), C0,0); \
    GAPB(o[1]=__builtin_amdgcn_mfma_f32_32x32x16_bf16(PAF(0),VFR(4),o[1],0,0,0), C0,4); \
    KRD(GL,0); GAPB(o[0]=__builtin_amdgcn_mfma_f32_32x32x16_bf16(PAF(1),VFR(1),o[0],0,0,0), C0,8); \
    KRD(GL,1); GAPB(o[1]=__builtin_amdgcn_mfma_f32_32x32x16_bf16(PAF(1),VFR(5),o[1],0,0,0), C0,12); \
    KRD(GL,2); GAPB(o[0]=__builtin_amdgcn_mfma_f32_32x32x16_bf16(PAF(2),VFR(2),o[0],0,0,0), C1,0); \
    KRD(GL,3); GAPB(o[1]=__builtin_amdgcn_mfma_f32_32x32x16_bf16(PAF(2),VFR(6),o[1],0,0,0), C1,4); \
    GAPB(o[0]=__builtin_amdgcn_mfma_f32_32x32x16_bf16(PAF(3),VFR(3),o[0],0,0,0), C1,8); \
    GAPB(o[1]=__builtin_amdgcn_mfma_f32_32x32x16_bf16(PAF(3),VFR(7),o[1],0,0,0), C1,12); \
    }while(0)
  int t=1;
  #undef CMASK
  #define CMASK(P0,P1,t) do{}while(0)
  for(;t+5<NT;t+=2){
    STEP(pB0,pB1,pA0,pA1,t,true,true,true);     WAIT_BAR(2); RESC(); ROT();
    STEP(pA0,pA1,pB0,pB1,t+1,true,true,true);   WAIT_BAR(2); RESC(); ROT();
  }
  #undef CMASK
  #define CMASK(P0,P1,t) do{}while(0)
  #define ENDW(tt) do{ if((tt)+3<NT){WAIT_BAR(2);} else if((tt)+2<NT){WAIT_BAR(1);} else {WAIT_BAR(0);} }while(0)
  for(;t+1<NT;t+=2){
    STEP(pB0,pB1,pA0,pA1,t,(t+3<NT),(t+1<NT),(t+1<NT));       ENDW(t);   RESC(); ROT();
    STEP(pA0,pA1,pB0,pB1,t+1,(t+4<NT),(t+2<NT),(t+2<NT));     ENDW(t+1); RESC(); ROT();
  }
  STEP(pB0,pB1,pA0,pA1,NT-1,false,false,false); RESC();
  { float sacc=pB0[0]+pB0[1]; _Pragma("unroll") for(int r=2;r<16;++r)sacc+=pB0[r]; _Pragma("unroll") for(int r=0;r<16;++r)sacc+=pB1[r]; l_reg+=sacc;
    pw0=(u32x4){PKW(pB0,0),PKW(pB0,2),PKW(pB0,4),PKW(pB0,6)};pw1=(u32x4){PKW(pB0,8),PKW(pB0,10),PKW(pB0,12),PKW(pB0,14)};pw2=(u32x4){PKW(pB1,0),PKW(pB1,2),PKW(pB1,4),PKW(pB1,6)};pw3=(u32x4){PKW(pB1,8),PKW(pB1,10),PKW(pB1,12),PKW(pB1,14)};
    SBAR(); pv(o,vb0+sl_cur,PAF(0),PAF(1),PAF(2),PAF(3)); }
  #undef PKW
  #undef PAF
  #undef VFR
  #undef PIN
  #undef MX3
  #undef GAPA
  #undef GAPB
  #undef EX
  #undef VRD
  #undef KRD
  #undef STEP
  #undef ENDW
  {auto rr=__builtin_amdgcn_permlane32_swap(__float_as_uint(l_reg),__float_as_uint(l_reg),false,false);l_reg=__uint_as_float(rr[0])+__uint_as_float(rr[1]);}
  if(hi==0)wsf[32+r32]=l_reg;asm volatile("s_waitcnt lgkmcnt(0)":::"memory");
  float rli[16];
  #pragma unroll
  for(int r=0;r<16;++r)rli[r]=__builtin_amdgcn_rcpf(wsf[32+crow(r,hi)]);
  bf16*Ow=Oblk+(long)wid*QBLK*DM;
  { bf16*stg=(bf16*)(shm+LDS_OST)+wid*2048;
    #pragma unroll
    for(int r=0;r<16;++r){const int orow=crow(r,hi);
      #pragma unroll
      for(int d0=0;d0<2;++d0)stg[orow*64+d0*32+r32]=__float2bfloat16(o[d0][r]*rli[r]);}
    asm volatile("s_waitcnt lgkmcnt(0)":::"memory");
    #pragma unroll
    for(int i=0;i<4;++i){const int row=i*8+(lane>>3),ch=lane&7; const u32x4 v=*(const u32x4*)(stg+row*64+ch*8); const u32x4 z=*(const u32x4*)(Ow+(long)row*DM+ch*8); u32x4 w;
      #pragma unroll
      for(int e=0;e<4;++e){ const float a0=__uint_as_float(v[e]<<16),a1=__uint_as_float(v[e]&0xffff0000u),z0=__uint_as_float(z[e]<<16),z1=__uint_as_float(z[e]&0xffff0000u);
        w[e]=cvtpk_s(a0*z0/(1.f+__expf(-z0)),a1*z1/(1.f+__expf(-z1))); }
      ATTN_STORE16(Ow+(long)row*DM+ch*8,w);} }
  asm volatile("s_waitcnt lgkmcnt(0)\n\ts_barrier":::"memory");
  #undef DMA_K
  #undef DMA_V
  #undef CMASK
  #undef START
  #undef RESC
  #undef ROT
}
constexpr int ATTN_LDS_BYTES=LDS_BYTES;
}
typedef unsigned short u16;
#define LAS __attribute__((address_space(3)))
#define DI __device__ __forceinline__
typedef unsigned v4u __attribute__((ext_vector_type(4)));
typedef unsigned v2u __attribute__((ext_vector_type(2)));
typedef float v4f __attribute__((ext_vector_type(4)));

constexpr int T_TOK = 32768, P1P = 2048, P2P = 1536;
constexpr int P1_Z = 0, P1_Q = 1280, P1_K = 1792, P1_V = 1920;
constexpr int P2_AQ = 0, P2_AK = 128, P2_AV = 256, P2_GF = 512, P2_GB = 640, P2_BU = 768, P2_DU = 1024, P2_DV = 1280, P2_U = 1024;
constexpr size_t MiB = 1u << 20;
constexpr size_t WS_DFT = 256 * 1024, WS_BAR = 512 * 1024, BAR_BYTES = 16384;
constexpr size_t WS_MOD = 0, WS_WIN = 2 * MiB, WS_WOUT = 16 * MiB, WS_WF = 21 * MiB, WS_U0 = 22 * MiB, WS_HB = 86 * MiB, WS_P2 = 150 * MiB, WS_DEC = 246 * MiB, WS_END = 247 * MiB;
constexpr size_t HB_GS = 0, HB_KC = 16 * MiB, HB_VC = 24 * MiB, HB_TP = 32 * MiB;
constexpr int LDS_BYTES = 147456;
constexpr float EPSN = 1e-6f;
constexpr float ATT_C2 = 0.125f * 1.4426950408889634f;

struct Params {
    const float *xp, *xs, *cp, *cs, *ada_w, *ada_b, *pre_g, *post_g, *w_in, *wg2f, *bgf, *wg2b, *bgb, *onorm_g, *fnet_w, *qn_g, *kn_g, *sgu_ng, *sgu_w, *sgu_b, *w_out;
    float* out; unsigned char* ws;
};
typedef const float* cfp;
struct Ctx { float* out; unsigned char* ws; LAS cfp* tab; };

DI float bf2f(u16 v) { return __uint_as_float((unsigned)v << 16); }
DI float bflo(unsigned w) { return __uint_as_float(w << 16); }
DI float bfhi(unsigned w) { return __uint_as_float(w & 0xffff0000u); }
DI unsigned f2bf(float f) { unsigned u = __float_as_uint(f); return (u + 0x7fffu + ((u >> 16) & 1u)) >> 16; }
DI unsigned pk2(float lo, float hi) { return f2bf(lo) | (f2bf(hi) << 16); }
DI float wave_sum(float v) {
#pragma unroll
    for (int o = 1; o < 64; o <<= 1) v += __shfl_xor(v, o);
    return v;
}
using pg8::silu_f;
DI float logsig(float x) { return fminf(x, 0.f) - log1pf(__expf(-fabsf(x))); }
DI void seq_info(int s, int& row0, int& N) { if (s < 4) { row0 = s * 4096; N = 4096; } else { row0 = 16384 + (s - 4) * 8192; N = 8192; } }
DI int row_seq(int r) { return r < 16384 ? (r >> 12) : 4 + ((r - 16384) >> 13); }
DI void unpack8(const v4u r, float (&f)[8]) { f[0] = bflo(r.x); f[1] = bfhi(r.x); f[2] = bflo(r.y); f[3] = bfhi(r.y); f[4] = bflo(r.z); f[5] = bfhi(r.z); f[6] = bflo(r.w); f[7] = bfhi(r.w); }
DI v4u pack8(const float (&f)[8]) { v4u r; r.x = pk2(f[0], f[1]); r.y = pk2(f[2], f[3]); r.z = pk2(f[4], f[5]); r.w = pk2(f[6], f[7]); return r; }
#define LDS_WAIT() asm volatile("s_waitcnt lgkmcnt(0)" ::: "memory")


typedef short bf16x8_t __attribute__((ext_vector_type(8)));
typedef float f32x4_t __attribute__((ext_vector_type(4)));
DI bf16x8_t ldfrag(const LAS u16* base, int pitch, int row0, int k0, int lane) { return *(const LAS bf16x8_t*)(base + (row0 + (lane & 15)) * pitch + k0 + 8 * (lane >> 4)); }
typedef short s16x4_t __attribute__((ext_vector_type(4)));
DI bf16x8_t ldfrag_tr(const LAS u16* base, int pitch, int k0, int n0, int lane) {
    const LAS u16* a0 = base + (k0 + 8 * (lane >> 4) + ((lane & 15) >> 2)) * pitch + n0 + 4 * (lane & 3);
    const s16x4_t lo = __builtin_amdgcn_ds_read_tr16_b64_v4i16((LAS s16x4_t*)a0), hi = __builtin_amdgcn_ds_read_tr16_b64_v4i16((LAS s16x4_t*)(a0 + 4 * pitch));
    return (bf16x8_t){lo[0], lo[1], lo[2], lo[3], hi[0], hi[1], hi[2], hi[3]};
}
#define MFMA16(a, b, c) __builtin_amdgcn_mfma_f32_16x16x32_bf16((a), (b), (c), 0, 0, 0)
DI float wave_prefix(float g, int lane) {
#pragma unroll
    for (int o = 1; o < 64; o <<= 1) { const float t = __shfl_up(g, o); if (lane >= o) g += t; }
    return g; }
DI float wave_suffix(float g, int lane) {
#pragma unroll
    for (int o = 1; o < 64; o <<= 1) { const float t = __shfl_down(g, o); if (lane + o < 64) g += t; }
    return g; }
DI int win_src_col(int j) {
    if (j < 1280) return 2080 + j;
    if (j < 1792) return 800 + (j - 1280);
    if (j < 1920) return 1312 + (j - 1792);
    if (j < 2048) return 1440 + (j - 1920);
    const int q = j - 2048;
    if (q < 512) return q;
    if (q < 768) return -1;
    if (q < 1024) return 544 + (q - 768);
    if (q < 1280) return 1568 + (q - 1024);
    return 1824 + (q - 1280);
}
DI void transpose_item(const float* W, int ldw, int src_n0, int K, u16* WT, int dst_n0, int k0, LAS float* scr, int lane) {
    float tv[32];
#pragma unroll
    for (int i = 0; i < 32; ++i) tv[i] = W[(size_t)(k0 + 2 * i + (lane >> 5)) * ldw + src_n0 + (lane & 31)];
#pragma unroll
    for (int i = 0; i < 32; ++i) scr[(2 * i + (lane >> 5)) * 33 + (lane & 31)] = tv[i];
    LDS_WAIT();
    const int c = lane & 7;
#pragma unroll
    for (int j = 0; j < 4; ++j) { const int n = (lane >> 3) + 8 * j; const LAS float* s = scr + (8 * c) * 33 + n;
        v4u o; o.x = pk2(s[0 * 33], s[1 * 33]); o.y = pk2(s[2 * 33], s[3 * 33]); o.z = pk2(s[4 * 33], s[5 * 33]); o.w = pk2(s[6 * 33], s[7 * 33]);
        *(v4u*)(WT + (size_t)(dst_n0 + n) * K + k0 + 8 * c) = o; }
    LDS_WAIT();
}
DI void phase0(const Ctx& p, LAS unsigned char* L) {
    const int tid = otid(), lane = tid & 63, wave = tid >> 6;
    const int gw = blockIdx.x * 8 + wave, NGW = gridDim.x * 8, gt = blockIdx.x * 512 + tid, NGT = gridDim.x * 512;
    LAS float* scr = (LAS float*)(L + wave * 16384);
    u16* WinT = (u16*)(p.ws + WS_WIN); u16* WoutT = (u16*)(p.ws + WS_WOUT); u16* WfT = (u16*)(p.ws + WS_WF); float* mod = (float*)(p.ws + WS_MOD);
    constexpr int I_IN = 16 * 112, I_OUT = 20 * 32, I_L = I_IN + I_OUT;
    for (int it = gw; it < 2 * I_L; it += NGW) {
        const int l = it / I_L; int r = it % I_L;
        if (r < I_IN) { const int kb = r / 112, nb = r % 112; const int src = win_src_col(nb * 32); if (src < 0) continue;
            transpose_item(p.tab[8] + (size_t)l * 1024 * 3360, 3360, src, 1024, WinT + (size_t)l * 3584 * 1024, nb * 32, kb * 64, scr, lane); }
        else { r -= I_IN; const int kb = r / 32, nb = r % 32;
            transpose_item(p.tab[20] + (size_t)l * 1280 * 1024, 1024, nb * 32, 1280, WoutT + (size_t)l * 1024 * 1280, nb * 32, kb * 64, scr, lane); }
    }
    for (int e = gt; e < 2 * 16 * 1024; e += NGT) { const int l = e >> 14, r = e & 16383, jg = r >> 10, k = r & 1023, dirb = jg >> 3, jj0 = (jg & 7) * 16;
        const float* wi = p.tab[8] + (size_t)l * 1024 * 3360 + (size_t)k * 3360 + 512 + dirb * 16; float wv[16];
#pragma unroll
        for (int r2 = 0; r2 < 16; ++r2) wv[r2] = wi[r2];
        const float* w2 = (dirb ? p.tab[11] : p.tab[9]) + l * 16 * 128 + jj0;
        for (int q = 0; q < 16; ++q) { float a = 0.f;
#pragma unroll
            for (int r2 = 0; r2 < 16; ++r2) a += wv[r2] * w2[r2 * 128 + q];
            WinT[(size_t)l * 3584 * 1024 + (size_t)(2560 + dirb * 128 + jj0 + q) * 1024 + k] = (u16)f2bf(a); } }
    { LAS float* trig = (LAS float*)(L + 126976);
        if (tid < 64) { trig[tid] = cospif((float)tid * (1.f / 32.f)); trig[64 + tid] = sinpif((float)tid * (1.f / 32.f)); }
        __syncthreads();
        for (int e = gt; e < 2 * 256 * 512; e += NGT) { const int l = e >> 17, r = e & 131071, n = r >> 9, kk = r & 511, im = kk >> 8, g = (kk & 255) >> 6, c = kk & 63;
            const float* fw = p.tab[14] + (size_t)l * 65536 + (size_t)(g * 64) * 256 + n; const LAS float* tb = trig + im * 64; float a = 0.f;
#pragma unroll 8
            for (int j2 = 0; j2 < 64; ++j2) a += tb[(j2 * c) & 63] * fw[j2 * 256];
            WfT[(size_t)l * 131072 + n * 512 + kk] = (u16)f2bf(a * 0.125f); } }
    { u16* dft = (u16*)(p.ws + WS_DFT);
        for (int e = gt; e < 4096; e += NGT) { const int k = e >> 6, n = e & 63; const float a = (float)((k * n) & 63) * (1.f / 32.f); dft[e] = (u16)f2bf(cospif(a)); dft[4096 + e] = (u16)f2bf(sinpif(a)); }
        for (int e = gt; e < 16384; e += NGT) { const int k = e >> 7, n = e & 127; const float a = (float)((k * n) & 127) * (1.f / 64.f); dft[8192 + e] = (u16)f2bf(cospif(a)); dft[8192 + 16384 + e] = (u16)f2bf(sinpif(a)); } }
    __syncthreads();
    LAS float* sc = (LAS float*)L;
    for (int e = tid; e < 6144; e += 512) { const int s = e >> 10, k = e & 1023; const float c = s < 4 ? p.tab[2][s * 1024 + k] : p.tab[3][(s - 4) * 1024 + k]; sc[e] = c / (1.f + expf(-c)); }
    __syncthreads();
    for (int unit = gw; unit < 768; unit += NGW) {
        const int ks = unit & 7, jb = (unit >> 3) % 48, l = unit / 384, j = jb * 64 + lane;
        float acc[6] = {0.f, 0.f, 0.f, 0.f, 0.f, 0.f};
        const float* aw = p.tab[4] + (size_t)l * 1024 * 3072 + (size_t)(ks * 128) * 3072 + j;
#pragma unroll 16
        for (int k = 0; k < 128; ++k) { const float w = aw[(size_t)k * 3072];
#pragma unroll
            for (int s = 0; s < 6; ++s) acc[s] += sc[s * 1024 + ks * 128 + k] * w; }
        if (ks == 0) { const float b = p.tab[5][l * 3072 + j];
#pragma unroll
            for (int s = 0; s < 6; ++s) acc[s] += b; }
#pragma unroll
        for (int s = 0; s < 6; ++s) atomicAdd(mod + (size_t)(l * 6 + s) * 3072 + j, acc[s]);
    }
}

DI void add_branch(v4f (&v)[4], const u16* urow, const float* gate, const float* pg, int lane) {
    v4f u[4]; float ss = 0.f;
#pragma unroll
    for (int j = 0; j < 4; ++j) { const v2u r = *(const v2u*)(urow + 256 * j + 4 * lane); u[j] = (v4f){bflo(r.x), bfhi(r.x), bflo(r.y), bfhi(r.y)};
        ss += (u[j].x * u[j].x + u[j].y * u[j].y) + (u[j].z * u[j].z + u[j].w * u[j].w); }
    const float rstd = 1.f / sqrtf(wave_sum(ss) * (1.f / 1024.f) + EPSN);
#pragma unroll
    for (int j = 0; j < 4; ++j) { const v4f g = *(const v4f*)(gate + 256 * j + 4 * lane), q = *(const v4f*)(pg + 256 * j + 4 * lane); v[j] += g * (u[j] * rstd * q); }
}
DI void phaseA(const Ctx& p, int l) {
    const int tid = otid(), lane = tid & 63, wave = tid >> 6, gw = blockIdx.x * 8 + wave, NGW = gridDim.x * 8;
    const float* mod = (const float*)(p.ws + WS_MOD); const u16* U0 = (const u16*)(p.ws + WS_U0); u16* HB = (u16*)(p.ws + WS_HB);
    for (int row = gw; row < T_TOK; row += NGW) {
        const int s = row_seq(row);
        const float* xr = row < 16384 ? p.tab[0] + (size_t)row * 1024 : p.tab[1] + (size_t)(row - 16384) * 1024;
        v4f v[4];
#pragma unroll
        for (int j = 0; j < 4; ++j) v[j] = *(const v4f*)(xr + 256 * j + 4 * lane);
        if (l >= 1) add_branch(v, U0 + (size_t)row * 1024, mod + (size_t)(0 * 6 + s) * 3072 + 2048, p.tab[7], lane);
        if (l == 2) { add_branch(v, HB + (size_t)row * 1024, mod + (size_t)(1 * 6 + s) * 3072 + 2048, p.tab[7] + 1024, lane);
            float* o = p.out + (size_t)row * 1024;
#pragma unroll
            for (int j = 0; j < 4; ++j) *(v4f*)(o + 256 * j + 4 * lane) = v[j];
            continue; }
        float ss = 0.f;
#pragma unroll
        for (int j = 0; j < 4; ++j) ss += (v[j].x * v[j].x + v[j].y * v[j].y) + (v[j].z * v[j].z + v[j].w * v[j].w);
        const float rstd = 1.f / sqrtf(wave_sum(ss) * (1.f / 1024.f) + EPSN);
        const float* md = mod + (size_t)(l * 6 + s) * 3072;
#pragma unroll
        for (int j = 0; j < 4; ++j) { const int col = 256 * j + 4 * lane;
            const v4f sh = *(const v4f*)(md + col), scl = *(const v4f*)(md + 1024 + col), g = *(const v4f*)(p.tab[6] + l * 1024 + col);
            const v4f h = v[j] * rstd * g * (scl + 1.f) + sh;
            v2u o; o.x = pk2(h.x, h.y); o.y = pk2(h.z, h.w); *(v2u*)(HB + (size_t)row * 1024 + col) = o; }
    }
}

DI void qk_prep(const Ctx& p, int l) {
    const int tid = otid(), lane = tid & 63, wave = tid >> 6, gw = blockIdx.x * 8 + wave, NGW = gridDim.x * 8;
    u16* P1 = (u16*)p.out; const int i = lane & 31; unsigned* KC = (unsigned*)(p.ws + WS_HB + HB_KC); unsigned* VC = (unsigned*)(p.ws + WS_HB + HB_VC);
    const float freq = exp2f(-(float)(i & 15) * (13.287712379549449f / 16.f));
    const float gk0 = p.tab[16][l * 64 + 2 * i], gk1 = p.tab[16][l * 64 + 2 * i + 1];
    for (int rowb = gw * 4; rowb < T_TOK; rowb += NGW * 4) {
        unsigned wv[4][2];
#pragma unroll
        for (int r = 0; r < 4; ++r) { const unsigned* ptr = (const unsigned*)(P1 + (size_t)(rowb + r) * P1P + P1_Q);
#pragma unroll
            for (int it = 0; it < 2; ++it) wv[r][it] = ptr[(4 + it) * 64 + lane]; }
#pragma unroll
        for (int r = 0; r < 4; ++r) { const int row = rowb + r;
            const int s = row_seq(row); int row0, N; seq_info(s, row0, N); const int pos = row - row0;
            const float coord = (i < 16) ? (float)(pos >> 6) : (float)(pos & 63);
            float sn, cs; sincosf(coord * freq, &sn, &cs);
            unsigned* ptr = (unsigned*)(P1 + (size_t)row * P1P + P1_Q);
            const size_t cidx = ((size_t)row0 * 2 + (size_t)(lane >> 5) * N + pos) * 32 + i;
            { const unsigned w = wv[r][0]; const float x0 = bflo(w), x1 = bfhi(w);
                float ss = x0 * x0 + x1 * x1;
#pragma unroll
                for (int o = 1; o < 32; o <<= 1) ss += __shfl_xor(ss, o);
                const float rstd = 1.f / sqrtf(ss * (1.f / 64.f) + EPSN);
                const float y0 = x0 * rstd * gk0, y1 = x1 * rstd * gk1;
                KC[cidx] = pk2(y0 * cs - y1 * sn, y0 * sn + y1 * cs); }
            VC[cidx] = wv[r][1]; }
    }
}
DI void gla_scan_cols(LAS float* Gf, LAS float* Gb, int lane) {
    LAS float* G = (lane >> 5) ? Gb : Gf; const int d = lane & 31; float v[64];
#pragma unroll
    for (int i = 0; i < 64; ++i) v[i] = G[i * 33 + d];
    if (lane >> 5) {
#pragma unroll
        for (int i = 62; i >= 0; --i) v[i] += v[i + 1];
    } else {
#pragma unroll
        for (int i = 1; i < 64; ++i) v[i] += v[i - 1];
    }
#pragma unroll
    for (int i = 0; i < 64; ++i) G[i * 33 + d] = v[i];
}
struct GLoad { v4u g, k, v; };
DI GLoad gla_local_load(const Ctx& p, int item) {
    const int tid = otid(); const int gc = item >> 2, h = item & 3; const size_t rb = (size_t)gc * 64; const u16* P2 = (const u16*)(p.ws + WS_P2); GLoad r;
    { const int t2 = tid & 255, i = t2 >> 2, c = t2 & 3; const u16* q = P2 + (rb + i) * P2P + h * 32 + c * 8; const int dirb = tid >> 8;
        r.g = *(const v4u*)(q + (dirb ? P2_GB : P2_GF)); r.k = *(const v4u*)(q + P2_AK); }
    { const int i = tid >> 3, c = tid & 7; r.v = *(const v4u*)(P2 + (rb + i) * P2P + P2_AV + h * 64 + c * 8); }
    return r;
}
DI void gla_local_item(const Ctx& p, int l, int item, LAS float* F, const GLoad ld) {
    const int tid = otid(), lane = tid & 63, w = tid >> 6; const int gc = item >> 2, h = item & 3; const size_t rb = (size_t)gc * 64;
    const u16* P2 = (const u16*)(p.ws + WS_P2);
    LAS float* Gf = F; LAS float* Gb = Gf + 2112; LAS float* Kx = Gb + 2112; LAS u16* KDT = (LAS u16*)(Kx + 2112); LAS u16* VT = KDT + 2 * 64 * 40;
    { const int t2 = tid & 255, i = t2 >> 2, c = t2 & 3; const u16* r = P2 + (rb + i) * P2P + h * 32 + c * 8; float f[8];
        const int dirb = tid >> 8; const float* bias = p.tab[dirb ? 12 : 10] + l * 128 + h * 32 + c * 8; LAS float* G = dirb ? Gb : Gf;
        unpack8(ld.g, f);
#pragma unroll
        for (int q = 0; q < 8; ++q) G[i * 33 + c * 8 + q] = logsig(f[q] + bias[q]) * (1.f / 16.f);
        if (!dirb) { unpack8(ld.k, f);
#pragma unroll
            for (int q = 0; q < 8; ++q) Kx[i * 33 + c * 8 + q] = f[q]; } }
    { const int i = tid >> 3, c = tid & 7; *(LAS v4u*)(VT + i * 72 + c * 8) = ld.v; }
    __syncthreads();
    if (w == 0) gla_scan_cols(Gf, Gb, lane);
    __syncthreads();
    u16* GS = (u16*)(p.ws + WS_HB + HB_GS); float* DEC = (float*)(p.ws + WS_DEC); const size_t slot = (size_t)(gc * 4 + h) * 2;
#pragma unroll
    for (int r = 0; r < 8; ++r) { const int e = tid + r * 512, d = e & 31, i = (e >> 5) & 63, dir = e >> 11; const LAS float* G = dir ? Gb : Gf;
        const float bl = G[(dir ? 0 : 63) * 33 + d];
        KDT[(dir * 64 + i) * 40 + d] = (u16)f2bf(Kx[i * 33 + d] * __expf(bl - G[i * 33 + d])); }
    if (tid < 64) { const int dir = tid >> 5, d = tid & 31; DEC[(slot + dir) * 32 + d] = __expf((dir ? Gb : Gf)[(dir ? 0 : 63) * 33 + d]); }
    __syncthreads();
    { const int dir = w >> 2, mt = (w >> 1) & 1;
#pragma unroll
        for (int q = 0; q < 2; ++q) { const int nt = (w & 1) * 2 + q; f32x4_t acc = {0.f, 0.f, 0.f, 0.f};
#pragma unroll
            for (int ks = 0; ks < 2; ++ks) acc = MFMA16(ldfrag_tr(KDT + dir * 64 * 40, 40, ks * 32, mt * 16, lane), ldfrag_tr(VT, 72, ks * 32, nt * 16, lane), acc);
#pragma unroll
            for (int j = 0; j < 4; ++j) GS[(slot + dir) * 2048 + (mt * 16 + 4 * (lane >> 4) + j) * 64 + nt * 16 + (lane & 15)] = (u16)f2bf(acc[j]); } }
    __syncthreads();
}
DI void sgu_item(const Ctx& p, int l, int item, LAS float* F) {
    const int tid = otid(), lane = tid & 63, w = tid >> 6; const int ch = item >> 2, g = item & 3; const size_t rb = (size_t)ch * 128;
    const u16* P2 = (const u16*)(p.ws + WS_P2); u16* P1 = (u16*)p.out;
    LAS float* OUTF = F; LAS u16* WB = (LAS u16*)(F + 128 * 65); LAS u16* VNT = WB + 128 * 136;
    v4u pu[2], pz[2];
#pragma unroll
    for (int r = 0; r < 2; ++r) { const int task = tid + r * 512, t = task >> 3, c8 = (task & 7) * 8; pu[r] = *(const v4u*)(P2 + (rb + t) * P2P + P2_DU + g * 64 + c8); pz[r] = *(const v4u*)(P1 + (rb + t) * P1P + 1024 + g * 64 + c8); }
    { const int row = tid >> 2, qt = tid & 3; const u16* dv = P2 + (rb + row) * P2P + P2_DV; float ss = 0.f; float f[8];
#pragma unroll
        for (int c = 0; c < 8; ++c) { unpack8(*(const v4u*)(dv + qt * 64 + c * 8), f);
#pragma unroll
            for (int q = 0; q < 8; ++q) ss += f[q] * f[q]; }
        ss += __shfl_xor(ss, 1); ss += __shfl_xor(ss, 2);
        const float rstd = 1.f / sqrtf(ss * (1.f / 256.f) + EPSN); const float* ng = p.tab[17] + l * 256 + g * 64 + qt * 16;
#pragma unroll
        for (int c = 0; c < 2; ++c) { unpack8(*(const v4u*)(dv + g * 64 + qt * 16 + c * 8), f);
#pragma unroll
            for (int q = 0; q < 8; ++q) f[q] = f[q] * rstd * ng[c * 8 + q];
            *(LAS v4u*)(VNT + row * 72 + qt * 16 + c * 8) = pack8(f); } }
    { const float* wsrc = p.tab[18] + (size_t)(l * 4 + g) * 16384;
#pragma unroll
        for (int r = 0; r < 8; ++r) { const int idx = tid + r * 512, t = idx >> 5, s4 = (idx & 31) * 4; const v4f v = *(const v4f*)(wsrc + idx * 4);
            v2u o; o.x = pk2(v.x, v.y); o.y = pk2(v.z, v.w); *(LAS v2u*)(WB + t * 136 + s4) = o; } }
    __syncthreads();
    {
#pragma unroll
        for (int nt = 0; nt < 4; ++nt) { f32x4_t acc = {0.f, 0.f, 0.f, 0.f};
#pragma unroll
            for (int ks = 0; ks < 4; ++ks) acc = MFMA16(ldfrag(WB, 136, w * 16, ks * 32, lane), ldfrag_tr(VNT, 72, ks * 32, nt * 16, lane), acc);
#pragma unroll
            for (int j = 0; j < 4; ++j) OUTF[(w * 16 + 4 * (lane >> 4) + j) * 65 + nt * 16 + (lane & 15)] = acc[j]; } }
    __syncthreads();
#pragma unroll
    for (int r = 0; r < 2; ++r) { const int task = tid + r * 512, t = task >> 3, c8 = (task & 7) * 8; float acc[8];
#pragma unroll
        for (int e = 0; e < 8; ++e) acc[e] = OUTF[t * 65 + c8 + e];
        const float bias = p.tab[19][(l * 4 + g) * 128 + t];
        float uu[8], zz[8]; unpack8(pu[r], uu);
        u16* mz = P1 + (rb + t) * P1P + 1024 + g * 64 + c8; unpack8(pz[r], zz);
#pragma unroll
        for (int e = 0; e < 8; ++e) acc[e] = (acc[e] + bias) * uu[e] * silu_f(zz[e]);
        *(v4u*)mz = pack8(acc); }
    __syncthreads();
}
template <int N1> DI void fnet1_body(const Ctx& p, int row0, int N, int n2, int cb, LAS float* F) {
    constexpr int PN = N1 + 8, MT = N1 / 16, NTW = MT;
    const int tid = otid(), lane = tid & 63, w = tid >> 6;
    const u16* P2 = (const u16*)(p.ws + WS_P2); u16* TP = (u16*)(p.ws + WS_HB + HB_TP);
    const u16* Cg = (const u16*)(p.ws + WS_DFT) + (N1 == 64 ? 0 : 8192); const u16* Sg = Cg + N1 * N1;
    LAS float* tw = F; LAS u16* XT = (LAS u16*)(F + 256); LAS u16* FC = XT + N1 * 136; LAS u16* FS = FC + N1 * PN; LAS u16* OUT = FC;
#pragma unroll
    for (int r = 0; r < N1 / 32; ++r) { const int idx = tid + r * 512, n1 = idx >> 4, c = idx & 15; const v4u raw = *(const v4u*)(P2 + (size_t)(row0 + n1 * 64 + n2) * P2P + P2_BU + cb * 128 + c * 8);
        *(LAS v4u*)(XT + n1 * 136 + c * 8) = raw; }
#pragma unroll
    for (int r = 0; r < N1 * N1 / 8 / 512; ++r) { const int idx = tid + r * 512, k1 = idx / (N1 / 8), c = idx % (N1 / 8);
        *(LAS v4u*)(FC + k1 * PN + c * 8) = *(const v4u*)(Cg + k1 * N1 + c * 8); *(LAS v4u*)(FS + k1 * PN + c * 8) = *(const v4u*)(Sg + k1 * N1 + c * 8); }
    if (tid < N1) { const float ph = 2.f * (float)((n2 * tid) & (N - 1)) / (float)N; tw[2 * tid] = cospif(ph); tw[2 * tid + 1] = sinpif(ph); }
    __syncthreads();
    f32x4_t ac[NTW], as[NTW];
#pragma unroll
    for (int q = 0; q < NTW; ++q) { const int id = w + 8 * q, mt = id % MT, nt = id / MT; ac[q] = (f32x4_t){0.f, 0.f, 0.f, 0.f}; as[q] = ac[q];
#pragma unroll
        for (int ks = 0; ks < N1 / 32; ++ks) { const bf16x8_t b = ldfrag_tr(XT, 136, ks * 32, nt * 16, lane);
            ac[q] = MFMA16(ldfrag(FC, PN, mt * 16, ks * 32, lane), b, ac[q]); as[q] = MFMA16(ldfrag(FS, PN, mt * 16, ks * 32, lane), b, as[q]); } }
    __syncthreads();
    const float scale = 1.f / sqrtf((float)N1);
#pragma unroll
    for (int q = 0; q < NTW; ++q) { const int id = w + 8 * q, mt = id % MT, nt = id / MT;
#pragma unroll
        for (int j = 0; j < 4; ++j) { const int k1 = mt * 16 + 4 * (lane >> 4) + j, col = nt * 16 + (lane & 15); const float cw = tw[2 * k1], sw = tw[2 * k1 + 1];
            const float tr = ac[q][j], ti = -as[q][j];
            OUT[k1 * 256 + col] = (u16)f2bf((tr * cw + ti * sw) * scale); OUT[k1 * 256 + 128 + col] = (u16)f2bf((ti * cw - tr * sw) * scale); } }
    __syncthreads();
#pragma unroll
    for (int r = 0; r < N1 / 16; ++r) { const int idx = tid + r * 512, k1 = idx >> 5, c = idx & 31;
        const v4u v = *(const LAS v4u*)(OUT + k1 * 256 + c * 8);
        *(v4u*)(TP + (size_t)(row0 + k1 * 64 + n2) * 512 + (c >> 4) * 256 + cb * 128 + (c & 15) * 8) = v; }
    __syncthreads();
}
DI void fnet1_item(const Ctx& p, int item, LAS float* F) {
    const int s = item >> 7, r = item & 127, n2 = r >> 1, cb = r & 1; int row0, N; seq_info(s, row0, N);
    if (N == 4096) fnet1_body<64>(p, row0, N, n2, cb, F); else fnet1_body<128>(p, row0, N, n2, cb, F);
}
struct F2Load { v4u t[8]; };
DI F2Load fnet2_load(const Ctx& p, int item) {
    const int tid = otid(); int s, k1; if (item < 256) { s = item >> 6; k1 = item & 63; } else { s = 4 + ((item - 256) >> 7); k1 = (item - 256) & 127; }
    int row0, N; seq_info(s, row0, N); const u16* TP = (const u16*)(p.ws + WS_HB + HB_TP); F2Load r;
#pragma unroll
    for (int q = 0; q < 8; ++q) { const int idx = tid + q * 512, n2 = idx >> 6, c = idx & 63; r.t[q] = *(const v4u*)(TP + (size_t)(row0 + k1 * 64 + n2) * 512 + c * 8); }
    return r;
}
DI void fnet2_item(const Ctx& p, int item, LAS float* F, const F2Load ld) {
    const int tid = otid(), lane = tid & 63, w = tid >> 6; int s, k1; if (item < 256) { s = item >> 6; k1 = item & 63; } else { s = 4 + ((item - 256) >> 7); k1 = (item - 256) & 127; }
    int row0, N; seq_info(s, row0, N); const int N1 = N >> 6;
    u16* P2 = (u16*)(p.ws + WS_P2); const u16* TP = (const u16*)(p.ws + WS_HB + HB_TP); const u16* Cg = (const u16*)(p.ws + WS_DFT); const u16* Sg = Cg + 4096;
    LAS u16* BT = (LAS u16*)F; LAS u16* A1 = BT + 128 * 264; LAS u16* A2 = A1 + 64 * 136; LAS u16* OUT = BT;
#pragma unroll
    for (int r = 0; r < 8; ++r) { const int idx = tid + r * 512, n2 = idx >> 6, c = idx & 63; *(LAS v4u*)(BT + ((c >> 5) * 64 + n2) * 264 + (c & 31) * 8) = ld.t[r]; }
    { const int k2 = tid >> 3, c8 = (tid & 7) * 8; const v4u c = *(const v4u*)(Cg + k2 * 64 + c8), sv = *(const v4u*)(Sg + k2 * 64 + c8); const v4u ns = sv ^ (v4u){0x80008000u, 0x80008000u, 0x80008000u, 0x80008000u};
        *(LAS v4u*)(A1 + k2 * 136 + c8) = c; *(LAS v4u*)(A1 + k2 * 136 + 64 + c8) = sv; *(LAS v4u*)(A2 + k2 * 136 + c8) = ns; *(LAS v4u*)(A2 + k2 * 136 + 64 + c8) = c; }
    __syncthreads();
    f32x4_t acc[16]; const LAS u16* Aw = (w < 4) ? A1 : A2; const int mt = w & 3;
#pragma unroll
    for (int nt = 0; nt < 16; ++nt) { acc[nt] = (f32x4_t){0.f, 0.f, 0.f, 0.f};
#pragma unroll
        for (int ks = 0; ks < 4; ++ks) acc[nt] = MFMA16(ldfrag(Aw, 136, mt * 16, ks * 32, lane), ldfrag_tr(BT, 264, ks * 32, nt * 16, lane), acc[nt]); }
    __syncthreads();
#pragma unroll
    for (int nt = 0; nt < 16; ++nt)
#pragma unroll
        for (int j = 0; j < 4; ++j) OUT[(mt * 16 + 4 * (lane >> 4) + j) * 512 + (w >> 2) * 256 + nt * 16 + (lane & 15)] = (u16)f2bf(acc[nt][j] * 0.125f);
    __syncthreads();
#pragma unroll
    for (int r = 0; r < 8; ++r) { const int idx = tid + r * 512, k2 = idx >> 6, c = idx & 63; const v4u v = *(const LAS v4u*)(OUT + k2 * 512 + c * 8);
        *(v4u*)(P2 + (size_t)(row0 + k1 + N1 * k2) * P2P + P2_U + c * 8) = v; }
    __syncthreads();
}
DI void gla_scan_item(const Ctx& p, int item) {
    const int tid = otid(); const int chain = item >> 2, e = (item & 3) * 512 + tid; const int s = chain >> 3, h = (chain >> 1) & 3, dir = chain & 1;
    int row0, N; seq_info(s, row0, N); const int NC = N >> 6, gc0 = row0 >> 6, d = e >> 6;
    u16* GS = (u16*)(p.ws + WS_HB + HB_GS); const float* DEC = (const float*)(p.ws + WS_DEC);
    float S = 0.f;
    for (int st = 0; st < NC; st += 32) { u16 tmp[32]; float dc[32];
#pragma unroll
        for (int u = 0; u < 32; ++u) { const int c = dir ? NC - 1 - (st + u) : st + u; const size_t slot = (size_t)((gc0 + c) * 4 + h) * 2 + dir; tmp[u] = GS[slot * 2048 + e]; dc[u] = DEC[slot * 32 + d]; }
#pragma unroll
        for (int u = 0; u < 32; ++u) { const int c = dir ? NC - 1 - (st + u) : st + u; const size_t slot = (size_t)((gc0 + c) * 4 + h) * 2 + dir; GS[slot * 2048 + e] = (u16)f2bf(S); S = dc[u] * S + bf2f(tmp[u]); } }
}
struct OLoad { v4u qk, g, v, z; v2u sf, sb; };
DI OLoad gla_out_load(const Ctx& p, int item) {
    const int tid = otid(); const int gc = item >> 2, h = item & 3; const size_t rb = (size_t)gc * 64; const u16* P2 = (const u16*)(p.ws + WS_P2); const u16* P1 = (const u16*)p.out; OLoad r;
    { const int t2 = tid & 255, i = t2 >> 2, c = t2 & 3; const u16* q = P2 + (rb + i) * P2P + h * 32 + c * 8; const int dirb = tid >> 8;
        r.qk = *(const v4u*)(q + (dirb ? P2_AK : P2_AQ)); r.g = *(const v4u*)(q + (dirb ? P2_GB : P2_GF)); }
    { const int i = tid >> 3, c = tid & 7; r.v = *(const v4u*)(P2 + (rb + i) * P2P + P2_AV + h * 64 + c * 8); r.z = *(const v4u*)(P1 + (rb + i) * P1P + h * 64 + c * 8); }
    { const u16* GS = (const u16*)(p.ws + WS_HB + HB_GS); const size_t slot = (size_t)(gc * 4 + h) * 2; const int e4 = tid * 4; r.sf = *(const v2u*)(GS + slot * 2048 + e4); r.sb = *(const v2u*)(GS + (slot + 1) * 2048 + e4); }
    return r;
}
DI void gla_out_item(const Ctx& p, int l, int item, LAS float* F, const OLoad ld) {
    const int tid = otid(), lane = tid & 63, w = tid >> 6; const int gc = item >> 2, h = item & 3; const size_t rb = (size_t)gc * 64;
    const u16* P2 = (const u16*)(p.ws + WS_P2); u16* P1 = (u16*)p.out;
    LAS float* Gf = F; LAS float* Gb = Gf + 2112; LAS float* Qx = Gb + 2112; LAS float* Kx = Qx + 2112; LAS float* O = Kx + 2112;
    LAS u16* QF = (LAS u16*)(O + 64 * 65); LAS u16* KF = QF + 64 * 40; LAS u16* QB = KF + 64 * 40; LAS u16* KB = QB + 64 * 40;
    LAS u16* VT = KB + 64 * 40; LAS u16* SC = VT + 64 * 72; LAS u16* SFT = SC + 64 * 72; LAS u16* SBT = SFT + 32 * 72;
    const u16* GS = (const u16*)(p.ws + WS_HB + HB_GS); const size_t slot = (size_t)(gc * 4 + h) * 2;
    { const int t2 = tid & 255, i = t2 >> 2, c = t2 & 3; const u16* r = P2 + (rb + i) * P2P + h * 32 + c * 8; float f[8];
        const int dirb = tid >> 8; LAS float* d0 = dirb ? Kx : Qx; LAS float* d1 = dirb ? Gb : Gf; const float* bias = p.tab[dirb ? 12 : 10] + l * 128 + h * 32 + c * 8;
        unpack8(ld.qk, f);
#pragma unroll
        for (int q = 0; q < 8; ++q) d0[i * 33 + c * 8 + q] = f[q];
        unpack8(ld.g, f);
#pragma unroll
        for (int q = 0; q < 8; ++q) d1[i * 33 + c * 8 + q] = logsig(f[q] + bias[q]) * (1.f / 16.f); }
    { const int i = tid >> 3, c = tid & 7; *(LAS v4u*)(VT + i * 72 + c * 8) = ld.v; }
    { const int e4 = tid * 4, d = e4 >> 6, v = e4 & 63; *(LAS v2u*)(SFT + d * 72 + v) = ld.sf; *(LAS v2u*)(SBT + d * 72 + v) = ld.sb; }
    __syncthreads();
    if (w == 0) gla_scan_cols(Gf, Gb, lane);
    __syncthreads();
#pragma unroll
    for (int r = 0; r < 4; ++r) { const int e = tid + r * 512, d = e & 31, i = e >> 5, a = i * 33 + d; const float q = Qx[a] * 0.17677669529663687f, k = Kx[a], bf = Gf[a], bb = Gb[a];
        QF[i * 40 + d] = (u16)f2bf(q * __expf(bf)); KF[i * 40 + d] = (u16)f2bf(k * __expf(-bf)); QB[i * 40 + d] = (u16)f2bf(q * __expf(bb)); KB[i * 40 + d] = (u16)f2bf(k * __expf(-bb)); }
    __syncthreads();
#pragma unroll
    for (int q = 0; q < 2; ++q) { const int id = 2 * w + q, ti = id >> 2, si = id & 3; const f32x4_t z4 = {0.f, 0.f, 0.f, 0.f}; f32x4_t acc;
        if (si < ti) acc = MFMA16(ldfrag(QF, 40, ti * 16, 0, lane), ldfrag(KF, 40, si * 16, 0, lane), z4);
        else if (si > ti) acc = MFMA16(ldfrag(QB, 40, ti * 16, 0, lane), ldfrag(KB, 40, si * 16, 0, lane), z4);
        else { const f32x4_t af = MFMA16(ldfrag(QF, 40, ti * 16, 0, lane), ldfrag(KF, 40, si * 16, 0, lane), z4), ab = MFMA16(ldfrag(QB, 40, ti * 16, 0, lane), ldfrag(KB, 40, si * 16, 0, lane), z4);
#pragma unroll
            for (int j = 0; j < 4; ++j) acc[j] = ((lane & 15) <= 4 * (lane >> 4) + j) ? af[j] : ab[j]; }
#pragma unroll
        for (int j = 0; j < 4; ++j) SC[(ti * 16 + 4 * (lane >> 4) + j) * 72 + si * 16 + (lane & 15)] = (u16)f2bf(acc[j]); }
    __syncthreads();
#pragma unroll
    for (int q = 0; q < 2; ++q) { const int id = 2 * w + q, ti = id >> 2, vi = id & 3; f32x4_t acc = {0.f, 0.f, 0.f, 0.f};
        acc = MFMA16(ldfrag(SC, 72, ti * 16, 0, lane), ldfrag_tr(VT, 72, 0, vi * 16, lane), acc);
        acc = MFMA16(ldfrag(SC, 72, ti * 16, 32, lane), ldfrag_tr(VT, 72, 32, vi * 16, lane), acc);
        acc = MFMA16(ldfrag(QF, 40, ti * 16, 0, lane), ldfrag_tr(SFT, 72, 0, vi * 16, lane), acc);
        acc = MFMA16(ldfrag(QB, 40, ti * 16, 0, lane), ldfrag_tr(SBT, 72, 0, vi * 16, lane), acc);
#pragma unroll
        for (int j = 0; j < 4; ++j) O[(ti * 16 + 4 * (lane >> 4) + j) * 65 + vi * 16 + (lane & 15)] = acc[j]; }
    __syncthreads();
    { const int t = tid >> 3, v8 = (tid & 7) * 8; float acc[8]; float ss = 0.f;
#pragma unroll
        for (int e = 0; e < 8; ++e) { acc[e] = O[t * 65 + v8 + e]; ss += acc[e] * acc[e]; }
        ss += __shfl_xor(ss, 1); ss += __shfl_xor(ss, 2); ss += __shfl_xor(ss, 4);
        const float rstd = 1.f / sqrtf(ss * (1.f / 64.f) + EPSN);
        u16* mz = P1 + (rb + t) * P1P + h * 64 + v8; float zz[8]; unpack8(ld.z, zz);
#pragma unroll
        for (int e = 0; e < 8; ++e) acc[e] = acc[e] * rstd * p.tab[13][l * 64 + v8 + e] * silu_f(zz[e]);
        *(v4u*)mz = pack8(acc); }
    __syncthreads();
}
#define XB_TMO      128
#define XB_XCNT(j)  (256  + 64 * (j))
#define XB_XSUB(j)  (1280 + 64 * (j))
#define XB_XGEN(j)  (2304 + 64 * (j))
#define XB_TOP      3328
#define XB_TOPGEN   3392
#define XCD_BAR_WORDS 3456
#define XB_SPIN_CAP (1u << 18)

__device__ __forceinline__ unsigned xb_ld(unsigned* p)              { return __hip_atomic_load(p, __ATOMIC_RELAXED, __HIP_MEMORY_SCOPE_AGENT); }
__device__ __forceinline__ unsigned xb_add(unsigned* p, unsigned v) { return __hip_atomic_fetch_add(p, v, __ATOMIC_RELAXED, __HIP_MEMORY_SCOPE_AGENT); }
__device__ __forceinline__ unsigned xb_xcc_id() { return (unsigned)__builtin_amdgcn_s_getreg((3 << 11) | 20) & 0xFu; }
#define XB_SPIN(cond, bar) do { unsigned _sp = 0; while (cond) { __builtin_amdgcn_s_sleep(1); \
    if ((++_sp & 255u) == 0u) { if (xb_ld(&(bar)[XB_TMO])) break; if (_sp > XB_SPIN_CAP) { atomicAdd(&(bar)[XB_TMO], 1u); break; } } } } while (0)

struct XcdBarrier {
    unsigned* bar; unsigned x;
    volatile LAS unsigned* st;
};

__device__ __forceinline__ XcdBarrier xcd_barrier_post(unsigned* bar, volatile LAS unsigned* st) {
    XcdBarrier b; b.bar = bar; b.x = xb_xcc_id(); b.st = st;
    if (threadIdx.x == 0) (void)xb_add(&bar[XB_XCNT(b.x)], 1u);
    return b;
}
__device__ __forceinline__ void xcd_barrier_complete(unsigned* bar, unsigned x, unsigned& nloc, unsigned& nx) {
    const unsigned G = gridDim.x * gridDim.y * gridDim.z;
    unsigned sum, cnt, mine, sp = 0u;
    for (;;) {
        sum = 0u; cnt = 0u; mine = 0u;
#pragma unroll
        for (unsigned j = 0; j < 16; ++j) { const unsigned c = xb_ld(&bar[XB_XCNT(j)]); sum += c; cnt += (c > 0u) ? 1u : 0u; mine = (j == x) ? c : mine; }
        if (sum == G) break;
        __builtin_amdgcn_s_sleep(1);
        if ((++sp & 255u) == 0u) { if (xb_ld(&bar[XB_TMO])) break; if (sp > XB_SPIN_CAP) { atomicAdd(&bar[XB_TMO], 1u); break; } }
    }
    nloc = mine > 0u ? mine : 1u; nx = cnt > 0u ? cnt : 1u;
}

__device__ __forceinline__ void xcd_barrier(const XcdBarrier& b) {
    asm volatile("s_waitcnt vmcnt(0)" ::: "memory");
    __syncthreads();
    if (threadIdx.x == 0) {
        unsigned* bar = b.bar;
        __builtin_amdgcn_s_waitcnt(0);
        unsigned nloc = b.st[0], nx = b.st[1];
        if (nloc == 0u) { xcd_barrier_complete(bar, b.x, nloc, nx); b.st[0] = nloc; b.st[1] = nx; }
        const unsigned old = xb_add(&bar[XB_XSUB(b.x)], 1u);
        const unsigned gen = old / nloc;
        if (old + 1u == (gen + 1u) * nloc) {
            __builtin_amdgcn_fence(__ATOMIC_RELEASE, "agent");
            asm volatile("s_waitcnt vmcnt(0)" ::: "memory");
            const unsigned og = xb_add(&bar[XB_TOP], 1u);
            const unsigned tg = og / nx;
            if (og + 1u == (tg + 1u) * nx) xb_add(&bar[XB_TOPGEN], 1u);
            else XB_SPIN(xb_ld(&bar[XB_TOPGEN]) == tg, bar);
            __builtin_amdgcn_fence(__ATOMIC_ACQUIRE, "agent");
            xb_add(&bar[XB_XGEN(b.x)], 1u);
            asm volatile("s_waitcnt vmcnt(0)" ::: "memory");
        } else {
            XB_SPIN(xb_ld(&bar[XB_XGEN(b.x)]) == gen, bar);
            __builtin_amdgcn_fence(__ATOMIC_ACQUIRE, "agent");
            asm volatile("s_waitcnt vmcnt(0)" ::: "memory");
        }
    }
    __syncthreads();
}


#ifndef GM
#define GM 7
#endif
#ifndef PH
#define PH 1023
#endif
__global__ void __launch_bounds__(512, 2) fwd_kernel(Params kp) {
    extern __shared__ __attribute__((aligned(16))) unsigned char lds[];
    cg::grid_group grid = cg::this_grid();
    LAS unsigned char* L = (LAS unsigned char*)lds; LAS float* F = (LAS float*)lds;
    const int G = gridDim.x, bid = blockIdx.x;
    Ctx p; p.out = kp.out; p.ws = kp.ws; p.tab = (LAS cfp*)(L + 131072);
    if (otid() == 0) { p.tab[0] = kp.xp; p.tab[1] = kp.xs; p.tab[2] = kp.cp; p.tab[3] = kp.cs; p.tab[4] = kp.ada_w; p.tab[5] = kp.ada_b; p.tab[6] = kp.pre_g; p.tab[7] = kp.post_g; p.tab[8] = kp.w_in;
        p.tab[9] = kp.wg2f; p.tab[10] = kp.bgf; p.tab[11] = kp.wg2b; p.tab[12] = kp.bgb; p.tab[13] = kp.onorm_g; p.tab[14] = kp.fnet_w; p.tab[15] = kp.qn_g; p.tab[16] = kp.kn_g; p.tab[17] = kp.sgu_ng;
        p.tab[18] = kp.sgu_w; p.tab[19] = kp.sgu_b; p.tab[20] = kp.w_out; }
    volatile LAS unsigned* bst = (volatile LAS unsigned*)(L + 131072 + 256);
    if (otid() < 4) bst[otid()] = 0u;
    __syncthreads();
    const XcdBarrier xbar = xcd_barrier_post((unsigned*)(p.ws + WS_BAR), bst);
    u16* P1 = (u16*)p.out; u16* P2 = (u16*)(p.ws + WS_P2); u16* HB = (u16*)(p.ws + WS_HB); u16* U0 = (u16*)(p.ws + WS_U0);


#if PH & 1
    phase0(p, L);
#endif
    grid.sync();
    for (int step = 0; step < 12; ++step) {
        const int l = step / 6, ph = step % 6;
        bool do_gemm = false; pg8::Gemm g{nullptr, nullptr, T_TOK, 0, 0, 0, 0}; pg8::EpiX E{0, nullptr, 0, nullptr, 0, 0};
        if (ph == 0) {
#if PH & 2
            phaseA(p, l);
#endif
        } else if (ph == 1) {
            g.A = HB; g.Bt = (const u16*)(p.ws + WS_WIN) + (size_t)l * 3584 * 1024; g.N = 3584; g.K = 1024; g.lda = 1024; g.ldb = 1024;
            E.mode = 0; E.O1 = P1; E.ld1 = P1P; E.O2 = P2; E.ld2 = P2P; do_gemm = true;
        } else if (ph == 2) {
#if PH & 4
            qk_prep(p, l);
#endif
#if PH & 8
            { GLoad nx = gla_local_load(p, bid < 2048 ? bid : 0); for (int it = bid; it < 2048; it += G) { const GLoad cur = nx; if (it + G < 2048) nx = gla_local_load(p, it + G); gla_local_item(p, l, it, F, cur); } }
#endif
#if PH & 16
            for (int it = bid; it < 1024; it += G) sgu_item(p, l, it, F);
#endif
#if PH & 32
            for (int it = bid; it < 768; it += G) fnet1_item(p, it, F);
#endif
        } else if (ph == 3) {
#if PH & 64
            for (int it = bid; it < 192; it += G) gla_scan_item(p, it);
#endif
#if PH & 128
            { F2Load nx = fnet2_load(p, bid < 512 ? bid : 0); for (int it = bid; it < 512; it += G) { const F2Load cur = nx; if (it + G < 512) nx = fnet2_load(p, it + G); fnet2_item(p, it, F, cur); } }
#endif
            __syncthreads();
#ifndef SKIP_ATTN
            for (int u = ((G & 7) == 0 ? (bid & 7) * (G >> 3) + (bid >> 3) : bid); u < 1024; u += G) {
                int s, h, qb;
                if (u < 512) { s = u >> 7; const int r = u & 127; h = r >> 4; qb = r & 15; } else { const int u2 = u - 512; s = 4 + (u2 >> 8); const int r = u2 & 255; h = r >> 5; qb = r & 31; }
                int row0, N; seq_info(s, row0, N);
                const attn_body::bf16* Pb = (const attn_body::bf16*)P1;
                const attn_body::bf16* KCb = (const attn_body::bf16*)(p.ws + WS_HB + HB_KC) + ((size_t)row0 * 2 + (size_t)(h >> 2) * N) * 64;
                const attn_body::bf16* VCb = (const attn_body::bf16*)(p.ws + WS_HB + HB_VC) + ((size_t)row0 * 2 + (size_t)(h >> 2) * N) * 64;
                attn_body::attn_unit<8>(Pb + (size_t)(row0 + qb * 256) * P1P + P1_Q + h * 64, KCb, VCb,
                                        (attn_body::bf16*)P1 + (size_t)(row0 + qb * 256) * P1P + 512 + h * 64, N >> 6, (char*)lds, qb * 256, p.tab[15] + l * 64);
            }
#endif
        } else if (ph == 4) {
#if PH & 256
            if (G == 256) { const int i0 = bid < 128 ? bid * 7 : 896 + (bid - 128) * 9, i1 = i0 + (bid < 128 ? 7 : 9);
                OLoad nx = gla_out_load(p, i0); for (int it = i0; it < i1; ++it) { const OLoad cur = nx; if (it + 1 < i1) nx = gla_out_load(p, it + 1); gla_out_item(p, l, it, F, cur); } }
            else { OLoad nx = gla_out_load(p, bid < 2048 ? bid : 0); for (int it = bid; it < 2048; it += G) { const OLoad cur = nx; if (it + G < 2048) nx = gla_out_load(p, it + G); gla_out_item(p, l, it, F, cur); } }
#endif
            g.A = P2 + P2_U; g.Bt = (const u16*)(p.ws + WS_WF) + (size_t)l * 131072; g.N = 256; g.K = 512; g.lda = P2P; g.ldb = 512;
            E.mode = 2; E.O1 = P1; E.ld1 = P1P; E.col_off = 256; do_gemm = true;
        } else {
            g.A = P1; g.Bt = (const u16*)(p.ws + WS_WOUT) + (size_t)l * 1024 * 1280; g.N = 1024; g.K = 1280; g.lda = P1P; g.ldb = 1280;
            E.mode = 1; E.O1 = (l == 0) ? U0 : HB; E.ld1 = 1024; do_gemm = true;
        }
#if GM
        if (do_gemm) { pg8::StaticOrder S; S.init(T_TOK, g.N, G, bid); pg8::gemm_phase<pg8::EpiX, pg8::StaticOrder, PG8_ALIGN, PG8_SP2>(L, g, S, E); }
#endif
        xcd_barrier(xbar);
    }
#if PH & 2
    phaseA(p, 2);
#endif
}

extern "C" void kernel_launch(void* const* d_in, const int* in_sizes, int n_in, void* d_out, int out_size, void* d_ws, size_t ws_size, hipStream_t stream) {
    static int grid = 0;
    if (grid == 0) {
        if (n_in != 21 || out_size != T_TOK * 1024 || ws_size < WS_END) { fprintf(stderr, "kernel_launch: unexpected sizes n_in %d out %d ws %zu\n", n_in, out_size, ws_size); grid = -1; return; }
        int dev = 0, cus = 0, per_cu = 0;
        (void)hipGetDevice(&dev); (void)hipDeviceGetAttribute(&cus, hipDeviceAttributeMultiprocessorCount, dev);
        if (hipFuncSetAttribute((const void*)fwd_kernel, hipFuncAttributeMaxDynamicSharedMemorySize, LDS_BYTES) != hipSuccess) { fprintf(stderr, "kernel_launch: hipFuncSetAttribute failed\n"); grid = -1; return; }
        if (hipOccupancyMaxActiveBlocksPerMultiprocessor(&per_cu, (const void*)fwd_kernel, 512, LDS_BYTES) != hipSuccess || per_cu < 1) { fprintf(stderr, "kernel_launch: occupancy query gave %d\n", per_cu); per_cu = 1; }
        (void)hipGetLastError();
        grid = cus * 1;
        fprintf(stderr, "kernel_launch: grid %d (per_cu %d) ws %zu\n", grid, per_cu, ws_size);
    }
    if (grid < 0) return;
    Params p{};
    const float** pp = (const float**)&p;
    for (int i = 0; i < 21; ++i) pp[i] = (const float*)d_in[i];
    p.out = (float*)d_out; p.ws = (unsigned char*)d_ws;
    if (hipMemsetAsync((char*)d_ws + WS_MOD, 0, 2 * 6 * 3072 * sizeof(float), stream) != hipSuccess) { fprintf(stderr, "kernel_launch: memset failed\n"); return; }
    if (hipMemsetAsync((char*)d_ws + WS_BAR, 0, BAR_BYTES, stream) != hipSuccess) { fprintf(stderr, "kernel_launch: memset failed\n"); return; }
    void* args[] = {&p};
    hipError_t e = hipLaunchCooperativeKernel((const void*)fwd_kernel, dim3(grid), dim3(512), args, LDS_BYTES, stream);
    if (e != hipSuccess) fprintf(stderr, "cooperative launch failed: %s (grid %d)\n", hipGetErrorString(e), grid);
}
```

```cpp
#include <hip/hip_runtime.h>
#include <hip/hip_cooperative_groups.h>
#include <cstdio>
#include <cstdint>
namespace cg = cooperative_groups;
__device__ __forceinline__ int otid() { int t = threadIdx.x; asm volatile("" : "+v"(t)); return t; }
namespace pg8 {
#define PG8_LAS __attribute__((address_space(3)))
typedef unsigned short bf16_t;
typedef short bf16x8 __attribute__((ext_vector_type(8)));
typedef float f32x4 __attribute__((ext_vector_type(4)));
typedef unsigned u32x4 __attribute__((ext_vector_type(4)));
constexpr int BM = 256, BK = 64, HALF = 128, HTB = HALF * BK * 2  , STAGE_BYTES = 8 * HTB, NXCD = 8, WGM = 8;

__host__ __device__ __forceinline__ int lds_byte(int r, int c) { const int st = (r >> 4) * 2 + (c >> 5), rr = r & 15, cc = c & 31, ob = rr * 64 + cc * 2; return st * 1024 + (ob ^ (((ob >> 9) & 1) << 5)); }
__host__ __device__ __forceinline__ void stage_rc(int b, int& R, int& C) { const int st = b / 1024, sb = b % 1024, swz = sb ^ (((sb >> 9) & 1) << 5); R = (st >> 1) * 16 + swz / 64; C = (st & 1) * 32 + (swz % 64) / 2; }
__host__ __device__ __forceinline__ int perm32(int rho) { const int n = rho >> 4, i = rho & 15; return 8 * (i >> 2) + 4 * n + (i & 3); }

struct Unit { int pm, pn; };
struct Gemm { const bf16_t* A; const bf16_t* Bt; int M, N, K, lda, ldb; };

struct StaticOrder {
    int nM, nN, nwg, G, c;
    __host__ __device__ void init(int M, int N, int G_, int c_) { nM = M / BM; nN = N / BM; nwg = nM * nN; G = G_; c = c_; }
    __host__ __device__ bool next(int i, Unit& u) const {
        const long L = (long)i * G + c; if (L >= nwg) return false;
        int wgid = (int)L; { const int q = nwg / NXCD, r = nwg % NXCD, xcd = wgid % NXCD, off = wgid / NXCD; wgid = (xcd < r ? xcd * (q + 1) : r * (q + 1) + (xcd - r) * q) + off; }
        const int nig = WGM * nN, gid = wgid / nig, fm = gid * WGM, gsz = (nM - fm) < WGM ? (nM - fm) : WGM;
        u.pm = fm + ((wgid % nig) % gsz); u.pn = (wgid % nig) / gsz; return true;
    }
    __device__ __forceinline__ void a_ready(const Unit&) const {}
    __device__ __forceinline__ void done(const Unit&) const {}
};

__device__ __forceinline__ unsigned cvt_pk_bf16(float lo, float hi) { unsigned r; asm volatile("v_cvt_pk_bf16_f32 %0, %1, %2" : "=v"(r) : "v"(lo), "v"(hi)); return r; }
__device__ __forceinline__ float silu_f(float z) { return z / (1.f + __expf(-z)); }
struct EpiX {
    static constexpr bool PERM = true, AFTER_DRAIN = false;
    int mode; bf16_t* O1; int ld1; bf16_t* O2; int ld2; int col_off;
    __device__ __forceinline__ void operator()(const f32x4 (&acc)[2][2][4][2], const Unit& u, int wr, int wc, int fr, int fq) const {
        const int row0 = u.pm * BM + wr * 64 + fr;
        bf16_t* base; int ld, colt;
        if (mode == 0) { if (u.pn < 8) { base = O1; ld = ld1; colt = u.pn * BM; } else { base = O2; ld = ld2; colt = (u.pn - 8) * BM; } }
        else { base = O1; ld = ld1; colt = col_off + u.pn * BM; }
        const int col0 = colt + wc * 32 + 8 * fq;
#pragma unroll
        for (int ai = 0; ai < 2; ++ai)
#pragma unroll
            for (int m = 0; m < 4; ++m) { bf16_t* rowp = base + (size_t)(row0 + ai * HALF + m * 16) * ld + col0;
#pragma unroll
                for (int bj = 0; bj < 2; ++bj) { f32x4 v0 = acc[ai][bj][m][0], v1 = acc[ai][bj][m][1];
                    if (mode == 2) { const u32x4 z = *(const u32x4*)(rowp + bj * HALF);
                        v0[0] *= silu_f(__uint_as_float(z.x << 16)); v0[1] *= silu_f(__uint_as_float(z.x & 0xffff0000u));
                        v0[2] *= silu_f(__uint_as_float(z.y << 16)); v0[3] *= silu_f(__uint_as_float(z.y & 0xffff0000u));
                        v1[0] *= silu_f(__uint_as_float(z.z << 16)); v1[1] *= silu_f(__uint_as_float(z.z & 0xffff0000u));
                        v1[2] *= silu_f(__uint_as_float(z.w << 16)); v1[3] *= silu_f(__uint_as_float(z.w & 0xffff0000u)); }
                    u32x4 w; w.x = cvt_pk_bf16(v0[0], v0[1]); w.y = cvt_pk_bf16(v0[2], v0[3]); w.z = cvt_pk_bf16(v1[0], v1[1]); w.w = cvt_pk_bf16(v1[2], v1[3]);
                    *(u32x4*)(rowp + bj * HALF) = w; } }
    }
};
#ifndef PG8_SP2
#define PG8_SP2 true
#endif
#ifndef PG8_ALIGN
#define PG8_ALIGN true
#endif
template <class Epi, class Sched, bool ALIGN_EPI = false, bool SP2 = false>
__device__ __forceinline__ void gemm_phase(PG8_LAS unsigned char* lds, const Gemm g, const Sched& S, const Epi& E) {
    const int tid = otid(), wid = __builtin_amdgcn_readfirstlane(tid >> 6), lane = tid & 63, wr = wid >> 2, wc = wid & 3, fr = lane & 15, fq = lane >> 4;
    const int K = g.K, nt = K / BK;
    unsigned voffA[2], voffB[2];
#pragma unroll
    for (int i = 0; i < 2; ++i) { int R, C; stage_rc(tid * 16 + i * 8192, R, C); const int Rb = Epi::PERM ? ((R & ~31) + perm32(R & 31)) : R;
        voffA[i] = (unsigned)(R * g.lda + C) * 2u; voffB[i] = (unsigned)(Rb * g.ldb + C) * 2u; }
    const size_t kstep = (size_t)(BK * 2);
    const size_t hstepA = (size_t)HALF * g.lda * 2, hstepB = (size_t)HALF * g.ldb * 2;
    const size_t tstepA = 2 * hstepA, tstepB = 2 * hstepB;
    const unsigned ldsw = (unsigned)wid * 1024u;
    const int aoff = lds_byte(wr * 64 + fr, fq * 8), boff = lds_byte(wc * 32 + fr, fq * 8);
#define PG8_SA(b, h) (((b) * 2 + (h)) * HTB)
#define PG8_SB(b, h) ((4 + (b) * 2 + (h)) * HTB)
#define PG8_STAGE(bufoff, gbase, voff) do { _Pragma("unroll") for (int _i = 0; _i < 2; ++_i) \
        __builtin_amdgcn_global_load_lds((const unsigned*)((const char*)(gbase) + (voff)[_i]), (PG8_LAS unsigned*)(lds + (bufoff) + ldsw + _i * 8192), 16, 0, 0); } while (0)
#define PG8_LDA(dst, b, h) do { _Pragma("unroll") for (int m = 0; m < 4; ++m) _Pragma("unroll") for (int k = 0; k < 2; ++k) dst[m][k] = *(const PG8_LAS bf16x8*)(lds + PG8_SA(b, h) + aoff + m * 2048 + k * 1024); } while (0)
#define PG8_LDB(dst, b, h) do { _Pragma("unroll") for (int n = 0; n < 2; ++n) _Pragma("unroll") for (int k = 0; k < 2; ++k) dst[n][k] = *(const PG8_LAS bf16x8*)(lds + PG8_SB(b, h) + boff + n * 2048 + k * 1024); } while (0)
#define PG8_MMA(ai, bj, At, Bt) do { __builtin_amdgcn_s_setprio(1); _Pragma("unroll") for (int m = 0; m < 4; ++m) _Pragma("unroll") for (int n = 0; n < 2; ++n) _Pragma("unroll") for (int k = 0; k < 2; ++k) \
        acc[ai][bj][m][n] = __builtin_amdgcn_mfma_f32_16x16x32_bf16(Bt[n][k], At[m][k], acc[ai][bj][m][n], 0, 0, 0); __builtin_amdgcn_s_setprio(0); } while (0)
#define PG8_WAIT_V(n) asm volatile("s_waitcnt vmcnt(" #n ")" ::: "memory")
#define PG8_WAIT_L(n) asm volatile("s_waitcnt lgkmcnt(" #n ")" ::: "memory")
#define PG8_BAR __builtin_amdgcn_s_barrier()
#define PG8_SCHED __builtin_amdgcn_sched_barrier(0)
    Unit cur, nxt; int ui = 0;
    if (!S.next(0, cur)) return;
    f32x4 acc[2][2][4][2];
#pragma unroll
    for (int a = 0; a < 2; ++a)
#pragma unroll
        for (int b = 0; b < 2; ++b)
#pragma unroll
            for (int m = 0; m < 4; ++m)
#pragma unroll
                for (int n = 0; n < 2; ++n) acc[a][b][m][n] = (f32x4){0.f, 0.f, 0.f, 0.f};
    bf16x8 At[4][2], B0[2][2], B1[2][2];
    const char* cA = (const char*)g.A + (size_t)cur.pm * tstepA; const char* cB = (const char*)g.Bt + (size_t)cur.pn * tstepB;
    S.a_ready(cur);
    if constexpr (SP2) {
        PG8_STAGE(PG8_SB(0, 0), cB, voffB); PG8_STAGE(PG8_SB(0, 1), cB + hstepB, voffB); PG8_STAGE(PG8_SA(0, 0), cA, voffA); PG8_STAGE(PG8_SA(0, 1), cA + hstepA, voffA);
        if (wr == 1) PG8_BAR;
        PG8_WAIT_V(2); PG8_BAR;
        PG8_STAGE(PG8_SB(1, 0), cB + kstep, voffB); PG8_STAGE(PG8_SA(1, 0), cA + kstep, voffA); PG8_STAGE(PG8_SB(1, 1), cB + hstepB + kstep, voffB);
        PG8_WAIT_V(6); PG8_BAR;
    } else {
        PG8_STAGE(PG8_SB(0, 0), cB, voffB); PG8_STAGE(PG8_SA(0, 0), cA, voffA); PG8_STAGE(PG8_SB(0, 1), cB + hstepB, voffB); PG8_STAGE(PG8_SA(0, 1), cA + hstepA, voffA);
        if (wr == 1) PG8_BAR;
        PG8_WAIT_V(4); PG8_BAR;
        PG8_STAGE(PG8_SB(1, 0), cB + kstep, voffB); PG8_STAGE(PG8_SA(1, 0), cA + kstep, voffA); PG8_STAGE(PG8_SB(1, 1), cB + hstepB + kstep, voffB);
        PG8_WAIT_V(6); PG8_BAR;
    }
    for (;;) {
        const bool has_next = S.next(ui + 1, nxt);
        const char* nA = has_next ? (const char*)g.A + (size_t)nxt.pm * tstepA : cA; const char* nB = has_next ? (const char*)g.Bt + (size_t)nxt.pn * tstepB : cB;
        for (int t = 0; t < nt; t += 2) {
            const bool last = (t == nt - 2);
            const char* a1 = cA + (size_t)(t + 1) * kstep;
            const char* a2 = last ? nA : cA + (size_t)(t + 2) * kstep; const char* b2 = last ? nB : cB + (size_t)(t + 2) * kstep;
            const char* a3 = a2 + kstep; const char* b3 = b2 + kstep;
            if (last && has_next) S.a_ready(nxt);
            if constexpr (SP2) {
            PG8_LDB(B0, 0, 0); PG8_LDB(B1, 0, 1); PG8_SCHED; PG8_LDA(At, 0, 0); PG8_STAGE(PG8_SA(1, 1), a1 + hstepA, voffA);
            PG8_WAIT_V(8); PG8_WAIT_L(0); PG8_BAR; PG8_MMA(0, 0, At, B0); PG8_MMA(0, 1, At, B1); PG8_BAR; PG8_SCHED;
            PG8_LDA(At, 0, 1); PG8_STAGE(PG8_SB(0, 0), b2, voffB); PG8_STAGE(PG8_SB(0, 1), b2 + hstepB, voffB); PG8_STAGE(PG8_SA(0, 0), a2, voffA);
            PG8_WAIT_V(8); PG8_WAIT_L(0); PG8_BAR; PG8_MMA(1, 0, At, B0); PG8_MMA(1, 1, At, B1); PG8_BAR; PG8_SCHED;
            PG8_LDB(B0, 1, 0); PG8_LDB(B1, 1, 1); PG8_SCHED; PG8_LDA(At, 1, 0); PG8_STAGE(PG8_SA(0, 1), a2 + hstepA, voffA);
            PG8_WAIT_V(8); PG8_WAIT_L(0); PG8_BAR; PG8_MMA(0, 0, At, B0); PG8_MMA(0, 1, At, B1); PG8_BAR; PG8_SCHED;
            PG8_LDA(At, 1, 1); PG8_STAGE(PG8_SB(1, 0), b3, voffB); PG8_STAGE(PG8_SB(1, 1), b3 + hstepB, voffB); PG8_STAGE(PG8_SA(1, 0), a3, voffA);
            PG8_WAIT_V(8); PG8_WAIT_L(0); PG8_BAR; PG8_MMA(1, 0, At, B0); PG8_MMA(1, 1, At, B1); PG8_BAR; PG8_SCHED;
            } else {
            PG8_LDB(B0, 0, 0); PG8_SCHED; PG8_LDA(At, 0, 0); PG8_STAGE(PG8_SA(1, 1), a1 + hstepA, voffA);
            PG8_WAIT_L(8); PG8_BAR; PG8_WAIT_L(0); PG8_MMA(0, 0, At, B0); PG8_BAR; PG8_SCHED;
            PG8_LDB(B1, 0, 1); PG8_STAGE(PG8_SB(0, 0), b2, voffB);
            PG8_BAR; PG8_WAIT_L(0); PG8_MMA(0, 1, At, B1); PG8_BAR;
            PG8_LDA(At, 0, 1); PG8_STAGE(PG8_SA(0, 0), a2, voffA);
            PG8_BAR; PG8_WAIT_L(0); PG8_MMA(1, 0, At, B0); PG8_BAR; PG8_SCHED;
            PG8_STAGE(PG8_SB(0, 1), b2 + hstepB, voffB);
            PG8_WAIT_V(6); PG8_BAR; PG8_MMA(1, 1, At, B1); PG8_BAR;
            PG8_LDB(B0, 1, 0); PG8_SCHED; PG8_LDA(At, 1, 0); PG8_STAGE(PG8_SA(0, 1), a2 + hstepA, voffA);
            PG8_WAIT_L(8); PG8_BAR; PG8_WAIT_L(0); PG8_MMA(0, 0, At, B0); PG8_BAR; PG8_SCHED;
            PG8_LDB(B1, 1, 1); PG8_STAGE(PG8_SB(1, 0), b3, voffB);
            PG8_BAR; PG8_WAIT_L(0); PG8_MMA(0, 1, At, B1); PG8_BAR;
            PG8_LDA(At, 1, 1); PG8_STAGE(PG8_SA(1, 0), a3, voffA);
            PG8_BAR; PG8_WAIT_L(0); PG8_MMA(1, 0, At, B0); PG8_BAR; PG8_SCHED;
            PG8_STAGE(PG8_SB(1, 1), b3 + hstepB, voffB);
            PG8_WAIT_V(6); PG8_BAR; PG8_MMA(1, 1, At, B1); PG8_BAR;
            }
        }
        if constexpr (ALIGN_EPI) { if (wr == 0) PG8_BAR; }
        if constexpr (!Epi::AFTER_DRAIN) { E(acc, cur, wr, wc, fr, fq); S.done(cur); }
        if (!has_next) break;
#pragma unroll
        for (int a = 0; a < 2; ++a)
#pragma unroll
            for (int b = 0; b < 2; ++b)
#pragma unroll
                for (int m = 0; m < 4; ++m)
#pragma unroll
                    for (int n = 0; n < 2; ++n) acc[a][b][m][n] = (f32x4){0.f, 0.f, 0.f, 0.f};
        cur = nxt; cA = nA; cB = nB; ++ui;
        if constexpr (ALIGN_EPI) { if (wr == 1) PG8_BAR; }
    }
    PG8_WAIT_V(0);
    if constexpr (!ALIGN_EPI) { if (wr == 0) PG8_BAR; }
    PG8_BAR;
    if constexpr (Epi::AFTER_DRAIN) { E.fused(acc, cur, wr, wc, fr, fq, lds, wid, lane); S.done(cur); }
#undef PG8_SA
#undef PG8_SB
#undef PG8_STAGE
#undef PG8_LDA
#undef PG8_LDB
#undef PG8_MMA
#undef PG8_WAIT_V
#undef PG8_WAIT_L
#undef PG8_BAR
#undef PG8_SCHED
}
}
#include <hip/hip_bf16.h>
#include <cmath>
namespace attn_body {
using bf16=__hip_bfloat16;
using bf16x8=__attribute__((ext_vector_type(8)))short;
using s16x4=__attribute__((ext_vector_type(4)))short;
using f32x16=__attribute__((ext_vector_type(16)))float;
using u32x4=__attribute__((ext_vector_type(4)))unsigned;
constexpr int D=64,DM=2048,KDM=64;
constexpr int NW=8,QBLK=32,QB=QBLK*NW,KVBLK=64;
constexpr int ATTN_PITCH=DM, ATTN_UNIT_ROWS=QB;
__device__ __forceinline__ int crow(int r,int hi){return (r&3)+8*(r>>2)+4*hi;}
#define SBAR() __builtin_amdgcn_sched_barrier(0)
__device__ __forceinline__ void cmask(f32x16&p0,f32x16&p1,int jb,int qrel,int hi){
  const float NEG=-INFINITY; int kb=64*jb+4*hi;
  #pragma unroll
  for(int r=0;r<16;++r){int kv=kb+(r&3)+8*(r>>2); if(kv>qrel)p0[r]=NEG; if(kv+32>qrel)p1[r]=NEG;}
}

constexpr int NSLOT=3, SLOTB=8192;
constexpr int LDS_K=0, LDS_V=NSLOT*SLOTB, LDS_WS=2*NSLOT*SLOTB, LDS_OST=LDS_WS+NW*64*4, LDS_BYTES=LDS_OST+NW*4096;
constexpr float C2=0.125f*1.4426950408889634f;
__device__ __forceinline__ void glds16(const void*gsrc,unsigned lds_dst){unsigned keep;
  asm volatile("s_mov_b32 %0, m0\n\ts_mov_b32 m0, %2\n\ts_nop 0\n\tglobal_load_lds_dwordx4 %1, off\n\ts_mov_b32 m0, %0":"=&s"(keep):"v"(gsrc),"s"(lds_dst):"memory");}
__device__ __forceinline__ float max3f(float a,float b,float c){float r;asm("v_max3_f32 %0, %1, %2, %3":"=v"(r):"v"(a),"v"(b),"v"(c));return r;}
__device__ __forceinline__ float max2f(float a,float b){float r;asm("v_max_f32_e32 %0, %1, %2":"=v"(r):"v"(a),"v"(b));return r;}
__device__ __forceinline__ float fadd_s(float a,float b){float r;asm("v_add_f32_e32 %0, %1, %2":"=v"(r):"v"(a),"v"(b));return r;}
__device__ __forceinline__ float fsub_s(float a,float b){float r;asm("v_sub_f32_e32 %0, %1, %2":"=v"(r):"v"(a),"v"(b));return r;}
typedef float f32x2_t __attribute__((ext_vector_type(2))); typedef __bf16 bf16x2_t __attribute__((ext_vector_type(2)));
__device__ __forceinline__ unsigned cvtpk_s(float lo,float hi){f32x2_t v={lo,hi};bf16x2_t b=__builtin_convertvector(v,bf16x2_t);return __builtin_bit_cast(unsigned,b);}
#define WAIT_BAR(N) asm volatile("s_waitcnt vmcnt(" #N ") lgkmcnt(0)\n\ts_barrier":::"memory")

__device__ __forceinline__ void qkt(f32x16&p0,f32x16&p1,const char*Kslot,const bf16x8*qr,const f32x16&negm,int r32,int hi){
  const char*kb=Kslot+hi*1024+r32*16;
  #pragma unroll
  for(int d0=0;d0<4;++d0){
    const bf16x8 b0=*reinterpret_cast<const bf16x8*>(kb+d0*2048);
    const bf16x8 b1=*reinterpret_cast<const bf16x8*>(kb+d0*2048+512);
    if(d0==0){p0=__builtin_amdgcn_mfma_f32_32x32x16_bf16(b0,qr[0],negm,0,0,0);p1=__builtin_amdgcn_mfma_f32_32x32x16_bf16(b1,qr[0],negm,0,0,0);}
    else{p0=__builtin_amdgcn_mfma_f32_32x32x16_bf16(b0,qr[d0],p0,0,0,0);p1=__builtin_amdgcn_mfma_f32_32x32x16_bf16(b1,qr[d0],p1,0,0,0);}}
}
typedef __attribute__((address_space(3))) const char* lds_cptr;
typedef short v4i16_t __attribute__((ext_vector_type(4)));
__device__ __forceinline__ void kload8(bf16x8*kf,lds_cptr kp){
  kf[0]=*(const __attribute__((address_space(3))) bf16x8*)(kp);      kf[1]=*(const __attribute__((address_space(3))) bf16x8*)(kp+512);
  kf[2]=*(const __attribute__((address_space(3))) bf16x8*)(kp+2048); kf[3]=*(const __attribute__((address_space(3))) bf16x8*)(kp+2560);
  kf[4]=*(const __attribute__((address_space(3))) bf16x8*)(kp+4096); kf[5]=*(const __attribute__((address_space(3))) bf16x8*)(kp+4608);
  kf[6]=*(const __attribute__((address_space(3))) bf16x8*)(kp+6144); kf[7]=*(const __attribute__((address_space(3))) bf16x8*)(kp+6656);
}
__device__ __forceinline__ void kload2(bf16x8*kf,lds_cptr kp,int j){ kf[2*j]=*(const __attribute__((address_space(3))) bf16x8*)(kp+j*2048); kf[2*j+1]=*(const __attribute__((address_space(3))) bf16x8*)(kp+j*2048+512); }
__device__ __forceinline__ s16x4 vtr(lds_cptr p){ return __builtin_bit_cast(s16x4,__builtin_amdgcn_ds_read_tr16_b64_v4i16((__attribute__((address_space(3))) v4i16_t*)p)); }
__device__ __forceinline__ float rowmax(const f32x16&p0,const f32x16&p1){
  float a=max3f(p0[0],p0[1],p1[0]),b=max3f(p0[2],p0[3],p1[1]);a=max3f(a,p1[2],p1[3]);
  #pragma unroll
  for(int r=4;r<16;r+=4){a=max3f(a,p0[r],p0[r+1]);b=max3f(b,p0[r+2],p0[r+3]);a=max3f(a,p1[r],p1[r+1]);b=max3f(b,p1[r+2],p1[r+3]);}
  const float m=max2f(a,b);
  auto rr=__builtin_amdgcn_permlane32_swap(__float_as_uint(m),__float_as_uint(m),false,false);
  return max2f(__uint_as_float(rr[0]),__uint_as_float(rr[1]));
}
__device__ __forceinline__ void pv(f32x16*o,int vb,bf16x8 pa0,bf16x8 pa1,bf16x8 pa2,bf16x8 pa3){
  #pragma unroll
  for(int d0=0;d0<2;++d0){s16x4 lo[4],hi[4];
    #pragma unroll
    for(int ks=0;ks<4;++ks){
      asm volatile("ds_read_b64_tr_b16 %0,%1 offset:%c2":"=&v"(lo[ks]):"v"(vb),"i"(d0*4096+ks*1024):"memory");
      asm volatile("ds_read_b64_tr_b16 %0,%1 offset:%c2":"=&v"(hi[ks]):"v"(vb),"i"(d0*4096+ks*1024+512):"memory");}
    asm volatile("s_waitcnt lgkmcnt(0)":::"memory");SBAR();
    #define PK(k) (bf16x8){lo[k][0],lo[k][1],lo[k][2],lo[k][3],hi[k][0],hi[k][1],hi[k][2],hi[k][3]}
    o[d0]=__builtin_amdgcn_mfma_f32_32x32x16_bf16(pa0,PK(0),o[d0],0,0,0);
    o[d0]=__builtin_amdgcn_mfma_f32_32x32x16_bf16(pa1,PK(1),o[d0],0,0,0);
    o[d0]=__builtin_amdgcn_mfma_f32_32x32x16_bf16(pa2,PK(2),o[d0],0,0,0);
    o[d0]=__builtin_amdgcn_mfma_f32_32x32x16_bf16(pa3,PK(3),o[d0],0,0,0);
    #undef PK
  }
}

#ifndef ATTN_STORE16
#define ATTN_STORE16(p,v) (*(u32x4*)(p)=(v))
#endif
template<int THRL> __device__ __forceinline__ void attn_unit(const bf16*Qblk,const bf16*__restrict__ Kh,const bf16*__restrict__ Vh,bf16*Oblk,const int NT,char*shm,const int qpos0,const float*__restrict__ qgain){
  const int tid=otid(),lane=tid&63,r32=lane&31,hi=lane>>5; const int wid=__builtin_amdgcn_readfirstlane(tid>>6);
  const bf16*Qw=Qblk+(long)wid*QBLK*DM;
  const unsigned lds0=(unsigned)(uintptr_t)shm;
  float*wsf=(float*)(shm+LDS_WS)+wid*64;
  const bf16*ksrc=Kh+(long)lane*KDM+wid*8;
  const bf16*vsrc=Vh+(long)(16*(wid&3)+(lane>>2))*KDM+(wid>>2)*32+(lane&3)*8;
  const unsigned kdst=lds0+LDS_K+wid*1024, vdst=lds0+LDS_V+wid*1024;
  #define DMA_K(t,slot) glds16(ksrc+(long)(t)*KVBLK*KDM,(unsigned)__builtin_amdgcn_readfirstlane(kdst+(slot)))
  #define DMA_V(t,slot) glds16(vsrc+(long)(t)*KVBLK*KDM,(unsigned)__builtin_amdgcn_readfirstlane(vdst+(slot)))
  const int vb0=(int)(lds0+LDS_V)+((lane>>4)&1)*32+(lane&3)*8+(4*hi+((lane&15)>>2))*64;
  const char*Kbase=shm+LDS_K; bf16x8 kf[8];
  const lds_cptr shm3=(lds_cptr)shm; const lds_cptr kp0=shm3+LDS_K+hi*1024+r32*16; const lds_cptr vp0=shm3+LDS_V+((lane>>4)&1)*32+(lane&3)*8+(4*hi+((lane&15)>>2))*64;
  DMA_K(0,0);DMA_V(0,0);DMA_K(1,SLOTB);
  bf16x8 qr[4];
  { float qf[4][8]; float ss=0.f;
    #pragma unroll
    for(int d0=0;d0<4;++d0){ const bf16x8 raw=*reinterpret_cast<const bf16x8*>(&Qw[(long)r32*DM+d0*16+hi*8]);
      #pragma unroll
      for(int j=0;j<8;++j){ qf[d0][j]=__uint_as_float(((unsigned)(unsigned short)raw[j])<<16); ss+=qf[d0][j]*qf[d0][j]; } }
    ss+=__shfl_xor(ss,32);
    const float rstd=1.0f/sqrtf(ss*(1.f/64.f)+1e-6f)*C2;
    const int pos=qpos0+wid*QBLK+r32; const float prow=(float)(pos>>6),pcol=(float)(pos&63);
    #pragma unroll
    for(int d0=0;d0<4;++d0){ u32x4 pk;
      #pragma unroll
      for(int jp=0;jp<4;++jp){ const int d=16*d0+8*hi+2*jp; const int m=8*(d0&1)+4*hi+jp;
        const float fr=__builtin_amdgcn_exp2f(-(float)m*(13.287712379549449f/16.f)); const float ang=((d0<2)?prow:pcol)*fr;
        const float sn=__sinf(ang),cs=__cosf(ang);
        const float y0=qf[d0][2*jp]*rstd*qgain[d],y1=qf[d0][2*jp+1]*rstd*qgain[d+1];
        pk[jp]=cvtpk_s(y0*cs-y1*sn,y0*sn+y1*cs); }
      qr[d0]=__builtin_bit_cast(bf16x8,pk); } }
  float mhat=0.f,l_reg=0.f;f32x16 o[2];o[0]=f32x16{};o[1]=f32x16{};f32x16 negm=f32x16{};asm volatile("":"+v"(negm));
  #define CMASK(P0,P1,t) do{}while(0)
  bool resc=false;
  #define START(P0,P1) do{ const float rm=rowmax(P0,P1); resc=false; \
    { const float dl=rm; mhat=fadd_s(mhat,dl); \
      _Pragma("unroll") for(int r=0;r<16;++r){P0[r]=fsub_s(P0[r],dl);P1[r]=fsub_s(P1[r],dl);} \
      _Pragma("unroll") for(int r=0;r<16;++r)negm[r]=-mhat; asm volatile("":"+v"(negm)); } \
    _Pragma("unroll") for(int r=0;r<16;++r)P0[r]=__builtin_amdgcn_exp2f(P0[r]); }while(0)
  #define RESC() do{ if(resc){ asm volatile("s_waitcnt lgkmcnt(0)":::"memory"); \
      _Pragma("unroll") for(int d_=0;d_<2;++d_) _Pragma("unroll") for(int r=0;r<16;++r)o[d_][r]*=wsf[crow(r,hi)]; } }while(0)
  f32x16 pA0,pA1,pB0,pB1;
  int sl_prev=0,sl_cur=0,sl_next=SLOTB;
  #define ROT() do{sl_prev=sl_cur;sl_cur=sl_next;sl_next=(sl_next==(NSLOT-1)*SLOTB)?0:sl_next+SLOTB;}while(0)
  DMA_K(2,2*SLOTB);
  WAIT_BAR(3);
  qkt(pA0,pA1,Kbase,qr,negm,r32,hi);asm volatile("s_nop 15\n\ts_nop 7":"+v"(pA0),"+v"(pA1));CMASK(pA0,pA1,0);
  START(pA0,pA1);
  _Pragma("unroll") for(int r=0;r<16;++r)pA1[r]=__builtin_amdgcn_exp2f(pA1[r]);
  WAIT_BAR(0);
  DMA_K(3,0);DMA_V(1,SLOTB);
  ROT();
  kload8(kf,kp0+sl_cur);
  WAIT_BAR(2);
  s16x4 vlo[8],vhi[8]; u32x4 pw0,pw1,pw2,pw3;
  #define PKW(P,B) cvtpk_s(P[B],P[B+1])
  #define PAF(k) __builtin_bit_cast(bf16x8,pw##k)
  #define VFR(i) (bf16x8){vlo[i][0],vlo[i][1],vlo[i][2],vlo[i][3],vhi[i][0],vhi[i][1],vhi[i][2],vhi[i][3]}
  #define PIN(x) asm volatile("":"+v"(x))
  #define MX3(a,b,c) __builtin_fmaxf(__builtin_fmaxf((a),(b)),(c))
  #define GAPA(MF,A0,A1,A2,A3,W0,W1,PW) do{ MF; sacc+=A0; sacc+=A1; sacc+=A2; sacc+=A3; PIN(sacc); W0; W1; PIN(PW); SBAR(); }while(0)
  #define EX(v) __builtin_amdgcn_exp2f(v)
  #define GAPB(MF,X,B) do{ MF; X[B]=EX(X[B]); X[B+1]=EX(X[B+1]); X[B+2]=EX(X[B+2]); X[B+3]=EX(X[B+3]); PIN(X); SBAR(); }while(0)
  #define VRD(i) do{ vlo[i]=vtr(vp_+(((i)>>2)*4096+((i)&3)*1024)); vhi[i]=vtr(vp_+(((i)>>2)*4096+((i)&3)*1024+512)); }while(0)
  #define KRD(G,j) do{ if(G){ kload2(kf,kp0+sl_next,j); SBAR(); } }while(0)
  #define STEP(C0,C1,P0,P1,t,GK,GV,GL) do{ SBAR(); \
    const lds_cptr vp_=vp0+sl_prev; \
    VRD(0); SBAR(); float sacc=(P0[0]+P0[1]); \
    GAPA(C0=__builtin_amdgcn_mfma_f32_32x32x16_bf16(kf[0],qr[0],negm,0,0,0), P0[2],P0[3],P0[4],P0[5],     pw0[0]=PKW(P0,0), pw0[1]=PKW(P0,2), pw0); \
    VRD(4); SBAR(); GAPA(C1=__builtin_amdgcn_mfma_f32_32x32x16_bf16(kf[1],qr[0],negm,0,0,0), P0[6],P0[7],P0[8],P0[9],     pw0[2]=PKW(P0,4), pw0[3]=PKW(P0,6), pw0); \
    VRD(1); SBAR(); GAPA(C0=__builtin_amdgcn_mfma_f32_32x32x16_bf16(kf[2],qr[1],C0,0,0,0),   P0[10],P0[11],P0[12],P0[13], pw1[0]=PKW(P0,8), pw1[1]=PKW(P0,10), pw1); \
    VRD(5); SBAR(); GAPA(C1=__builtin_amdgcn_mfma_f32_32x32x16_bf16(kf[3],qr[1],C1,0,0,0),   P0[14],P0[15],P1[0],P1[1],   pw1[2]=PKW(P0,12),pw1[3]=PKW(P0,14), pw1); \
    VRD(2); SBAR(); GAPA(C0=__builtin_amdgcn_mfma_f32_32x32x16_bf16(kf[4],qr[2],C0,0,0,0),   P1[2],P1[3],P1[4],P1[5],     pw2[0]=PKW(P1,0), pw2[1]=PKW(P1,2), pw2); \
    VRD(6); SBAR(); GAPA(C1=__builtin_amdgcn_mfma_f32_32x32x16_bf16(kf[5],qr[2],C1,0,0,0),   P1[6],P1[7],P1[8],P1[9],     pw2[2]=PKW(P1,4), pw2[3]=PKW(P1,6), pw2); \
    VRD(3); SBAR(); GAPA(C0=__builtin_amdgcn_mfma_f32_32x32x16_bf16(kf[6],qr[3],C0,0,0,0),   P1[10],P1[11],P1[12],P1[13], pw3[0]=PKW(P1,8), pw3[1]=PKW(P1,10), pw3); \
    VRD(7); SBAR(); GAPA(C1=__builtin_amdgcn_mfma_f32_32x32x16_bf16(kf[7],qr[3],C1,0,0,0),   P1[14],P1[15],0.f,0.f,       pw3[2]=PKW(P1,12),pw3[3]=PKW(P1,14), pw3); \
    l_reg+=sacc; \
    if(GK){DMA_K((t)+3,sl_cur);} if(GV){DMA_V((t)+1,sl_next);} \
    CMASK(C0,C1,t); \
    { float a=MX3(C0[0],C0[1],C1[0]),b=MX3(C0[2],C0[3],C1[1]); a=MX3(a,C1[2],C1[3]); \
      _Pragma("unroll") for(int r=4;r<16;r+=4){a=MX3(a,C0[r],C0[r+1]);b=MX3(b,C0[r+2],C0[r+3]);a=MX3(a,C1[r],C1[r+1]);b=MX3(b,C1[r+2],C1[r+3]);} \
      float rm=__builtin_fmaxf(a,b); { auto rr=__builtin_amdgcn_permlane32_swap(__float_as_uint(rm),__float_as_uint(rm),false,false); rm=__builtin_fmaxf(__uint_as_float(rr[0]),__uint_as_float(rr[1])); } \
      resc=false; \
      if(__builtin_expect(__any(rm>(float)THRL),0)){ const float dl=__builtin_fmaxf(rm,0.f); mhat+=dl; \
        _Pragma("unroll") for(int r=0;r<16;++r){C0[r]-=dl;C1[r]-=dl;} \
        _Pragma("unroll") for(int r=0;r<16;++r)negm[r]=-mhat; asm volatile("":"+v"(negm)); \
        const float f=__builtin_amdgcn_exp2f(-dl); l_reg*=f; if(hi==0)wsf[r32]=f; resc=true; } } \
    SBAR(); \
    GAPB(o[0]=__builtin_amdgcn_mfma_f32_32x32x16_bf16(PAF(0),VFR(0),o[0],0,0,0), C0,0); \
    GAPB(o[1]=__builtin_amdgcn_mfma_f32_32x32x16_bf16(PAF(0),VFR(4),o[1],0,0,0), C0,4); \
    KRD(GL,0); GAPB(o[0]=__builtin_amdgcn_mfma_f32_32x32x16_bf16(PAF(1),VFR(1),o[0],0,0,0), C0,8); \
    KRD(GL,1); GAPB(o[1]=__builtin_amdgcn_mfma_f32_32x32x16_bf16(PAF(1),VFR(5),o[1],0,0,0), C0,12); \
    KRD(GL,2); GAPB(o[0]=__builtin_amdgcn_mfma_f32_32x32x16_bf16(PAF(2),VFR(2),o[0],0,0,0), C1,0); \
    KRD(GL,3); GAPB(o[1]=__builtin_amdgcn_mfma_f32_32x32x16_bf16(PAF(2),VFR(6),o[1],0,0,0), C1,4); \
    GAPB(o[0]=__builtin_amdgcn_mfma_f32_32x32x16_bf16(PAF(3),VFR(3),o[0],0,0,0), C1,8); \
    GAPB(o[1]=__builtin_amdgcn_mfma_f32_32x32x16_bf16(PAF(3),VFR(7),o[1],0,0,0), C1,12); \
    }while(0)
  int t=1;
  #undef CMASK
  #define CMASK(P0,P1,t) do{}while(0)
  for(;t+5<NT;t+=2){
    STEP(pB0,pB1,pA0,pA1,t,true,true,true);     WAIT_BAR(2); RESC(); ROT();
    STEP(pA0,pA1,pB0,pB1,t+1,true,true,true);   WAIT_BAR(2); RESC(); ROT();
  }
  #undef CMASK
  #define CMASK(P0,P1,t) do{}while(0)
  #define ENDW(tt) do{ if((tt)+3<NT){WAIT_BAR(2);} else if((tt)+2<NT){WAIT_BAR(1);} else {WAIT_BAR(0);} }while(0)
  for(;t+1<NT;t+=2){
    STEP(pB0,pB1,pA0,pA1,t,(t+3<NT),(t+1<NT),(t+1<NT));       ENDW(t);   RESC(); ROT();
    STEP(pA0,pA1,pB0,pB1,t+1,(t+4<NT),(t+2<NT),(t+2<NT));     ENDW(t+1); RESC(); ROT();
  }
  STEP(pB0,pB1,pA0,pA1,NT-1,false,false,false); RESC();
  { float sacc=pB0[0]+pB0[1]; _Pragma("unroll") for(int r=2;r<16;++r)sacc+=pB0[r]; _Pragma("unroll") for(int r=0;r<16;++r)sacc+=pB1[r]; l_reg+=sacc;
    pw0=(u32x4){PKW(pB0,0),PKW(pB0,2),PKW(pB0,4),PKW(pB0,6)};pw1=(u32x4){PKW(pB0,8),PKW(pB0,10),PKW(pB0,12),PKW(pB0,14)};pw2=(u32x4){PKW(pB1,0),PKW(pB1,2),PKW(pB1,4),PKW(pB1,6)};pw3=(u32x4){PKW(pB1,8),PKW(pB1,10),PKW(pB1,12),PKW(pB1,14)};
    SBAR(); pv(o,vb0+sl_cur,PAF(0),PAF(1),PAF(2),PAF(3)); }
  #undef PKW
  #undef PAF
  #undef VFR
  #undef PIN
  #undef MX3
  #undef GAPA
  #undef GAPB
  #undef EX
  #undef VRD
  #undef KRD
  #undef STEP
  #undef ENDW
  {auto rr=__builtin_amdgcn_permlane32_swap(__float_as_uint(l_reg),__float_as_uint(l_reg),false,false);l_reg=__uint_as_float(rr[0])+__uint_as_float(rr[1]);}
  if(hi==0)wsf[32+r32]=l_reg;asm volatile("s_waitcnt lgkmcnt(0)":::"memory");
  float rli[16];
  #pragma unroll
  for(int r=0;r<16;++r)rli[r]=__builtin_amdgcn_rcpf(wsf[32+crow(r,hi)]);
  bf16*Ow=Oblk+(long)wid*QBLK*DM;
  { bf16*stg=(bf16*)(shm+LDS_OST)+wid*2048;
    #pragma unroll
    for(int r=0;r<16;++r){const int orow=crow(r,hi);
      #pragma unroll
      for(int d0=0;d0<2;++d0)stg[orow*64+d0*32+r32]=__float2bfloat16(o[d0][r]*rli[r]);}
    asm volatile("s_waitcnt lgkmcnt(0)":::"memory");
    #pragma unroll
    for(int i=0;i<4;++i){const int row=i*8+(lane>>3),ch=lane&7; const u32x4 v=*(const u32x4*)(stg+row*64+ch*8); const u32x4 z=*(const u32x4*)(Ow+(long)row*DM+ch*8); u32x4 w;
      #pragma unroll
      for(int e=0;e<4;++e){ const float a0=__uint_as_float(v[e]<<16),a1=__uint_as_float(v[e]&0xffff0000u),z0=__uint_as_float(z[e]<<16),z1=__uint_as_float(z[e]&0xffff0000u);
        w[e]=cvtpk_s(a0*z0/(1.f+__expf(-z0)),a1*z1/(1.f+__expf(-z1))); }
      ATTN_STORE16(Ow+(long)row*DM+ch*8,w);} }
  asm volatile("s_waitcnt lgkmcnt(0)\n\ts_barrier":::"memory");
  #undef DMA_K
  #undef DMA_V
  #undef CMASK
  #undef START
  #undef RESC
  #undef ROT
}
constexpr int ATTN_LDS_BYTES=LDS_BYTES;
}
typedef unsigned short u16;
#define LAS __attribute__((address_space(3)))
#define DI __device__ __forceinline__
typedef unsigned v4u __attribute__((ext_vector_type(4)));
typedef unsigned v2u __attribute__((ext_vector_type(2)));
typedef float v4f __attribute__((ext_vector_type(4)));

constexpr int T_TOK = 32768, P1P = 2048, P2P = 1536;
constexpr int P1_Z = 0, P1_Q = 1280, P1_K = 1792, P1_V = 1920;
constexpr int P2_AQ = 0, P2_AK = 128, P2_AV = 256, P2_GF = 512, P2_GB = 640, P2_BU = 768, P2_DU = 1024, P2_DV = 1280, P2_U = 1024;
constexpr size_t MiB = 1u << 20;
constexpr size_t WS_DFT = 256 * 1024, WS_BAR = 512 * 1024, BAR_BYTES = 16384;
constexpr size_t WS_MOD = 0, WS_WIN = 2 * MiB, WS_WOUT = 16 * MiB, WS_WF = 21 * MiB, WS_U0 = 22 * MiB, WS_HB = 86 * MiB, WS_P2 = 150 * MiB, WS_DEC = 246 * MiB, WS_END = 247 * MiB;
constexpr size_t HB_GS = 0, HB_KC = 16 * MiB, HB_VC = 24 * MiB, HB_TP = 32 * MiB;
constexpr int LDS_BYTES = 147456;
constexpr float EPSN = 1e-6f;
constexpr float ATT_C2 = 0.125f * 1.4426950408889634f;

struct Params {
    const float *xp, *xs, *cp, *cs, *ada_w, *ada_b, *pre_g, *post_g, *w_in, *wg2f, *bgf, *wg2b, *bgb, *onorm_g, *fnet_w, *qn_g, *kn_g, *sgu_ng, *sgu_w, *sgu_b, *w_out;
    float* out; unsigned char* ws;
};
typedef const float* cfp;
struct Ctx { float* out; unsigned char* ws; LAS cfp* tab; };

DI float bf2f(u16 v) { return __uint_as_float((unsigned)v << 16); }
DI float bflo(unsigned w) { return __uint_as_float(w << 16); }
DI float bfhi(unsigned w) { return __uint_as_float(w & 0xffff0000u); }
DI unsigned f2bf(float f) { unsigned u = __float_as_uint(f); return (u + 0x7fffu + ((u >> 16) & 1u)) >> 16; }
DI unsigned pk2(float lo, float hi) { return f2bf(lo) | (f2bf(hi) << 16); }
DI float wave_sum(float v) {
#pragma unroll
    for (int o = 1; o < 64; o <<= 1) v += __shfl_xor(v, o);
    return v;
}
using pg8::silu_f;
DI float logsig(float x) { return fminf(x, 0.f) - __logf(1.f + __expf(-fabsf(x))); }
DI void seq_info(int s, int& row0, int& N) { if (s < 4) { row0 = s * 4096; N = 4096; } else { row0 = 16384 + (s - 4) * 8192; N = 8192; } }
DI int row_seq(int r) { return r < 16384 ? (r >> 12) : 4 + ((r - 16384) >> 13); }
DI void unpack8(const v4u r, float (&f)[8]) { f[0] = bflo(r.x); f[1] = bfhi(r.x); f[2] = bflo(r.y); f[3] = bfhi(r.y); f[4] = bflo(r.z); f[5] = bfhi(r.z); f[6] = bflo(r.w); f[7] = bfhi(r.w); }
DI v4u pack8(const float (&f)[8]) { v4u r; r.x = pk2(f[0], f[1]); r.y = pk2(f[2], f[3]); r.z = pk2(f[4], f[5]); r.w = pk2(f[6], f[7]); return r; }
#define LDS_WAIT() asm volatile("s_waitcnt lgkmcnt(0)" ::: "memory")


typedef short bf16x8_t __attribute__((ext_vector_type(8)));
typedef float f32x4_t __attribute__((ext_vector_type(4)));
DI bf16x8_t ldfrag(const LAS u16* base, int pitch, int row0, int k0, int lane) { return *(const LAS bf16x8_t*)(base + (row0 + (lane & 15)) * pitch + k0 + 8 * (lane >> 4)); }
typedef short s16x4_t __attribute__((ext_vector_type(4)));
DI bf16x8_t ldfrag_tr(const LAS u16* base, int pitch, int k0, int n0, int lane) {
    const LAS u16* a0 = base + (k0 + 8 * (lane >> 4) + ((lane & 15) >> 2)) * pitch + n0 + 4 * (lane & 3);
    const s16x4_t lo = __builtin_amdgcn_ds_read_tr16_b64_v4i16((LAS s16x4_t*)a0), hi = __builtin_amdgcn_ds_read_tr16_b64_v4i16((LAS s16x4_t*)(a0 + 4 * pitch));
    return (bf16x8_t){lo[0], lo[1], lo[2], lo[3], hi[0], hi[1], hi[2], hi[3]};
}
#define MFMA16(a, b, c) __builtin_amdgcn_mfma_f32_16x16x32_bf16((a), (b), (c), 0, 0, 0)
DI float wave_prefix(float g, int lane) {
#pragma unroll
    for (int o = 1; o < 64; o <<= 1) { const float t = __shfl_up(g, o); if (lane >= o) g += t; }
    return g; }
DI float wave_suffix(float g, int lane) {
#pragma unroll
    for (int o = 1; o < 64; o <<= 1) { const float t = __shfl_down(g, o); if (lane + o < 64) g += t; }
    return g; }
DI int win_src_col(int j) {
    if (j < 1280) return 2080 + j;
    if (j < 1792) return 800 + (j - 1280);
    if (j < 1920) return 1312 + (j - 1792);
    if (j < 2048) return 1440 + (j - 1920);
    const int q = j - 2048;
    if (q < 512) return q;
    if (q < 768) return -1;
    if (q < 1024) return 544 + (q - 768);
    if (q < 1280) return 1568 + (q - 1024);
    return 1824 + (q - 1280);
}
DI void transpose_item(const float* W, int ldw, int src_n0, int K, u16* WT, int dst_n0, int k0, LAS float* scr, int lane) {
    float tv[32];
#pragma unroll
    for (int i = 0; i < 32; ++i) tv[i] = W[(size_t)(k0 + 2 * i + (lane >> 5)) * ldw + src_n0 + (lane & 31)];
#pragma unroll
    for (int i = 0; i < 32; ++i) scr[(2 * i + (lane >> 5)) * 33 + (lane & 31)] = tv[i];
    LDS_WAIT();
    const int c = lane & 7;
#pragma unroll
    for (int j = 0; j < 4; ++j) { const int n = (lane >> 3) + 8 * j; const LAS float* s = scr + (8 * c) * 33 + n;
        v4u o; o.x = pk2(s[0 * 33], s[1 * 33]); o.y = pk2(s[2 * 33], s[3 * 33]); o.z = pk2(s[4 * 33], s[5 * 33]); o.w = pk2(s[6 * 33], s[7 * 33]);
        *(v4u*)(WT + (size_t)(dst_n0 + n) * K + k0 + 8 * c) = o; }
    LDS_WAIT();
}
DI void phase0(const Ctx& p, LAS unsigned char* L) {
    const int tid = otid(), lane = tid & 63, wave = tid >> 6;
    const int gw = blockIdx.x * 8 + wave, NGW = gridDim.x * 8, gt = blockIdx.x * 512 + tid, NGT = gridDim.x * 512;
    LAS float* scr = (LAS float*)(L + wave * 16384);
    u16* WinT = (u16*)(p.ws + WS_WIN); u16* WoutT = (u16*)(p.ws + WS_WOUT); u16* WfT = (u16*)(p.ws + WS_WF); float* mod = (float*)(p.ws + WS_MOD);
    constexpr int I_IN = 16 * 112, I_OUT = 20 * 32, I_L = I_IN + I_OUT;
    for (int it = gw; it < 2 * I_L; it += NGW) {
        const int l = it / I_L; int r = it % I_L;
        if (r < I_IN) { const int kb = r / 112, nb = r % 112; const int src = win_src_col(nb * 32); if (src < 0) continue;
            transpose_item(p.tab[8] + (size_t)l * 1024 * 3360, 3360, src, 1024, WinT + (size_t)l * 3584 * 1024, nb * 32, kb * 64, scr, lane); }
        else { r -= I_IN; const int kb = r / 32, nb = r % 32;
            transpose_item(p.tab[20] + (size_t)l * 1280 * 1024, 1024, nb * 32, 1280, WoutT + (size_t)l * 1024 * 1280, nb * 32, kb * 64, scr, lane); }
    }
    for (int e = gt; e < 2 * 16 * 1024; e += NGT) { const int l = e >> 14, r = e & 16383, jg = r >> 10, k = r & 1023, dirb = jg >> 3, jj0 = (jg & 7) * 16;
        const float* wi = p.tab[8] + (size_t)l * 1024 * 3360 + (size_t)k * 3360 + 512 + dirb * 16; float wv[16];
#pragma unroll
        for (int r2 = 0; r2 < 16; ++r2) wv[r2] = wi[r2];
        const float* w2 = (dirb ? p.tab[11] : p.tab[9]) + l * 16 * 128 + jj0;
        for (int q = 0; q < 16; ++q) { float a = 0.f;
#pragma unroll
            for (int r2 = 0; r2 < 16; ++r2) a += wv[r2] * w2[r2 * 128 + q];
            WinT[(size_t)l * 3584 * 1024 + (size_t)(2560 + dirb * 128 + jj0 + q) * 1024 + k] = (u16)f2bf(a); } }
    { LAS float* trig = (LAS float*)(L + 126976);
        if (tid < 64) { trig[tid] = cospif((float)tid * (1.f / 32.f)); trig[64 + tid] = sinpif((float)tid * (1.f / 32.f)); }
        __syncthreads();
        for (int e = gt; e < 2 * 256 * 512; e += NGT) { const int l = e >> 17, r = e & 131071, n = r >> 9, kk = r & 511, im = kk >> 8, g = (kk & 255) >> 6, c = kk & 63;
            const float* fw = p.tab[14] + (size_t)l * 65536 + (size_t)(g * 64) * 256 + n; const LAS float* tb = trig + im * 64; float a = 0.f;
#pragma unroll 8
            for (int j2 = 0; j2 < 64; ++j2) a += tb[(j2 * c) & 63] * fw[j2 * 256];
            WfT[(size_t)l * 131072 + n * 512 + kk] = (u16)f2bf(a * 0.125f); } }
    { u16* dft = (u16*)(p.ws + WS_DFT);
        for (int e = gt; e < 4096; e += NGT) { const int k = e >> 6, n = e & 63; const float a = (float)((k * n) & 63) * (1.f / 32.f); dft[e] = (u16)f2bf(cospif(a)); dft[4096 + e] = (u16)f2bf(sinpif(a)); }
        for (int e = gt; e < 16384; e += NGT) { const int k = e >> 7, n = e & 127; const float a = (float)((k * n) & 127) * (1.f / 64.f); dft[8192 + e] = (u16)f2bf(cospif(a)); dft[8192 + 16384 + e] = (u16)f2bf(sinpif(a)); } }
    __syncthreads();
    LAS float* sc = (LAS float*)L;
    for (int e = tid; e < 6144; e += 512) { const int s = e >> 10, k = e & 1023; const float c = s < 4 ? p.tab[2][s * 1024 + k] : p.tab[3][(s - 4) * 1024 + k]; sc[e] = c / (1.f + expf(-c)); }
    __syncthreads();
    for (int unit = gw; unit < 768; unit += NGW) {
        const int ks = unit & 7, jb = (unit >> 3) % 48, l = unit / 384, j = jb * 64 + lane;
        float acc[6] = {0.f, 0.f, 0.f, 0.f, 0.f, 0.f};
        const float* aw = p.tab[4] + (size_t)l * 1024 * 3072 + (size_t)(ks * 128) * 3072 + j;
#pragma unroll 16
        for (int k = 0; k < 128; ++k) { const float w = aw[(size_t)k * 3072];
#pragma unroll
            for (int s = 0; s < 6; ++s) acc[s] += sc[s * 1024 + ks * 128 + k] * w; }
        if (ks == 0) { const float b = p.tab[5][l * 3072 + j];
#pragma unroll
            for (int s = 0; s < 6; ++s) acc[s] += b; }
#pragma unroll
        for (int s = 0; s < 6; ++s) atomicAdd(mod + (size_t)(l * 6 + s) * 3072 + j, acc[s]);
    }
}

DI void add_branch(v4f (&v)[4], const u16* urow, const float* gate, const float* pg, int lane) {
    v4f u[4]; float ss = 0.f;
#pragma unroll
    for (int j = 0; j < 4; ++j) { const v2u r = *(const v2u*)(urow + 256 * j + 4 * lane); u[j] = (v4f){bflo(r.x), bfhi(r.x), bflo(r.y), bfhi(r.y)};
        ss += (u[j].x * u[j].x + u[j].y * u[j].y) + (u[j].z * u[j].z + u[j].w * u[j].w); }
    const float rstd = 1.f / sqrtf(wave_sum(ss) * (1.f / 1024.f) + EPSN);
#pragma unroll
    for (int j = 0; j < 4; ++j) { const v4f g = *(const v4f*)(gate + 256 * j + 4 * lane), q = *(const v4f*)(pg + 256 * j + 4 * lane); v[j] += g * (u[j] * rstd * q); }
}
DI void phaseA(const Ctx& p, int l) {
    const int tid = otid(), lane = tid & 63, wave = tid >> 6, gw = blockIdx.x * 8 + wave, NGW = gridDim.x * 8;
    const float* mod = (const float*)(p.ws + WS_MOD); const u16* U0 = (const u16*)(p.ws + WS_U0); u16* HB = (u16*)(p.ws + WS_HB);
    for (int row = gw; row < T_TOK; row += NGW) {
        const int s = row_seq(row);
        const float* xr = row < 16384 ? p.tab[0] + (size_t)row * 1024 : p.tab[1] + (size_t)(row - 16384) * 1024;
        v4f v[4];
#pragma unroll
        for (int j = 0; j < 4; ++j) v[j] = *(const v4f*)(xr + 256 * j + 4 * lane);
        if (l >= 1) add_branch(v, U0 + (size_t)row * 1024, mod + (size_t)(0 * 6 + s) * 3072 + 2048, p.tab[7], lane);
        if (l == 2) { add_branch(v, HB + (size_t)row * 1024, mod + (size_t)(1 * 6 + s) * 3072 + 2048, p.tab[7] + 1024, lane);
            float* o = p.out + (size_t)row * 1024;
#pragma unroll
            for (int j = 0; j < 4; ++j) *(v4f*)(o + 256 * j + 4 * lane) = v[j];
            continue; }
        float ss = 0.f;
#pragma unroll
        for (int j = 0; j < 4; ++j) ss += (v[j].x * v[j].x + v[j].y * v[j].y) + (v[j].z * v[j].z + v[j].w * v[j].w);
        const float rstd = 1.f / sqrtf(wave_sum(ss) * (1.f / 1024.f) + EPSN);
        const float* md = mod + (size_t)(l * 6 + s) * 3072;
#pragma unroll
        for (int j = 0; j < 4; ++j) { const int col = 256 * j + 4 * lane;
            const v4f sh = *(const v4f*)(md + col), scl = *(const v4f*)(md + 1024 + col), g = *(const v4f*)(p.tab[6] + l * 1024 + col);
            const v4f h = v[j] * rstd * g * (scl + 1.f) + sh;
            v2u o; o.x = pk2(h.x, h.y); o.y = pk2(h.z, h.w); *(v2u*)(HB + (size_t)row * 1024 + col) = o; }
    }
}

DI void qk_prep(const Ctx& p, int l) {
    const int tid = otid(), lane = tid & 63, wave = tid >> 6, gw = blockIdx.x * 8 + wave, NGW = gridDim.x * 8;
    u16* P1 = (u16*)p.out; const int i = lane & 31; unsigned* KC = (unsigned*)(p.ws + WS_HB + HB_KC); unsigned* VC = (unsigned*)(p.ws + WS_HB + HB_VC);
    const float freq = exp2f(-(float)(i & 15) * (13.287712379549449f / 16.f));
    const float gk0 = p.tab[16][l * 64 + 2 * i], gk1 = p.tab[16][l * 64 + 2 * i + 1];
    for (int rowb = gw * 4; rowb < T_TOK; rowb += NGW * 4) {
        unsigned wv[4][2];
#pragma unroll
        for (int r = 0; r < 4; ++r) { const unsigned* ptr = (const unsigned*)(P1 + (size_t)(rowb + r) * P1P + P1_Q);
#pragma unroll
            for (int it = 0; it < 2; ++it) wv[r][it] = ptr[(4 + it) * 64 + lane]; }
#pragma unroll
        for (int r = 0; r < 4; ++r) { const int row = rowb + r;
            const int s = row_seq(row); int row0, N; seq_info(s, row0, N); const int pos = row - row0;
            const float coord = (i < 16) ? (float)(pos >> 6) : (float)(pos & 63);
            float sn, cs; sincosf(coord * freq, &sn, &cs);
            unsigned* ptr = (unsigned*)(P1 + (size_t)row * P1P + P1_Q);
            const size_t cidx = ((size_t)row0 * 2 + (size_t)(lane >> 5) * N + pos) * 32 + i;
            { const unsigned w = wv[r][0]; const float x0 = bflo(w), x1 = bfhi(w);
                float ss = x0 * x0 + x1 * x1;
#pragma unroll
                for (int o = 1; o < 32; o <<= 1) ss += __shfl_xor(ss, o);
                const float rstd = 1.f / sqrtf(ss * (1.f / 64.f) + EPSN);
                const float y0 = x0 * rstd * gk0, y1 = x1 * rstd * gk1;
                KC[cidx] = pk2(y0 * cs - y1 * sn, y0 * sn + y1 * cs); }
            VC[cidx] = wv[r][1]; }
    }
}
DI void gla_scan_cols(LAS float* Gf, LAS float* Gb, int lane) {
    LAS float* G = (lane >> 5) ? Gb : Gf; const int d = lane & 31; float v[64];
#pragma unroll
    for (int i = 0; i < 64; ++i) v[i] = G[i * 33 + d];
    if (lane >> 5) {
#pragma unroll
        for (int i = 62; i >= 0; --i) v[i] += v[i + 1];
    } else {
#pragma unroll
        for (int i = 1; i < 64; ++i) v[i] += v[i - 1];
    }
#pragma unroll
    for (int i = 0; i < 64; ++i) G[i * 33 + d] = v[i];
}
struct GLoad { v4u g[2], k[2], v[2]; };
DI GLoad gla_local_load(const Ctx& p, int item) {
    const int tid = otid(); const int gc = item >> 1, hp = item & 1; const size_t rb = (size_t)gc * 64; const u16* P2 = (const u16*)(p.ws + WS_P2); GLoad r;
#pragma unroll
    for (int hh = 0; hh < 2; ++hh) { const int h = 2 * hp + hh;
        { const int t2 = tid & 255, i = t2 >> 2, c = t2 & 3; const u16* q = P2 + (rb + i) * P2P + h * 32 + c * 8; const int dirb = tid >> 8;
            r.g[hh] = *(const v4u*)(q + (dirb ? P2_GB : P2_GF)); r.k[hh] = *(const v4u*)(q + P2_AK); }
        { const int i = tid >> 3, c = tid & 7; r.v[hh] = *(const v4u*)(P2 + (rb + i) * P2P + P2_AV + h * 64 + c * 8); } }
    return r;
}
DI void gla_local_item(const Ctx& p, int l, int item, LAS float* F, const GLoad ld) {
    const int tid = otid(), lane = tid & 63, w = tid >> 6; const int gc = item >> 1, hp = item & 1;
    constexpr int HF = 3 * 2112 + (2 * 64 * 40 + 64 * 72) / 2;
#pragma unroll
    for (int hh = 0; hh < 2; ++hh) { const int h = 2 * hp + hh; LAS float* Gf = F + hh * HF; LAS float* Gb = Gf + 2112; LAS float* Kx = Gb + 2112; LAS u16* KDT = (LAS u16*)(Kx + 2112); LAS u16* VT = KDT + 2 * 64 * 40;
        { const int t2 = tid & 255, i = t2 >> 2, c = t2 & 3; float f[8];
            const int dirb = tid >> 8; const float* bias = p.tab[dirb ? 12 : 10] + l * 128 + h * 32 + c * 8; LAS float* G = dirb ? Gb : Gf;
            unpack8(ld.g[hh], f);
#pragma unroll
            for (int q = 0; q < 8; ++q) G[i * 33 + c * 8 + q] = logsig(f[q] + bias[q]) * (1.f / 16.f);
            if (!dirb) { unpack8(ld.k[hh], f);
#pragma unroll
                for (int q = 0; q < 8; ++q) Kx[i * 33 + c * 8 + q] = f[q]; } }
        { const int i = tid >> 3, c = tid & 7; *(LAS v4u*)(VT + i * 72 + c * 8) = ld.v[hh]; } }
    __syncthreads();
    if (w < 2) { LAS float* Gf = F + w * HF; gla_scan_cols(Gf, Gf + 2112, lane); }
    __syncthreads();
    u16* GS = (u16*)(p.ws + WS_HB + HB_GS); float* DEC = (float*)(p.ws + WS_DEC);
#pragma unroll
    for (int hh = 0; hh < 2; ++hh) { const int h = 2 * hp + hh; LAS float* Gf = F + hh * HF; LAS float* Gb = Gf + 2112; LAS float* Kx = Gb + 2112; LAS u16* KDT = (LAS u16*)(Kx + 2112); const size_t slot = (size_t)(gc * 4 + h) * 2;
#pragma unroll
        for (int r = 0; r < 8; ++r) { const int e = tid + r * 512, d = e & 31, i = (e >> 5) & 63, dir = e >> 11; const LAS float* G = dir ? Gb : Gf;
            const float bl = G[(dir ? 0 : 63) * 33 + d];
            KDT[(dir * 64 + i) * 40 + d] = (u16)f2bf(Kx[i * 33 + d] * __expf(bl - G[i * 33 + d])); }
        if (tid < 64) { const int dir = tid >> 5, d = tid & 31; DEC[(slot + dir) * 32 + d] = __expf((dir ? Gb : Gf)[(dir ? 0 : 63) * 33 + d]); } }
    __syncthreads();
#pragma unroll
    for (int hh = 0; hh < 2; ++hh) { const int h = 2 * hp + hh; LAS u16* KDT = (LAS u16*)(F + hh * HF + 3 * 2112); LAS u16* VT = KDT + 2 * 64 * 40; const size_t slot = (size_t)(gc * 4 + h) * 2;
        const int dir = w >> 2, mt = (w >> 1) & 1;
#pragma unroll
        for (int q = 0; q < 2; ++q) { const int nt = (w & 1) * 2 + q; f32x4_t acc = {0.f, 0.f, 0.f, 0.f};
#pragma unroll
            for (int ks = 0; ks < 2; ++ks) acc = MFMA16(ldfrag_tr(KDT + dir * 64 * 40, 40, ks * 32, mt * 16, lane), ldfrag_tr(VT, 72, ks * 32, nt * 16, lane), acc);
#pragma unroll
            for (int j = 0; j < 4; ++j) GS[(slot + dir) * 2048 + (mt * 16 + 4 * (lane >> 4) + j) * 64 + nt * 16 + (lane & 15)] = (u16)f2bf(acc[j]); } }
    __syncthreads();
}
DI void sgu_item(const Ctx& p, int l, int item, LAS float* F, bool stage_w) {
    const int tid = otid(), lane = tid & 63, w = tid >> 6; const int ch = item >> 2, g = item & 3; const size_t rb = (size_t)ch * 128;
    const u16* P2 = (const u16*)(p.ws + WS_P2); u16* P1 = (u16*)p.out;
    LAS float* OUTF = F; LAS u16* WB = (LAS u16*)(F + 128 * 65); LAS u16* VNT = WB + 128 * 136;
    v4u pu[2], pz[2];
#pragma unroll
    for (int r = 0; r < 2; ++r) { const int task = tid + r * 512, t = task >> 3, c8 = (task & 7) * 8; pu[r] = *(const v4u*)(P2 + (rb + t) * P2P + P2_DU + g * 64 + c8); pz[r] = *(const v4u*)(P1 + (rb + t) * P1P + 1024 + g * 64 + c8); }
    { const int row = tid >> 2, qt = tid & 3; const u16* dv = P2 + (rb + row) * P2P + P2_DV; float ss = 0.f; float f[8];
#pragma unroll
        for (int c = 0; c < 8; ++c) { unpack8(*(const v4u*)(dv + qt * 64 + c * 8), f);
#pragma unroll
            for (int q = 0; q < 8; ++q) ss += f[q] * f[q]; }
        ss += __shfl_xor(ss, 1); ss += __shfl_xor(ss, 2);
        const float rstd = 1.f / sqrtf(ss * (1.f / 256.f) + EPSN); const float* ng = p.tab[17] + l * 256 + g * 64 + qt * 16;
#pragma unroll
        for (int c = 0; c < 2; ++c) { unpack8(*(const v4u*)(dv + g * 64 + qt * 16 + c * 8), f);
#pragma unroll
            for (int q = 0; q < 8; ++q) f[q] = f[q] * rstd * ng[c * 8 + q];
            *(LAS v4u*)(VNT + row * 72 + qt * 16 + c * 8) = pack8(f); } }
    if (stage_w) { const float* wsrc = p.tab[18] + (size_t)(l * 4 + g) * 16384;
#pragma unroll
        for (int r = 0; r < 8; ++r) { const int idx = tid + r * 512, t = idx >> 5, s4 = (idx & 31) * 4; const v4f v = *(const v4f*)(wsrc + idx * 4);
            v2u o; o.x = pk2(v.x, v.y); o.y = pk2(v.z, v.w); *(LAS v2u*)(WB + t * 136 + s4) = o; } }
    __syncthreads();
    {
#pragma unroll
        for (int nt = 0; nt < 4; ++nt) { f32x4_t acc = {0.f, 0.f, 0.f, 0.f};
#pragma unroll
            for (int ks = 0; ks < 4; ++ks) acc = MFMA16(ldfrag(WB, 136, w * 16, ks * 32, lane), ldfrag_tr(VNT, 72, ks * 32, nt * 16, lane), acc);
#pragma unroll
            for (int j = 0; j < 4; ++j) OUTF[(w * 16 + 4 * (lane >> 4) + j) * 65 + nt * 16 + (lane & 15)] = acc[j]; } }
    __syncthreads();
#pragma unroll
    for (int r = 0; r < 2; ++r) { const int task = tid + r * 512, t = task >> 3, c8 = (task & 7) * 8; float acc[8];
#pragma unroll
        for (int e = 0; e < 8; ++e) acc[e] = OUTF[t * 65 + c8 + e];
        const float bias = p.tab[19][(l * 4 + g) * 128 + t];
        float uu[8], zz[8]; unpack8(pu[r], uu);
        u16* mz = P1 + (rb + t) * P1P + 1024 + g * 64 + c8; unpack8(pz[r], zz);
#pragma unroll
        for (int e = 0; e < 8; ++e) acc[e] = (acc[e] + bias) * uu[e] * silu_f(zz[e]);
        *(v4u*)mz = pack8(acc); }
    __syncthreads();
}
template <int N1> DI void fnet1_body(const Ctx& p, int row0, int N, int n2, int cb, LAS float* F) {
    constexpr int PN = N1 + 8, MT = N1 / 16, NTW = MT;
    const int tid = otid(), lane = tid & 63, w = tid >> 6;
    const u16* P2 = (const u16*)(p.ws + WS_P2); u16* TP = (u16*)(p.ws + WS_HB + HB_TP);
    const u16* Cg = (const u16*)(p.ws + WS_DFT) + (N1 == 64 ? 0 : 8192); const u16* Sg = Cg + N1 * N1;
    LAS float* tw = F; LAS u16* XT = (LAS u16*)(F + 256); LAS u16* FC = XT + N1 * 136; LAS u16* FS = FC + N1 * PN; LAS u16* OUT = FC;
#pragma unroll
    for (int r = 0; r < N1 / 32; ++r) { const int idx = tid + r * 512, n1 = idx >> 4, c = idx & 15; const v4u raw = *(const v4u*)(P2 + (size_t)(row0 + n1 * 64 + n2) * P2P + P2_BU + cb * 128 + c * 8);
        *(LAS v4u*)(XT + n1 * 136 + c * 8) = raw; }
#pragma unroll
    for (int r = 0; r < N1 * N1 / 8 / 512; ++r) { const int idx = tid + r * 512, k1 = idx / (N1 / 8), c = idx % (N1 / 8);
        *(LAS v4u*)(FC + k1 * PN + c * 8) = *(const v4u*)(Cg + k1 * N1 + c * 8); *(LAS v4u*)(FS + k1 * PN + c * 8) = *(const v4u*)(Sg + k1 * N1 + c * 8); }
    if (tid < N1) { const float ph = 2.f * (float)((n2 * tid) & (N - 1)) / (float)N; tw[2 * tid] = cospif(ph); tw[2 * tid + 1] = sinpif(ph); }
    __syncthreads();
    f32x4_t ac[NTW], as[NTW];
#pragma unroll
    for (int q = 0; q < NTW; ++q) { const int id = w + 8 * q, mt = id % MT, nt = id / MT; ac[q] = (f32x4_t){0.f, 0.f, 0.f, 0.f}; as[q] = ac[q];
#pragma unroll
        for (int ks = 0; ks < N1 / 32; ++ks) { const bf16x8_t b = ldfrag_tr(XT, 136, ks * 32, nt * 16, lane);
            ac[q] = MFMA16(ldfrag(FC, PN, mt * 16, ks * 32, lane), b, ac[q]); as[q] = MFMA16(ldfrag(FS, PN, mt * 16, ks * 32, lane), b, as[q]); } }
    __syncthreads();
    const float scale = 1.f / sqrtf((float)N1);
#pragma unroll
    for (int q = 0; q < NTW; ++q) { const int id = w + 8 * q, mt = id % MT, nt = id / MT;
#pragma unroll
        for (int j = 0; j < 4; ++j) { const int k1 = mt * 16 + 4 * (lane >> 4) + j, col = nt * 16 + (lane & 15); const float cw = tw[2 * k1], sw = tw[2 * k1 + 1];
            const float tr = ac[q][j], ti = -as[q][j];
            OUT[k1 * 256 + col] = (u16)f2bf((tr * cw + ti * sw) * scale); OUT[k1 * 256 + 128 + col] = (u16)f2bf((ti * cw - tr * sw) * scale); } }
    __syncthreads();
#pragma unroll
    for (int r = 0; r < N1 / 16; ++r) { const int idx = tid + r * 512, k1 = idx >> 5, c = idx & 31;
        const v4u v = *(const LAS v4u*)(OUT + k1 * 256 + c * 8);
        *(v4u*)(TP + (size_t)(row0 + k1 * 64 + n2) * 512 + (c >> 4) * 256 + cb * 128 + (c & 15) * 8) = v; }
    __syncthreads();
}
DI void fnet1_item(const Ctx& p, int item, LAS float* F) {
    const int s = item >> 7, r = item & 127, n2 = r >> 1, cb = r & 1; int row0, N; seq_info(s, row0, N);
    if (N == 4096) fnet1_body<64>(p, row0, N, n2, cb, F); else fnet1_body<128>(p, row0, N, n2, cb, F);
}
struct F2Load { v4u t[8]; };
DI F2Load fnet2_load(const Ctx& p, int item) {
    const int tid = otid(); int s, k1; if (item < 256) { s = item >> 6; k1 = item & 63; } else { s = 4 + ((item - 256) >> 7); k1 = (item - 256) & 127; }
    int row0, N; seq_info(s, row0, N); const u16* TP = (const u16*)(p.ws + WS_HB + HB_TP); F2Load r;
#pragma unroll
    for (int q = 0; q < 8; ++q) { const int idx = tid + q * 512, n2 = idx >> 6, c = idx & 63; r.t[q] = *(const v4u*)(TP + (size_t)(row0 + k1 * 64 + n2) * 512 + c * 8); }
    return r;
}
DI void fnet2_item(const Ctx& p, int item, LAS float* F, const F2Load ld) {
    const int tid = otid(), lane = tid & 63, w = tid >> 6; int s, k1; if (item < 256) { s = item >> 6; k1 = item & 63; } else { s = 4 + ((item - 256) >> 7); k1 = (item - 256) & 127; }
    int row0, N; seq_info(s, row0, N); const int N1 = N >> 6;
    u16* P2 = (u16*)(p.ws + WS_P2); const u16* TP = (const u16*)(p.ws + WS_HB + HB_TP); const u16* Cg = (const u16*)(p.ws + WS_DFT); const u16* Sg = Cg + 4096;
    LAS u16* BT = (LAS u16*)F; LAS u16* A1 = BT + 128 * 264; LAS u16* A2 = A1 + 64 * 136; LAS u16* OUT = BT;
#pragma unroll
    for (int r = 0; r < 8; ++r) { const int idx = tid + r * 512, n2 = idx >> 6, c = idx & 63; *(LAS v4u*)(BT + ((c >> 5) * 64 + n2) * 264 + (c & 31) * 8) = ld.t[r]; }
    { const int k2 = tid >> 3, c8 = (tid & 7) * 8; const v4u c = *(const v4u*)(Cg + k2 * 64 + c8), sv = *(const v4u*)(Sg + k2 * 64 + c8); const v4u ns = sv ^ (v4u){0x80008000u, 0x80008000u, 0x80008000u, 0x80008000u};
        *(LAS v4u*)(A1 + k2 * 136 + c8) = c; *(LAS v4u*)(A1 + k2 * 136 + 64 + c8) = sv; *(LAS v4u*)(A2 + k2 * 136 + c8) = ns; *(LAS v4u*)(A2 + k2 * 136 + 64 + c8) = c; }
    __syncthreads();
    f32x4_t acc[16]; const LAS u16* Aw = (w < 4) ? A1 : A2; const int mt = w & 3;
#pragma unroll
    for (int nt = 0; nt < 16; ++nt) { acc[nt] = (f32x4_t){0.f, 0.f, 0.f, 0.f};
#pragma unroll
        for (int ks = 0; ks < 4; ++ks) acc[nt] = MFMA16(ldfrag(Aw, 136, mt * 16, ks * 32, lane), ldfrag_tr(BT, 264, ks * 32, nt * 16, lane), acc[nt]); }
    __syncthreads();
#pragma unroll
    for (int nt = 0; nt < 16; ++nt)
#pragma unroll
        for (int j = 0; j < 4; ++j) OUT[(mt * 16 + 4 * (lane >> 4) + j) * 512 + (w >> 2) * 256 + nt * 16 + (lane & 15)] = (u16)f2bf(acc[nt][j] * 0.125f);
    __syncthreads();
#pragma unroll
    for (int r = 0; r < 8; ++r) { const int idx = tid + r * 512, k2 = idx >> 6, c = idx & 63; const v4u v = *(const LAS v4u*)(OUT + k2 * 512 + c * 8);
        *(v4u*)(P2 + (size_t)(row0 + k1 + N1 * k2) * P2P + P2_U + c * 8) = v; }
    __syncthreads();
}
DI void gla_scan_item(const Ctx& p, int item) {
    const int tid = otid(); const int chain = item >> 2, e = (item & 3) * 512 + tid; const int s = chain >> 3, h = (chain >> 1) & 3, dir = chain & 1;
    int row0, N; seq_info(s, row0, N); const int NC = N >> 6, gc0 = row0 >> 6, d = e >> 6;
    u16* GS = (u16*)(p.ws + WS_HB + HB_GS); const float* DEC = (const float*)(p.ws + WS_DEC);
    float S = 0.f;
    for (int st = 0; st < NC; st += 32) { u16 tmp[32]; float dc[32];
#pragma unroll
        for (int u = 0; u < 32; ++u) { const int c = dir ? NC - 1 - (st + u) : st + u; const size_t slot = (size_t)((gc0 + c) * 4 + h) * 2 + dir; tmp[u] = GS[slot * 2048 + e]; dc[u] = DEC[slot * 32 + d]; }
#pragma unroll
        for (int u = 0; u < 32; ++u) { const int c = dir ? NC - 1 - (st + u) : st + u; const size_t slot = (size_t)((gc0 + c) * 4 + h) * 2 + dir; GS[slot * 2048 + e] = (u16)f2bf(S); S = dc[u] * S + bf2f(tmp[u]); } }
}
struct OLoad { v4u qk, g, v, z; v2u sf, sb; };
DI OLoad gla_out_load(const Ctx& p, int item) {
    const int tid = otid(); const int gc = item >> 2, h = item & 3; const size_t rb = (size_t)gc * 64; const u16* P2 = (const u16*)(p.ws + WS_P2); const u16* P1 = (const u16*)p.out; OLoad r;
    { const int t2 = tid & 255, i = t2 >> 2, c = t2 & 3; const u16* q = P2 + (rb + i) * P2P + h * 32 + c * 8; const int dirb = tid >> 8;
        r.qk = *(const v4u*)(q + (dirb ? P2_AK : P2_AQ)); r.g = *(const v4u*)(q + (dirb ? P2_GB : P2_GF)); }
    { const int i = tid >> 3, c = tid & 7; r.v = *(const v4u*)(P2 + (rb + i) * P2P + P2_AV + h * 64 + c * 8); r.z = *(const v4u*)(P1 + (rb + i) * P1P + h * 64 + c * 8); }
    { const u16* GS = (const u16*)(p.ws + WS_HB + HB_GS); const size_t slot = (size_t)(gc * 4 + h) * 2; const int e4 = tid * 4; r.sf = *(const v2u*)(GS + slot * 2048 + e4); r.sb = *(const v2u*)(GS + (slot + 1) * 2048 + e4); }
    return r;
}
DI void gla_out_item(const Ctx& p, int l, int item, LAS float* F, const OLoad ld) {
    const int tid = otid(), lane = tid & 63, w = tid >> 6; const int gc = item >> 2, h = item & 3; const size_t rb = (size_t)gc * 64;
    const u16* P2 = (const u16*)(p.ws + WS_P2); u16* P1 = (u16*)p.out;
    LAS float* Gf = F; LAS float* Gb = Gf + 2112; LAS float* Qx = Gb + 2112; LAS float* Kx = Qx + 2112; LAS float* O = Kx + 2112;
    LAS u16* QF = (LAS u16*)(O + 64 * 65); LAS u16* KF = QF + 64 * 40; LAS u16* QB = KF + 64 * 40; LAS u16* KB = QB + 64 * 40;
    LAS u16* VT = KB + 64 * 40; LAS u16* SC = VT + 64 * 72; LAS u16* SFT = SC + 64 * 72; LAS u16* SBT = SFT + 32 * 72;
    const u16* GS = (const u16*)(p.ws + WS_HB + HB_GS); const size_t slot = (size_t)(gc * 4 + h) * 2;
    { const int t2 = tid & 255, i = t2 >> 2, c = t2 & 3; const u16* r = P2 + (rb + i) * P2P + h * 32 + c * 8; float f[8];
        const int dirb = tid >> 8; LAS float* d0 = dirb ? Kx : Qx; LAS float* d1 = dirb ? Gb : Gf; const float* bias = p.tab[dirb ? 12 : 10] + l * 128 + h * 32 + c * 8;
        unpack8(ld.qk, f);
#pragma unroll
        for (int q = 0; q < 8; ++q) d0[i * 33 + c * 8 + q] = f[q];
        unpack8(ld.g, f);
#pragma unroll
        for (int q = 0; q < 8; ++q) d1[i * 33 + c * 8 + q] = logsig(f[q] + bias[q]) * (1.f / 16.f); }
    { const int i = tid >> 3, c = tid & 7; *(LAS v4u*)(VT + i * 72 + c * 8) = ld.v; }
    { const int e4 = tid * 4, d = e4 >> 6, v = e4 & 63; *(LAS v2u*)(SFT + d * 72 + v) = ld.sf; *(LAS v2u*)(SBT + d * 72 + v) = ld.sb; }
    __syncthreads();
    if (w == 0) gla_scan_cols(Gf, Gb, lane);
    __syncthreads();
#pragma unroll
    for (int r = 0; r < 4; ++r) { const int e = tid + r * 512, d = e & 31, i = e >> 5, a = i * 33 + d; const float q = Qx[a] * 0.17677669529663687f, k = Kx[a], bf = Gf[a], bb = Gb[a];
        QF[i * 40 + d] = (u16)f2bf(q * __expf(bf)); KF[i * 40 + d] = (u16)f2bf(k * __expf(-bf)); QB[i * 40 + d] = (u16)f2bf(q * __expf(bb)); KB[i * 40 + d] = (u16)f2bf(k * __expf(-bb)); }
    __syncthreads();
#pragma unroll
    for (int q = 0; q < 2; ++q) { const int id = 2 * w + q, ti = id >> 2, si = id & 3; const f32x4_t z4 = {0.f, 0.f, 0.f, 0.f}; f32x4_t acc;
        if (si < ti) acc = MFMA16(ldfrag(QF, 40, ti * 16, 0, lane), ldfrag(KF, 40, si * 16, 0, lane), z4);
        else if (si > ti) acc = MFMA16(ldfrag(QB, 40, ti * 16, 0, lane), ldfrag(KB, 40, si * 16, 0, lane), z4);
        else { const f32x4_t af = MFMA16(ldfrag(QF, 40, ti * 16, 0, lane), ldfrag(KF, 40, si * 16, 0, lane), z4), ab = MFMA16(ldfrag(QB, 40, ti * 16, 0, lane), ldfrag(KB, 40, si * 16, 0, lane), z4);
#pragma unroll
            for (int j = 0; j < 4; ++j) acc[j] = ((lane & 15) <= 4 * (lane >> 4) + j) ? af[j] : ab[j]; }
#pragma unroll
        for (int j = 0; j < 4; ++j) SC[(ti * 16 + 4 * (lane >> 4) + j) * 72 + si * 16 + (lane & 15)] = (u16)f2bf(acc[j]); }
    __syncthreads();
#pragma unroll
    for (int q = 0; q < 2; ++q) { const int id = 2 * w + q, ti = id >> 2, vi = id & 3; f32x4_t acc = {0.f, 0.f, 0.f, 0.f};
        acc = MFMA16(ldfrag(SC, 72, ti * 16, 0, lane), ldfrag_tr(VT, 72, 0, vi * 16, lane), acc);
        acc = MFMA16(ldfrag(SC, 72, ti * 16, 32, lane), ldfrag_tr(VT, 72, 32, vi * 16, lane), acc);
        acc = MFMA16(ldfrag(QF, 40, ti * 16, 0, lane), ldfrag_tr(SFT, 72, 0, vi * 16, lane), acc);
        acc = MFMA16(ldfrag(QB, 40, ti * 16, 0, lane), ldfrag_tr(SBT, 72, 0, vi * 16, lane), acc);
#pragma unroll
        for (int j = 0; j < 4; ++j) O[(ti * 16 + 4 * (lane >> 4) + j) * 65 + vi * 16 + (lane & 15)] = acc[j]; }
    __syncthreads();
    { const int t = tid >> 3, v8 = (tid & 7) * 8; float acc[8]; float ss = 0.f;
#pragma unroll
        for (int e = 0; e < 8; ++e) { acc[e] = O[t * 65 + v8 + e]; ss += acc[e] * acc[e]; }
        ss += __shfl_xor(ss, 1); ss += __shfl_xor(ss, 2); ss += __shfl_xor(ss, 4);
        const float rstd = 1.f / sqrtf(ss * (1.f / 64.f) + EPSN);
        u16* mz = P1 + (rb + t) * P1P + h * 64 + v8; float zz[8]; unpack8(ld.z, zz);
#pragma unroll
        for (int e = 0; e < 8; ++e) acc[e] = acc[e] * rstd * p.tab[13][l * 64 + v8 + e] * silu_f(zz[e]);
        *(v4u*)mz = pack8(acc); }
    __syncthreads();
}
#define XB_TMO      128
#define XB_XCNT(j)  (256  + 64 * (j))
#define XB_XSUB(j)  (1280 + 64 * (j))
#define XB_XGEN(j)  (2304 + 64 * (j))
#define XB_TOP      3328
#define XB_TOPGEN   3392
#define XCD_BAR_WORDS 3456
#define XB_SPIN_CAP (1u << 18)

__device__ __forceinline__ unsigned xb_ld(unsigned* p)              { return __hip_atomic_load(p, __ATOMIC_RELAXED, __HIP_MEMORY_SCOPE_AGENT); }
__device__ __forceinline__ unsigned xb_add(unsigned* p, unsigned v) { return __hip_atomic_fetch_add(p, v, __ATOMIC_RELAXED, __HIP_MEMORY_SCOPE_AGENT); }
__device__ __forceinline__ unsigned xb_xcc_id() { return (unsigned)__builtin_amdgcn_s_getreg((3 << 11) | 20) & 0xFu; }
#define XB_SPIN(cond, bar) do { unsigned _sp = 0; while (cond) { __builtin_amdgcn_s_sleep(1); \
    if ((++_sp & 255u) == 0u) { if (xb_ld(&(bar)[XB_TMO])) break; if (_sp > XB_SPIN_CAP) { atomicAdd(&(bar)[XB_TMO], 1u); break; } } } } while (0)

struct XcdBarrier {
    unsigned* bar; unsigned x;
    volatile LAS unsigned* st;
};

__device__ __forceinline__ XcdBarrier xcd_barrier_post(unsigned* bar, volatile LAS unsigned* st) {
    XcdBarrier b; b.bar = bar; b.x = xb_xcc_id(); b.st = st;
    if (threadIdx.x == 0) (void)xb_add(&bar[XB_XCNT(b.x)], 1u);
    return b;
}
__device__ __forceinline__ void xcd_barrier_complete(unsigned* bar, unsigned x, unsigned& nloc, unsigned& nx) {
    const unsigned G = gridDim.x * gridDim.y * gridDim.z;
    unsigned sum, cnt, mine, sp = 0u;
    for (;;) {
        sum = 0u; cnt = 0u; mine = 0u;
#pragma unroll
        for (unsigned j = 0; j < 16; ++j) { const unsigned c = xb_ld(&bar[XB_XCNT(j)]); sum += c; cnt += (c > 0u) ? 1u : 0u; mine = (j == x) ? c : mine; }
        if (sum == G) break;
        __builtin_amdgcn_s_sleep(1);
        if ((++sp & 255u) == 0u) { if (xb_ld(&bar[XB_TMO])) break; if (sp > XB_SPIN_CAP) { atomicAdd(&bar[XB_TMO], 1u); break; } }
    }
    nloc = mine > 0u ? mine : 1u; nx = cnt > 0u ? cnt : 1u;
}

__device__ __forceinline__ void xcd_barrier(const XcdBarrier& b) {
    asm volatile("s_waitcnt vmcnt(0)" ::: "memory");
    __syncthreads();
    if (threadIdx.x == 0) {
        unsigned* bar = b.bar;
        __builtin_amdgcn_s_waitcnt(0);
        unsigned nloc = b.st[0], nx = b.st[1];
        if (nloc == 0u) { xcd_barrier_complete(bar, b.x, nloc, nx); b.st[0] = nloc; b.st[1] = nx; }
        const unsigned old = xb_add(&bar[XB_XSUB(b.x)], 1u);
        const unsigned gen = old / nloc;
        if (old + 1u == (gen + 1u) * nloc) {
            __builtin_amdgcn_fence(__ATOMIC_RELEASE, "agent");
            asm volatile("s_waitcnt vmcnt(0)" ::: "memory");
            const unsigned og = xb_add(&bar[XB_TOP], 1u);
            const unsigned tg = og / nx;
            if (og + 1u == (tg + 1u) * nx) xb_add(&bar[XB_TOPGEN], 1u);
            else XB_SPIN(xb_ld(&bar[XB_TOPGEN]) == tg, bar);
            __builtin_amdgcn_fence(__ATOMIC_ACQUIRE, "agent");
            xb_add(&bar[XB_XGEN(b.x)], 1u);
            asm volatile("s_waitcnt vmcnt(0)" ::: "memory");
        } else {
            XB_SPIN(xb_ld(&bar[XB_XGEN(b.x)]) == gen, bar);
            __builtin_amdgcn_fence(__ATOMIC_ACQUIRE, "agent");
            asm volatile("s_waitcnt vmcnt(0)" ::: "memory");
        }
    }
    __syncthreads();
}


#ifndef GM
#define GM 7
#endif
#ifndef PH
#define PH 1023
#endif
__global__ void __launch_bounds__(512, 2) fwd_kernel(Params kp) {
    extern __shared__ __attribute__((aligned(16))) unsigned char lds[];
    cg::grid_group grid = cg::this_grid();
    LAS unsigned char* L = (LAS unsigned char*)lds; LAS float* F = (LAS float*)lds;
    const int G = gridDim.x, bid = blockIdx.x;
    Ctx p; p.out = kp.out; p.ws = kp.ws; p.tab = (LAS cfp*)(L + 131072);
    if (otid() == 0) { p.tab[0] = kp.xp; p.tab[1] = kp.xs; p.tab[2] = kp.cp; p.tab[3] = kp.cs; p.tab[4] = kp.ada_w; p.tab[5] = kp.ada_b; p.tab[6] = kp.pre_g; p.tab[7] = kp.post_g; p.tab[8] = kp.w_in;
        p.tab[9] = kp.wg2f; p.tab[10] = kp.bgf; p.tab[11] = kp.wg2b; p.tab[12] = kp.bgb; p.tab[13] = kp.onorm_g; p.tab[14] = kp.fnet_w; p.tab[15] = kp.qn_g; p.tab[16] = kp.kn_g; p.tab[17] = kp.sgu_ng;
        p.tab[18] = kp.sgu_w; p.tab[19] = kp.sgu_b; p.tab[20] = kp.w_out; }
    volatile LAS unsigned* bst = (volatile LAS unsigned*)(L + 131072 + 256);
    if (otid() < 4) bst[otid()] = 0u;
    __syncthreads();
    const XcdBarrier xbar = xcd_barrier_post((unsigned*)(p.ws + WS_BAR), bst);
    u16* P1 = (u16*)p.out; u16* P2 = (u16*)(p.ws + WS_P2); u16* HB = (u16*)(p.ws + WS_HB); u16* U0 = (u16*)(p.ws + WS_U0);


#if PH & 1
    phase0(p, L);
#endif
    grid.sync();
    for (int step = 0; step < 12; ++step) {
        const int l = step / 6, ph = step % 6;
        bool do_gemm = false; pg8::Gemm g{nullptr, nullptr, T_TOK, 0, 0, 0, 0}; pg8::EpiX E{0, nullptr, 0, nullptr, 0, 0};
        if (ph == 0) {
#if PH & 2
            phaseA(p, l);
#endif
        } else if (ph == 1) {
            g.A = HB; g.Bt = (const u16*)(p.ws + WS_WIN) + (size_t)l * 3584 * 1024; g.N = 3584; g.K = 1024; g.lda = 1024; g.ldb = 1024;
            E.mode = 0; E.O1 = P1; E.ld1 = P1P; E.O2 = P2; E.ld2 = P2P; do_gemm = true;
        } else if (ph == 2) {
#if PH & 4
            qk_prep(p, l);
#endif
#if PH & 8
            { GLoad nx = gla_local_load(p, bid < 1024 ? bid : 0); for (int it = bid; it < 1024; it += G) { const GLoad cur = nx; if (it + G < 1024) nx = gla_local_load(p, it + G); gla_local_item(p, l, it, F, cur); } }
#endif
#if PH & 16
            for (int it = bid; it < 1024; it += G) sgu_item(p, l, it, F, (it == bid) || (G & 3) != 0);
#endif
#if PH & 32
            for (int it = bid; it < 768; it += G) fnet1_item(p, it, F);
#endif
        } else if (ph == 3) {
#if PH & 64
            for (int it = bid; it < 192; it += G) gla_scan_item(p, it);
#endif
#if PH & 128
            { F2Load nx = fnet2_load(p, bid < 512 ? bid : 0); for (int it = bid; it < 512; it += G) { const F2Load cur = nx; if (it + G < 512) nx = fnet2_load(p, it + G); fnet2_item(p, it, F, cur); } }
#endif
            __syncthreads();
#ifndef SKIP_ATTN
            for (int u = ((G & 7) == 0 ? (bid & 7) * (G >> 3) + (bid >> 3) : bid); u < 1024; u += G) {
                int s, h, qb;
                if (u < 512) { s = u >> 7; const int r = u & 127; h = r >> 4; qb = r & 15; } else { const int u2 = u - 512; s = 4 + (u2 >> 8); const int r = u2 & 255; h = r >> 5; qb = r & 31; }
                int row0, N; seq_info(s, row0, N);
                const attn_body::bf16* Pb = (const attn_body::bf16*)P1;
                const attn_body::bf16* KCb = (const attn_body::bf16*)(p.ws + WS_HB + HB_KC) + ((size_t)row0 * 2 + (size_t)(h >> 2) * N) * 64;
                const attn_body::bf16* VCb = (const attn_body::bf16*)(p.ws + WS_HB + HB_VC) + ((size_t)row0 * 2 + (size_t)(h >> 2) * N) * 64;
                attn_body::attn_unit<8>(Pb + (size_t)(row0 + qb * 256) * P1P + P1_Q + h * 64, KCb, VCb,
                                        (attn_body::bf16*)P1 + (size_t)(row0 + qb * 256) * P1P + 512 + h * 64, N >> 6, (char*)lds, qb * 256, p.tab[15] + l * 64);
            }
#endif
        } else if (ph == 4) {
#if PH & 256
            if (G == 256) { const int i0 = bid < 128 ? bid * 7 : 896 + (bid - 128) * 9, i1 = i0 + (bid < 128 ? 7 : 9);
                OLoad nx = gla_out_load(p, i0); for (int it = i0; it < i1; ++it) { const OLoad cur = nx; if (it + 1 < i1) nx = gla_out_load(p, it + 1); gla_out_item(p, l, it, F, cur); } }
            else { OLoad nx = gla_out_load(p, bid < 2048 ? bid : 0); for (int it = bid; it < 2048; it += G) { const OLoad cur = nx; if (it + G < 2048) nx = gla_out_load(p, it + G); gla_out_item(p, l, it, F, cur); } }
#endif
            g.A = P2 + P2_U; g.Bt = (const u16*)(p.ws + WS_WF) + (size_t)l * 131072; g.N = 256; g.K = 512; g.lda = P2P; g.ldb = 512;
            E.mode = 2; E.O1 = P1; E.ld1 = P1P; E.col_off = 256; do_gemm = true;
        } else {
            g.A = P1; g.Bt = (const u16*)(p.ws + WS_WOUT) + (size_t)l * 1024 * 1280; g.N = 1024; g.K = 1280; g.lda = P1P; g.ldb = 1280;
            E.mode = 1; E.O1 = (l == 0) ? U0 : HB; E.ld1 = 1024; do_gemm = true;
        }
#if GM
        if (do_gemm) { pg8::StaticOrder S; S.init(T_TOK, g.N, G, bid); pg8::gemm_phase<pg8::EpiX, pg8::StaticOrder, PG8_ALIGN, PG8_SP2>(L, g, S, E); }
#endif
        xcd_barrier(xbar);
    }
#if PH & 2
    phaseA(p, 2);
#endif
}

extern "C" void kernel_launch(void* const* d_in, const int* in_sizes, int n_in, void* d_out, int out_size, void* d_ws, size_t ws_size, hipStream_t stream) {
    static int grid = 0;
    if (grid == 0) {
        if (n_in != 21 || out_size != T_TOK * 1024 || ws_size < WS_END) { fprintf(stderr, "kernel_launch: unexpected sizes n_in %d out %d ws %zu\n", n_in, out_size, ws_size); grid = -1; return; }
        int dev = 0, cus = 0, per_cu = 0;
        (void)hipGetDevice(&dev); (void)hipDeviceGetAttribute(&cus, hipDeviceAttributeMultiprocessorCount, dev);
        if (hipFuncSetAttribute((const void*)fwd_kernel, hipFuncAttributeMaxDynamicSharedMemorySize, LDS_BYTES) != hipSuccess) { fprintf(stderr, "kernel_launch: hipFuncSetAttribute failed\n"); grid = -1; return; }
        if (hipOccupancyMaxActiveBlocksPerMultiprocessor(&per_cu, (const void*)fwd_kernel, 512, LDS_BYTES) != hipSuccess || per_cu < 1) { fprintf(stderr, "kernel_launch: occupancy query gave %d\n", per_cu); per_cu = 1; }
        (void)hipGetLastError();
        grid = cus * 1;
        fprintf(stderr, "kernel_launch: grid %d (per_cu %d) ws %zu\n", grid, per_cu, ws_size);
    }
    if (grid < 0) return;
    Params p{};
    const float** pp = (const float**)&p;
    for (int i = 0; i < 21; ++i) pp[i] = (const float*)d_in[i];
    p.out = (float*)d_out; p.ws = (unsigned char*)d_ws;
    if (hipMemsetAsync((char*)d_ws + WS_MOD, 0, 2 * 6 * 3072 * sizeof(float), stream) != hipSuccess) { fprintf(stderr, "kernel_launch: memset failed\n"); return; }
    if (hipMemsetAsync((char*)d_ws + WS_BAR, 0, BAR_BYTES, stream) != hipSuccess) { fprintf(stderr, "kernel_launch: memset failed\n"); return; }
    void* args[] = {&p};
    hipError_t e = hipLaunchCooperativeKernel((const void*)fwd_kernel, dim3(grid), dim3(512), args, LDS_BYTES, stream);
    if (e != hipSuccess) fprintf(stderr, "cooperative launch failed: %s (grid %d)\n", hipGetErrorString(e), grid);
}
```

```cpp
#include <hip/hip_runtime.h>
#include <hip/hip_cooperative_groups.h>
#include <cstdio>
#include <cstdint>
namespace cg = cooperative_groups;
__device__ __forceinline__ int otid() { int t = threadIdx.x; asm volatile("" : "+v"(t)); return t; }
namespace pg8 {
#define PG8_LAS __attribute__((address_space(3)))
typedef unsigned short bf16_t;
typedef short bf16x8 __attribute__((ext_vector_type(8)));
typedef float f32x4 __attribute__((ext_vector_type(4)));
typedef unsigned u32x4 __attribute__((ext_vector_type(4)));
constexpr int BM = 256, BK = 64, HALF = 128, HTB = HALF * BK * 2  , STAGE_BYTES = 8 * HTB, NXCD = 8, WGM = 8;

__host__ __device__ __forceinline__ int lds_byte(int r, int c) { const int st = (r >> 4) * 2 + (c >> 5), rr = r & 15, cc = c & 31, ob = rr * 64 + cc * 2; return st * 1024 + (ob ^ (((ob >> 9) & 1) << 5)); }
__host__ __device__ __forceinline__ void stage_rc(int b, int& R, int& C) { const int st = b / 1024, sb = b % 1024, swz = sb ^ (((sb >> 9) & 1) << 5); R = (st >> 1) * 16 + swz / 64; C = (st & 1) * 32 + (swz % 64) / 2; }
__host__ __device__ __forceinline__ int perm32(int rho) { const int n = rho >> 4, i = rho & 15; return 8 * (i >> 2) + 4 * n + (i & 3); }

struct Unit { int pm, pn; };
struct Gemm { const bf16_t* A; const bf16_t* Bt; int M, N, K, lda, ldb; };

struct StaticOrder {
    int nM, nN, nwg, G, c;
    __host__ __device__ void init(int M, int N, int G_, int c_) { nM = M / BM; nN = N / BM; nwg = nM * nN; G = G_; c = c_; }
    __host__ __device__ bool next(int i, Unit& u) const {
        const long L = (long)i * G + c; if (L >= nwg) return false;
        int wgid = (int)L; { const int q = nwg / NXCD, r = nwg % NXCD, xcd = wgid % NXCD, off = wgid / NXCD; wgid = (xcd < r ? xcd * (q + 1) : r * (q + 1) + (xcd - r) * q) + off; }
        const int nig = WGM * nN, gid = wgid / nig, fm = gid * WGM, gsz = (nM - fm) < WGM ? (nM - fm) : WGM;
        u.pm = fm + ((wgid % nig) % gsz); u.pn = (wgid % nig) / gsz; return true;
    }
    __device__ __forceinline__ void a_ready(const Unit&) const {}
    __device__ __forceinline__ void done(const Unit&) const {}
};

__device__ __forceinline__ unsigned cvt_pk_bf16(float lo, float hi) { unsigned r; asm volatile("v_cvt_pk_bf16_f32 %0, %1, %2" : "=v"(r) : "v"(lo), "v"(hi)); return r; }
__device__ __forceinline__ float silu_f(float z) { return z * __builtin_amdgcn_rcpf(1.f + __expf(-z)); }
struct EpiX {
    static constexpr bool PERM = true, AFTER_DRAIN = false;
    int mode; bf16_t* O1; int ld1; bf16_t* O2; int ld2; int col_off;
    __device__ __forceinline__ void operator()(const f32x4 (&acc)[2][2][4][2], const Unit& u, int wr, int wc, int fr, int fq) const {
        const int row0 = u.pm * BM + wr * 64 + fr;
        bf16_t* base; int ld, colt;
        if (mode == 0) { if (u.pn < 8) { base = O1; ld = ld1; colt = u.pn * BM; } else { base = O2; ld = ld2; colt = (u.pn - 8) * BM; } }
        else { base = O1; ld = ld1; colt = col_off + u.pn * BM; }
        const int col0 = colt + wc * 32 + 8 * fq;
#pragma unroll
        for (int ai = 0; ai < 2; ++ai)
#pragma unroll
            for (int m = 0; m < 4; ++m) { bf16_t* rowp = base + (size_t)(row0 + ai * HALF + m * 16) * ld + col0;
#pragma unroll
                for (int bj = 0; bj < 2; ++bj) { f32x4 v0 = acc[ai][bj][m][0], v1 = acc[ai][bj][m][1];
                    if (mode == 2) { const u32x4 z = *(const u32x4*)(rowp + bj * HALF);
                        v0[0] *= silu_f(__uint_as_float(z.x << 16)); v0[1] *= silu_f(__uint_as_float(z.x & 0xffff0000u));
                        v0[2] *= silu_f(__uint_as_float(z.y << 16)); v0[3] *= silu_f(__uint_as_float(z.y & 0xffff0000u));
                        v1[0] *= silu_f(__uint_as_float(z.z << 16)); v1[1] *= silu_f(__uint_as_float(z.z & 0xffff0000u));
                        v1[2] *= silu_f(__uint_as_float(z.w << 16)); v1[3] *= silu_f(__uint_as_float(z.w & 0xffff0000u)); }
                    u32x4 w; w.x = cvt_pk_bf16(v0[0], v0[1]); w.y = cvt_pk_bf16(v0[2], v0[3]); w.z = cvt_pk_bf16(v1[0], v1[1]); w.w = cvt_pk_bf16(v1[2], v1[3]);
                    *(u32x4*)(rowp + bj * HALF) = w; } }
    }
};
#ifndef PG8_SP2
#define PG8_SP2 true
#endif
#ifndef PG8_ALIGN
#define PG8_ALIGN true
#endif
template <class Epi, class Sched, bool ALIGN_EPI = false, bool SP2 = false>
__device__ __forceinline__ void gemm_phase(PG8_LAS unsigned char* lds, const Gemm g, const Sched& S, const Epi& E) {
    const int tid = otid(), wid = __builtin_amdgcn_readfirstlane(tid >> 6), lane = tid & 63, wr = wid >> 2, wc = wid & 3, fr = lane & 15, fq = lane >> 4;
    const int K = g.K, nt = K / BK;
    unsigned voffA[2], voffB[2];
#pragma unroll
    for (int i = 0; i < 2; ++i) { int R, C; stage_rc(tid * 16 + i * 8192, R, C); const int Rb = Epi::PERM ? ((R & ~31) + perm32(R & 31)) : R;
        voffA[i] = (unsigned)(R * g.lda + C) * 2u; voffB[i] = (unsigned)(Rb * g.ldb + C) * 2u; }
    const size_t kstep = (size_t)(BK * 2);
    const size_t hstepA = (size_t)HALF * g.lda * 2, hstepB = (size_t)HALF * g.ldb * 2;
    const size_t tstepA = 2 * hstepA, tstepB = 2 * hstepB;
    const unsigned ldsw = (unsigned)wid * 1024u;
    const int aoff = lds_byte(wr * 64 + fr, fq * 8), boff = lds_byte(wc * 32 + fr, fq * 8);
#define PG8_SA(b, h) (((b) * 2 + (h)) * HTB)
#define PG8_SB(b, h) ((4 + (b) * 2 + (h)) * HTB)
#define PG8_STAGE(bufoff, gbase, voff) do { _Pragma("unroll") for (int _i = 0; _i < 2; ++_i) \
        __builtin_amdgcn_global_load_lds((const unsigned*)((const char*)(gbase) + (voff)[_i]), (PG8_LAS unsigned*)(lds + (bufoff) + ldsw + _i * 8192), 16, 0, 0); } while (0)
#define PG8_LDA(dst, b, h) do { _Pragma("unroll") for (int m = 0; m < 4; ++m) _Pragma("unroll") for (int k = 0; k < 2; ++k) dst[m][k] = *(const PG8_LAS bf16x8*)(lds + PG8_SA(b, h) + aoff + m * 2048 + k * 1024); } while (0)
#define PG8_LDB(dst, b, h) do { _Pragma("unroll") for (int n = 0; n < 2; ++n) _Pragma("unroll") for (int k = 0; k < 2; ++k) dst[n][k] = *(const PG8_LAS bf16x8*)(lds + PG8_SB(b, h) + boff + n * 2048 + k * 1024); } while (0)
#define PG8_MMA(ai, bj, At, Bt) do { __builtin_amdgcn_s_setprio(1); _Pragma("unroll") for (int m = 0; m < 4; ++m) _Pragma("unroll") for (int n = 0; n < 2; ++n) _Pragma("unroll") for (int k = 0; k < 2; ++k) \
        acc[ai][bj][m][n] = __builtin_amdgcn_mfma_f32_16x16x32_bf16(Bt[n][k], At[m][k], acc[ai][bj][m][n], 0, 0, 0); __builtin_amdgcn_s_setprio(0); } while (0)
#define PG8_WAIT_V(n) asm volatile("s_waitcnt vmcnt(" #n ")" ::: "memory")
#define PG8_WAIT_L(n) asm volatile("s_waitcnt lgkmcnt(" #n ")" ::: "memory")
#define PG8_BAR __builtin_amdgcn_s_barrier()
#define PG8_SCHED __builtin_amdgcn_sched_barrier(0)
    Unit cur, nxt; int ui = 0;
    if (!S.next(0, cur)) return;
    f32x4 acc[2][2][4][2];
#pragma unroll
    for (int a = 0; a < 2; ++a)
#pragma unroll
        for (int b = 0; b < 2; ++b)
#pragma unroll
            for (int m = 0; m < 4; ++m)
#pragma unroll
                for (int n = 0; n < 2; ++n) acc[a][b][m][n] = (f32x4){0.f, 0.f, 0.f, 0.f};
    bf16x8 At[4][2], B0[2][2], B1[2][2];
    const char* cA = (const char*)g.A + (size_t)cur.pm * tstepA; const char* cB = (const char*)g.Bt + (size_t)cur.pn * tstepB;
    S.a_ready(cur);
    if constexpr (SP2) {
        PG8_STAGE(PG8_SB(0, 0), cB, voffB); PG8_STAGE(PG8_SB(0, 1), cB + hstepB, voffB); PG8_STAGE(PG8_SA(0, 0), cA, voffA); PG8_STAGE(PG8_SA(0, 1), cA + hstepA, voffA);
        if (wr == 1) PG8_BAR;
        PG8_WAIT_V(2); PG8_BAR;
        PG8_STAGE(PG8_SB(1, 0), cB + kstep, voffB); PG8_STAGE(PG8_SA(1, 0), cA + kstep, voffA); PG8_STAGE(PG8_SB(1, 1), cB + hstepB + kstep, voffB);
        PG8_WAIT_V(6); PG8_BAR;
    } else {
        PG8_STAGE(PG8_SB(0, 0), cB, voffB); PG8_STAGE(PG8_SA(0, 0), cA, voffA); PG8_STAGE(PG8_SB(0, 1), cB + hstepB, voffB); PG8_STAGE(PG8_SA(0, 1), cA + hstepA, voffA);
        if (wr == 1) PG8_BAR;
        PG8_WAIT_V(4); PG8_BAR;
        PG8_STAGE(PG8_SB(1, 0), cB + kstep, voffB); PG8_STAGE(PG8_SA(1, 0), cA + kstep, voffA); PG8_STAGE(PG8_SB(1, 1), cB + hstepB + kstep, voffB);
        PG8_WAIT_V(6); PG8_BAR;
    }
    for (;;) {
        const bool has_next = S.next(ui + 1, nxt);
        const char* nA = has_next ? (const char*)g.A + (size_t)nxt.pm * tstepA : cA; const char* nB = has_next ? (const char*)g.Bt + (size_t)nxt.pn * tstepB : cB;
        for (int t = 0; t < nt; t += 2) {
            const bool last = (t == nt - 2);
            const char* a1 = cA + (size_t)(t + 1) * kstep;
            const char* a2 = last ? nA : cA + (size_t)(t + 2) * kstep; const char* b2 = last ? nB : cB + (size_t)(t + 2) * kstep;
            const char* a3 = a2 + kstep; const char* b3 = b2 + kstep;
            if (last && has_next) S.a_ready(nxt);
            if constexpr (SP2) {
            PG8_LDB(B0, 0, 0); PG8_LDB(B1, 0, 1); PG8_SCHED; PG8_LDA(At, 0, 0); PG8_STAGE(PG8_SA(1, 1), a1 + hstepA, voffA);
            PG8_WAIT_V(8); PG8_WAIT_L(0); PG8_BAR; PG8_MMA(0, 0, At, B0); PG8_MMA(0, 1, At, B1); PG8_BAR; PG8_SCHED;
            PG8_LDA(At, 0, 1); PG8_STAGE(PG8_SB(0, 0), b2, voffB); PG8_STAGE(PG8_SB(0, 1), b2 + hstepB, voffB); PG8_STAGE(PG8_SA(0, 0), a2, voffA);
            PG8_WAIT_V(8); PG8_WAIT_L(0); PG8_BAR; PG8_MMA(1, 0, At, B0); PG8_MMA(1, 1, At, B1); PG8_BAR; PG8_SCHED;
            PG8_LDB(B0, 1, 0); PG8_LDB(B1, 1, 1); PG8_SCHED; PG8_LDA(At, 1, 0); PG8_STAGE(PG8_SA(0, 1), a2 + hstepA, voffA);
            PG8_WAIT_V(8); PG8_WAIT_L(0); PG8_BAR; PG8_MMA(0, 0, At, B0); PG8_MMA(0, 1, At, B1); PG8_BAR; PG8_SCHED;
            PG8_LDA(At, 1, 1); PG8_STAGE(PG8_SB(1, 0), b3, voffB); PG8_STAGE(PG8_SB(1, 1), b3 + hstepB, voffB); PG8_STAGE(PG8_SA(1, 0), a3, voffA);
            PG8_WAIT_V(8); PG8_WAIT_L(0); PG8_BAR; PG8_MMA(1, 0, At, B0); PG8_MMA(1, 1, At, B1); PG8_BAR; PG8_SCHED;
            } else {
            PG8_LDB(B0, 0, 0); PG8_SCHED; PG8_LDA(At, 0, 0); PG8_STAGE(PG8_SA(1, 1), a1 + hstepA, voffA);
            PG8_WAIT_L(8); PG8_BAR; PG8_WAIT_L(0); PG8_MMA(0, 0, At, B0); PG8_BAR; PG8_SCHED;
            PG8_LDB(B1, 0, 1); PG8_STAGE(PG8_SB(0, 0), b2, voffB);
            PG8_BAR; PG8_WAIT_L(0); PG8_MMA(0, 1, At, B1); PG8_BAR;
            PG8_LDA(At, 0, 1); PG8_STAGE(PG8_SA(0, 0), a2, voffA);
            PG8_BAR; PG8_WAIT_L(0); PG8_MMA(1, 0, At, B0); PG8_BAR; PG8_SCHED;
            PG8_STAGE(PG8_SB(0, 1), b2 + hstepB, voffB);
            PG8_WAIT_V(6); PG8_BAR; PG8_MMA(1, 1, At, B1); PG8_BAR;
            PG8_LDB(B0, 1, 0); PG8_SCHED; PG8_LDA(At, 1, 0); PG8_STAGE(PG8_SA(0, 1), a2 + hstepA, voffA);
            PG8_WAIT_L(8); PG8_BAR; PG8_WAIT_L(0); PG8_MMA(0, 0, At, B0); PG8_BAR; PG8_SCHED;
            PG8_LDB(B1, 1, 1); PG8_STAGE(PG8_SB(1, 0), b3, voffB);
            PG8_BAR; PG8_WAIT_L(0); PG8_MMA(0, 1, At, B1); PG8_BAR;
            PG8_LDA(At, 1, 1); PG8_STAGE(PG8_SA(1, 0), a3, voffA);
            PG8_BAR; PG8_WAIT_L(0); PG8_MMA(1, 0, At, B0); PG8_BAR; PG8_SCHED;
            PG8_STAGE(PG8_SB(1, 1), b3 + hstepB, voffB);
            PG8_WAIT_V(6); PG8_BAR; PG8_MMA(1, 1, At, B1); PG8_BAR;
            }
        }
        if constexpr (ALIGN_EPI) { if (wr == 0) PG8_BAR; }
        if constexpr (!Epi::AFTER_DRAIN) { E(acc, cur, wr, wc, fr, fq); S.done(cur); }
        if (!has_next) break;
#pragma unroll
        for (int a = 0; a < 2; ++a)
#pragma unroll
            for (int b = 0; b < 2; ++b)
#pragma unroll
                for (int m = 0; m < 4; ++m)
#pragma unroll
                    for (int n = 0; n < 2; ++n) acc[a][b][m][n] = (f32x4){0.f, 0.f, 0.f, 0.f};
        cur = nxt; cA = nA; cB = nB; ++ui;
        if constexpr (ALIGN_EPI) { if (wr == 1) PG8_BAR; }
    }
    PG8_WAIT_V(0);
    if constexpr (!ALIGN_EPI) { if (wr == 0) PG8_BAR; }
    PG8_BAR;
    if constexpr (Epi::AFTER_DRAIN) { E.fused(acc, cur, wr, wc, fr, fq, lds, wid, lane); S.done(cur); }
#undef PG8_SA
#undef PG8_SB
#undef PG8_STAGE
#undef PG8_LDA
#undef PG8_LDB
#undef PG8_MMA
#undef PG8_WAIT_V
#undef PG8_WAIT_L
#undef PG8_BAR
#undef PG8_SCHED
}
}
#include <hip/hip_bf16.h>
#include <cmath>
namespace attn_body {
using bf16=__hip_bfloat16;
using bf16x8=__attribute__((ext_vector_type(8)))short;
using s16x4=__attribute__((ext_vector_type(4)))short;
using f32x16=__attribute__((ext_vector_type(16)))float;
using u32x4=__attribute__((ext_vector_type(4)))unsigned;
constexpr int D=64,DM=2048,KDM=64;
constexpr int NW=8,QBLK=32,QB=QBLK*NW,KVBLK=64;
constexpr int ATTN_PITCH=DM, ATTN_UNIT_ROWS=QB;
__device__ __forceinline__ int crow(int r,int hi){return (r&3)+8*(r>>2)+4*hi;}
#define SBAR() __builtin_amdgcn_sched_barrier(0)
__device__ __forceinline__ void cmask(f32x16&p0,f32x16&p1,int jb,int qrel,int hi){
  const float NEG=-INFINITY; int kb=64*jb+4*hi;
  #pragma unroll
  for(int r=0;r<16;++r){int kv=kb+(r&3)+8*(r>>2); if(kv>qrel)p0[r]=NEG; if(kv+32>qrel)p1[r]=NEG;}
}

constexpr int NSLOT=3, SLOTB=8192;
constexpr int LDS_K=0, LDS_V=NSLOT*SLOTB, LDS_WS=2*NSLOT*SLOTB, LDS_OST=LDS_WS+NW*64*4, LDS_BYTES=LDS_OST+NW*4096;
constexpr float C2=0.125f*1.4426950408889634f;
__device__ __forceinline__ void glds16(const void*gsrc,unsigned lds_dst){unsigned keep;
  asm volatile("s_mov_b32 %0, m0\n\ts_mov_b32 m0, %2\n\ts_nop 0\n\tglobal_load_lds_dwordx4 %1, off\n\ts_mov_b32 m0, %0":"=&s"(keep):"v"(gsrc),"s"(lds_dst):"memory");}
__device__ __forceinline__ float max3f(float a,float b,float c){float r;asm("v_max3_f32 %0, %1, %2, %3":"=v"(r):"v"(a),"v"(b),"v"(c));return r;}
__device__ __forceinline__ float max2f(float a,float b){float r;asm("v_max_f32_e32 %0, %1, %2":"=v"(r):"v"(a),"v"(b));return r;}
__device__ __forceinline__ float fadd_s(float a,float b){float r;asm("v_add_f32_e32 %0, %1, %2":"=v"(r):"v"(a),"v"(b));return r;}
__device__ __forceinline__ float fsub_s(float a,float b){float r;asm("v_sub_f32_e32 %0, %1, %2":"=v"(r):"v"(a),"v"(b));return r;}
typedef float f32x2_t __attribute__((ext_vector_type(2))); typedef __bf16 bf16x2_t __attribute__((ext_vector_type(2)));
__device__ __forceinline__ unsigned cvtpk_s(float lo,float hi){f32x2_t v={lo,hi};bf16x2_t b=__builtin_convertvector(v,bf16x2_t);return __builtin_bit_cast(unsigned,b);}
#define WAIT_BAR(N) asm volatile("s_waitcnt vmcnt(" #N ") lgkmcnt(0)\n\ts_barrier":::"memory")

__device__ __forceinline__ void qkt(f32x16&p0,f32x16&p1,const char*Kslot,const bf16x8*qr,const f32x16&negm,int r32,int hi){
  const char*kb=Kslot+hi*1024+r32*16;
  #pragma unroll
  for(int d0=0;d0<4;++d0){
    const bf16x8 b0=*reinterpret_cast<const bf16x8*>(kb+d0*2048);
    const bf16x8 b1=*reinterpret_cast<const bf16x8*>(kb+d0*2048+512);
    if(d0==0){p0=__builtin_amdgcn_mfma_f32_32x32x16_bf16(b0,qr[0],negm,0,0,0);p1=__builtin_amdgcn_mfma_f32_32x32x16_bf16(b1,qr[0],negm,0,0,0);}
    else{p0=__builtin_amdgcn_mfma_f32_32x32x16_bf16(b0,qr[d0],p0,0,0,0);p1=__builtin_amdgcn_mfma_f32_32x32x16_bf16(b1,qr[d0],p1,0,0,0);}}
}
typedef __attribute__((address_space(3))) const char* lds_cptr;
typedef short v4i16_t __attribute__((ext_vector_type(4)));
__device__ __forceinline__ void kload8(bf16x8*kf,lds_cptr kp){
  kf[0]=*(const __attribute__((address_space(3))) bf16x8*)(kp);      kf[1]=*(const __attribute__((address_space(3))) bf16x8*)(kp+512);
  kf[2]=*(const __attribute__((address_space(3))) bf16x8*)(kp+2048); kf[3]=*(const __attribute__((address_space(3))) bf16x8*)(kp+2560);
  kf[4]=*(const __attribute__((address_space(3))) bf16x8*)(kp+4096); kf[5]=*(const __attribute__((address_space(3))) bf16x8*)(kp+4608);
  kf[6]=*(const __attribute__((address_space(3))) bf16x8*)(kp+6144); kf[7]=*(const __attribute__((address_space(3))) bf16x8*)(kp+6656);
}
__device__ __forceinline__ void kload2(bf16x8*kf,lds_cptr kp,int j){ kf[2*j]=*(const __attribute__((address_space(3))) bf16x8*)(kp+j*2048); kf[2*j+1]=*(const __attribute__((address_space(3))) bf16x8*)(kp+j*2048+512); }
__device__ __forceinline__ s16x4 vtr(lds_cptr p){ return __builtin_bit_cast(s16x4,__builtin_amdgcn_ds_read_tr16_b64_v4i16((__attribute__((address_space(3))) v4i16_t*)p)); }
__device__ __forceinline__ float rowmax(const f32x16&p0,const f32x16&p1){
  float a=max3f(p0[0],p0[1],p1[0]),b=max3f(p0[2],p0[3],p1[1]);a=max3f(a,p1[2],p1[3]);
  #pragma unroll
  for(int r=4;r<16;r+=4){a=max3f(a,p0[r],p0[r+1]);b=max3f(b,p0[r+2],p0[r+3]);a=max3f(a,p1[r],p1[r+1]);b=max3f(b,p1[r+2],p1[r+3]);}
  const float m=max2f(a,b);
  auto rr=__builtin_amdgcn_permlane32_swap(__float_as_uint(m),__float_as_uint(m),false,false);
  return max2f(__uint_as_float(rr[0]),__uint_as_float(rr[1]));
}
__device__ __forceinline__ void pv(f32x16*o,int vb,bf16x8 pa0,bf16x8 pa1,bf16x8 pa2,bf16x8 pa3){
  #pragma unroll
  for(int d0=0;d0<2;++d0){s16x4 lo[4],hi[4];
    #pragma unroll
    for(int ks=0;ks<4;++ks){
      asm volatile("ds_read_b64_tr_b16 %0,%1 offset:%c2":"=&v"(lo[ks]):"v"(vb),"i"(d0*4096+ks*1024):"memory");
      asm volatile("ds_read_b64_tr_b16 %0,%1 offset:%c2":"=&v"(hi[ks]):"v"(vb),"i"(d0*4096+ks*1024+512):"memory");}
    asm volatile("s_waitcnt lgkmcnt(0)":::"memory");SBAR();
    #define PK(k) (bf16x8){lo[k][0],lo[k][1],lo[k][2],lo[k][3],hi[k][0],hi[k][1],hi[k][2],hi[k][3]}
    o[d0]=__builtin_amdgcn_mfma_f32_32x32x16_bf16(pa0,PK(0),o[d0],0,0,0);
    o[d0]=__builtin_amdgcn_mfma_f32_32x32x16_bf16(pa1,PK(1),o[d0],0,0,0);
    o[d0]=__builtin_amdgcn_mfma_f32_32x32x16_bf16(pa2,PK(2),o[d0],0,0,0);
    o[d0]=__builtin_amdgcn_mfma_f32_32x32x16_bf16(pa3,PK(3),o[d0],0,0,0);
    #undef PK
  }
}

#ifndef ATTN_STORE16
#define ATTN_STORE16(p,v) (*(u32x4*)(p)=(v))
#endif
template<int THRL> __device__ __forceinline__ void attn_unit(const bf16*Qblk,const bf16*__restrict__ Kh,const bf16*__restrict__ Vh,bf16*Oblk,const int NT,char*shm,const int qpos0,const float*__restrict__ qgain){
  const int tid=otid(),lane=tid&63,r32=lane&31,hi=lane>>5; const int wid=__builtin_amdgcn_readfirstlane(tid>>6);
  const bf16*Qw=Qblk+(long)wid*QBLK*DM;
  const unsigned lds0=(unsigned)(uintptr_t)shm;
  float*wsf=(float*)(shm+LDS_WS)+wid*64;
  const bf16*ksrc=Kh+(long)lane*KDM+wid*8;
  const bf16*vsrc=Vh+(long)(16*(wid&3)+(lane>>2))*KDM+(wid>>2)*32+(lane&3)*8;
  const unsigned kdst=lds0+LDS_K+wid*1024, vdst=lds0+LDS_V+wid*1024;
  #define DMA_K(t,slot) glds16(ksrc+(long)(t)*KVBLK*KDM,(unsigned)__builtin_amdgcn_readfirstlane(kdst+(slot)))
  #define DMA_V(t,slot) glds16(vsrc+(long)(t)*KVBLK*KDM,(unsigned)__builtin_amdgcn_readfirstlane(vdst+(slot)))
  const int vb0=(int)(lds0+LDS_V)+((lane>>4)&1)*32+(lane&3)*8+(4*hi+((lane&15)>>2))*64;
  const char*Kbase=shm+LDS_K; bf16x8 kf[8];
  const lds_cptr shm3=(lds_cptr)shm; const lds_cptr kp0=shm3+LDS_K+hi*1024+r32*16; const lds_cptr vp0=shm3+LDS_V+((lane>>4)&1)*32+(lane&3)*8+(4*hi+((lane&15)>>2))*64;
  DMA_K(0,0);DMA_V(0,0);DMA_K(1,SLOTB);
  bf16x8 qr[4];
  { float qf[4][8]; float ss=0.f;
    #pragma unroll
    for(int d0=0;d0<4;++d0){ const bf16x8 raw=*reinterpret_cast<const bf16x8*>(&Qw[(long)r32*DM+d0*16+hi*8]);
      #pragma unroll
      for(int j=0;j<8;++j){ qf[d0][j]=__uint_as_float(((unsigned)(unsigned short)raw[j])<<16); ss+=qf[d0][j]*qf[d0][j]; } }
    ss+=__shfl_xor(ss,32);
    const float rstd=1.0f/sqrtf(ss*(1.f/64.f)+1e-6f)*C2;
    const int pos=qpos0+wid*QBLK+r32; const float prow=(float)(pos>>6),pcol=(float)(pos&63);
    #pragma unroll
    for(int d0=0;d0<4;++d0){ u32x4 pk;
      #pragma unroll
      for(int jp=0;jp<4;++jp){ const int d=16*d0+8*hi+2*jp; const int m=8*(d0&1)+4*hi+jp;
        const float fr=__builtin_amdgcn_exp2f(-(float)m*(13.287712379549449f/16.f)); const float ang=((d0<2)?prow:pcol)*fr;
        const float sn=__sinf(ang),cs=__cosf(ang);
        const float y0=qf[d0][2*jp]*rstd*qgain[d],y1=qf[d0][2*jp+1]*rstd*qgain[d+1];
        pk[jp]=cvtpk_s(y0*cs-y1*sn,y0*sn+y1*cs); }
      qr[d0]=__builtin_bit_cast(bf16x8,pk); } }
  float mhat=0.f,l_reg=0.f;f32x16 o[2];o[0]=f32x16{};o[1]=f32x16{};f32x16 negm=f32x16{};asm volatile("":"+v"(negm));
  #define CMASK(P0,P1,t) do{}while(0)
  bool resc=false;
  #define START(P0,P1) do{ const float rm=rowmax(P0,P1); resc=false; \
    { const float dl=rm; mhat=fadd_s(mhat,dl); \
      _Pragma("unroll") for(int r=0;r<16;++r){P0[r]=fsub_s(P0[r],dl);P1[r]=fsub_s(P1[r],dl);} \
      _Pragma("unroll") for(int r=0;r<16;++r)negm[r]=-mhat; asm volatile("":"+v"(negm)); } \
    _Pragma("unroll") for(int r=0;r<16;++r)P0[r]=__builtin_amdgcn_exp2f(P0[r]); }while(0)
  #define RESC() do{ if(resc){ asm volatile("s_waitcnt lgkmcnt(0)":::"memory"); \
      _Pragma("unroll") for(int d_=0;d_<2;++d_) _Pragma("unroll") for(int r=0;r<16;++r)o[d_][r]*=wsf[crow(r,hi)]; } }while(0)
  f32x16 pA0,pA1,pB0,pB1;
  int sl_prev=0,sl_cur=0,sl_next=SLOTB;
  #define ROT() do{sl_prev=sl_cur;sl_cur=sl_next;sl_next=(sl_next==(NSLOT-1)*SLOTB)?0:sl_next+SLOTB;}while(0)
  DMA_K(2,2*SLOTB);
  WAIT_BAR(3);
  qkt(pA0,pA1,Kbase,qr,negm,r32,hi);asm volatile("s_nop 15\n\ts_nop 7":"+v"(pA0),"+v"(pA1));CMASK(pA0,pA1,0);
  START(pA0,pA1);
  _Pragma("unroll") for(int r=0;r<16;++r)pA1[r]=__builtin_amdgcn_exp2f(pA1[r]);
  WAIT_BAR(0);
  DMA_K(3,0);DMA_V(1,SLOTB);
  ROT();
  kload8(kf,kp0+sl_cur);
  WAIT_BAR(2);
  s16x4 vlo[8],vhi[8]; u32x4 pw0,pw1,pw2,pw3;
  #define PKW(P,B) cvtpk_s(P[B],P[B+1])
  #define PAF(k) __builtin_bit_cast(bf16x8,pw##k)
  #define VFR(i) (bf16x8){vlo[i][0],vlo[i][1],vlo[i][2],vlo[i][3],vhi[i][0],vhi[i][1],vhi[i][2],vhi[i][3]}
  #define PIN(x) asm volatile("":"+v"(x))
  #define MX3(a,b,c) __builtin_fmaxf(__builtin_fmaxf((a),(b)),(c))
  #define GAPA(MF,A0,A1,A2,A3,W0,W1,PW) do{ MF; sacc+=A0; sacc+=A1; sacc+=A2; sacc+=A3; PIN(sacc); W0; W1; PIN(PW); SBAR(); }while(0)
  #define EX(v) __builtin_amdgcn_exp2f(v)
  #define GAPB(MF,X,B) do{ MF; X[B]=EX(X[B]); X[B+1]=EX(X[B+1]); X[B+2]=EX(X[B+2]); X[B+3]=EX(X[B+3]); PIN(X); SBAR(); }while(0)
  #define VRD(i) do{ vlo[i]=vtr(vp_+(((i)>>2)*4096+((i)&3)*1024)); vhi[i]=vtr(vp_+(((i)>>2)*4096+((i)&3)*1024+512)); }while(0)
  #define KRD(G,j) do{ if(G){ kload2(kf,kp0+sl_next,j); SBAR(); } }while(0)
  #define STEP(C0,C1,P0,P1,t,GK,GV,GL) do{ SBAR(); \
    const lds_cptr vp_=vp0+sl_prev; \
    VRD(0); SBAR(); float sacc=(P0[0]+P0[1]); \
    GAPA(C0=__builtin_amdgcn_mfma_f32_32x32x16_bf16(kf[0],qr[0],negm,0,0,0), P0[2],P0[3],P0[4],P0[5],     pw0[0]=PKW(P0,0), pw0[1]=PKW(P0,2), pw0); \
    VRD(4); SBAR(); GAPA(C1=__builtin_amdgcn_mfma_f32_32x32x16_bf16(kf[1],qr[0],negm,0,0,0), P0[6],P0[7],P0[8],P0[9],     pw0[2]=PKW(P0,4), pw0[3]=PKW(P0,6), pw0); \
    VRD(1); SBAR(); GAPA(C0=__builtin_amdgcn_mfma_f32_32x32x16_bf16(kf[2],qr[1],C0,0,0,0),   P0[10],P0[11],P0[12],P0[13], pw1[0]=PKW(P0,8), pw1[1]=PKW(P0,10), pw1); \
    VRD(5); SBAR(); GAPA(C1=__builtin_amdgcn_mfma_f32_32x32x16_bf16(kf[3],qr[1],C1,0,0,0),   P0[14],P0[15],P1[0],P1[1],   pw1[2]=PKW(P0,12),pw1[3]=PKW(P0,14), pw1); \
    VRD(2); SBAR(); GAPA(C0=__builtin_amdgcn_mfma_f32_32x32x16_bf16(kf[4],qr[2],C0,0,0,0),   P1[2],P1[3],P1[4],P1[5],     pw2[0]=PKW(P1,0), pw2[1]=PKW(P1,2), pw2); \
    VRD(6); SBAR(); GAPA(C1=__builtin_amdgcn_mfma_f32_32x32x16_bf16(kf[5],qr[2],C1,0,0,0),   P1[6],P1[7],P1[8],P1[9],     pw2[2]=PKW(P1,4), pw2[3]=PKW(P1,6), pw2); \
    VRD(3); SBAR(); GAPA(C0=__builtin_amdgcn_mfma_f32_32x32x16_bf16(kf[6],qr[3],C0,0,0,0),   P1[10],P1[11],P1[12],P1[13], pw3[0]=PKW(P1,8), pw3[1]=PKW(P1,10), pw3); \
    VRD(7); SBAR(); GAPA(C1=__builtin_amdgcn_mfma_f32_32x32x16_bf16(kf[7],qr[3],C1,0,0,0),   P1[14],P1[15],0.f,0.f,       pw3[2]=PKW(P1,12),pw3[3]=PKW(P1,14), pw3); \
    l_reg+=sacc; \
    if(GK){DMA_K((t)+3,sl_cur);} if(GV){DMA_V((t)+1,sl_next);} \
    CMASK(C0,C1,t); \
    { float a=MX3(C0[0],C0[1],C1[0]),b=MX3(C0[2],C0[3],C1[1]); a=MX3(a,C1[2],C1[3]); \
      _Pragma("unroll") for(int r=4;r<16;r+=4){a=MX3(a,C0[r],C0[r+1]);b=MX3(b,C0[r+2],C0[r+3]);a=MX3(a,C1[r],C1[r+1]);b=MX3(b,C1[r+2],C1[r+3]);} \
      float rm=__builtin_fmaxf(a,b); { auto rr=__builtin_amdgcn_permlane32_swap(__float_as_uint(rm),__float_as_uint(rm),false,false); rm=__builtin_fmaxf(__uint_as_float(rr[0]),__uint_as_float(rr[1])); } \
      resc=false; \
      if(__builtin_expect(__any(rm>(float)THRL),0)){ const float dl=__builtin_fmaxf(rm,0.f); mhat+=dl; \
        _Pragma("unroll") for(int r=0;r<16;++r){C0[r]-=dl;C1[r]-=dl;} \
        _Pragma("unroll") for(int r=0;r<16;++r)negm[r]=-mhat; asm volatile("":"+v"(negm)); \
        const float f=__builtin_amdgcn_exp2f(-dl); l_reg*=f; if(hi==0)wsf[r32]=f; resc=true; } } \
    SBAR(); \
    GAPB(o[0]=__builtin_amdgcn_mfma_f32_32x32x16_bf16(PAF(0),VFR(0),o[0],0,0,0), C0,0); \
    GAPB(o[1]=__builtin_amdgcn_mfma_f32_32x32x16_bf16(PAF(0),VFR(4),o[1],0,0,0), C0,4); \
    KRD(GL,0); GAPB(o[0]=__builtin_amdgcn_mfma_f32_32x32x16_bf16(PAF(1),VFR(1),o[0],0,0,0), C0,8); \
    KRD(GL,1); GAPB(o[1]=__builtin_amdgcn_mfma_f32_32x32x16_bf16(PAF(1),VFR(5),o[1],0,0,0), C0,12); \
    KRD(GL,2); GAPB(o[0]=__builtin_amdgcn_mfma_f32_32x32x16_bf16(PAF(2),VFR(2),o[0],0,0,0), C1,0); \
    KRD(GL,3); GAPB(o[1]=__builtin_amdgcn_mfma_f32_32x32x16_bf16(PAF(2),VFR(6),o[1],0,0,0), C1,4); \
    GAPB(o[0]=__builtin_amdgcn_mfma_f32_32x32x16_bf16(PAF(3),VFR(3),o[0],0,0,0), C1,8); \
    GAPB(o[1]=__builtin_amdgcn_mfma_f32_32x32x16_bf16(PAF(3),VFR(7),o[1],0,0,0), C1,12); \
    }while(0)
  int t=1;
  #undef CMASK
  #define CMASK(P0,P1,t) do{}while(0)
  for(;t+5<NT;t+=2){
    STEP(pB0,pB1,pA0,pA1,t,true,true,true);     WAIT_BAR(2); RESC(); ROT();
    STEP(pA0,pA1,pB0,pB1,t+1,true,true,true);   WAIT_BAR(2); RESC(); ROT();
  }
  #undef CMASK
  #define CMASK(P0,P1,t) do{}while(0)
  #define ENDW(tt) do{ if((tt)+3<NT){WAIT_BAR(2);} else if((tt)+2<NT){WAIT_BAR(1);} else {WAIT_BAR(0);} }while(0)
  for(;t+1<NT;t+=2){
    STEP(pB0,pB1,pA0,pA1,t,(t+3<NT),(t+1<NT),(t+1<NT));       ENDW(t);   RESC(); ROT();
    STEP(pA0,pA1,pB0,pB1,t+1,(t+4<NT),(t+2<NT),(t+2<NT));     ENDW(t+1); RESC(); ROT();
  }
  STEP(pB0,pB1,pA0,pA1,NT-1,false,false,false); RESC();
  { float sacc=pB0[0]+pB0[1]; _Pragma("unroll") for(int r=2;r<16;++r)sacc+=pB0[r]; _Pragma("unroll") for(int r=0;r<16;++r)sacc+=pB1[r]; l_reg+=sacc;
    pw0=(u32x4){PKW(pB0,0),PKW(pB0,2),PKW(pB0,4),PKW(pB0,6)};pw1=(u32x4){PKW(pB0,8),PKW(pB0,10),PKW(pB0,12),PKW(pB0,14)};pw2=(u32x4){PKW(pB1,0),PKW(pB1,2),PKW(pB1,4),PKW(pB1,6)};pw3=(u32x4){PKW(pB1,8),PKW(pB1,10),PKW(pB1,12),PKW(pB1,14)};
    SBAR(); pv(o,vb0+sl_cur,PAF(0),PAF(1),PAF(2),PAF(3)); }
  #undef PKW
  #undef PAF
  #undef VFR
  #undef PIN
  #undef MX3
  #undef GAPA
  #undef GAPB
  #undef EX
  #undef VRD
  #undef KRD
  #undef STEP
  #undef ENDW
  {auto rr=__builtin_amdgcn_permlane32_swap(__float_as_uint(l_reg),__float_as_uint(l_reg),false,false);l_reg=__uint_as_float(rr[0])+__uint_as_float(rr[1]);}
  if(hi==0)wsf[32+r32]=l_reg;asm volatile("s_waitcnt lgkmcnt(0)":::"memory");
  float rli[16];
  #pragma unroll
  for(int r=0;r<16;++r)rli[r]=__builtin_amdgcn_rcpf(wsf[32+crow(r,hi)]);
  bf16*Ow=Oblk+(long)wid*QBLK*DM;
  { bf16*stg=(bf16*)(shm+LDS_OST)+wid*2048;
    #pragma unroll
    for(int r=0;r<16;++r){const int orow=crow(r,hi);
      #pragma unroll
      for(int d0=0;d0<2;++d0)stg[orow*64+d0*32+r32]=__float2bfloat16(o[d0][r]*rli[r]);}
    asm volatile("s_waitcnt lgkmcnt(0)":::"memory");
    #pragma unroll
    for(int i=0;i<4;++i){const int row=i*8+(lane>>3),ch=lane&7; const u32x4 v=*(const u32x4*)(stg+row*64+ch*8); const u32x4 z=*(const u32x4*)(Ow+(long)row*DM+ch*8); u32x4 w;
      #pragma unroll
      for(int e=0;e<4;++e){ const float a0=__uint_as_float(v[e]<<16),a1=__uint_as_float(v[e]&0xffff0000u),z0=__uint_as_float(z[e]<<16),z1=__uint_as_float(z[e]&0xffff0000u);
        w[e]=cvtpk_s(a0*z0*__builtin_amdgcn_rcpf(1.f+__expf(-z0)),a1*z1*__builtin_amdgcn_rcpf(1.f+__expf(-z1))); }
      ATTN_STORE16(Ow+(long)row*DM+ch*8,w);} }
  asm volatile("s_waitcnt lgkmcnt(0)\n\ts_barrier":::"memory");
  #undef DMA_K
  #undef DMA_V
  #undef CMASK
  #undef START
  #undef RESC
  #undef ROT
}
constexpr int ATTN_LDS_BYTES=LDS_BYTES;
}
typedef unsigned short u16;
#define LAS __attribute__((address_space(3)))
#define DI __device__ __forceinline__
typedef unsigned v4u __attribute__((ext_vector_type(4)));
typedef unsigned v2u __attribute__((ext_vector_type(2)));
typedef float v4f __attribute__((ext_vector_type(4)));

constexpr int T_TOK = 32768, P1P = 2048, P2P = 1536;
constexpr int P1_Z = 0, P1_Q = 1280, P1_K = 1792, P1_V = 1920;
constexpr int P2_AQ = 0, P2_AK = 128, P2_AV = 256, P2_GF = 512, P2_GB = 640, P2_BU = 768, P2_DU = 1024, P2_DV = 1280, P2_U = 1024;
constexpr size_t MiB = 1u << 20;
constexpr size_t WS_DFT = 256 * 1024, WS_BAR = 512 * 1024, BAR_BYTES = 16384;
constexpr size_t WS_MOD = 0, WS_WIN = 2 * MiB, WS_WOUT = 16 * MiB, WS_WF = 21 * MiB, WS_U0 = 22 * MiB, WS_HB = 86 * MiB, WS_P2 = 150 * MiB, WS_DEC = 246 * MiB, WS_END = 247 * MiB;
constexpr size_t HB_GS = 0, HB_KC = 16 * MiB, HB_VC = 24 * MiB, HB_TP = 32 * MiB;
constexpr int LDS_BYTES = 147456;
constexpr float EPSN = 1e-6f;
constexpr float ATT_C2 = 0.125f * 1.4426950408889634f;

struct Params {
    const float *xp, *xs, *cp, *cs, *ada_w, *ada_b, *pre_g, *post_g, *w_in, *wg2f, *bgf, *wg2b, *bgb, *onorm_g, *fnet_w, *qn_g, *kn_g, *sgu_ng, *sgu_w, *sgu_b, *w_out;
    float* out; unsigned char* ws;
};
typedef const float* cfp;
struct Ctx { float* out; unsigned char* ws; LAS cfp* tab; };

DI float bf2f(u16 v) { return __uint_as_float((unsigned)v << 16); }
DI float bflo(unsigned w) { return __uint_as_float(w << 16); }
DI float bfhi(unsigned w) { return __uint_as_float(w & 0xffff0000u); }
DI unsigned f2bf(float f) { unsigned u = __float_as_uint(f); return (u + 0x7fffu + ((u >> 16) & 1u)) >> 16; }
DI unsigned pk2(float lo, float hi) { return f2bf(lo) | (f2bf(hi) << 16); }
DI float wave_sum(float v) {
#pragma unroll
    for (int o = 1; o < 64; o <<= 1) v += __shfl_xor(v, o);
    return v;
}
using pg8::silu_f;
DI float logsig(float x) { return fminf(x, 0.f) - __logf(1.f + __expf(-fabsf(x))); }
DI void seq_info(int s, int& row0, int& N) { if (s < 4) { row0 = s * 4096; N = 4096; } else { row0 = 16384 + (s - 4) * 8192; N = 8192; } }
DI int row_seq(int r) { return r < 16384 ? (r >> 12) : 4 + ((r - 16384) >> 13); }
DI void unpack8(const v4u r, float (&f)[8]) { f[0] = bflo(r.x); f[1] = bfhi(r.x); f[2] = bflo(r.y); f[3] = bfhi(r.y); f[4] = bflo(r.z); f[5] = bfhi(r.z); f[6] = bflo(r.w); f[7] = bfhi(r.w); }
DI v4u pack8(const float (&f)[8]) { v4u r; r.x = pk2(f[0], f[1]); r.y = pk2(f[2], f[3]); r.z = pk2(f[4], f[5]); r.w = pk2(f[6], f[7]); return r; }
#define LDS_WAIT() asm volatile("s_waitcnt lgkmcnt(0)" ::: "memory")


typedef short bf16x8_t __attribute__((ext_vector_type(8)));
typedef float f32x4_t __attribute__((ext_vector_type(4)));
DI bf16x8_t ldfrag(const LAS u16* base, int pitch, int row0, int k0, int lane) { return *(const LAS bf16x8_t*)(base + (row0 + (lane & 15)) * pitch + k0 + 8 * (lane >> 4)); }
typedef short s16x4_t __attribute__((ext_vector_type(4)));
DI bf16x8_t ldfrag_tr(const LAS u16* base, int pitch, int k0, int n0, int lane) {
    const LAS u16* a0 = base + (k0 + 8 * (lane >> 4) + ((lane & 15) >> 2)) * pitch + n0 + 4 * (lane & 3);
    const s16x4_t lo = __builtin_amdgcn_ds_read_tr16_b64_v4i16((LAS s16x4_t*)a0), hi = __builtin_amdgcn_ds_read_tr16_b64_v4i16((LAS s16x4_t*)(a0 + 4 * pitch));
    return (bf16x8_t){lo[0], lo[1], lo[2], lo[3], hi[0], hi[1], hi[2], hi[3]};
}
#define MFMA16(a, b, c) __builtin_amdgcn_mfma_f32_16x16x32_bf16((a), (b), (c), 0, 0, 0)
DI float wave_prefix(float g, int lane) {
#pragma unroll
    for (int o = 1; o < 64; o <<= 1) { const float t = __shfl_up(g, o); if (lane >= o) g += t; }
    return g; }
DI float wave_suffix(float g, int lane) {
#pragma unroll
    for (int o = 1; o < 64; o <<= 1) { const float t = __shfl_down(g, o); if (lane + o < 64) g += t; }
    return g; }
DI int win_src_col(int j) {
    if (j < 1280) return 2080 + j;
    if (j < 1792) return 800 + (j - 1280);
    if (j < 1920) return 1312 + (j - 1792);
    if (j < 2048) return 1440 + (j - 1920);
    const int q = j - 2048;
    if (q < 512) return q;
    if (q < 768) return -1;
    if (q < 1024) return 544 + (q - 768);
    if (q < 1280) return 1568 + (q - 1024);
    return 1824 + (q - 1280);
}
DI void transpose_item(const float* W, int ldw, int src_n0, int K, u16* WT, int dst_n0, int k0, LAS float* scr, int lane) {
    float tv[32];
#pragma unroll
    for (int i = 0; i < 32; ++i) tv[i] = W[(size_t)(k0 + 2 * i + (lane >> 5)) * ldw + src_n0 + (lane & 31)];
#pragma unroll
    for (int i = 0; i < 32; ++i) scr[(2 * i + (lane >> 5)) * 33 + (lane & 31)] = tv[i];
    LDS_WAIT();
    const int c = lane & 7;
#pragma unroll
    for (int j = 0; j < 4; ++j) { const int n = (lane >> 3) + 8 * j; const LAS float* s = scr + (8 * c) * 33 + n;
        v4u o; o.x = pk2(s[0 * 33], s[1 * 33]); o.y = pk2(s[2 * 33], s[3 * 33]); o.z = pk2(s[4 * 33], s[5 * 33]); o.w = pk2(s[6 * 33], s[7 * 33]);
        *(v4u*)(WT + (size_t)(dst_n0 + n) * K + k0 + 8 * c) = o; }
    LDS_WAIT();
}
DI void phase0(const Ctx& p, LAS unsigned char* L) {
    const int tid = otid(), lane = tid & 63, wave = tid >> 6;
    const int gw = blockIdx.x * 8 + wave, NGW = gridDim.x * 8, gt = blockIdx.x * 512 + tid, NGT = gridDim.x * 512;
    LAS float* scr = (LAS float*)(L + wave * 16384);
    u16* WinT = (u16*)(p.ws + WS_WIN); u16* WoutT = (u16*)(p.ws + WS_WOUT); u16* WfT = (u16*)(p.ws + WS_WF); float* mod = (float*)(p.ws + WS_MOD);
    constexpr int I_IN = 16 * 112, I_OUT = 20 * 32, I_L = I_IN + I_OUT;
    for (int it = gw; it < 2 * I_L; it += NGW) {
        const int l = it / I_L; int r = it % I_L;
        if (r < I_IN) { const int kb = r / 112, nb = r % 112; const int src = win_src_col(nb * 32); if (src < 0) continue;
            transpose_item(p.tab[8] + (size_t)l * 1024 * 3360, 3360, src, 1024, WinT + (size_t)l * 3584 * 1024, nb * 32, kb * 64, scr, lane); }
        else { r -= I_IN; const int kb = r / 32, nb = r % 32;
            transpose_item(p.tab[20] + (size_t)l * 1280 * 1024, 1024, nb * 32, 1280, WoutT + (size_t)l * 1024 * 1280, nb * 32, kb * 64, scr, lane); }
    }
    for (int e = gt; e < 2 * 16 * 1024; e += NGT) { const int l = e >> 14, r = e & 16383, jg = r >> 10, k = r & 1023, dirb = jg >> 3, jj0 = (jg & 7) * 16;
        const float* wi = p.tab[8] + (size_t)l * 1024 * 3360 + (size_t)k * 3360 + 512 + dirb * 16; float wv[16];
#pragma unroll
        for (int r2 = 0; r2 < 16; ++r2) wv[r2] = wi[r2];
        const float* w2 = (dirb ? p.tab[11] : p.tab[9]) + l * 16 * 128 + jj0;
        for (int q = 0; q < 16; ++q) { float a = 0.f;
#pragma unroll
            for (int r2 = 0; r2 < 16; ++r2) a += wv[r2] * w2[r2 * 128 + q];
            WinT[(size_t)l * 3584 * 1024 + (size_t)(2560 + dirb * 128 + jj0 + q) * 1024 + k] = (u16)f2bf(a); } }
    { LAS float* trig = (LAS float*)(L + 126976);
        if (tid < 64) { trig[tid] = cospif((float)tid * (1.f / 32.f)); trig[64 + tid] = sinpif((float)tid * (1.f / 32.f)); }
        __syncthreads();
        for (int e = gt; e < 2 * 256 * 512; e += NGT) { const int l = e >> 17, r = e & 131071, n = r >> 9, kk = r & 511, im = kk >> 8, g = (kk & 255) >> 6, c = kk & 63;
            const float* fw = p.tab[14] + (size_t)l * 65536 + (size_t)(g * 64) * 256 + n; const LAS float* tb = trig + im * 64; float a = 0.f;
#pragma unroll 8
            for (int j2 = 0; j2 < 64; ++j2) a += tb[(j2 * c) & 63] * fw[j2 * 256];
            WfT[(size_t)l * 131072 + n * 512 + kk] = (u16)f2bf(a * 0.125f); } }
    { u16* dft = (u16*)(p.ws + WS_DFT);
        for (int e = gt; e < 4096; e += NGT) { const int k = e >> 6, n = e & 63; const float a = (float)((k * n) & 63) * (1.f / 32.f); dft[e] = (u16)f2bf(cospif(a)); dft[4096 + e] = (u16)f2bf(sinpif(a)); }
        for (int e = gt; e < 16384; e += NGT) { const int k = e >> 7, n = e & 127; const float a = (float)((k * n) & 127) * (1.f / 64.f); dft[8192 + e] = (u16)f2bf(cospif(a)); dft[8192 + 16384 + e] = (u16)f2bf(sinpif(a)); } }
    __syncthreads();
    LAS float* sc = (LAS float*)L;
    for (int e = tid; e < 6144; e += 512) { const int s = e >> 10, k = e & 1023; const float c = s < 4 ? p.tab[2][s * 1024 + k] : p.tab[3][(s - 4) * 1024 + k]; sc[e] = c / (1.f + expf(-c)); }
    __syncthreads();
    for (int unit = gw; unit < 768; unit += NGW) {
        const int ks = unit & 7, jb = (unit >> 3) % 48, l = unit / 384, j = jb * 64 + lane;
        float acc[6] = {0.f, 0.f, 0.f, 0.f, 0.f, 0.f};
        const float* aw = p.tab[4] + (size_t)l * 1024 * 3072 + (size_t)(ks * 128) * 3072 + j;
#pragma unroll 16
        for (int k = 0; k < 128; ++k) { const float w = aw[(size_t)k * 3072];
#pragma unroll
            for (int s = 0; s < 6; ++s) acc[s] += sc[s * 1024 + ks * 128 + k] * w; }
        if (ks == 0) { const float b = p.tab[5][l * 3072 + j];
#pragma unroll
            for (int s = 0; s < 6; ++s) acc[s] += b; }
#pragma unroll
        for (int s = 0; s < 6; ++s) atomicAdd(mod + (size_t)(l * 6 + s) * 3072 + j, acc[s]);
    }
}

DI void add_branch(v4f (&v)[4], const u16* urow, const float* gate, const float* pg, int lane) {
    v4f u[4]; float ss = 0.f;
#pragma unroll
    for (int j = 0; j < 4; ++j) { const v2u r = *(const v2u*)(urow + 256 * j + 4 * lane); u[j] = (v4f){bflo(r.x), bfhi(r.x), bflo(r.y), bfhi(r.y)};
        ss += (u[j].x * u[j].x + u[j].y * u[j].y) + (u[j].z * u[j].z + u[j].w * u[j].w); }
    const float rstd = 1.f / sqrtf(wave_sum(ss) * (1.f / 1024.f) + EPSN);
#pragma unroll
    for (int j = 0; j < 4; ++j) { const v4f g = *(const v4f*)(gate + 256 * j + 4 * lane), q = *(const v4f*)(pg + 256 * j + 4 * lane); v[j] += g * (u[j] * rstd * q); }
}
DI void phaseA(const Ctx& p, int l) {
    const int tid = otid(), lane = tid & 63, wave = tid >> 6, gw = blockIdx.x * 8 + wave, NGW = gridDim.x * 8;
    const float* mod = (const float*)(p.ws + WS_MOD); const u16* U0 = (const u16*)(p.ws + WS_U0); u16* HB = (u16*)(p.ws + WS_HB);
    for (int row = gw; row < T_TOK; row += NGW) {
        const int s = row_seq(row);
        const float* xr = row < 16384 ? p.tab[0] + (size_t)row * 1024 : p.tab[1] + (size_t)(row - 16384) * 1024;
        v4f v[4];
#pragma unroll
        for (int j = 0; j < 4; ++j) v[j] = *(const v4f*)(xr + 256 * j + 4 * lane);
        if (l >= 1) add_branch(v, U0 + (size_t)row * 1024, mod + (size_t)(0 * 6 + s) * 3072 + 2048, p.tab[7], lane);
        if (l == 2) { add_branch(v, HB + (size_t)row * 1024, mod + (size_t)(1 * 6 + s) * 3072 + 2048, p.tab[7] + 1024, lane);
            float* o = p.out + (size_t)row * 1024;
#pragma unroll
            for (int j = 0; j < 4; ++j) *(v4f*)(o + 256 * j + 4 * lane) = v[j];
            continue; }
        float ss = 0.f;
#pragma unroll
        for (int j = 0; j < 4; ++j) ss += (v[j].x * v[j].x + v[j].y * v[j].y) + (v[j].z * v[j].z + v[j].w * v[j].w);
        const float rstd = 1.f / sqrtf(wave_sum(ss) * (1.f / 1024.f) + EPSN);
        const float* md = mod + (size_t)(l * 6 + s) * 3072;
#pragma unroll
        for (int j = 0; j < 4; ++j) { const int col = 256 * j + 4 * lane;
            const v4f sh = *(const v4f*)(md + col), scl = *(const v4f*)(md + 1024 + col), g = *(const v4f*)(p.tab[6] + l * 1024 + col);
            const v4f h = v[j] * rstd * g * (scl + 1.f) + sh;
            v2u o; o.x = pk2(h.x, h.y); o.y = pk2(h.z, h.w); *(v2u*)(HB + (size_t)row * 1024 + col) = o; }
    }
}

DI void qk_prep(const Ctx& p, int l) {
    const int tid = otid(), lane = tid & 63, wave = tid >> 6, gw = blockIdx.x * 8 + wave, NGW = gridDim.x * 8;
    u16* P1 = (u16*)p.out; const int i = lane & 31; unsigned* KC = (unsigned*)(p.ws + WS_HB + HB_KC); unsigned* VC = (unsigned*)(p.ws + WS_HB + HB_VC);
    const float freq = exp2f(-(float)(i & 15) * (13.287712379549449f / 16.f));
    const float gk0 = p.tab[16][l * 64 + 2 * i], gk1 = p.tab[16][l * 64 + 2 * i + 1];
    for (int rowb = gw * 4; rowb < T_TOK; rowb += NGW * 4) {
        unsigned wv[4][2];
#pragma unroll
        for (int r = 0; r < 4; ++r) { const unsigned* ptr = (const unsigned*)(P1 + (size_t)(rowb + r) * P1P + P1_Q);
#pragma unroll
            for (int it = 0; it < 2; ++it) wv[r][it] = ptr[(4 + it) * 64 + lane]; }
#pragma unroll
        for (int r = 0; r < 4; ++r) { const int row = rowb + r;
            const int s = row_seq(row); int row0, N; seq_info(s, row0, N); const int pos = row - row0;
            const float coord = (i < 16) ? (float)(pos >> 6) : (float)(pos & 63);
            const float sn = __sinf(coord * freq), cs = __cosf(coord * freq);
            unsigned* ptr = (unsigned*)(P1 + (size_t)row * P1P + P1_Q);
            const size_t cidx = ((size_t)row0 * 2 + (size_t)(lane >> 5) * N + pos) * 32 + i;
            { const unsigned w = wv[r][0]; const float x0 = bflo(w), x1 = bfhi(w);
                float ss = x0 * x0 + x1 * x1;
#pragma unroll
                for (int o = 1; o < 32; o <<= 1) ss += __shfl_xor(ss, o);
                const float rstd = 1.f / sqrtf(ss * (1.f / 64.f) + EPSN);
                const float y0 = x0 * rstd * gk0, y1 = x1 * rstd * gk1;
                KC[cidx] = pk2(y0 * cs - y1 * sn, y0 * sn + y1 * cs); }
            VC[cidx] = wv[r][1]; }
    }
}
DI void gla_scan_cols(LAS float* Gf, LAS float* Gb, int lane) {
    LAS float* G = (lane >> 5) ? Gb : Gf; const int d = lane & 31; float v[64];
#pragma unroll
    for (int i = 0; i < 64; ++i) v[i] = G[i * 33 + d];
    if (lane >> 5) {
#pragma unroll
        for (int i = 62; i >= 0; --i) v[i] += v[i + 1];
    } else {
#pragma unroll
        for (int i = 1; i < 64; ++i) v[i] += v[i - 1];
    }
#pragma unroll
    for (int i = 0; i < 64; ++i) G[i * 33 + d] = v[i];
}
struct GLoad { v4u g[2], k[2], v[2]; };
DI GLoad gla_local_load(const Ctx& p, int item) {
    const int tid = otid(); const int gc = item >> 1, hp = item & 1; const size_t rb = (size_t)gc * 64; const u16* P2 = (const u16*)(p.ws + WS_P2); GLoad r;
#pragma unroll
    for (int hh = 0; hh < 2; ++hh) { const int h = 2 * hp + hh;
        { const int t2 = tid & 255, i = t2 >> 2, c = t2 & 3; const u16* q = P2 + (rb + i) * P2P + h * 32 + c * 8; const int dirb = tid >> 8;
            r.g[hh] = *(const v4u*)(q + (dirb ? P2_GB : P2_GF)); r.k[hh] = *(const v4u*)(q + P2_AK); }
        { const int i = tid >> 3, c = tid & 7; r.v[hh] = *(const v4u*)(P2 + (rb + i) * P2P + P2_AV + h * 64 + c * 8); } }
    return r;
}
DI void gla_local_item(const Ctx& p, int l, int item, LAS float* F, const GLoad ld) {
    const int tid = otid(), lane = tid & 63, w = tid >> 6; const int gc = item >> 1, hp = item & 1;
    constexpr int HF = 3 * 2112 + (2 * 64 * 40 + 64 * 72) / 2;
#pragma unroll
    for (int hh = 0; hh < 2; ++hh) { const int h = 2 * hp + hh; LAS float* Gf = F + hh * HF; LAS float* Gb = Gf + 2112; LAS float* Kx = Gb + 2112; LAS u16* KDT = (LAS u16*)(Kx + 2112); LAS u16* VT = KDT + 2 * 64 * 40;
        { const int t2 = tid & 255, i = t2 >> 2, c = t2 & 3; float f[8];
            const int dirb = tid >> 8; const float* bias = p.tab[dirb ? 12 : 10] + l * 128 + h * 32 + c * 8; LAS float* G = dirb ? Gb : Gf;
            unpack8(ld.g[hh], f);
#pragma unroll
            for (int q = 0; q < 8; ++q) G[i * 33 + c * 8 + q] = logsig(f[q] + bias[q]) * (1.f / 16.f);
            if (!dirb) { unpack8(ld.k[hh], f);
#pragma unroll
                for (int q = 0; q < 8; ++q) Kx[i * 33 + c * 8 + q] = f[q]; } }
        { const int i = tid >> 3, c = tid & 7; *(LAS v4u*)(VT + i * 72 + c * 8) = ld.v[hh]; } }
    __syncthreads();
    if (w < 2) { LAS float* Gf = F + w * HF; gla_scan_cols(Gf, Gf + 2112, lane); }
    __syncthreads();
    u16* GS = (u16*)(p.ws + WS_HB + HB_GS); float* DEC = (float*)(p.ws + WS_DEC);
#pragma unroll
    for (int hh = 0; hh < 2; ++hh) { const int h = 2 * hp + hh; LAS float* Gf = F + hh * HF; LAS float* Gb = Gf + 2112; LAS float* Kx = Gb + 2112; LAS u16* KDT = (LAS u16*)(Kx + 2112); const size_t slot = (size_t)(gc * 4 + h) * 2;
#pragma unroll
        for (int r = 0; r < 8; ++r) { const int e = tid + r * 512, d = e & 31, i = (e >> 5) & 63, dir = e >> 11; const LAS float* G = dir ? Gb : Gf;
            const float bl = G[(dir ? 0 : 63) * 33 + d];
            KDT[(dir * 64 + i) * 40 + d] = (u16)f2bf(Kx[i * 33 + d] * __expf(bl - G[i * 33 + d])); }
        if (tid < 64) { const int dir = tid >> 5, d = tid & 31; DEC[(slot + dir) * 32 + d] = __expf((dir ? Gb : Gf)[(dir ? 0 : 63) * 33 + d]); } }
    __syncthreads();
#pragma unroll
    for (int hh = 0; hh < 2; ++hh) { const int h = 2 * hp + hh; LAS u16* KDT = (LAS u16*)(F + hh * HF + 3 * 2112); LAS u16* VT = KDT + 2 * 64 * 40; const size_t slot = (size_t)(gc * 4 + h) * 2;
        const int dir = w >> 2, mt = (w >> 1) & 1;
#pragma unroll
        for (int q = 0; q < 2; ++q) { const int nt = (w & 1) * 2 + q; f32x4_t acc = {0.f, 0.f, 0.f, 0.f};
#pragma unroll
            for (int ks = 0; ks < 2; ++ks) acc = MFMA16(ldfrag_tr(KDT + dir * 64 * 40, 40, ks * 32, mt * 16, lane), ldfrag_tr(VT, 72, ks * 32, nt * 16, lane), acc);
#pragma unroll
            for (int j = 0; j < 4; ++j) GS[(slot + dir) * 2048 + (mt * 16 + 4 * (lane >> 4) + j) * 64 + nt * 16 + (lane & 15)] = (u16)f2bf(acc[j]); } }
    __syncthreads();
}
DI void sgu_item(const Ctx& p, int l, int item, LAS float* F, bool stage_w) {
    const int tid = otid(), lane = tid & 63, w = tid >> 6; const int ch = item >> 2, g = item & 3; const size_t rb = (size_t)ch * 128;
    const u16* P2 = (const u16*)(p.ws + WS_P2); u16* P1 = (u16*)p.out;
    LAS float* OUTF = F; LAS u16* WB = (LAS u16*)(F + 128 * 65); LAS u16* VNT = WB + 128 * 136;
    v4u pu[2], pz[2];
#pragma unroll
    for (int r = 0; r < 2; ++r) { const int task = tid + r * 512, t = task >> 3, c8 = (task & 7) * 8; pu[r] = *(const v4u*)(P2 + (rb + t) * P2P + P2_DU + g * 64 + c8); pz[r] = *(const v4u*)(P1 + (rb + t) * P1P + 1024 + g * 64 + c8); }
    { const int row = tid >> 2, qt = tid & 3; const u16* dv = P2 + (rb + row) * P2P + P2_DV; float ss = 0.f; float f[8];
#pragma unroll
        for (int c = 0; c < 8; ++c) { unpack8(*(const v4u*)(dv + qt * 64 + c * 8), f);
#pragma unroll
            for (int q = 0; q < 8; ++q) ss += f[q] * f[q]; }
        ss += __shfl_xor(ss, 1); ss += __shfl_xor(ss, 2);
        const float rstd = 1.f / sqrtf(ss * (1.f / 256.f) + EPSN); const float* ng = p.tab[17] + l * 256 + g * 64 + qt * 16;
#pragma unroll
        for (int c = 0; c < 2; ++c) { unpack8(*(const v4u*)(dv + g * 64 + qt * 16 + c * 8), f);
#pragma unroll
            for (int q = 0; q < 8; ++q) f[q] = f[q] * rstd * ng[c * 8 + q];
            *(LAS v4u*)(VNT + row * 72 + qt * 16 + c * 8) = pack8(f); } }
    if (stage_w) { const float* wsrc = p.tab[18] + (size_t)(l * 4 + g) * 16384;
#pragma unroll
        for (int r = 0; r < 8; ++r) { const int idx = tid + r * 512, t = idx >> 5, s4 = (idx & 31) * 4; const v4f v = *(const v4f*)(wsrc + idx * 4);
            v2u o; o.x = pk2(v.x, v.y); o.y = pk2(v.z, v.w); *(LAS v2u*)(WB + t * 136 + s4) = o; } }
    __syncthreads();
    {
#pragma unroll
        for (int nt = 0; nt < 4; ++nt) { f32x4_t acc = {0.f, 0.f, 0.f, 0.f};
#pragma unroll
            for (int ks = 0; ks < 4; ++ks) acc = MFMA16(ldfrag(WB, 136, w * 16, ks * 32, lane), ldfrag_tr(VNT, 72, ks * 32, nt * 16, lane), acc);
#pragma unroll
            for (int j = 0; j < 4; ++j) OUTF[(w * 16 + 4 * (lane >> 4) + j) * 65 + nt * 16 + (lane & 15)] = acc[j]; } }
    __syncthreads();
#pragma unroll
    for (int r = 0; r < 2; ++r) { const int task = tid + r * 512, t = task >> 3, c8 = (task & 7) * 8; float acc[8];
#pragma unroll
        for (int e = 0; e < 8; ++e) acc[e] = OUTF[t * 65 + c8 + e];
        const float bias = p.tab[19][(l * 4 + g) * 128 + t];
        float uu[8], zz[8]; unpack8(pu[r], uu);
        u16* mz = P1 + (rb + t) * P1P + 1024 + g * 64 + c8; unpack8(pz[r], zz);
#pragma unroll
        for (int e = 0; e < 8; ++e) acc[e] = (acc[e] + bias) * uu[e] * silu_f(zz[e]);
        *(v4u*)mz = pack8(acc); }
    __syncthreads();
}
template <int N1> DI void fnet1_body(const Ctx& p, int row0, int N, int n2, int cb, LAS float* F) {
    constexpr int PN = N1 + 8, MT = N1 / 16, NTW = MT;
    const int tid = otid(), lane = tid & 63, w = tid >> 6;
    const u16* P2 = (const u16*)(p.ws + WS_P2); u16* TP = (u16*)(p.ws + WS_HB + HB_TP);
    const u16* Cg = (const u16*)(p.ws + WS_DFT) + (N1 == 64 ? 0 : 8192); const u16* Sg = Cg + N1 * N1;
    LAS float* tw = F; LAS u16* XT = (LAS u16*)(F + 256); LAS u16* FC = XT + N1 * 136; LAS u16* FS = FC + N1 * PN; LAS u16* OUT = FC;
#pragma unroll
    for (int r = 0; r < N1 / 32; ++r) { const int idx = tid + r * 512, n1 = idx >> 4, c = idx & 15; const v4u raw = *(const v4u*)(P2 + (size_t)(row0 + n1 * 64 + n2) * P2P + P2_BU + cb * 128 + c * 8);
        *(LAS v4u*)(XT + n1 * 136 + c * 8) = raw; }
#pragma unroll
    for (int r = 0; r < N1 * N1 / 8 / 512; ++r) { const int idx = tid + r * 512, k1 = idx / (N1 / 8), c = idx % (N1 / 8);
        *(LAS v4u*)(FC + k1 * PN + c * 8) = *(const v4u*)(Cg + k1 * N1 + c * 8); *(LAS v4u*)(FS + k1 * PN + c * 8) = *(const v4u*)(Sg + k1 * N1 + c * 8); }
    if (tid < N1) { const float ph = 2.f * (float)((n2 * tid) & (N - 1)) / (float)N; tw[2 * tid] = cospif(ph); tw[2 * tid + 1] = sinpif(ph); }
    __syncthreads();
    f32x4_t ac[NTW], as[NTW];
#pragma unroll
    for (int q = 0; q < NTW; ++q) { const int id = w + 8 * q, mt = id % MT, nt = id / MT; ac[q] = (f32x4_t){0.f, 0.f, 0.f, 0.f}; as[q] = ac[q];
#pragma unroll
        for (int ks = 0; ks < N1 / 32; ++ks) { const bf16x8_t b = ldfrag_tr(XT, 136, ks * 32, nt * 16, lane);
            ac[q] = MFMA16(ldfrag(FC, PN, mt * 16, ks * 32, lane), b, ac[q]); as[q] = MFMA16(ldfrag(FS, PN, mt * 16, ks * 32, lane), b, as[q]); } }
    __syncthreads();
    const float scale = 1.f / sqrtf((float)N1);
#pragma unroll
    for (int q = 0; q < NTW; ++q) { const int id = w + 8 * q, mt = id % MT, nt = id / MT;
#pragma unroll
        for (int j = 0; j < 4; ++j) { const int k1 = mt * 16 + 4 * (lane >> 4) + j, col = nt * 16 + (lane & 15); const float cw = tw[2 * k1], sw = tw[2 * k1 + 1];
            const float tr = ac[q][j], ti = -as[q][j];
            OUT[k1 * 256 + col] = (u16)f2bf((tr * cw + ti * sw) * scale); OUT[k1 * 256 + 128 + col] = (u16)f2bf((ti * cw - tr * sw) * scale); } }
    __syncthreads();
#pragma unroll
    for (int r = 0; r < N1 / 16; ++r) { const int idx = tid + r * 512, k1 = idx >> 5, c = idx & 31;
        const v4u v = *(const LAS v4u*)(OUT + k1 * 256 + c * 8);
        *(v4u*)(TP + (size_t)(row0 + k1 * 64 + n2) * 512 + (c >> 4) * 256 + cb * 128 + (c & 15) * 8) = v; }
    __syncthreads();
}
DI void fnet1_item(const Ctx& p, int item, LAS float* F) {
    const int s = item >> 7, r = item & 127, n2 = r >> 1, cb = r & 1; int row0, N; seq_info(s, row0, N);
    if (N == 4096) fnet1_body<64>(p, row0, N, n2, cb, F); else fnet1_body<128>(p, row0, N, n2, cb, F);
}
struct F2Load { v4u t[8]; };
DI F2Load fnet2_load(const Ctx& p, int item) {
    const int tid = otid(); int s, k1; if (item < 256) { s = item >> 6; k1 = item & 63; } else { s = 4 + ((item - 256) >> 7); k1 = (item - 256) & 127; }
    int row0, N; seq_info(s, row0, N); const u16* TP = (const u16*)(p.ws + WS_HB + HB_TP); F2Load r;
#pragma unroll
    for (int q = 0; q < 8; ++q) { const int idx = tid + q * 512, n2 = idx >> 6, c = idx & 63; r.t[q] = *(const v4u*)(TP + (size_t)(row0 + k1 * 64 + n2) * 512 + c * 8); }
    return r;
}
DI void fnet2_item(const Ctx& p, int item, LAS float* F, const F2Load ld) {
    const int tid = otid(), lane = tid & 63, w = tid >> 6; int s, k1; if (item < 256) { s = item >> 6; k1 = item & 63; } else { s = 4 + ((item - 256) >> 7); k1 = (item - 256) & 127; }
    int row0, N; seq_info(s, row0, N); const int N1 = N >> 6;
    u16* P2 = (u16*)(p.ws + WS_P2); const u16* TP = (const u16*)(p.ws + WS_HB + HB_TP); const u16* Cg = (const u16*)(p.ws + WS_DFT); const u16* Sg = Cg + 4096;
    LAS u16* BT = (LAS u16*)F; LAS u16* A1 = BT + 128 * 264; LAS u16* A2 = A1 + 64 * 136; LAS u16* OUT = BT;
#pragma unroll
    for (int r = 0; r < 8; ++r) { const int idx = tid + r * 512, n2 = idx >> 6, c = idx & 63; *(LAS v4u*)(BT + ((c >> 5) * 64 + n2) * 264 + (c & 31) * 8) = ld.t[r]; }
    { const int k2 = tid >> 3, c8 = (tid & 7) * 8; const v4u c = *(const v4u*)(Cg + k2 * 64 + c8), sv = *(const v4u*)(Sg + k2 * 64 + c8); const v4u ns = sv ^ (v4u){0x80008000u, 0x80008000u, 0x80008000u, 0x80008000u};
        *(LAS v4u*)(A1 + k2 * 136 + c8) = c; *(LAS v4u*)(A1 + k2 * 136 + 64 + c8) = sv; *(LAS v4u*)(A2 + k2 * 136 + c8) = ns; *(LAS v4u*)(A2 + k2 * 136 + 64 + c8) = c; }
    __syncthreads();
    f32x4_t acc[16]; const LAS u16* Aw = (w < 4) ? A1 : A2; const int mt = w & 3;
#pragma unroll
    for (int nt = 0; nt < 16; ++nt) { acc[nt] = (f32x4_t){0.f, 0.f, 0.f, 0.f};
#pragma unroll
        for (int ks = 0; ks < 4; ++ks) acc[nt] = MFMA16(ldfrag(Aw, 136, mt * 16, ks * 32, lane), ldfrag_tr(BT, 264, ks * 32, nt * 16, lane), acc[nt]); }
    __syncthreads();
#pragma unroll
    for (int nt = 0; nt < 16; ++nt)
#pragma unroll
        for (int j = 0; j < 4; ++j) OUT[(mt * 16 + 4 * (lane >> 4) + j) * 512 + (w >> 2) * 256 + nt * 16 + (lane & 15)] = (u16)f2bf(acc[nt][j] * 0.125f);
    __syncthreads();
#pragma unroll
    for (int r = 0; r < 8; ++r) { const int idx = tid + r * 512, k2 = idx >> 6, c = idx & 63; const v4u v = *(const LAS v4u*)(OUT + k2 * 512 + c * 8);
        *(v4u*)(P2 + (size_t)(row0 + k1 + N1 * k2) * P2P + P2_U + c * 8) = v; }
    __syncthreads();
}
DI void gla_scan_item(const Ctx& p, int item) {
    const int tid = otid(); const int chain = item >> 2, e = (item & 3) * 512 + tid; const int s = chain >> 3, h = (chain >> 1) & 3, dir = chain & 1;
    int row0, N; seq_info(s, row0, N); const int NC = N >> 6, gc0 = row0 >> 6, d = e >> 6;
    u16* GS = (u16*)(p.ws + WS_HB + HB_GS); const float* DEC = (const float*)(p.ws + WS_DEC);
    float S = 0.f;
    for (int st = 0; st < NC; st += 32) { u16 tmp[32]; float dc[32];
#pragma unroll
        for (int u = 0; u < 32; ++u) { const int c = dir ? NC - 1 - (st + u) : st + u; const size_t slot = (size_t)((gc0 + c) * 4 + h) * 2 + dir; tmp[u] = GS[slot * 2048 + e]; dc[u] = DEC[slot * 32 + d]; }
#pragma unroll
        for (int u = 0; u < 32; ++u) { const int c = dir ? NC - 1 - (st + u) : st + u; const size_t slot = (size_t)((gc0 + c) * 4 + h) * 2 + dir; GS[slot * 2048 + e] = (u16)f2bf(S); S = dc[u] * S + bf2f(tmp[u]); } }
}
struct OLoad { v4u qk, g, v, z; v2u sf, sb; };
DI OLoad gla_out_load(const Ctx& p, int item) {
    const int tid = otid(); const int gc = item >> 2, h = item & 3; const size_t rb = (size_t)gc * 64; const u16* P2 = (const u16*)(p.ws + WS_P2); const u16* P1 = (const u16*)p.out; OLoad r;
    { const int t2 = tid & 255, i = t2 >> 2, c = t2 & 3; const u16* q = P2 + (rb + i) * P2P + h * 32 + c * 8; const int dirb = tid >> 8;
        r.qk = *(const v4u*)(q + (dirb ? P2_AK : P2_AQ)); r.g = *(const v4u*)(q + (dirb ? P2_GB : P2_GF)); }
    { const int i = tid >> 3, c = tid & 7; r.v = *(const v4u*)(P2 + (rb + i) * P2P + P2_AV + h * 64 + c * 8); r.z = *(const v4u*)(P1 + (rb + i) * P1P + h * 64 + c * 8); }
    { const u16* GS = (const u16*)(p.ws + WS_HB + HB_GS); const size_t slot = (size_t)(gc * 4 + h) * 2; const int e4 = tid * 4; r.sf = *(const v2u*)(GS + slot * 2048 + e4); r.sb = *(const v2u*)(GS + (slot + 1) * 2048 + e4); }
    return r;
}
DI void gla_out_item(const Ctx& p, int l, int item, LAS float* F, const OLoad ld) {
    const int tid = otid(), lane = tid & 63, w = tid >> 6; const int gc = item >> 2, h = item & 3; const size_t rb = (size_t)gc * 64;
    const u16* P2 = (const u16*)(p.ws + WS_P2); u16* P1 = (u16*)p.out;
    LAS float* Gf = F; LAS float* Gb = Gf + 2112; LAS float* Qx = Gb + 2112; LAS float* Kx = Qx + 2112; LAS float* O = Kx + 2112;
    LAS u16* QF = (LAS u16*)(O + 64 * 65); LAS u16* KF = QF + 64 * 40; LAS u16* QB = KF + 64 * 40; LAS u16* KB = QB + 64 * 40;
    LAS u16* VT = KB + 64 * 40; LAS u16* SC = VT + 64 * 72; LAS u16* SFT = SC + 64 * 72; LAS u16* SBT = SFT + 32 * 72;
    const u16* GS = (const u16*)(p.ws + WS_HB + HB_GS); const size_t slot = (size_t)(gc * 4 + h) * 2;
    { const int t2 = tid & 255, i = t2 >> 2, c = t2 & 3; const u16* r = P2 + (rb + i) * P2P + h * 32 + c * 8; float f[8];
        const int dirb = tid >> 8; LAS float* d0 = dirb ? Kx : Qx; LAS float* d1 = dirb ? Gb : Gf; const float* bias = p.tab[dirb ? 12 : 10] + l * 128 + h * 32 + c * 8;
        unpack8(ld.qk, f);
#pragma unroll
        for (int q = 0; q < 8; ++q) d0[i * 33 + c * 8 + q] = f[q];
        unpack8(ld.g, f);
#pragma unroll
        for (int q = 0; q < 8; ++q) d1[i * 33 + c * 8 + q] = logsig(f[q] + bias[q]) * (1.f / 16.f); }
    { const int i = tid >> 3, c = tid & 7; *(LAS v4u*)(VT + i * 72 + c * 8) = ld.v; }
    { const int e4 = tid * 4, d = e4 >> 6, v = e4 & 63; *(LAS v2u*)(SFT + d * 72 + v) = ld.sf; *(LAS v2u*)(SBT + d * 72 + v) = ld.sb; }
    __syncthreads();
    if (w == 0) gla_scan_cols(Gf, Gb, lane);
    __syncthreads();
#pragma unroll
    for (int r = 0; r < 4; ++r) { const int e = tid + r * 512, d = e & 31, i = e >> 5, a = i * 33 + d; const float q = Qx[a] * 0.17677669529663687f, k = Kx[a], bf = Gf[a], bb = Gb[a];
        QF[i * 40 + d] = (u16)f2bf(q * __expf(bf)); KF[i * 40 + d] = (u16)f2bf(k * __expf(-bf)); QB[i * 40 + d] = (u16)f2bf(q * __expf(bb)); KB[i * 40 + d] = (u16)f2bf(k * __expf(-bb)); }
    __syncthreads();
#pragma unroll
    for (int q = 0; q < 2; ++q) { const int id = 2 * w + q, ti = id >> 2, si = id & 3; const f32x4_t z4 = {0.f, 0.f, 0.f, 0.f}; f32x4_t acc;
        if (si < ti) acc = MFMA16(ldfrag(QF, 40, ti * 16, 0, lane), ldfrag(KF, 40, si * 16, 0, lane), z4);
        else if (si > ti) acc = MFMA16(ldfrag(QB, 40, ti * 16, 0, lane), ldfrag(KB, 40, si * 16, 0, lane), z4);
        else { const f32x4_t af = MFMA16(ldfrag(QF, 40, ti * 16, 0, lane), ldfrag(KF, 40, si * 16, 0, lane), z4), ab = MFMA16(ldfrag(QB, 40, ti * 16, 0, lane), ldfrag(KB, 40, si * 16, 0, lane), z4);
#pragma unroll
            for (int j = 0; j < 4; ++j) acc[j] = ((lane & 15) <= 4 * (lane >> 4) + j) ? af[j] : ab[j]; }
#pragma unroll
        for (int j = 0; j < 4; ++j) SC[(ti * 16 + 4 * (lane >> 4) + j) * 72 + si * 16 + (lane & 15)] = (u16)f2bf(acc[j]); }
    __syncthreads();
#pragma unroll
    for (int q = 0; q < 2; ++q) { const int id = 2 * w + q, ti = id >> 2, vi = id & 3; f32x4_t acc = {0.f, 0.f, 0.f, 0.f};
        acc = MFMA16(ldfrag(SC, 72, ti * 16, 0, lane), ldfrag_tr(VT, 72, 0, vi * 16, lane), acc);
        acc = MFMA16(ldfrag(SC, 72, ti * 16, 32, lane), ldfrag_tr(VT, 72, 32, vi * 16, lane), acc);
        acc = MFMA16(ldfrag(QF, 40, ti * 16, 0, lane), ldfrag_tr(SFT, 72, 0, vi * 16, lane), acc);
        acc = MFMA16(ldfrag(QB, 40, ti * 16, 0, lane), ldfrag_tr(SBT, 72, 0, vi * 16, lane), acc);
#pragma unroll
        for (int j = 0; j < 4; ++j) O[(ti * 16 + 4 * (lane >> 4) + j) * 65 + vi * 16 + (lane & 15)] = acc[j]; }
    __syncthreads();
    { const int t = tid >> 3, v8 = (tid & 7) * 8; float acc[8]; float ss = 0.f;
#pragma unroll
        for (int e = 0; e < 8; ++e) { acc[e] = O[t * 65 + v8 + e]; ss += acc[e] * acc[e]; }
        ss += __shfl_xor(ss, 1); ss += __shfl_xor(ss, 2); ss += __shfl_xor(ss, 4);
        const float rstd = 1.f / sqrtf(ss * (1.f / 64.f) + EPSN);
        u16* mz = P1 + (rb + t) * P1P + h * 64 + v8; float zz[8]; unpack8(ld.z, zz);
#pragma unroll
        for (int e = 0; e < 8; ++e) acc[e] = acc[e] * rstd * p.tab[13][l * 64 + v8 + e] * silu_f(zz[e]);
        *(v4u*)mz = pack8(acc); }
    __syncthreads();
}
#define XB_TMO      128
#define XB_XCNT(j)  (256  + 64 * (j))
#define XB_XSUB(j)  (1280 + 64 * (j))
#define XB_XGEN(j)  (2304 + 64 * (j))
#define XB_TOP      3328
#define XB_TOPGEN   3392
#define XCD_BAR_WORDS 3456
#define XB_SPIN_CAP (1u << 18)

__device__ __forceinline__ unsigned xb_ld(unsigned* p)              { return __hip_atomic_load(p, __ATOMIC_RELAXED, __HIP_MEMORY_SCOPE_AGENT); }
__device__ __forceinline__ unsigned xb_add(unsigned* p, unsigned v) { return __hip_atomic_fetch_add(p, v, __ATOMIC_RELAXED, __HIP_MEMORY_SCOPE_AGENT); }
__device__ __forceinline__ unsigned xb_xcc_id() { return (unsigned)__builtin_amdgcn_s_getreg((3 << 11) | 20) & 0xFu; }
#define XB_SPIN(cond, bar) do { unsigned _sp = 0; while (cond) { __builtin_amdgcn_s_sleep(1); \
    if ((++_sp & 255u) == 0u) { if (xb_ld(&(bar)[XB_TMO])) break; if (_sp > XB_SPIN_CAP) { atomicAdd(&(bar)[XB_TMO], 1u); break; } } } } while (0)

struct XcdBarrier {
    unsigned* bar; unsigned x;
    volatile LAS unsigned* st;
};

__device__ __forceinline__ XcdBarrier xcd_barrier_post(unsigned* bar, volatile LAS unsigned* st) {
    XcdBarrier b; b.bar = bar; b.x = xb_xcc_id(); b.st = st;
    if (threadIdx.x == 0) (void)xb_add(&bar[XB_XCNT(b.x)], 1u);
    return b;
}
__device__ __forceinline__ void xcd_barrier_complete(unsigned* bar, unsigned x, unsigned& nloc, unsigned& nx) {
    const unsigned G = gridDim.x * gridDim.y * gridDim.z;
    unsigned sum, cnt, mine, sp = 0u;
    for (;;) {
        sum = 0u; cnt = 0u; mine = 0u;
#pragma unroll
        for (unsigned j = 0; j < 16; ++j) { const unsigned c = xb_ld(&bar[XB_XCNT(j)]); sum += c; cnt += (c > 0u) ? 1u : 0u; mine = (j == x) ? c : mine; }
        if (sum == G) break;
        __builtin_amdgcn_s_sleep(1);
        if ((++sp & 255u) == 0u) { if (xb_ld(&bar[XB_TMO])) break; if (sp > XB_SPIN_CAP) { atomicAdd(&bar[XB_TMO], 1u); break; } }
    }
    nloc = mine > 0u ? mine : 1u; nx = cnt > 0u ? cnt : 1u;
}

__device__ __forceinline__ void xcd_barrier(const XcdBarrier& b) {
    asm volatile("s_waitcnt vmcnt(0)" ::: "memory");
    __syncthreads();
    if (threadIdx.x == 0) {
        unsigned* bar = b.bar;
        __builtin_amdgcn_s_waitcnt(0);
        unsigned nloc = b.st[0], nx = b.st[1];
        if (nloc == 0u) { xcd_barrier_complete(bar, b.x, nloc, nx); b.st[0] = nloc; b.st[1] = nx; }
        const unsigned old = xb_add(&bar[XB_XSUB(b.x)], 1u);
        const unsigned gen = old / nloc;
        if (old + 1u == (gen + 1u) * nloc) {
            __builtin_amdgcn_fence(__ATOMIC_RELEASE, "agent");
            asm volatile("s_waitcnt vmcnt(0)" ::: "memory");
            const unsigned og = xb_add(&bar[XB_TOP], 1u);
            const unsigned tg = og / nx;
            if (og + 1u == (tg + 1u) * nx) xb_add(&bar[XB_TOPGEN], 1u);
            else XB_SPIN(xb_ld(&bar[XB_TOPGEN]) == tg, bar);
            __builtin_amdgcn_fence(__ATOMIC_ACQUIRE, "agent");
            xb_add(&bar[XB_XGEN(b.x)], 1u);
            asm volatile("s_waitcnt vmcnt(0)" ::: "memory");
        } else {
            XB_SPIN(xb_ld(&bar[XB_XGEN(b.x)]) == gen, bar);
            __builtin_amdgcn_fence(__ATOMIC_ACQUIRE, "agent");
            asm volatile("s_waitcnt vmcnt(0)" ::: "memory");
        }
    }
    __syncthreads();
}


#ifndef GM
#define GM 7
#endif
#ifndef PH
#define PH 1023
#endif
__global__ void __launch_bounds__(512, 2) fwd_kernel(Params kp) {
    extern __shared__ __attribute__((aligned(16))) unsigned char lds[];
    cg::grid_group grid = cg::this_grid();
    LAS unsigned char* L = (LAS unsigned char*)lds; LAS float* F = (LAS float*)lds;
    const int G = gridDim.x, bid = blockIdx.x;
    Ctx p; p.out = kp.out; p.ws = kp.ws; p.tab = (LAS cfp*)(L + 131072);
    if (otid() == 0) { p.tab[0] = kp.xp; p.tab[1] = kp.xs; p.tab[2] = kp.cp; p.tab[3] = kp.cs; p.tab[4] = kp.ada_w; p.tab[5] = kp.ada_b; p.tab[6] = kp.pre_g; p.tab[7] = kp.post_g; p.tab[8] = kp.w_in;
        p.tab[9] = kp.wg2f; p.tab[10] = kp.bgf; p.tab[11] = kp.wg2b; p.tab[12] = kp.bgb; p.tab[13] = kp.onorm_g; p.tab[14] = kp.fnet_w; p.tab[15] = kp.qn_g; p.tab[16] = kp.kn_g; p.tab[17] = kp.sgu_ng;
        p.tab[18] = kp.sgu_w; p.tab[19] = kp.sgu_b; p.tab[20] = kp.w_out; }
    volatile LAS unsigned* bst = (volatile LAS unsigned*)(L + 131072 + 256);
    if (otid() < 4) bst[otid()] = 0u;
    __syncthreads();
    const XcdBarrier xbar = xcd_barrier_post((unsigned*)(p.ws + WS_BAR), bst);
    u16* P1 = (u16*)p.out; u16* P2 = (u16*)(p.ws + WS_P2); u16* HB = (u16*)(p.ws + WS_HB); u16* U0 = (u16*)(p.ws + WS_U0);


#if PH & 1
    phase0(p, L);
#endif
    grid.sync();
    for (int step = 0; step < 12; ++step) {
        const int l = step / 6, ph = step % 6;
        bool do_gemm = false; pg8::Gemm g{nullptr, nullptr, T_TOK, 0, 0, 0, 0}; pg8::EpiX E{0, nullptr, 0, nullptr, 0, 0};
        if (ph == 0) {
#if PH & 2
            phaseA(p, l);
#endif
        } else if (ph == 1) {
            g.A = HB; g.Bt = (const u16*)(p.ws + WS_WIN) + (size_t)l * 3584 * 1024; g.N = 3584; g.K = 1024; g.lda = 1024; g.ldb = 1024;
            E.mode = 0; E.O1 = P1; E.ld1 = P1P; E.O2 = P2; E.ld2 = P2P; do_gemm = true;
        } else if (ph == 2) {
#if PH & 4
            qk_prep(p, l);
#endif
#if PH & 8
            { GLoad nx = gla_local_load(p, bid < 1024 ? bid : 0); for (int it = bid; it < 1024; it += G) { const GLoad cur = nx; if (it + G < 1024) nx = gla_local_load(p, it + G); gla_local_item(p, l, it, F, cur); } }
#endif
#if PH & 16
            for (int it = bid; it < 1024; it += G) sgu_item(p, l, it, F, (it == bid) || (G & 3) != 0);
#endif
#if PH & 32
            for (int it = bid; it < 768; it += G) fnet1_item(p, it, F);
#endif
        } else if (ph == 3) {
#if PH & 64
            for (int it = bid; it < 192; it += G) gla_scan_item(p, it);
#endif
#if PH & 128
            { F2Load nx = fnet2_load(p, bid < 512 ? bid : 0); for (int it = bid; it < 512; it += G) { const F2Load cur = nx; if (it + G < 512) nx = fnet2_load(p, it + G); fnet2_item(p, it, F, cur); } }
#endif
            __syncthreads();
#ifndef SKIP_ATTN
            for (int u = ((G & 7) == 0 ? (bid & 7) * (G >> 3) + (bid >> 3) : bid); u < 1024; u += G) {
                int s, h, qb;
                if (u < 512) { s = u >> 7; const int r = u & 127; h = r >> 4; qb = r & 15; } else { const int u2 = u - 512; s = 4 + (u2 >> 8); const int r = u2 & 255; h = r >> 5; qb = r & 31; }
                int row0, N; seq_info(s, row0, N);
                const attn_body::bf16* Pb = (const attn_body::bf16*)P1;
                const attn_body::bf16* KCb = (const attn_body::bf16*)(p.ws + WS_HB + HB_KC) + ((size_t)row0 * 2 + (size_t)(h >> 2) * N) * 64;
                const attn_body::bf16* VCb = (const attn_body::bf16*)(p.ws + WS_HB + HB_VC) + ((size_t)row0 * 2 + (size_t)(h >> 2) * N) * 64;
                attn_body::attn_unit<8>(Pb + (size_t)(row0 + qb * 256) * P1P + P1_Q + h * 64, KCb, VCb,
                                        (attn_body::bf16*)P1 + (size_t)(row0 + qb * 256) * P1P + 512 + h * 64, N >> 6, (char*)lds, qb * 256, p.tab[15] + l * 64);
            }
#endif
        } else if (ph == 4) {
#if PH & 256
            if (G == 256) { const int i0 = bid < 128 ? bid * 7 : 896 + (bid - 128) * 9, i1 = i0 + (bid < 128 ? 7 : 9);
                OLoad nx = gla_out_load(p, i0); for (int it = i0; it < i1; ++it) { const OLoad cur = nx; if (it + 1 < i1) nx = gla_out_load(p, it + 1); gla_out_item(p, l, it, F, cur); } }
            else { OLoad nx = gla_out_load(p, bid < 2048 ? bid : 0); for (int it = bid; it < 2048; it += G) { const OLoad cur = nx; if (it + G < 2048) nx = gla_out_load(p, it + G); gla_out_item(p, l, it, F, cur); } }
#endif
            g.A = P2 + P2_U; g.Bt = (const u16*)(p.ws + WS_WF) + (size_t)l * 131072; g.N = 256; g.K = 512; g.lda = P2P; g.ldb = 512;
            E.mode = 2; E.O1 = P1; E.ld1 = P1P; E.col_off = 256; do_gemm = true;
        } else {
            g.A = P1; g.Bt = (const u16*)(p.ws + WS_WOUT) + (size_t)l * 1024 * 1280; g.N = 1024; g.K = 1280; g.lda = P1P; g.ldb = 1280;
            E.mode = 1; E.O1 = (l == 0) ? U0 : HB; E.ld1 = 1024; do_gemm = true;
        }
#if GM
        if (do_gemm) { pg8::StaticOrder S; S.init(T_TOK, g.N, G, bid); pg8::gemm_phase<pg8::EpiX, pg8::StaticOrder, PG8_ALIGN, PG8_SP2>(L, g, S, E); }
#endif
        xcd_barrier(xbar);
    }
#if PH & 2
    phaseA(p, 2);
#endif
}

extern "C" void kernel_launch(void* const* d_in, const int* in_sizes, int n_in, void* d_out, int out_size, void* d_ws, size_t ws_size, hipStream_t stream) {
    static int grid = 0;
    if (grid == 0) {
        if (n_in != 21 || out_size != T_TOK * 1024 || ws_size < WS_END) { fprintf(stderr, "kernel_launch: unexpected sizes n_in %d out %d ws %zu\n", n_in, out_size, ws_size); grid = -1; return; }
        int dev = 0, cus = 0, per_cu = 0;
        (void)hipGetDevice(&dev); (void)hipDeviceGetAttribute(&cus, hipDeviceAttributeMultiprocessorCount, dev);
        if (hipFuncSetAttribute((const void*)fwd_kernel, hipFuncAttributeMaxDynamicSharedMemorySize, LDS_BYTES) != hipSuccess) { fprintf(stderr, "kernel_launch: hipFuncSetAttribute failed\n"); grid = -1; return; }
        if (hipOccupancyMaxActiveBlocksPerMultiprocessor(&per_cu, (const void*)fwd_kernel, 512, LDS_BYTES) != hipSuccess || per_cu < 1) { fprintf(stderr, "kernel_launch: occupancy query gave %d\n", per_cu); per_cu = 1; }
        (void)hipGetLastError();
        grid = cus * 1;
        fprintf(stderr, "kernel_launch: grid %d (per_cu %d) ws %zu\n", grid, per_cu, ws_size);
    }
    if (grid < 0) return;
    Params p{};
    const float** pp = (const float**)&p;
    for (int i = 0; i < 21; ++i) pp[i] = (const float*)d_in[i];
    p.out = (float*)d_out; p.ws = (unsigned char*)d_ws;
    if (hipMemsetAsync((char*)d_ws + WS_MOD, 0, 2 * 6 * 3072 * sizeof(float), stream) != hipSuccess) { fprintf(stderr, "kernel_launch: memset failed\n"); return; }
    if (hipMemsetAsync((char*)d_ws + WS_BAR, 0, BAR_BYTES, stream) != hipSuccess) { fprintf(stderr, "kernel_launch: memset failed\n"); return; }
    void* args[] = {&p};
    hipError_t e = hipLaunchCooperativeKernel((const void*)fwd_kernel, dim3(grid), dim3(512), args, LDS_BYTES, stream);
    if (e != hipSuccess) fprintf(stderr, "cooperative launch failed: %s (grid %d)\n", hipGetErrorString(e), grid);
}
```

```cpp
#include <hip/hip_runtime.h>
#include <hip/hip_cooperative_groups.h>
#include <cstdio>
#include <cstdint>
namespace cg = cooperative_groups;
__device__ __forceinline__ int otid() { int t = threadIdx.x; asm volatile("" : "+v"(t)); return t; }
namespace pg8 {
#define PG8_LAS __attribute__((address_space(3)))
typedef unsigned short bf16_t;
typedef short bf16x8 __attribute__((ext_vector_type(8)));
typedef float f32x4 __attribute__((ext_vector_type(4)));
typedef unsigned u32x4 __attribute__((ext_vector_type(4)));
constexpr int BM = 256, BK = 64, HALF = 128, HTB = HALF * BK * 2  , STAGE_BYTES = 8 * HTB, NXCD = 8, WGM = 8;

__host__ __device__ __forceinline__ int lds_byte(int r, int c) { const int st = (r >> 4) * 2 + (c >> 5), rr = r & 15, cc = c & 31, ob = rr * 64 + cc * 2; return st * 1024 + (ob ^ (((ob >> 9) & 1) << 5)); }
__host__ __device__ __forceinline__ void stage_rc(int b, int& R, int& C) { const int st = b / 1024, sb = b % 1024, swz = sb ^ (((sb >> 9) & 1) << 5); R = (st >> 1) * 16 + swz / 64; C = (st & 1) * 32 + (swz % 64) / 2; }
__host__ __device__ __forceinline__ int perm32(int rho) { const int n = rho >> 4, i = rho & 15; return 8 * (i >> 2) + 4 * n + (i & 3); }

struct Unit { int pm, pn; };
struct Gemm { const bf16_t* A; const bf16_t* Bt; int M, N, K, lda, ldb; };

struct StaticOrder {
    int nM, nN, nwg, G, c;
    __host__ __device__ void init(int M, int N, int G_, int c_) { nM = M / BM; nN = N / BM; nwg = nM * nN; G = G_; c = c_; }
    __host__ __device__ bool next(int i, Unit& u) const {
        const long L = (long)i * G + c; if (L >= nwg) return false;
        int wgid = (int)L; { const int q = nwg / NXCD, r = nwg % NXCD, xcd = wgid % NXCD, off = wgid / NXCD; wgid = (xcd < r ? xcd * (q + 1) : r * (q + 1) + (xcd - r) * q) + off; }
        const int nig = WGM * nN, gid = wgid / nig, fm = gid * WGM, gsz = (nM - fm) < WGM ? (nM - fm) : WGM;
        u.pm = fm + ((wgid % nig) % gsz); u.pn = (wgid % nig) / gsz; return true;
    }
    __device__ __forceinline__ void a_ready(const Unit&) const {}
    __device__ __forceinline__ void done(const Unit&) const {}
};

__device__ __forceinline__ unsigned cvt_pk_bf16(float lo, float hi) { unsigned r; asm volatile("v_cvt_pk_bf16_f32 %0, %1, %2" : "=v"(r) : "v"(lo), "v"(hi)); return r; }
__device__ __forceinline__ float silu_f(float z) { return z * __builtin_amdgcn_rcpf(1.f + __expf(-z)); }
struct EpiX {
    static constexpr bool PERM = true, AFTER_DRAIN = false;
    int mode; bf16_t* O1; int ld1; bf16_t* O2; int ld2; int col_off;
    __device__ __forceinline__ void operator()(const f32x4 (&acc)[2][2][4][2], const Unit& u, int wr, int wc, int fr, int fq) const {
        const int row0 = u.pm * BM + wr * 64 + fr;
        bf16_t* base; int ld, colt;
        if (mode == 0) { if (u.pn < 8) { base = O1; ld = ld1; colt = u.pn * BM; } else { base = O2; ld = ld2; colt = (u.pn - 8) * BM; } }
        else { base = O1; ld = ld1; colt = col_off + u.pn * BM; }
        const int col0 = colt + wc * 32 + 8 * fq;
#pragma unroll
        for (int ai = 0; ai < 2; ++ai)
#pragma unroll
            for (int m = 0; m < 4; ++m) { bf16_t* rowp = base + (size_t)(row0 + ai * HALF + m * 16) * ld + col0;
#pragma unroll
                for (int bj = 0; bj < 2; ++bj) { f32x4 v0 = acc[ai][bj][m][0], v1 = acc[ai][bj][m][1];
                    if (mode == 2) { const u32x4 z = *(const u32x4*)(rowp + bj * HALF);
                        v0[0] *= silu_f(__uint_as_float(z.x << 16)); v0[1] *= silu_f(__uint_as_float(z.x & 0xffff0000u));
                        v0[2] *= silu_f(__uint_as_float(z.y << 16)); v0[3] *= silu_f(__uint_as_float(z.y & 0xffff0000u));
                        v1[0] *= silu_f(__uint_as_float(z.z << 16)); v1[1] *= silu_f(__uint_as_float(z.z & 0xffff0000u));
                        v1[2] *= silu_f(__uint_as_float(z.w << 16)); v1[3] *= silu_f(__uint_as_float(z.w & 0xffff0000u)); }
                    u32x4 w; w.x = cvt_pk_bf16(v0[0], v0[1]); w.y = cvt_pk_bf16(v0[2], v0[3]); w.z = cvt_pk_bf16(v1[0], v1[1]); w.w = cvt_pk_bf16(v1[2], v1[3]);
                    *(u32x4*)(rowp + bj * HALF) = w; } }
    }
};
#ifndef PG8_SP2
#define PG8_SP2 true
#endif
#ifndef PG8_ALIGN
#define PG8_ALIGN true
#endif
template <class Epi, class Sched, bool ALIGN_EPI = false, bool SP2 = false>
__device__ __forceinline__ void gemm_phase(PG8_LAS unsigned char* lds, const Gemm g, const Sched& S, const Epi& E) {
    const int tid = otid(), wid = __builtin_amdgcn_readfirstlane(tid >> 6), lane = tid & 63, wr = wid >> 2, wc = wid & 3, fr = lane & 15, fq = lane >> 4;
    const int K = g.K, nt = K / BK;
    unsigned voffA[2], voffB[2];
#pragma unroll
    for (int i = 0; i < 2; ++i) { int R, C; stage_rc(tid * 16 + i * 8192, R, C); const int Rb = Epi::PERM ? ((R & ~31) + perm32(R & 31)) : R;
        voffA[i] = (unsigned)(R * g.lda + C) * 2u; voffB[i] = (unsigned)(Rb * g.ldb + C) * 2u; }
    const size_t kstep = (size_t)(BK * 2);
    const size_t hstepA = (size_t)HALF * g.lda * 2, hstepB = (size_t)HALF * g.ldb * 2;
    const size_t tstepA = 2 * hstepA, tstepB = 2 * hstepB;
    const unsigned ldsw = (unsigned)wid * 1024u;
    const int aoff = lds_byte(wr * 64 + fr, fq * 8), boff = lds_byte(wc * 32 + fr, fq * 8);
#define PG8_SA(b, h) (((b) * 2 + (h)) * HTB)
#define PG8_SB(b, h) ((4 + (b) * 2 + (h)) * HTB)
#define PG8_STAGE(bufoff, gbase, voff) do { _Pragma("unroll") for (int _i = 0; _i < 2; ++_i) \
        __builtin_amdgcn_global_load_lds((const unsigned*)((const char*)(gbase) + (voff)[_i]), (PG8_LAS unsigned*)(lds + (bufoff) + ldsw + _i * 8192), 16, 0, 0); } while (0)
#define PG8_LDA(dst, b, h) do { _Pragma("unroll") for (int m = 0; m < 4; ++m) _Pragma("unroll") for (int k = 0; k < 2; ++k) dst[m][k] = *(const PG8_LAS bf16x8*)(lds + PG8_SA(b, h) + aoff + m * 2048 + k * 1024); } while (0)
#define PG8_LDB(dst, b, h) do { _Pragma("unroll") for (int n = 0; n < 2; ++n) _Pragma("unroll") for (int k = 0; k < 2; ++k) dst[n][k] = *(const PG8_LAS bf16x8*)(lds + PG8_SB(b, h) + boff + n * 2048 + k * 1024); } while (0)
#define PG8_MMA(ai, bj, At, Bt) do { __builtin_amdgcn_s_setprio(1); _Pragma("unroll") for (int m = 0; m < 4; ++m) _Pragma("unroll") for (int n = 0; n < 2; ++n) _Pragma("unroll") for (int k = 0; k < 2; ++k) \
        acc[ai][bj][m][n] = __builtin_amdgcn_mfma_f32_16x16x32_bf16(Bt[n][k], At[m][k], acc[ai][bj][m][n], 0, 0, 0); __builtin_amdgcn_s_setprio(0); } while (0)
#define PG8_WAIT_V(n) asm volatile("s_waitcnt vmcnt(" #n ")" ::: "memory")
#define PG8_WAIT_L(n) asm volatile("s_waitcnt lgkmcnt(" #n ")" ::: "memory")
#define PG8_BAR __builtin_amdgcn_s_barrier()
#define PG8_SCHED __builtin_amdgcn_sched_barrier(0)
    Unit cur, nxt; int ui = 0;
    if (!S.next(0, cur)) return;
    f32x4 acc[2][2][4][2];
#pragma unroll
    for (int a = 0; a < 2; ++a)
#pragma unroll
        for (int b = 0; b < 2; ++b)
#pragma unroll
            for (int m = 0; m < 4; ++m)
#pragma unroll
                for (int n = 0; n < 2; ++n) acc[a][b][m][n] = (f32x4){0.f, 0.f, 0.f, 0.f};
    bf16x8 At[4][2], B0[2][2], B1[2][2];
    const char* cA = (const char*)g.A + (size_t)cur.pm * tstepA; const char* cB = (const char*)g.Bt + (size_t)cur.pn * tstepB;
    S.a_ready(cur);
    if constexpr (SP2) {
        PG8_STAGE(PG8_SB(0, 0), cB, voffB); PG8_STAGE(PG8_SB(0, 1), cB + hstepB, voffB); PG8_STAGE(PG8_SA(0, 0), cA, voffA); PG8_STAGE(PG8_SA(0, 1), cA + hstepA, voffA);
        if (wr == 1) PG8_BAR;
        PG8_WAIT_V(2); PG8_BAR;
        PG8_STAGE(PG8_SB(1, 0), cB + kstep, voffB); PG8_STAGE(PG8_SA(1, 0), cA + kstep, voffA); PG8_STAGE(PG8_SB(1, 1), cB + hstepB + kstep, voffB);
        PG8_WAIT_V(6); PG8_BAR;
    } else {
        PG8_STAGE(PG8_SB(0, 0), cB, voffB); PG8_STAGE(PG8_SA(0, 0), cA, voffA); PG8_STAGE(PG8_SB(0, 1), cB + hstepB, voffB); PG8_STAGE(PG8_SA(0, 1), cA + hstepA, voffA);
        if (wr == 1) PG8_BAR;
        PG8_WAIT_V(4); PG8_BAR;
        PG8_STAGE(PG8_SB(1, 0), cB + kstep, voffB); PG8_STAGE(PG8_SA(1, 0), cA + kstep, voffA); PG8_STAGE(PG8_SB(1, 1), cB + hstepB + kstep, voffB);
        PG8_WAIT_V(6); PG8_BAR;
    }
    for (;;) {
        const bool has_next = S.next(ui + 1, nxt);
        const char* nA = has_next ? (const char*)g.A + (size_t)nxt.pm * tstepA : cA; const char* nB = has_next ? (const char*)g.Bt + (size_t)nxt.pn * tstepB : cB;
        for (int t = 0; t < nt; t += 2) {
            const bool last = (t == nt - 2);
            const char* a1 = cA + (size_t)(t + 1) * kstep;
            const char* a2 = last ? nA : cA + (size_t)(t + 2) * kstep; const char* b2 = last ? nB : cB + (size_t)(t + 2) * kstep;
            const char* a3 = a2 + kstep; const char* b3 = b2 + kstep;
            if (last && has_next) S.a_ready(nxt);
            if constexpr (SP2) {
            PG8_LDB(B0, 0, 0); PG8_LDB(B1, 0, 1); PG8_SCHED; PG8_LDA(At, 0, 0); PG8_STAGE(PG8_SA(1, 1), a1 + hstepA, voffA);
            PG8_WAIT_V(8); PG8_WAIT_L(0); PG8_BAR; PG8_MMA(0, 0, At, B0); PG8_MMA(0, 1, At, B1); PG8_BAR; PG8_SCHED;
            PG8_LDA(At, 0, 1); PG8_STAGE(PG8_SB(0, 0), b2, voffB); PG8_STAGE(PG8_SB(0, 1), b2 + hstepB, voffB); PG8_STAGE(PG8_SA(0, 0), a2, voffA);
            PG8_WAIT_V(8); PG8_WAIT_L(0); PG8_BAR; PG8_MMA(1, 0, At, B0); PG8_MMA(1, 1, At, B1); PG8_BAR; PG8_SCHED;
            PG8_LDB(B0, 1, 0); PG8_LDB(B1, 1, 1); PG8_SCHED; PG8_LDA(At, 1, 0); PG8_STAGE(PG8_SA(0, 1), a2 + hstepA, voffA);
            PG8_WAIT_V(8); PG8_WAIT_L(0); PG8_BAR; PG8_MMA(0, 0, At, B0); PG8_MMA(0, 1, At, B1); PG8_BAR; PG8_SCHED;
            PG8_LDA(At, 1, 1); PG8_STAGE(PG8_SB(1, 0), b3, voffB); PG8_STAGE(PG8_SB(1, 1), b3 + hstepB, voffB); PG8_STAGE(PG8_SA(1, 0), a3, voffA);
            PG8_WAIT_V(8); PG8_WAIT_L(0); PG8_BAR; PG8_MMA(1, 0, At, B0); PG8_MMA(1, 1, At, B1); PG8_BAR; PG8_SCHED;
            } else {
            PG8_LDB(B0, 0, 0); PG8_SCHED; PG8_LDA(At, 0, 0); PG8_STAGE(PG8_SA(1, 1), a1 + hstepA, voffA);
            PG8_WAIT_L(8); PG8_BAR; PG8_WAIT_L(0); PG8_MMA(0, 0, At, B0); PG8_BAR; PG8_SCHED;
            PG8_LDB(B1, 0, 1); PG8_STAGE(PG8_SB(0, 0), b2, voffB);
            PG8_BAR; PG8_WAIT_L(0); PG8_MMA(0, 1, At, B1); PG8_BAR;
            PG8_LDA(At, 0, 1); PG8_STAGE(PG8_SA(0, 0), a2, voffA);
            PG8_BAR; PG8_WAIT_L(0); PG8_MMA(1, 0, At, B0); PG8_BAR; PG8_SCHED;
            PG8_STAGE(PG8_SB(0, 1), b2 + hstepB, voffB);
            PG8_WAIT_V(6); PG8_BAR; PG8_MMA(1, 1, At, B1); PG8_BAR;
            PG8_LDB(B0, 1, 0); PG8_SCHED; PG8_LDA(At, 1, 0); PG8_STAGE(PG8_SA(0, 1), a2 + hstepA, voffA);
            PG8_WAIT_L(8); PG8_BAR; PG8_WAIT_L(0); PG8_MMA(0, 0, At, B0); PG8_BAR; PG8_SCHED;
            PG8_LDB(B1, 1, 1); PG8_STAGE(PG8_SB(1, 0), b3, voffB);
            PG8_BAR; PG8_WAIT_L(0); PG8_MMA(0, 1, At, B1); PG8_BAR;
            PG8_LDA(At, 1, 1); PG8_STAGE(PG8_SA(1, 0), a3, voffA);
            PG8_BAR; PG8_WAIT_L(0); PG8_MMA(1, 0, At, B0); PG8_BAR; PG8_SCHED;
            PG8_STAGE(PG8_SB(1, 1), b3 + hstepB, voffB);
            PG8_WAIT_V(6); PG8_BAR; PG8_MMA(1, 1, At, B1); PG8_BAR;
            }
        }
        if constexpr (ALIGN_EPI) { if (wr == 0) PG8_BAR; }
        if constexpr (!Epi::AFTER_DRAIN) { E(acc, cur, wr, wc, fr, fq); S.done(cur); }
        if (!has_next) break;
#pragma unroll
        for (int a = 0; a < 2; ++a)
#pragma unroll
            for (int b = 0; b < 2; ++b)
#pragma unroll
                for (int m = 0; m < 4; ++m)
#pragma unroll
                    for (int n = 0; n < 2; ++n) acc[a][b][m][n] = (f32x4){0.f, 0.f, 0.f, 0.f};
        cur = nxt; cA = nA; cB = nB; ++ui;
        if constexpr (ALIGN_EPI) { if (wr == 1) PG8_BAR; }
    }
    PG8_WAIT_V(0);
    if constexpr (!ALIGN_EPI) { if (wr == 0) PG8_BAR; }
    PG8_BAR;
    if constexpr (Epi::AFTER_DRAIN) { E.fused(acc, cur, wr, wc, fr, fq, lds, wid, lane); S.done(cur); }
#undef PG8_SA
#undef PG8_SB
#undef PG8_STAGE
#undef PG8_LDA
#undef PG8_LDB
#undef PG8_MMA
#undef PG8_WAIT_V
#undef PG8_WAIT_L
#undef PG8_BAR
#undef PG8_SCHED
}
}
#include <hip/hip_bf16.h>
#include <cmath>
namespace attn_body {
using bf16=__hip_bfloat16;
using bf16x8=__attribute__((ext_vector_type(8)))short;
using s16x4=__attribute__((ext_vector_type(4)))short;
using f32x16=__attribute__((ext_vector_type(16)))float;
using u32x4=__attribute__((ext_vector_type(4)))unsigned;
constexpr int D=64,DM=2048,KDM=64;
constexpr int NW=8,QBLK=32,QB=QBLK*NW,KVBLK=64;
constexpr int ATTN_PITCH=DM, ATTN_UNIT_ROWS=QB;
__device__ __forceinline__ int crow(int r,int hi){return (r&3)+8*(r>>2)+4*hi;}
#define SBAR() __builtin_amdgcn_sched_barrier(0)
__device__ __forceinline__ void cmask(f32x16&p0,f32x16&p1,int jb,int qrel,int hi){
  const float NEG=-INFINITY; int kb=64*jb+4*hi;
  #pragma unroll
  for(int r=0;r<16;++r){int kv=kb+(r&3)+8*(r>>2); if(kv>qrel)p0[r]=NEG; if(kv+32>qrel)p1[r]=NEG;}
}

constexpr int NSLOT=3, SLOTB=8192;
constexpr int LDS_K=0, LDS_V=NSLOT*SLOTB, LDS_WS=2*NSLOT*SLOTB, LDS_OST=LDS_WS+NW*64*4, LDS_BYTES=LDS_OST+NW*4096;
constexpr float C2=0.125f*1.4426950408889634f;
__device__ __forceinline__ void glds16(const void*gsrc,unsigned lds_dst){unsigned keep;
  asm volatile("s_mov_b32 %0, m0\n\ts_mov_b32 m0, %2\n\ts_nop 0\n\tglobal_load_lds_dwordx4 %1, off\n\ts_mov_b32 m0, %0":"=&s"(keep):"v"(gsrc),"s"(lds_dst):"memory");}
__device__ __forceinline__ float max3f(float a,float b,float c){float r;asm("v_max3_f32 %0, %1, %2, %3":"=v"(r):"v"(a),"v"(b),"v"(c));return r;}
__device__ __forceinline__ float max2f(float a,float b){float r;asm("v_max_f32_e32 %0, %1, %2":"=v"(r):"v"(a),"v"(b));return r;}
__device__ __forceinline__ float fadd_s(float a,float b){float r;asm("v_add_f32_e32 %0, %1, %2":"=v"(r):"v"(a),"v"(b));return r;}
__device__ __forceinline__ float fsub_s(float a,float b){float r;asm("v_sub_f32_e32 %0, %1, %2":"=v"(r):"v"(a),"v"(b));return r;}
typedef float f32x2_t __attribute__((ext_vector_type(2))); typedef __bf16 bf16x2_t __attribute__((ext_vector_type(2)));
__device__ __forceinline__ unsigned cvtpk_s(float lo,float hi){f32x2_t v={lo,hi};bf16x2_t b=__builtin_convertvector(v,bf16x2_t);return __builtin_bit_cast(unsigned,b);}
#define WAIT_BAR(N) asm volatile("s_waitcnt vmcnt(" #N ") lgkmcnt(0)\n\ts_barrier":::"memory")

__device__ __forceinline__ void qkt(f32x16&p0,f32x16&p1,const char*Kslot,const bf16x8*qr,const f32x16&negm,int r32,int hi){
  const char*kb=Kslot+hi*1024+r32*16;
  #pragma unroll
  for(int d0=0;d0<4;++d0){
    const bf16x8 b0=*reinterpret_cast<const bf16x8*>(kb+d0*2048);
    const bf16x8 b1=*reinterpret_cast<const bf16x8*>(kb+d0*2048+512);
    if(d0==0){p0=__builtin_amdgcn_mfma_f32_32x32x16_bf16(b0,qr[0],negm,0,0,0);p1=__builtin_amdgcn_mfma_f32_32x32x16_bf16(b1,qr[0],negm,0,0,0);}
    else{p0=__builtin_amdgcn_mfma_f32_32x32x16_bf16(b0,qr[d0],p0,0,0,0);p1=__builtin_amdgcn_mfma_f32_32x32x16_bf16(b1,qr[d0],p1,0,0,0);}}
}
typedef __attribute__((address_space(3))) const char* lds_cptr;
typedef short v4i16_t __attribute__((ext_vector_type(4)));
__device__ __forceinline__ void kload8(bf16x8*kf,lds_cptr kp){
  kf[0]=*(const __attribute__((address_space(3))) bf16x8*)(kp);      kf[1]=*(const __attribute__((address_space(3))) bf16x8*)(kp+512);
  kf[2]=*(const __attribute__((address_space(3))) bf16x8*)(kp+2048); kf[3]=*(const __attribute__((address_space(3))) bf16x8*)(kp+2560);
  kf[4]=*(const __attribute__((address_space(3))) bf16x8*)(kp+4096); kf[5]=*(const __attribute__((address_space(3))) bf16x8*)(kp+4608);
  kf[6]=*(const __attribute__((address_space(3))) bf16x8*)(kp+6144); kf[7]=*(const __attribute__((address_space(3))) bf16x8*)(kp+6656);
}
__device__ __forceinline__ void kload2(bf16x8*kf,lds_cptr kp,int j){ kf[2*j]=*(const __attribute__((address_space(3))) bf16x8*)(kp+j*2048); kf[2*j+1]=*(const __attribute__((address_space(3))) bf16x8*)(kp+j*2048+512); }
__device__ __forceinline__ s16x4 vtr(lds_cptr p){ return __builtin_bit_cast(s16x4,__builtin_amdgcn_ds_read_tr16_b64_v4i16((__attribute__((address_space(3))) v4i16_t*)p)); }
__device__ __forceinline__ float rowmax(const f32x16&p0,const f32x16&p1){
  float a=max3f(p0[0],p0[1],p1[0]),b=max3f(p0[2],p0[3],p1[1]);a=max3f(a,p1[2],p1[3]);
  #pragma unroll
  for(int r=4;r<16;r+=4){a=max3f(a,p0[r],p0[r+1]);b=max3f(b,p0[r+2],p0[r+3]);a=max3f(a,p1[r],p1[r+1]);b=max3f(b,p1[r+2],p1[r+3]);}
  const float m=max2f(a,b);
  auto rr=__builtin_amdgcn_permlane32_swap(__float_as_uint(m),__float_as_uint(m),false,false);
  return max2f(__uint_as_float(rr[0]),__uint_as_float(rr[1]));
}
__device__ __forceinline__ void pv(f32x16*o,int vb,bf16x8 pa0,bf16x8 pa1,bf16x8 pa2,bf16x8 pa3){
  #pragma unroll
  for(int d0=0;d0<2;++d0){s16x4 lo[4],hi[4];
    #pragma unroll
    for(int ks=0;ks<4;++ks){
      asm volatile("ds_read_b64_tr_b16 %0,%1 offset:%c2":"=&v"(lo[ks]):"v"(vb),"i"(d0*4096+ks*1024):"memory");
      asm volatile("ds_read_b64_tr_b16 %0,%1 offset:%c2":"=&v"(hi[ks]):"v"(vb),"i"(d0*4096+ks*1024+512):"memory");}
    asm volatile("s_waitcnt lgkmcnt(0)":::"memory");SBAR();
    #define PK(k) (bf16x8){lo[k][0],lo[k][1],lo[k][2],lo[k][3],hi[k][0],hi[k][1],hi[k][2],hi[k][3]}
    o[d0]=__builtin_amdgcn_mfma_f32_32x32x16_bf16(pa0,PK(0),o[d0],0,0,0);
    o[d0]=__builtin_amdgcn_mfma_f32_32x32x16_bf16(pa1,PK(1),o[d0],0,0,0);
    o[d0]=__builtin_amdgcn_mfma_f32_32x32x16_bf16(pa2,PK(2),o[d0],0,0,0);
    o[d0]=__builtin_amdgcn_mfma_f32_32x32x16_bf16(pa3,PK(3),o[d0],0,0,0);
    #undef PK
  }
}

#ifndef ATTN_STORE16
#define ATTN_STORE16(p,v) (*(u32x4*)(p)=(v))
#endif
template<int THRL> __device__ __forceinline__ void attn_unit(const bf16*Qblk,const bf16*__restrict__ Kh,const bf16*__restrict__ Vh,bf16*Oblk,const int NT,char*shm,const int qpos0,const float*__restrict__ qgain){
  const int tid=otid(),lane=tid&63,r32=lane&31,hi=lane>>5; const int wid=__builtin_amdgcn_readfirstlane(tid>>6);
  const bf16*Qw=Qblk+(long)wid*QBLK*DM;
  const unsigned lds0=(unsigned)(uintptr_t)shm;
  float*wsf=(float*)(shm+LDS_WS)+wid*64;
  const bf16*ksrc=Kh+(long)lane*KDM+wid*8;
  const bf16*vsrc=Vh+(long)(16*(wid&3)+(lane>>2))*KDM+(wid>>2)*32+(lane&3)*8;
  const unsigned kdst=lds0+LDS_K+wid*1024, vdst=lds0+LDS_V+wid*1024;
  #define DMA_K(t,slot) glds16(ksrc+(long)(t)*KVBLK*KDM,(unsigned)__builtin_amdgcn_readfirstlane(kdst+(slot)))
  #define DMA_V(t,slot) glds16(vsrc+(long)(t)*KVBLK*KDM,(unsigned)__builtin_amdgcn_readfirstlane(vdst+(slot)))
  const int vb0=(int)(lds0+LDS_V)+((lane>>4)&1)*32+(lane&3)*8+(4*hi+((lane&15)>>2))*64;
  const char*Kbase=shm+LDS_K; bf16x8 kf[8];
  const lds_cptr shm3=(lds_cptr)shm; const lds_cptr kp0=shm3+LDS_K+hi*1024+r32*16; const lds_cptr vp0=shm3+LDS_V+((lane>>4)&1)*32+(lane&3)*8+(4*hi+((lane&15)>>2))*64;
  DMA_K(0,0);DMA_V(0,0);DMA_K(1,SLOTB);
  bf16x8 qr[4];
  { float qf[4][8]; float ss=0.f;
    #pragma unroll
    for(int d0=0;d0<4;++d0){ const bf16x8 raw=*reinterpret_cast<const bf16x8*>(&Qw[(long)r32*DM+d0*16+hi*8]);
      #pragma unroll
      for(int j=0;j<8;++j){ qf[d0][j]=__uint_as_float(((unsigned)(unsigned short)raw[j])<<16); ss+=qf[d0][j]*qf[d0][j]; } }
    ss+=__shfl_xor(ss,32);
    const float rstd=1.0f/sqrtf(ss*(1.f/64.f)+1e-6f)*C2;
    const int pos=qpos0+wid*QBLK+r32; const float prow=(float)(pos>>6),pcol=(float)(pos&63);
    #pragma unroll
    for(int d0=0;d0<4;++d0){ u32x4 pk;
      #pragma unroll
      for(int jp=0;jp<4;++jp){ const int d=16*d0+8*hi+2*jp; const int m=8*(d0&1)+4*hi+jp;
        const float fr=__builtin_amdgcn_exp2f(-(float)m*(13.287712379549449f/16.f)); const float ang=((d0<2)?prow:pcol)*fr;
        const float sn=__sinf(ang),cs=__cosf(ang);
        const float y0=qf[d0][2*jp]*rstd*qgain[d],y1=qf[d0][2*jp+1]*rstd*qgain[d+1];
        pk[jp]=cvtpk_s(y0*cs-y1*sn,y0*sn+y1*cs); }
      qr[d0]=__builtin_bit_cast(bf16x8,pk); } }
  float mhat=0.f,l_reg=0.f;f32x16 o[2];o[0]=f32x16{};o[1]=f32x16{};f32x16 negm=f32x16{};asm volatile("":"+v"(negm));
  #define CMASK(P0,P1,t) do{}while(0)
  bool resc=false;
  #define START(P0,P1) do{ const float rm=rowmax(P0,P1); resc=false; \
    { const float dl=rm; mhat=fadd_s(mhat,dl); \
      _Pragma("unroll") for(int r=0;r<16;++r){P0[r]=fsub_s(P0[r],dl);P1[r]=fsub_s(P1[r],dl);} \
      _Pragma("unroll") for(int r=0;r<16;++r)negm[r]=-mhat; asm volatile("":"+v"(negm)); } \
    _Pragma("unroll") for(int r=0;r<16;++r)P0[r]=__builtin_amdgcn_exp2f(P0[r]); }while(0)
  #define RESC() do{ if(resc){ asm volatile("s_waitcnt lgkmcnt(0)":::"memory"); \
      _Pragma("unroll") for(int d_=0;d_<2;++d_) _Pragma("unroll") for(int r=0;r<16;++r)o[d_][r]*=wsf[crow(r,hi)]; } }while(0)
  f32x16 pA0,pA1,pB0,pB1;
  int sl_prev=0,sl_cur=0,sl_next=SLOTB;
  #define ROT() do{sl_prev=sl_cur;sl_cur=sl_next;sl_next=(sl_next==(NSLOT-1)*SLOTB)?0:sl_next+SLOTB;}while(0)
  DMA_K(2,2*SLOTB);
  WAIT_BAR(3);
  qkt(pA0,pA1,Kbase,qr,negm,r32,hi);asm volatile("s_nop 15\n\ts_nop 7":"+v"(pA0),"+v"(pA1));CMASK(pA0,pA1,0);
  START(pA0,pA1);
  _Pragma("unroll") for(int r=0;r<16;++r)pA1[r]=__builtin_amdgcn_exp2f(pA1[r]);
  WAIT_BAR(0);
  DMA_K(3,0);DMA_V(1,SLOTB);
  ROT();
  kload8(kf,kp0+sl_cur);
  WAIT_BAR(2);
  s16x4 vlo[8],vhi[8]; u32x4 pw0,pw1,pw2,pw3;
  #define PKW(P,B) cvtpk_s(P[B],P[B+1])
  #define PAF(k) __builtin_bit_cast(bf16x8,pw##k)
  #define VFR(i) (bf16x8){vlo[i][0],vlo[i][1],vlo[i][2],vlo[i][3],vhi[i][0],vhi[i][1],vhi[i][2],vhi[i][3]}
  #define PIN(x) asm volatile("":"+v"(x))
  #define MX3(a,b,c) __builtin_fmaxf(__builtin_fmaxf((a),(b)),(c))
  #define GAPA(MF,A0,A1,A2,A3,W0,W1,PW) do{ MF; sacc+=A0; sacc+=A1; sacc+=A2; sacc+=A3; PIN(sacc); W0; W1; PIN(PW); SBAR(); }while(0)
  #define EX(v) __builtin_amdgcn_exp2f(v)
  #define GAPB(MF,X,B) do{ MF; X[B]=EX(X[B]); X[B+1]=EX(X[B+1]); X[B+2]=EX(X[B+2]); X[B+3]=EX(X[B+3]); PIN(X); SBAR(); }while(0)
  #define VRD(i) do{ vlo[i]=vtr(vp_+(((i)>>2)*4096+((i)&3)*1024)); vhi[i]=vtr(vp_+(((i)>>2)*4096+((i)&3)*1024+512)); }while(0)
  #define KRD(G,j) do{ if(G){ kload2(kf,kp0+sl_next,j); SBAR(); } }while(0)
  #define STEP(C0,C1,P0,P1,t,GK,GV,GL) do{ SBAR(); \
    const lds_cptr vp_=vp0+sl_prev; \
    VRD(0); SBAR(); float sacc=(P0[0]+P0[1]); \
    GAPA(C0=__builtin_amdgcn_mfma_f32_32x32x16_bf16(kf[0],qr[0],negm,0,0,0), P0[2],P0[3],P0[4],P0[5],     pw0[0]=PKW(P0,0), pw0[1]=PKW(P0,2), pw0); \
    VRD(4); SBAR(); GAPA(C1=__builtin_amdgcn_mfma_f32_32x32x16_bf16(kf[1],qr[0],negm,0,0,0), P0[6],P0[7],P0[8],P0[9],     pw0[2]=PKW(P0,4), pw0[3]=PKW(P0,6), pw0); \
    VRD(1); SBAR(); GAPA(C0=__builtin_amdgcn_mfma_f32_32x32x16_bf16(kf[2],qr[1],C0,0,0,0),   P0[10],P0[11],P0[12],P0[13], pw1[0]=PKW(P0,8), pw1[1]=PKW(P0,10), pw1); \
    VRD(5); SBAR(); GAPA(C1=__builtin_amdgcn_mfma_f32_32x32x16_bf16(kf[3],qr[1],C1,0,0,0),   P0[14],P0[15],P1[0],P1[1],   pw1[2]=PKW(P0,12),pw1[3]=PKW(P0,14), pw1); \
    VRD(2); SBAR(); GAPA(C0=__builtin_amdgcn_mfma_f32_32x32x16_bf16(kf[4],qr[2],C0,0,0,0),   P1[2],P1[3],P1[4],P1[5],     pw2[0]=PKW(P1,0), pw2[1]=PKW(P1,2), pw2); \
    VRD(6); SBAR(); GAPA(C1=__builtin_amdgcn_mfma_f32_32x32x16_bf16(kf[5],qr[2],C1,0,0,0),   P1[6],P1[7],P1[8],P1[9],     pw2[2]=PKW(P1,4), pw2[3]=PKW(P1,6), pw2); \
    VRD(3); SBAR(); GAPA(C0=__builtin_amdgcn_mfma_f32_32x32x16_bf16(kf[6],qr[3],C0,0,0,0),   P1[10],P1[11],P1[12],P1[13], pw3[0]=PKW(P1,8), pw3[1]=PKW(P1,10), pw3); \
    VRD(7); SBAR(); GAPA(C1=__builtin_amdgcn_mfma_f32_32x32x16_bf16(kf[7],qr[3],C1,0,0,0),   P1[14],P1[15],0.f,0.f,       pw3[2]=PKW(P1,12),pw3[3]=PKW(P1,14), pw3); \
    l_reg+=sacc; \
    if(GK){DMA_K((t)+3,sl_cur);} if(GV){DMA_V((t)+1,sl_next);} \
    CMASK(C0,C1,t); \
    { float a=MX3(C0[0],C0[1],C1[0]),b=MX3(C0[2],C0[3],C1[1]); a=MX3(a,C1[2],C1[3]); \
      _Pragma("unroll") for(int r=4;r<16;r+=4){a=MX3(a,C0[r],C0[r+1]);b=MX3(b,C0[r+2],C0[r+3]);a=MX3(a,C1[r],C1[r+1]);b=MX3(b,C1[r+2],C1[r+3]);} \
      float rm=__builtin_fmaxf(a,b); { auto rr=__builtin_amdgcn_permlane32_swap(__float_as_uint(rm),__float_as_uint(rm),false,false); rm=__builtin_fmaxf(__uint_as_float(rr[0]),__uint_as_float(rr[1])); } \
      resc=false; \
      if(__builtin_expect(__any(rm>(float)THRL),0)){ const float dl=__builtin_fmaxf(rm,0.f); mhat+=dl; \
        _Pragma("unroll") for(int r=0;r<16;++r){C0[r]-=dl;C1[r]-=dl;} \
        _Pragma("unroll") for(int r=0;r<16;++r)negm[r]=-mhat; asm volatile("":"+v"(negm)); \
        const float f=__builtin_amdgcn_exp2f(-dl); l_reg*=f; if(hi==0)wsf[r32]=f; resc=true; } } \
    SBAR(); \
    GAPB(o[0]=__builtin_amdgcn_mfma_f32_32x32x16_bf16(PAF(0),VFR(0),o[0],0,0,0), C0,0); \
    GAPB(o[1]=__builtin_amdgcn_mfma_f32_32x32x16_bf16(PAF(0),VFR(4),o[1],0,0,0), C0,4); \
    KRD(GL,0); GAPB(o[0]=__builtin_amdgcn_mfma_f32_32x32x16_bf16(PAF(1),VFR(1),o[0],0,0,0), C0,8); \
    KRD(GL,1); GAPB(o[1]=__builtin_amdgcn_mfma_f32_32x32x16_bf16(PAF(1),VFR(5),o[1],0,0,0), C0,12); \
    KRD(GL,2); GAPB(o[0]=__builtin_amdgcn_mfma_f32_32x32x16_bf16(PAF(2),VFR(2),o[0],0,0,0), C1,0); \
    KRD(GL,3); GAPB(o[1]=__builtin_amdgcn_mfma_f32_32x32x16_bf16(PAF(2),VFR(6),o[1],0,0,0), C1,4); \
    GAPB(o[0]=__builtin_amdgcn_mfma_f32_32x32x16_bf16(PAF(3),VFR(3),o[0],0,0,0), C1,8); \
    GAPB(o[1]=__builtin_amdgcn_mfma_f32_32x32x16_bf16(PAF(3),VFR(7),o[1],0,0,0), C1,12); \
    }while(0)
  int t=1;
  #undef CMASK
  #define CMASK(P0,P1,t) do{}while(0)
  for(;t+5<NT;t+=2){
    STEP(pB0,pB1,pA0,pA1,t,true,true,true);     WAIT_BAR(2); RESC(); ROT();
    STEP(pA0,pA1,pB0,pB1,t+1,true,true,true);   WAIT_BAR(2); RESC(); ROT();
  }
  #undef CMASK
  #define CMASK(P0,P1,t) do{}while(0)
  #define ENDW(tt) do{ if((tt)+3<NT){WAIT_BAR(2);} else if((tt)+2<NT){WAIT_BAR(1);} else {WAIT_BAR(0);} }while(0)
  for(;t+1<NT;t+=2){
    STEP(pB0,pB1,pA0,pA1,t,(t+3<NT),(t+1<NT),(t+1<NT));       ENDW(t);   RESC(); ROT();
    STEP(pA0,pA1,pB0,pB1,t+1,(t+4<NT),(t+2<NT),(t+2<NT));     ENDW(t+1); RESC(); ROT();
  }
  STEP(pB0,pB1,pA0,pA1,NT-1,false,false,false); RESC();
  { float sacc=pB0[0]+pB0[1]; _Pragma("unroll") for(int r=2;r<16;++r)sacc+=pB0[r]; _Pragma("unroll") for(int r=0;r<16;++r)sacc+=pB1[r]; l_reg+=sacc;
    pw0=(u32x4){PKW(pB0,0),PKW(pB0,2),PKW(pB0,4),PKW(pB0,6)};pw1=(u32x4){PKW(pB0,8),PKW(pB0,10),PKW(pB0,12),PKW(pB0,14)};pw2=(u32x4){PKW(pB1,0),PKW(pB1,2),PKW(pB1,4),PKW(pB1,6)};pw3=(u32x4){PKW(pB1,8),PKW(pB1,10),PKW(pB1,12),PKW(pB1,14)};
    SBAR(); pv(o,vb0+sl_cur,PAF(0),PAF(1),PAF(2),PAF(3)); }
  #undef PKW
  #undef PAF
  #undef VFR
  #undef PIN
  #undef MX3
  #undef GAPA
  #undef GAPB
  #undef EX
  #undef VRD
  #undef KRD
  #undef STEP
  #undef ENDW
  {auto rr=__builtin_amdgcn_permlane32_swap(__float_as_uint(l_reg),__float_as_uint(l_reg),false,false);l_reg=__uint_as_float(rr[0])+__uint_as_float(rr[1]);}
  if(hi==0)wsf[32+r32]=l_reg;asm volatile("s_waitcnt lgkmcnt(0)":::"memory");
  float rli[16];
  #pragma unroll
  for(int r=0;r<16;++r)rli[r]=__builtin_amdgcn_rcpf(wsf[32+crow(r,hi)]);
  bf16*Ow=Oblk+(long)wid*QBLK*DM;
  { bf16*stg=(bf16*)(shm+LDS_OST)+wid*2048;
    #pragma unroll
    for(int r=0;r<16;++r){const int orow=crow(r,hi);
      #pragma unroll
      for(int d0=0;d0<2;++d0)stg[orow*64+d0*32+r32]=__float2bfloat16(o[d0][r]*rli[r]);}
    asm volatile("s_waitcnt lgkmcnt(0)":::"memory");
    #pragma unroll
    for(int i=0;i<4;++i){const int row=i*8+(lane>>3),ch=lane&7; const u32x4 v=*(const u32x4*)(stg+row*64+ch*8); const u32x4 z=*(const u32x4*)(Ow+(long)row*DM+ch*8); u32x4 w;
      #pragma unroll
      for(int e=0;e<4;++e){ const float a0=__uint_as_float(v[e]<<16),a1=__uint_as_float(v[e]&0xffff0000u),z0=__uint_as_float(z[e]<<16),z1=__uint_as_float(z[e]&0xffff0000u);
        w[e]=cvtpk_s(a0*z0*__builtin_amdgcn_rcpf(1.f+__expf(-z0)),a1*z1*__builtin_amdgcn_rcpf(1.f+__expf(-z1))); }
      ATTN_STORE16(Ow+(long)row*DM+ch*8,w);} }
  asm volatile("s_waitcnt lgkmcnt(0)\n\ts_barrier":::"memory");
  #undef DMA_K
  #undef DMA_V
  #undef CMASK
  #undef START
  #undef RESC
  #undef ROT
}
constexpr int ATTN_LDS_BYTES=LDS_BYTES;
}
typedef unsigned short u16;
#define LAS __attribute__((address_space(3)))
#define DI __device__ __forceinline__
typedef unsigned v4u __attribute__((ext_vector_type(4)));
typedef unsigned v2u __attribute__((ext_vector_type(2)));
typedef float v4f __attribute__((ext_vector_type(4)));

constexpr int T_TOK = 32768, P1P = 2048, P2P = 1536;
constexpr int P1_Z = 0, P1_Q = 1280, P1_K = 1792, P1_V = 1920;
constexpr int P2_AQ = 0, P2_AK = 128, P2_AV = 256, P2_GF = 512, P2_GB = 640, P2_BU = 768, P2_DU = 1024, P2_DV = 1280, P2_U = 1024;
constexpr size_t MiB = 1u << 20;
constexpr size_t WS_DFT = 256 * 1024, WS_BAR = 512 * 1024, BAR_BYTES = 16384;
constexpr size_t WS_MOD = 0, WS_WIN = 2 * MiB, WS_WOUT = 16 * MiB, WS_WF = 21 * MiB, WS_U0 = 22 * MiB, WS_HB = 86 * MiB, WS_P2 = 150 * MiB, WS_DEC = 246 * MiB, WS_END = 247 * MiB;
constexpr size_t HB_GS = 0, HB_KC = 16 * MiB, HB_VC = 24 * MiB, HB_TP = 32 * MiB;
constexpr int LDS_BYTES = 147456;
constexpr float EPSN = 1e-6f;
constexpr float ATT_C2 = 0.125f * 1.4426950408889634f;

struct Params {
    const float *xp, *xs, *cp, *cs, *ada_w, *ada_b, *pre_g, *post_g, *w_in, *wg2f, *bgf, *wg2b, *bgb, *onorm_g, *fnet_w, *qn_g, *kn_g, *sgu_ng, *sgu_w, *sgu_b, *w_out;
    float* out; unsigned char* ws;
};
typedef const float* cfp;
struct Ctx { float* out; unsigned char* ws; LAS cfp* tab; };

DI float bf2f(u16 v) { return __uint_as_float((unsigned)v << 16); }
DI float bflo(unsigned w) { return __uint_as_float(w << 16); }
DI float bfhi(unsigned w) { return __uint_as_float(w & 0xffff0000u); }
DI unsigned f2bf(float f) { unsigned u = __float_as_uint(f); return (u + 0x7fffu + ((u >> 16) & 1u)) >> 16; }
DI unsigned pk2(float lo, float hi) { return f2bf(lo) | (f2bf(hi) << 16); }
DI float wave_sum(float v) {
#pragma unroll
    for (int o = 1; o < 64; o <<= 1) v += __shfl_xor(v, o);
    return v;
}
using pg8::silu_f;
DI float logsig(float x) { return fminf(x, 0.f) - __logf(1.f + __expf(-fabsf(x))); }
DI void seq_info(int s, int& row0, int& N) { if (s < 4) { row0 = s * 4096; N = 4096; } else { row0 = 16384 + (s - 4) * 8192; N = 8192; } }
DI int row_seq(int r) { return r < 16384 ? (r >> 12) : 4 + ((r - 16384) >> 13); }
DI void unpack8(const v4u r, float (&f)[8]) { f[0] = bflo(r.x); f[1] = bfhi(r.x); f[2] = bflo(r.y); f[3] = bfhi(r.y); f[4] = bflo(r.z); f[5] = bfhi(r.z); f[6] = bflo(r.w); f[7] = bfhi(r.w); }
DI v4u pack8(const float (&f)[8]) { v4u r; r.x = pk2(f[0], f[1]); r.y = pk2(f[2], f[3]); r.z = pk2(f[4], f[5]); r.w = pk2(f[6], f[7]); return r; }
#define LDS_WAIT() asm volatile("s_waitcnt lgkmcnt(0)" ::: "memory")


typedef short bf16x8_t __attribute__((ext_vector_type(8)));
typedef float f32x4_t __attribute__((ext_vector_type(4)));
DI bf16x8_t ldfrag(const LAS u16* base, int pitch, int row0, int k0, int lane) { return *(const LAS bf16x8_t*)(base + (row0 + (lane & 15)) * pitch + k0 + 8 * (lane >> 4)); }
typedef short s16x4_t __attribute__((ext_vector_type(4)));
DI bf16x8_t ldfrag_tr(const LAS u16* base, int pitch, int k0, int n0, int lane) {
    const LAS u16* a0 = base + (k0 + 8 * (lane >> 4) + ((lane & 15) >> 2)) * pitch + n0 + 4 * (lane & 3);
    const s16x4_t lo = __builtin_amdgcn_ds_read_tr16_b64_v4i16((LAS s16x4_t*)a0), hi = __builtin_amdgcn_ds_read_tr16_b64_v4i16((LAS s16x4_t*)(a0 + 4 * pitch));
    return (bf16x8_t){lo[0], lo[1], lo[2], lo[3], hi[0], hi[1], hi[2], hi[3]};
}
#define MFMA16(a, b, c) __builtin_amdgcn_mfma_f32_16x16x32_bf16((a), (b), (c), 0, 0, 0)
DI float wave_prefix(float g, int lane) {
#pragma unroll
    for (int o = 1; o < 64; o <<= 1) { const float t = __shfl_up(g, o); if (lane >= o) g += t; }
    return g; }
DI float wave_suffix(float g, int lane) {
#pragma unroll
    for (int o = 1; o < 64; o <<= 1) { const float t = __shfl_down(g, o); if (lane + o < 64) g += t; }
    return g; }
DI int win_src_col(int j) {
    if (j < 1280) return 2080 + j;
    if (j < 1792) return 800 + (j - 1280);
    if (j < 1920) return 1312 + (j - 1792);
    if (j < 2048) return 1440 + (j - 1920);
    const int q = j - 2048;
    if (q < 512) return q;
    if (q < 768) return -1;
    if (q < 1024) return 544 + (q - 768);
    if (q < 1280) return 1568 + (q - 1024);
    return 1824 + (q - 1280);
}
DI void transpose_item(const float* W, int ldw, int src_n0, int K, u16* WT, int dst_n0, int k0, LAS float* scr, int lane) {
    float tv[32];
#pragma unroll
    for (int i = 0; i < 32; ++i) tv[i] = W[(size_t)(k0 + 2 * i + (lane >> 5)) * ldw + src_n0 + (lane & 31)];
#pragma unroll
    for (int i = 0; i < 32; ++i) scr[(2 * i + (lane >> 5)) * 33 + (lane & 31)] = tv[i];
    LDS_WAIT();
    const int c = lane & 7;
#pragma unroll
    for (int j = 0; j < 4; ++j) { const int n = (lane >> 3) + 8 * j; const LAS float* s = scr + (8 * c) * 33 + n;
        v4u o; o.x = pk2(s[0 * 33], s[1 * 33]); o.y = pk2(s[2 * 33], s[3 * 33]); o.z = pk2(s[4 * 33], s[5 * 33]); o.w = pk2(s[6 * 33], s[7 * 33]);
        *(v4u*)(WT + (size_t)(dst_n0 + n) * K + k0 + 8 * c) = o; }
    LDS_WAIT();
}
DI void phase0(const Ctx& p, LAS unsigned char* L) {
    const int tid = otid(), lane = tid & 63, wave = tid >> 6;
    const int gw = blockIdx.x * 8 + wave, NGW = gridDim.x * 8, gt = blockIdx.x * 512 + tid, NGT = gridDim.x * 512;
    LAS float* scr = (LAS float*)(L + wave * 16384);
    u16* WinT = (u16*)(p.ws + WS_WIN); u16* WoutT = (u16*)(p.ws + WS_WOUT); u16* WfT = (u16*)(p.ws + WS_WF); float* mod = (float*)(p.ws + WS_MOD);
    constexpr int I_IN = 16 * 112, I_OUT = 20 * 32, I_L = I_IN + I_OUT;
    for (int it = gw; it < 2 * I_L; it += NGW) {
        const int l = it / I_L; int r = it % I_L;
        if (r < I_IN) { const int kb = r / 112, nb = r % 112; const int src = win_src_col(nb * 32); if (src < 0) continue;
            transpose_item(p.tab[8] + (size_t)l * 1024 * 3360, 3360, src, 1024, WinT + (size_t)l * 3584 * 1024, nb * 32, kb * 64, scr, lane); }
        else { r -= I_IN; const int kb = r / 32, nb = r % 32;
            transpose_item(p.tab[20] + (size_t)l * 1280 * 1024, 1024, nb * 32, 1280, WoutT + (size_t)l * 1024 * 1280, nb * 32, kb * 64, scr, lane); }
    }
    for (int e = gt; e < 2 * 16 * 1024; e += NGT) { const int l = e >> 14, r = e & 16383, jg = r >> 10, k = r & 1023, dirb = jg >> 3, jj0 = (jg & 7) * 16;
        const float* wi = p.tab[8] + (size_t)l * 1024 * 3360 + (size_t)k * 3360 + 512 + dirb * 16; float wv[16];
#pragma unroll
        for (int r2 = 0; r2 < 16; ++r2) wv[r2] = wi[r2];
        const float* w2 = (dirb ? p.tab[11] : p.tab[9]) + l * 16 * 128 + jj0;
        for (int q = 0; q < 16; ++q) { float a = 0.f;
#pragma unroll
            for (int r2 = 0; r2 < 16; ++r2) a += wv[r2] * w2[r2 * 128 + q];
            WinT[(size_t)l * 3584 * 1024 + (size_t)(2560 + dirb * 128 + jj0 + q) * 1024 + k] = (u16)f2bf(a); } }
    { LAS float* trig = (LAS float*)(L + 126976);
        if (tid < 64) { trig[tid] = cospif((float)tid * (1.f / 32.f)); trig[64 + tid] = sinpif((float)tid * (1.f / 32.f)); }
        __syncthreads();
        for (int e = gt; e < 2 * 256 * 512; e += NGT) { const int l = e >> 17, r = e & 131071, n = r >> 9, kk = r & 511, im = kk >> 8, g = (kk & 255) >> 6, c = kk & 63;
            const float* fw = p.tab[14] + (size_t)l * 65536 + (size_t)(g * 64) * 256 + n; const LAS float* tb = trig + im * 64; float a = 0.f;
#pragma unroll 8
            for (int j2 = 0; j2 < 64; ++j2) a += tb[(j2 * c) & 63] * fw[j2 * 256];
            WfT[(size_t)l * 131072 + n * 512 + kk] = (u16)f2bf(a * 0.125f); } }
    { u16* dft = (u16*)(p.ws + WS_DFT);
        for (int e = gt; e < 4096; e += NGT) { const int k = e >> 6, n = e & 63; const float a = (float)((k * n) & 63) * (1.f / 32.f); dft[e] = (u16)f2bf(cospif(a)); dft[4096 + e] = (u16)f2bf(sinpif(a)); }
        for (int e = gt; e < 16384; e += NGT) { const int k = e >> 7, n = e & 127; const float a = (float)((k * n) & 127) * (1.f / 64.f); dft[8192 + e] = (u16)f2bf(cospif(a)); dft[8192 + 16384 + e] = (u16)f2bf(sinpif(a)); } }
    __syncthreads();
    LAS float* sc = (LAS float*)L;
    for (int e = tid; e < 6144; e += 512) { const int s = e >> 10, k = e & 1023; const float c = s < 4 ? p.tab[2][s * 1024 + k] : p.tab[3][(s - 4) * 1024 + k]; sc[e] = c / (1.f + expf(-c)); }
    __syncthreads();
    for (int unit = gw; unit < 768; unit += NGW) {
        const int ks = unit & 7, jb = (unit >> 3) % 48, l = unit / 384, j = jb * 64 + lane;
        float acc[6] = {0.f, 0.f, 0.f, 0.f, 0.f, 0.f};
        const float* aw = p.tab[4] + (size_t)l * 1024 * 3072 + (size_t)(ks * 128) * 3072 + j;
#pragma unroll 16
        for (int k = 0; k < 128; ++k) { const float w = aw[(size_t)k * 3072];
#pragma unroll
            for (int s = 0; s < 6; ++s) acc[s] += sc[s * 1024 + ks * 128 + k] * w; }
        if (ks == 0) { const float b = p.tab[5][l * 3072 + j];
#pragma unroll
            for (int s = 0; s < 6; ++s) acc[s] += b; }
#pragma unroll
        for (int s = 0; s < 6; ++s) atomicAdd(mod + (size_t)(l * 6 + s) * 3072 + j, acc[s]);
    }
}

DI void add_branch(v4f (&v)[4], const u16* urow, const float* gate, const float* pg, int lane) {
    v4f u[4]; float ss = 0.f;
#pragma unroll
    for (int j = 0; j < 4; ++j) { const v2u r = *(const v2u*)(urow + 256 * j + 4 * lane); u[j] = (v4f){bflo(r.x), bfhi(r.x), bflo(r.y), bfhi(r.y)};
        ss += (u[j].x * u[j].x + u[j].y * u[j].y) + (u[j].z * u[j].z + u[j].w * u[j].w); }
    const float rstd = 1.f / sqrtf(wave_sum(ss) * (1.f / 1024.f) + EPSN);
#pragma unroll
    for (int j = 0; j < 4; ++j) { const v4f g = *(const v4f*)(gate + 256 * j + 4 * lane), q = *(const v4f*)(pg + 256 * j + 4 * lane); v[j] += g * (u[j] * rstd * q); }
}
DI void phaseA(const Ctx& p, int l) {
    const int tid = otid(), lane = tid & 63, wave = tid >> 6, gw = blockIdx.x * 8 + wave, NGW = gridDim.x * 8;
    const float* mod = (const float*)(p.ws + WS_MOD); const u16* U0 = (const u16*)(p.ws + WS_U0); u16* HB = (u16*)(p.ws + WS_HB);
    for (int row = gw; row < T_TOK; row += NGW) {
        const int s = row_seq(row);
        const float* xr = row < 16384 ? p.tab[0] + (size_t)row * 1024 : p.tab[1] + (size_t)(row - 16384) * 1024;
        v4f v[4];
#pragma unroll
        for (int j = 0; j < 4; ++j) v[j] = *(const v4f*)(xr + 256 * j + 4 * lane);
        if (l >= 1) add_branch(v, U0 + (size_t)row * 1024, mod + (size_t)(0 * 6 + s) * 3072 + 2048, p.tab[7], lane);
        if (l == 2) { add_branch(v, HB + (size_t)row * 1024, mod + (size_t)(1 * 6 + s) * 3072 + 2048, p.tab[7] + 1024, lane);
            float* o = p.out + (size_t)row * 1024;
#pragma unroll
            for (int j = 0; j < 4; ++j) *(v4f*)(o + 256 * j + 4 * lane) = v[j];
            continue; }
        float ss = 0.f;
#pragma unroll
        for (int j = 0; j < 4; ++j) ss += (v[j].x * v[j].x + v[j].y * v[j].y) + (v[j].z * v[j].z + v[j].w * v[j].w);
        const float rstd = 1.f / sqrtf(wave_sum(ss) * (1.f / 1024.f) + EPSN);
        const float* md = mod + (size_t)(l * 6 + s) * 3072;
#pragma unroll
        for (int j = 0; j < 4; ++j) { const int col = 256 * j + 4 * lane;
            const v4f sh = *(const v4f*)(md + col), scl = *(const v4f*)(md + 1024 + col), g = *(const v4f*)(p.tab[6] + l * 1024 + col);
            const v4f h = v[j] * rstd * g * (scl + 1.f) + sh;
            v2u o; o.x = pk2(h.x, h.y); o.y = pk2(h.z, h.w); *(v2u*)(HB + (size_t)row * 1024 + col) = o; }
    }
}

DI void qk_prep(const Ctx& p, int l) {
    const int tid = otid(), lane = tid & 63, wave = tid >> 6, gw = blockIdx.x * 8 + wave, NGW = gridDim.x * 8;
    u16* P1 = (u16*)p.out; const int i = lane & 31; unsigned* KC = (unsigned*)(p.ws + WS_HB + HB_KC); unsigned* VC = (unsigned*)(p.ws + WS_HB + HB_VC);
    const float freq = exp2f(-(float)(i & 15) * (13.287712379549449f / 16.f));
    const float gk0 = p.tab[16][l * 64 + 2 * i], gk1 = p.tab[16][l * 64 + 2 * i + 1];
    for (int rowb = gw * 4; rowb < T_TOK; rowb += NGW * 4) {
        unsigned wv[4][2];
#pragma unroll
        for (int r = 0; r < 4; ++r) { const unsigned* ptr = (const unsigned*)(P1 + (size_t)(rowb + r) * P1P + P1_Q);
#pragma unroll
            for (int it = 0; it < 2; ++it) wv[r][it] = ptr[(4 + it) * 64 + lane]; }
#pragma unroll
        for (int r = 0; r < 4; ++r) { const int row = rowb + r;
            const int s = row_seq(row); int row0, N; seq_info(s, row0, N); const int pos = row - row0;
            const float coord = (i < 16) ? (float)(pos >> 6) : (float)(pos & 63);
            const float sn = __sinf(coord * freq), cs = __cosf(coord * freq);
            unsigned* ptr = (unsigned*)(P1 + (size_t)row * P1P + P1_Q);
            const size_t cidx = ((size_t)row0 * 2 + (size_t)(lane >> 5) * N + pos) * 32 + i;
            { const unsigned w = wv[r][0]; const float x0 = bflo(w), x1 = bfhi(w);
                float ss = x0 * x0 + x1 * x1;
#pragma unroll
                for (int o = 1; o < 32; o <<= 1) ss += __shfl_xor(ss, o);
                const float rstd = 1.f / sqrtf(ss * (1.f / 64.f) + EPSN);
                const float y0 = x0 * rstd * gk0, y1 = x1 * rstd * gk1;
                KC[cidx] = pk2(y0 * cs - y1 * sn, y0 * sn + y1 * cs); }
            VC[cidx] = wv[r][1]; }
    }
}
DI void gla_scan_cols(LAS float* Gf, LAS float* Gb, int lane) {
    LAS float* G = (lane >> 5) ? Gb : Gf; const int d = lane & 31; float v[64];
#pragma unroll
    for (int i = 0; i < 64; ++i) v[i] = G[i * 33 + d];
    if (lane >> 5) {
#pragma unroll
        for (int i = 62; i >= 0; --i) v[i] += v[i + 1];
    } else {
#pragma unroll
        for (int i = 1; i < 64; ++i) v[i] += v[i - 1];
    }
#pragma unroll
    for (int i = 0; i < 64; ++i) G[i * 33 + d] = v[i];
}
struct GLoad { v4u g[2], k[2], v[2]; };
DI GLoad gla_local_load(const Ctx& p, int item) {
    const int tid = otid(); const int gc = item >> 1, hp = item & 1; const size_t rb = (size_t)gc * 64; const u16* P2 = (const u16*)(p.ws + WS_P2); GLoad r;
#pragma unroll
    for (int hh = 0; hh < 2; ++hh) { const int h = 2 * hp + hh;
        { const int t2 = tid & 255, i = t2 >> 2, c = t2 & 3; const u16* q = P2 + (rb + i) * P2P + h * 32 + c * 8; const int dirb = tid >> 8;
            r.g[hh] = *(const v4u*)(q + (dirb ? P2_GB : P2_GF)); r.k[hh] = *(const v4u*)(q + P2_AK); }
        { const int i = tid >> 3, c = tid & 7; r.v[hh] = *(const v4u*)(P2 + (rb + i) * P2P + P2_AV + h * 64 + c * 8); } }
    return r;
}
DI void gla_local_item(const Ctx& p, int l, int item, LAS float* F, const GLoad ld) {
    const int tid = otid(), lane = tid & 63, w = tid >> 6; const int gc = item >> 1, hp = item & 1;
    constexpr int HF = 3 * 2112 + (2 * 64 * 40 + 64 * 72) / 2;
#pragma unroll
    for (int hh = 0; hh < 2; ++hh) { const int h = 2 * hp + hh; LAS float* Gf = F + hh * HF; LAS float* Gb = Gf + 2112; LAS float* Kx = Gb + 2112; LAS u16* KDT = (LAS u16*)(Kx + 2112); LAS u16* VT = KDT + 2 * 64 * 40;
        { const int t2 = tid & 255, i = t2 >> 2, c = t2 & 3; float f[8];
            const int dirb = tid >> 8; const float* bias = p.tab[dirb ? 12 : 10] + l * 128 + h * 32 + c * 8; LAS float* G = dirb ? Gb : Gf;
            unpack8(ld.g[hh], f);
#pragma unroll
            for (int q = 0; q < 8; ++q) G[i * 33 + c * 8 + q] = logsig(f[q] + bias[q]) * (1.f / 16.f);
            if (!dirb) { unpack8(ld.k[hh], f);
#pragma unroll
                for (int q = 0; q < 8; ++q) Kx[i * 33 + c * 8 + q] = f[q]; } }
        { const int i = tid >> 3, c = tid & 7; *(LAS v4u*)(VT + i * 72 + c * 8) = ld.v[hh]; } }
    __syncthreads();
    if (w < 2) { LAS float* Gf = F + w * HF; gla_scan_cols(Gf, Gf + 2112, lane); }
    __syncthreads();
    u16* GS = (u16*)(p.ws + WS_HB + HB_GS); float* DEC = (float*)(p.ws + WS_DEC);
#pragma unroll
    for (int hh = 0; hh < 2; ++hh) { const int h = 2 * hp + hh; LAS float* Gf = F + hh * HF; LAS float* Gb = Gf + 2112; LAS float* Kx = Gb + 2112; LAS u16* KDT = (LAS u16*)(Kx + 2112); const size_t slot = (size_t)(gc * 4 + h) * 2;
#pragma unroll
        for (int r = 0; r < 8; ++r) { const int e = tid + r * 512, d = e & 31, i = (e >> 5) & 63, dir = e >> 11; const LAS float* G = dir ? Gb : Gf;
            const float bl = G[(dir ? 0 : 63) * 33 + d];
            KDT[(dir * 64 + i) * 40 + d] = (u16)f2bf(Kx[i * 33 + d] * __expf(bl - G[i * 33 + d])); }
        if (tid < 64) { const int dir = tid >> 5, d = tid & 31; DEC[(slot + dir) * 32 + d] = __expf((dir ? Gb : Gf)[(dir ? 0 : 63) * 33 + d]); } }
    __syncthreads();
#pragma unroll
    for (int hh = 0; hh < 2; ++hh) { const int h = 2 * hp + hh; LAS u16* KDT = (LAS u16*)(F + hh * HF + 3 * 2112); LAS u16* VT = KDT + 2 * 64 * 40; const size_t slot = (size_t)(gc * 4 + h) * 2;
        const int dir = w >> 2, mt = (w >> 1) & 1;
#pragma unroll
        for (int q = 0; q < 2; ++q) { const int nt = (w & 1) * 2 + q; f32x4_t acc = {0.f, 0.f, 0.f, 0.f};
#pragma unroll
            for (int ks = 0; ks < 2; ++ks) acc = MFMA16(ldfrag_tr(KDT + dir * 64 * 40, 40, ks * 32, mt * 16, lane), ldfrag_tr(VT, 72, ks * 32, nt * 16, lane), acc);
#pragma unroll
            for (int j = 0; j < 4; ++j) GS[(slot + dir) * 2048 + (mt * 16 + 4 * (lane >> 4) + j) * 64 + nt * 16 + (lane & 15)] = (u16)f2bf(acc[j]); } }
    __syncthreads();
}
DI void sgu_item(const Ctx& p, int l, int item, LAS float* F, bool stage_w) {
    const int tid = otid(), lane = tid & 63, w = tid >> 6; const int ch = item >> 2, g = item & 3; const size_t rb = (size_t)ch * 128;
    const u16* P2 = (const u16*)(p.ws + WS_P2); u16* P1 = (u16*)p.out;
    LAS float* OUTF = F; LAS u16* WB = (LAS u16*)(F + 128 * 65); LAS u16* VNT = WB + 128 * 136;
    v4u pu[2], pz[2];
#pragma unroll
    for (int r = 0; r < 2; ++r) { const int task = tid + r * 512, t = task >> 3, c8 = (task & 7) * 8; pu[r] = *(const v4u*)(P2 + (rb + t) * P2P + P2_DU + g * 64 + c8); pz[r] = *(const v4u*)(P1 + (rb + t) * P1P + 1024 + g * 64 + c8); }
    { const int row = tid >> 2, qt = tid & 3; const u16* dv = P2 + (rb + row) * P2P + P2_DV; float ss = 0.f; float f[8];
#pragma unroll
        for (int c = 0; c < 8; ++c) { unpack8(*(const v4u*)(dv + qt * 64 + c * 8), f);
#pragma unroll
            for (int q = 0; q < 8; ++q) ss += f[q] * f[q]; }
        ss += __shfl_xor(ss, 1); ss += __shfl_xor(ss, 2);
        const float rstd = 1.f / sqrtf(ss * (1.f / 256.f) + EPSN); const float* ng = p.tab[17] + l * 256 + g * 64 + qt * 16;
#pragma unroll
        for (int c = 0; c < 2; ++c) { unpack8(*(const v4u*)(dv + g * 64 + qt * 16 + c * 8), f);
#pragma unroll
            for (int q = 0; q < 8; ++q) f[q] = f[q] * rstd * ng[c * 8 + q];
            *(LAS v4u*)(VNT + row * 72 + qt * 16 + c * 8) = pack8(f); } }
    if (stage_w) { const float* wsrc = p.tab[18] + (size_t)(l * 4 + g) * 16384;
#pragma unroll
        for (int r = 0; r < 8; ++r) { const int idx = tid + r * 512, t = idx >> 5, s4 = (idx & 31) * 4; const v4f v = *(const v4f*)(wsrc + idx * 4);
            v2u o; o.x = pk2(v.x, v.y); o.y = pk2(v.z, v.w); *(LAS v2u*)(WB + t * 136 + s4) = o; } }
    __syncthreads();
    {
#pragma unroll
        for (int nt = 0; nt < 4; ++nt) { f32x4_t acc = {0.f, 0.f, 0.f, 0.f};
#pragma unroll
            for (int ks = 0; ks < 4; ++ks) acc = MFMA16(ldfrag(WB, 136, w * 16, ks * 32, lane), ldfrag_tr(VNT, 72, ks * 32, nt * 16, lane), acc);
#pragma unroll
            for (int j = 0; j < 4; ++j) OUTF[(w * 16 + 4 * (lane >> 4) + j) * 65 + nt * 16 + (lane & 15)] = acc[j]; } }
    __syncthreads();
#pragma unroll
    for (int r = 0; r < 2; ++r) { const int task = tid + r * 512, t = task >> 3, c8 = (task & 7) * 8; float acc[8];
#pragma unroll
        for (int e = 0; e < 8; ++e) acc[e] = OUTF[t * 65 + c8 + e];
        const float bias = p.tab[19][(l * 4 + g) * 128 + t];
        float uu[8], zz[8]; unpack8(pu[r], uu);
        u16* mz = P1 + (rb + t) * P1P + 1024 + g * 64 + c8; unpack8(pz[r], zz);
#pragma unroll
        for (int e = 0; e < 8; ++e) acc[e] = (acc[e] + bias) * uu[e] * silu_f(zz[e]);
        *(v4u*)mz = pack8(acc); }
    __syncthreads();
}
template <int N1> DI void fnet1_body(const Ctx& p, int row0, int N, int n2, int cb, LAS float* F) {
    constexpr int PN = N1 + 8, MT = N1 / 16, NTW = MT;
    const int tid = otid(), lane = tid & 63, w = tid >> 6;
    const u16* P2 = (const u16*)(p.ws + WS_P2); u16* TP = (u16*)(p.ws + WS_HB + HB_TP);
    const u16* Cg = (const u16*)(p.ws + WS_DFT) + (N1 == 64 ? 0 : 8192); const u16* Sg = Cg + N1 * N1;
    LAS float* tw = F; LAS u16* XT = (LAS u16*)(F + 256); LAS u16* FC = XT + N1 * 136; LAS u16* FS = FC + N1 * PN; LAS u16* OUT = FC;
#pragma unroll
    for (int r = 0; r < N1 / 32; ++r) { const int idx = tid + r * 512, n1 = idx >> 4, c = idx & 15; const v4u raw = *(const v4u*)(P2 + (size_t)(row0 + n1 * 64 + n2) * P2P + P2_BU + cb * 128 + c * 8);
        *(LAS v4u*)(XT + n1 * 136 + c * 8) = raw; }
#pragma unroll
    for (int r = 0; r < N1 * N1 / 8 / 512; ++r) { const int idx = tid + r * 512, k1 = idx / (N1 / 8), c = idx % (N1 / 8);
        *(LAS v4u*)(FC + k1 * PN + c * 8) = *(const v4u*)(Cg + k1 * N1 + c * 8); *(LAS v4u*)(FS + k1 * PN + c * 8) = *(const v4u*)(Sg + k1 * N1 + c * 8); }
    if (tid < N1) { const float ph = 2.f * (float)((n2 * tid) & (N - 1)) / (float)N; tw[2 * tid] = cospif(ph); tw[2 * tid + 1] = sinpif(ph); }
    __syncthreads();
    f32x4_t ac[NTW], as[NTW];
#pragma unroll
    for (int q = 0; q < NTW; ++q) { const int id = w + 8 * q, mt = id % MT, nt = id / MT; ac[q] = (f32x4_t){0.f, 0.f, 0.f, 0.f}; as[q] = ac[q];
#pragma unroll
        for (int ks = 0; ks < N1 / 32; ++ks) { const bf16x8_t b = ldfrag_tr(XT, 136, ks * 32, nt * 16, lane);
            ac[q] = MFMA16(ldfrag(FC, PN, mt * 16, ks * 32, lane), b, ac[q]); as[q] = MFMA16(ldfrag(FS, PN, mt * 16, ks * 32, lane), b, as[q]); } }
    __syncthreads();
    const float scale = 1.f / sqrtf((float)N1);
#pragma unroll
    for (int q = 0; q < NTW; ++q) { const int id = w + 8 * q, mt = id % MT, nt = id / MT;
#pragma unroll
        for (int j = 0; j < 4; ++j) { const int k1 = mt * 16 + 4 * (lane >> 4) + j, col = nt * 16 + (lane & 15); const float cw = tw[2 * k1], sw = tw[2 * k1 + 1];
            const float tr = ac[q][j], ti = -as[q][j];
            OUT[k1 * 256 + col] = (u16)f2bf((tr * cw + ti * sw) * scale); OUT[k1 * 256 + 128 + col] = (u16)f2bf((ti * cw - tr * sw) * scale); } }
    __syncthreads();
#pragma unroll
    for (int r = 0; r < N1 / 16; ++r) { const int idx = tid + r * 512, k1 = idx >> 5, c = idx & 31;
        const v4u v = *(const LAS v4u*)(OUT + k1 * 256 + c * 8);
        *(v4u*)(TP + (size_t)(row0 + k1 * 64 + n2) * 512 + (c >> 4) * 256 + cb * 128 + (c & 15) * 8) = v; }
    __syncthreads();
}
DI void fnet1_item(const Ctx& p, int item, LAS float* F) {
    const int s = item >> 7, r = item & 127, n2 = r >> 1, cb = r & 1; int row0, N; seq_info(s, row0, N);
    if (N == 4096) fnet1_body<64>(p, row0, N, n2, cb, F); else fnet1_body<128>(p, row0, N, n2, cb, F);
}
struct F2Load { v4u t[8]; };
DI F2Load fnet2_load(const Ctx& p, int item) {
    const int tid = otid(); int s, k1; if (item < 256) { s = item >> 6; k1 = item & 63; } else { s = 4 + ((item - 256) >> 7); k1 = (item - 256) & 127; }
    int row0, N; seq_info(s, row0, N); const u16* TP = (const u16*)(p.ws + WS_HB + HB_TP); F2Load r;
#pragma unroll
    for (int q = 0; q < 8; ++q) { const int idx = tid + q * 512, n2 = idx >> 6, c = idx & 63; r.t[q] = *(const v4u*)(TP + (size_t)(row0 + k1 * 64 + n2) * 512 + c * 8); }
    return r;
}
DI void fnet2_item(const Ctx& p, int item, LAS float* F, const F2Load ld) {
    const int tid = otid(), lane = tid & 63, w = tid >> 6; int s, k1; if (item < 256) { s = item >> 6; k1 = item & 63; } else { s = 4 + ((item - 256) >> 7); k1 = (item - 256) & 127; }
    int row0, N; seq_info(s, row0, N); const int N1 = N >> 6;
    u16* P2 = (u16*)(p.ws + WS_P2); const u16* TP = (const u16*)(p.ws + WS_HB + HB_TP); const u16* Cg = (const u16*)(p.ws + WS_DFT); const u16* Sg = Cg + 4096;
    LAS u16* BT = (LAS u16*)F; LAS u16* A1 = BT + 128 * 264; LAS u16* A2 = A1 + 64 * 136; LAS u16* OUT = BT;
#pragma unroll
    for (int r = 0; r < 8; ++r) { const int idx = tid + r * 512, n2 = idx >> 6, c = idx & 63; *(LAS v4u*)(BT + ((c >> 5) * 64 + n2) * 264 + (c & 31) * 8) = ld.t[r]; }
    { const int k2 = tid >> 3, c8 = (tid & 7) * 8; const v4u c = *(const v4u*)(Cg + k2 * 64 + c8), sv = *(const v4u*)(Sg + k2 * 64 + c8); const v4u ns = sv ^ (v4u){0x80008000u, 0x80008000u, 0x80008000u, 0x80008000u};
        *(LAS v4u*)(A1 + k2 * 136 + c8) = c; *(LAS v4u*)(A1 + k2 * 136 + 64 + c8) = sv; *(LAS v4u*)(A2 + k2 * 136 + c8) = ns; *(LAS v4u*)(A2 + k2 * 136 + 64 + c8) = c; }
    __syncthreads();
    f32x4_t acc[16]; const LAS u16* Aw = (w < 4) ? A1 : A2; const int mt = w & 3;
#pragma unroll
    for (int nt = 0; nt < 16; ++nt) { acc[nt] = (f32x4_t){0.f, 0.f, 0.f, 0.f};
#pragma unroll
        for (int ks = 0; ks < 4; ++ks) acc[nt] = MFMA16(ldfrag(Aw, 136, mt * 16, ks * 32, lane), ldfrag_tr(BT, 264, ks * 32, nt * 16, lane), acc[nt]); }
    __syncthreads();
#pragma unroll
    for (int nt = 0; nt < 16; ++nt)
#pragma unroll
        for (int j = 0; j < 4; ++j) OUT[(mt * 16 + 4 * (lane >> 4) + j) * 512 + (w >> 2) * 256 + nt * 16 + (lane & 15)] = (u16)f2bf(acc[nt][j] * 0.125f);
    __syncthreads();
#pragma unroll
    for (int r = 0; r < 8; ++r) { const int idx = tid + r * 512, k2 = idx >> 6, c = idx & 63; const v4u v = *(const LAS v4u*)(OUT + k2 * 512 + c * 8);
        *(v4u*)(P2 + (size_t)(row0 + k1 + N1 * k2) * P2P + P2_U + c * 8) = v; }
    __syncthreads();
}
DI void gla_scan_item(const Ctx& p, int item) {
    const int tid = otid(); const int chain = item >> 2, e = (item & 3) * 512 + tid; const int s = chain >> 3, h = (chain >> 1) & 3, dir = chain & 1;
    int row0, N; seq_info(s, row0, N); const int NC = N >> 6, gc0 = row0 >> 6, d = e >> 6;
    u16* GS = (u16*)(p.ws + WS_HB + HB_GS); const float* DEC = (const float*)(p.ws + WS_DEC);
    float S = 0.f;
    for (int st = 0; st < NC; st += 32) { u16 tmp[32]; float dc[32];
#pragma unroll
        for (int u = 0; u < 32; ++u) { const int c = dir ? NC - 1 - (st + u) : st + u; const size_t slot = (size_t)((gc0 + c) * 4 + h) * 2 + dir; tmp[u] = GS[slot * 2048 + e]; dc[u] = DEC[slot * 32 + d]; }
#pragma unroll
        for (int u = 0; u < 32; ++u) { const int c = dir ? NC - 1 - (st + u) : st + u; const size_t slot = (size_t)((gc0 + c) * 4 + h) * 2 + dir; GS[slot * 2048 + e] = (u16)f2bf(S); S = dc[u] * S + bf2f(tmp[u]); } }
}
struct OLoad { v4u qk, g, v, z; v2u sf, sb; };
DI OLoad gla_out_load(const Ctx& p, int item) {
    const int tid = otid(); const int gc = item >> 2, h = item & 3; const size_t rb = (size_t)gc * 64; const u16* P2 = (const u16*)(p.ws + WS_P2); const u16* P1 = (const u16*)p.out; OLoad r;
    { const int t2 = tid & 255, i = t2 >> 2, c = t2 & 3; const u16* q = P2 + (rb + i) * P2P + h * 32 + c * 8; const int dirb = tid >> 8;
        r.qk = *(const v4u*)(q + (dirb ? P2_AK : P2_AQ)); r.g = *(const v4u*)(q + (dirb ? P2_GB : P2_GF)); }
    { const int i = tid >> 3, c = tid & 7; r.v = *(const v4u*)(P2 + (rb + i) * P2P + P2_AV + h * 64 + c * 8); r.z = *(const v4u*)(P1 + (rb + i) * P1P + h * 64 + c * 8); }
    { const u16* GS = (const u16*)(p.ws + WS_HB + HB_GS); const size_t slot = (size_t)(gc * 4 + h) * 2; const int e4 = tid * 4; r.sf = *(const v2u*)(GS + slot * 2048 + e4); r.sb = *(const v2u*)(GS + (slot + 1) * 2048 + e4); }
    return r;
}
DI void gla_out_item(const Ctx& p, int l, int item, LAS float* F, const OLoad ld) {
    const int tid = otid(), lane = tid & 63, w = tid >> 6; const int gc = item >> 2, h = item & 3; const size_t rb = (size_t)gc * 64;
    const u16* P2 = (const u16*)(p.ws + WS_P2); u16* P1 = (u16*)p.out;
    LAS float* Gf = F; LAS float* Gb = Gf + 2112; LAS float* Qx = Gb + 2112; LAS float* Kx = Qx + 2112; LAS float* O = Kx + 2112;
    LAS u16* QF = (LAS u16*)(O + 64 * 65); LAS u16* KF = QF + 64 * 40; LAS u16* QB = KF + 64 * 40; LAS u16* KB = QB + 64 * 40;
    LAS u16* VT = KB + 64 * 40; LAS u16* SC = VT + 64 * 72; LAS u16* SFT = SC + 64 * 72; LAS u16* SBT = SFT + 32 * 72;
    const u16* GS = (const u16*)(p.ws + WS_HB + HB_GS); const size_t slot = (size_t)(gc * 4 + h) * 2;
    { const int t2 = tid & 255, i = t2 >> 2, c = t2 & 3; const u16* r = P2 + (rb + i) * P2P + h * 32 + c * 8; float f[8];
        const int dirb = tid >> 8; LAS float* d0 = dirb ? Kx : Qx; LAS float* d1 = dirb ? Gb : Gf; const float* bias = p.tab[dirb ? 12 : 10] + l * 128 + h * 32 + c * 8;
        unpack8(ld.qk, f);
#pragma unroll
        for (int q = 0; q < 8; ++q) d0[i * 33 + c * 8 + q] = f[q];
        unpack8(ld.g, f);
#pragma unroll
        for (int q = 0; q < 8; ++q) d1[i * 33 + c * 8 + q] = logsig(f[q] + bias[q]) * (1.f / 16.f); }
    { const int i = tid >> 3, c = tid & 7; *(LAS v4u*)(VT + i * 72 + c * 8) = ld.v; }
    { const int e4 = tid * 4, d = e4 >> 6, v = e4 & 63; *(LAS v2u*)(SFT + d * 72 + v) = ld.sf; *(LAS v2u*)(SBT + d * 72 + v) = ld.sb; }
    __syncthreads();
    if (w == 0) gla_scan_cols(Gf, Gb, lane);
    __syncthreads();
#pragma unroll
    for (int r = 0; r < 4; ++r) { const int e = tid + r * 512, d = e & 31, i = e >> 5, a = i * 33 + d; const float q = Qx[a] * 0.17677669529663687f, k = Kx[a], bf = Gf[a], bb = Gb[a];
        QF[i * 40 + d] = (u16)f2bf(q * __expf(bf)); KF[i * 40 + d] = (u16)f2bf(k * __expf(-bf)); QB[i * 40 + d] = (u16)f2bf(q * __expf(bb)); KB[i * 40 + d] = (u16)f2bf(k * __expf(-bb)); }
    __syncthreads();
#pragma unroll
    for (int q = 0; q < 2; ++q) { const int id = 2 * w + q, ti = id >> 2, si = id & 3; const f32x4_t z4 = {0.f, 0.f, 0.f, 0.f}; f32x4_t acc;
        if (si < ti) acc = MFMA16(ldfrag(QF, 40, ti * 16, 0, lane), ldfrag(KF, 40, si * 16, 0, lane), z4);
        else if (si > ti) acc = MFMA16(ldfrag(QB, 40, ti * 16, 0, lane), ldfrag(KB, 40, si * 16, 0, lane), z4);
        else { const f32x4_t af = MFMA16(ldfrag(QF, 40, ti * 16, 0, lane), ldfrag(KF, 40, si * 16, 0, lane), z4), ab = MFMA16(ldfrag(QB, 40, ti * 16, 0, lane), ldfrag(KB, 40, si * 16, 0, lane), z4);
#pragma unroll
            for (int j = 0; j < 4; ++j) acc[j] = ((lane & 15) <= 4 * (lane >> 4) + j) ? af[j] : ab[j]; }
#pragma unroll
        for (int j = 0; j < 4; ++j) SC[(ti * 16 + 4 * (lane >> 4) + j) * 72 + si * 16 + (lane & 15)] = (u16)f2bf(acc[j]); }
    __syncthreads();
#pragma unroll
    for (int q = 0; q < 2; ++q) { const int id = 2 * w + q, ti = id >> 2, vi = id & 3; f32x4_t acc = {0.f, 0.f, 0.f, 0.f};
        acc = MFMA16(ldfrag(SC, 72, ti * 16, 0, lane), ldfrag_tr(VT, 72, 0, vi * 16, lane), acc);
        acc = MFMA16(ldfrag(SC, 72, ti * 16, 32, lane), ldfrag_tr(VT, 72, 32, vi * 16, lane), acc);
        acc = MFMA16(ldfrag(QF, 40, ti * 16, 0, lane), ldfrag_tr(SFT, 72, 0, vi * 16, lane), acc);
        acc = MFMA16(ldfrag(QB, 40, ti * 16, 0, lane), ldfrag_tr(SBT, 72, 0, vi * 16, lane), acc);
#pragma unroll
        for (int j = 0; j < 4; ++j) O[(ti * 16 + 4 * (lane >> 4) + j) * 65 + vi * 16 + (lane & 15)] = acc[j]; }
    __syncthreads();
    { const int t = tid >> 3, v8 = (tid & 7) * 8; float acc[8]; float ss = 0.f;
#pragma unroll
        for (int e = 0; e < 8; ++e) { acc[e] = O[t * 65 + v8 + e]; ss += acc[e] * acc[e]; }
        ss += __shfl_xor(ss, 1); ss += __shfl_xor(ss, 2); ss += __shfl_xor(ss, 4);
        const float rstd = 1.f / sqrtf(ss * (1.f / 64.f) + EPSN);
        u16* mz = P1 + (rb + t) * P1P + h * 64 + v8; float zz[8]; unpack8(ld.z, zz);
#pragma unroll
        for (int e = 0; e < 8; ++e) acc[e] = acc[e] * rstd * p.tab[13][l * 64 + v8 + e] * silu_f(zz[e]);
        *(v4u*)mz = pack8(acc); }
    __syncthreads();
}
#define XB_TMO      128
#define XB_XCNT(j)  (256  + 64 * (j))
#define XB_XSUB(j)  (1280 + 64 * (j))
#define XB_XGEN(j)  (2304 + 64 * (j))
#define XB_TOP      3328
#define XB_TOPGEN   3392
#define XCD_BAR_WORDS 3456
#define XB_SPIN_CAP (1u << 18)

__device__ __forceinline__ unsigned xb_ld(unsigned* p)              { return __hip_atomic_load(p, __ATOMIC_RELAXED, __HIP_MEMORY_SCOPE_AGENT); }
__device__ __forceinline__ unsigned xb_add(unsigned* p, unsigned v) { return __hip_atomic_fetch_add(p, v, __ATOMIC_RELAXED, __HIP_MEMORY_SCOPE_AGENT); }
__device__ __forceinline__ unsigned xb_xcc_id() { return (unsigned)__builtin_amdgcn_s_getreg((3 << 11) | 20) & 0xFu; }
#define XB_SPIN(cond, bar) do { unsigned _sp = 0; while (cond) { __builtin_amdgcn_s_sleep(1); \
    if ((++_sp & 255u) == 0u) { if (xb_ld(&(bar)[XB_TMO])) break; if (_sp > XB_SPIN_CAP) { atomicAdd(&(bar)[XB_TMO], 1u); break; } } } } while (0)

struct XcdBarrier {
    unsigned* bar; unsigned x;
    volatile LAS unsigned* st;
};

__device__ __forceinline__ XcdBarrier xcd_barrier_post(unsigned* bar, volatile LAS unsigned* st) {
    XcdBarrier b; b.bar = bar; b.x = xb_xcc_id(); b.st = st;
    if (threadIdx.x == 0) (void)xb_add(&bar[XB_XCNT(b.x)], 1u);
    return b;
}
__device__ __forceinline__ void xcd_barrier_complete(unsigned* bar, unsigned x, unsigned& nloc, unsigned& nx) {
    const unsigned G = gridDim.x * gridDim.y * gridDim.z;
    unsigned sum, cnt, mine, sp = 0u;
    for (;;) {
        sum = 0u; cnt = 0u; mine = 0u;
#pragma unroll
        for (unsigned j = 0; j < 16; ++j) { const unsigned c = xb_ld(&bar[XB_XCNT(j)]); sum += c; cnt += (c > 0u) ? 1u : 0u; mine = (j == x) ? c : mine; }
        if (sum == G) break;
        __builtin_amdgcn_s_sleep(1);
        if ((++sp & 255u) == 0u) { if (xb_ld(&bar[XB_TMO])) break; if (sp > XB_SPIN_CAP) { atomicAdd(&bar[XB_TMO], 1u); break; } }
    }
    nloc = mine > 0u ? mine : 1u; nx = cnt > 0u ? cnt : 1u;
}

__device__ __forceinline__ void xcd_barrier(const XcdBarrier& b) {
    asm volatile("s_waitcnt vmcnt(0)" ::: "memory");
    __syncthreads();
    if (threadIdx.x == 0) {
        unsigned* bar = b.bar;
        __builtin_amdgcn_s_waitcnt(0);
        unsigned nloc = b.st[0], nx = b.st[1];
        if (nloc == 0u) { xcd_barrier_complete(bar, b.x, nloc, nx); b.st[0] = nloc; b.st[1] = nx; }
        const unsigned old = xb_add(&bar[XB_XSUB(b.x)], 1u);
        const unsigned gen = old / nloc;
        if (old + 1u == (gen + 1u) * nloc) {
            __builtin_amdgcn_fence(__ATOMIC_RELEASE, "agent");
            asm volatile("s_waitcnt vmcnt(0)" ::: "memory");
            const unsigned og = xb_add(&bar[XB_TOP], 1u);
            const unsigned tg = og / nx;
            if (og + 1u == (tg + 1u) * nx) xb_add(&bar[XB_TOPGEN], 1u);
            else XB_SPIN(xb_ld(&bar[XB_TOPGEN]) == tg, bar);
            __builtin_amdgcn_fence(__ATOMIC_ACQUIRE, "agent");
            xb_add(&bar[XB_XGEN(b.x)], 1u);
            asm volatile("s_waitcnt vmcnt(0)" ::: "memory");
        } else {
            XB_SPIN(xb_ld(&bar[XB_XGEN(b.x)]) == gen, bar);
            __builtin_amdgcn_fence(__ATOMIC_ACQUIRE, "agent");
            asm volatile("s_waitcnt vmcnt(0)" ::: "memory");
        }
    }
    __syncthreads();
}


#ifndef GM
#define GM 7
#endif
#ifndef PH
#define PH 1023
#endif
__global__ void __launch_bounds__(512, 2) fwd_kernel(Params kp) {
    extern __shared__ __attribute__((aligned(16))) unsigned char lds[];
    cg::grid_group grid = cg::this_grid();
    LAS unsigned char* L = (LAS unsigned char*)lds; LAS float* F = (LAS float*)lds;
    const int G = gridDim.x, bid = blockIdx.x;
    Ctx p; p.out = kp.out; p.ws = kp.ws; p.tab = (LAS cfp*)(L + 131072);
    if (otid() == 0) { p.tab[0] = kp.xp; p.tab[1] = kp.xs; p.tab[2] = kp.cp; p.tab[3] = kp.cs; p.tab[4] = kp.ada_w; p.tab[5] = kp.ada_b; p.tab[6] = kp.pre_g; p.tab[7] = kp.post_g; p.tab[8] = kp.w_in;
        p.tab[9] = kp.wg2f; p.tab[10] = kp.bgf; p.tab[11] = kp.wg2b; p.tab[12] = kp.bgb; p.tab[13] = kp.onorm_g; p.tab[14] = kp.fnet_w; p.tab[15] = kp.qn_g; p.tab[16] = kp.kn_g; p.tab[17] = kp.sgu_ng;
        p.tab[18] = kp.sgu_w; p.tab[19] = kp.sgu_b; p.tab[20] = kp.w_out; }
    volatile LAS unsigned* bst = (volatile LAS unsigned*)(L + 131072 + 256);
    if (otid() < 4) bst[otid()] = 0u;
    __syncthreads();
    const XcdBarrier xbar = xcd_barrier_post((unsigned*)(p.ws + WS_BAR), bst);
    u16* P1 = (u16*)p.out; u16* P2 = (u16*)(p.ws + WS_P2); u16* HB = (u16*)(p.ws + WS_HB); u16* U0 = (u16*)(p.ws + WS_U0);


#if PH & 1
    phase0(p, L);
#endif
    if (kp.ws == nullptr) grid.sync();
    xcd_barrier(xbar);
    for (int step = 0; step < 12; ++step) {
        const int l = step / 6, ph = step % 6;
        bool do_gemm = false; pg8::Gemm g{nullptr, nullptr, T_TOK, 0, 0, 0, 0}; pg8::EpiX E{0, nullptr, 0, nullptr, 0, 0};
        if (ph == 0) {
#if PH & 2
            phaseA(p, l);
#endif
        } else if (ph == 1) {
            g.A = HB; g.Bt = (const u16*)(p.ws + WS_WIN) + (size_t)l * 3584 * 1024; g.N = 3584; g.K = 1024; g.lda = 1024; g.ldb = 1024;
            E.mode = 0; E.O1 = P1; E.ld1 = P1P; E.O2 = P2; E.ld2 = P2P; do_gemm = true;
        } else if (ph == 2) {
#if PH & 4
            qk_prep(p, l);
#endif
#if PH & 8
            { GLoad nx = gla_local_load(p, bid < 1024 ? bid : 0); for (int it = bid; it < 1024; it += G) { const GLoad cur = nx; if (it + G < 1024) nx = gla_local_load(p, it + G); gla_local_item(p, l, it, F, cur); } }
#endif
#if PH & 16
            for (int it = bid; it < 1024; it += G) sgu_item(p, l, it, F, (it == bid) || (G & 3) != 0);
#endif
#if PH & 32
            for (int it = bid; it < 768; it += G) fnet1_item(p, it, F);
#endif
        } else if (ph == 3) {
#if PH & 64
            for (int it = bid; it < 192; it += G) gla_scan_item(p, it);
#endif
#if PH & 128
            { F2Load nx = fnet2_load(p, bid < 512 ? bid : 0); for (int it = bid; it < 512; it += G) { const F2Load cur = nx; if (it + G < 512) nx = fnet2_load(p, it + G); fnet2_item(p, it, F, cur); } }
#endif
            __syncthreads();
#ifndef SKIP_ATTN
            for (int u = ((G & 7) == 0 ? (bid & 7) * (G >> 3) + (bid >> 3) : bid); u < 1024; u += G) {
                int s, h, qb;
                if (u < 512) { s = u >> 7; const int r = u & 127; h = r >> 4; qb = r & 15; } else { const int u2 = u - 512; s = 4 + (u2 >> 8); const int r = u2 & 255; h = r >> 5; qb = r & 31; }
                int row0, N; seq_info(s, row0, N);
                const attn_body::bf16* Pb = (const attn_body::bf16*)P1;
                const attn_body::bf16* KCb = (const attn_body::bf16*)(p.ws + WS_HB + HB_KC) + ((size_t)row0 * 2 + (size_t)(h >> 2) * N) * 64;
                const attn_body::bf16* VCb = (const attn_body::bf16*)(p.ws + WS_HB + HB_VC) + ((size_t)row0 * 2 + (size_t)(h >> 2) * N) * 64;
                attn_body::attn_unit<8>(Pb + (size_t)(row0 + qb * 256) * P1P + P1_Q + h * 64, KCb, VCb,
                                        (attn_body::bf16*)P1 + (size_t)(row0 + qb * 256) * P1P + 512 + h * 64, N >> 6, (char*)lds, qb * 256, p.tab[15] + l * 64);
            }
#endif
        } else if (ph == 4) {
#if PH & 256
            if (G == 256) { const int i0 = bid < 128 ? bid * 7 : 896 + (bid - 128) * 9, i1 = i0 + (bid < 128 ? 7 : 9);
                OLoad nx = gla_out_load(p, i0); for (int it = i0; it < i1; ++it) { const OLoad cur = nx; if (it + 1 < i1) nx = gla_out_load(p, it + 1); gla_out_item(p, l, it, F, cur); } }
            else { OLoad nx = gla_out_load(p, bid < 2048 ? bid : 0); for (int it = bid; it < 2048; it += G) { const OLoad cur = nx; if (it + G < 2048) nx = gla_out_load(p, it + G); gla_out_item(p, l, it, F, cur); } }
#endif
            g.A = P2 + P2_U; g.Bt = (const u16*)(p.ws + WS_WF) + (size_t)l * 131072; g.N = 256; g.K = 512; g.lda = P2P; g.ldb = 512;
            E.mode = 2; E.O1 = P1; E.ld1 = P1P; E.col_off = 256; do_gemm = true;
        } else {
            g.A = P1; g.Bt = (const u16*)(p.ws + WS_WOUT) + (size_t)l * 1024 * 1280; g.N = 1024; g.K = 1280; g.lda = P1P; g.ldb = 1280;
            E.mode = 1; E.O1 = (l == 0) ? U0 : HB; E.ld1 = 1024; do_gemm = true;
        }
#if GM
        if (do_gemm) { pg8::StaticOrder S; S.init(T_TOK, g.N, G, bid); pg8::gemm_phase<pg8::EpiX, pg8::StaticOrder, PG8_ALIGN, PG8_SP2>(L, g, S, E); }
#endif
        xcd_barrier(xbar);
    }
#if PH & 2
    phaseA(p, 2);
#endif
}

extern "C" void kernel_launch(void* const* d_in, const int* in_sizes, int n_in, void* d_out, int out_size, void* d_ws, size_t ws_size, hipStream_t stream) {
    static int grid = 0;
    if (grid == 0) {
        if (n_in != 21 || out_size != T_TOK * 1024 || ws_size < WS_END) { fprintf(stderr, "kernel_launch: unexpected sizes n_in %d out %d ws %zu\n", n_in, out_size, ws_size); grid = -1; return; }
        int dev = 0, cus = 0, per_cu = 0;
        (void)hipGetDevice(&dev); (void)hipDeviceGetAttribute(&cus, hipDeviceAttributeMultiprocessorCount, dev);
        if (hipFuncSetAttribute((const void*)fwd_kernel, hipFuncAttributeMaxDynamicSharedMemorySize, LDS_BYTES) != hipSuccess) { fprintf(stderr, "kernel_launch: hipFuncSetAttribute failed\n"); grid = -1; return; }
        if (hipOccupancyMaxActiveBlocksPerMultiprocessor(&per_cu, (const void*)fwd_kernel, 512, LDS_BYTES) != hipSuccess || per_cu < 1) { fprintf(stderr, "kernel_launch: occupancy query gave %d\n", per_cu); per_cu = 1; }
        (void)hipGetLastError();
        grid = cus * 1;
        fprintf(stderr, "kernel_launch: grid %d (per_cu %d) ws %zu\n", grid, per_cu, ws_size);
    }
    if (grid < 0) return;
    Params p{};
    const float** pp = (const float**)&p;
    for (int i = 0; i < 21; ++i) pp[i] = (const float*)d_in[i];
    p.out = (float*)d_out; p.ws = (unsigned char*)d_ws;
    if (hipMemsetAsync((char*)d_ws + WS_MOD, 0, 2 * 6 * 3072 * sizeof(float), stream) != hipSuccess) { fprintf(stderr, "kernel_launch: memset failed\n"); return; }
    if (hipMemsetAsync((char*)d_ws + WS_BAR, 0, BAR_BYTES, stream) != hipSuccess) { fprintf(stderr, "kernel_launch: memset failed\n"); return; }
    void* args[] = {&p};
    hipError_t e = hipLaunchCooperativeKernel((const void*)fwd_kernel, dim3(grid), dim3(512), args, LDS_BYTES, stream);
    if (e != hipSuccess) fprintf(stderr, "cooperative launch failed: %s (grid %d)\n", hipGetErrorString(e), grid);
}
```
